# Optimizing an MI355X kernel written in HIP

```python
import math
import jax
import jax.numpy as jnp
from jax import lax
import numpy as np

D_MODEL = 1024
BATCH = 16
SEQ = 4096
DEPTH = 1

CTX_LEN = 256
GRID_W = 64
MIX_W = D_MODEL
HEAD_DIM = 64
ATT_W = MIX_W // 2
HYENA_W = MIX_W - ATT_W
N_HEADS = ATT_W // HEAD_DIM
N_KV_HEADS = 2
GQA_GROUP = N_HEADS // N_KV_HEADS
KV_W = N_KV_HEADS * HEAD_DIM
ATT_SCALE = HEAD_DIM ** -0.5
WINDOW = 128
Q_BLOCK = 128
NEG_INF = -1e30
ROPE_THETA = 10000.0
ROPE_PAIRS = HEAD_DIM // 4
HYENA_ORDER = 2
HYENA_PROJ_W = (HYENA_ORDER + 1) * HYENA_W
HYENA_BANDS = 16
HYENA_EMB = 2 * HYENA_BANDS + 1
HYENA_FILTER_HIDDEN = 64
SHORT_CONV = 3
DECAY_TARGET = 1e-2
FAST_DECAY_PCT = 0.3
SLOW_DECAY_PCT = 1.5
K_OFF = ATT_W
V_OFF = ATT_W + KV_W
HY_OFF = ATT_W + 2 * KV_W
PROJ_W = HY_OFF + HYENA_PROJ_W
N_GROUPS = 4
EXPERTS_PER_GROUP = 8
N_EXPERTS = N_GROUPS * EXPERTS_PER_GROUP
EXPERT_HIDDEN = D_MODEL // 2
TOP_K = 2
MOE_BLOCK = 128
EPS = 1e-6

kernel_name = 'hymba_swa_hyena_hmoe_dit_block'


def rms_norm(x, w):
    xf = x.astype(jnp.float32)
    y = xf * lax.rsqrt(jnp.mean(xf * xf, axis=-1, keepdims=True) + EPS)
    return y.astype(x.dtype) * w


def modulate(h, shift, scale):
    return h * (1.0 + scale) + shift


def split_heads(t, n_heads):
    return t.reshape(t.shape[:-1] + (n_heads, HEAD_DIM))


def rotate_pairs(x, ang):
    m = x.shape[-1] // 2
    cos = jnp.cos(ang).astype(x.dtype)
    sin = jnp.sin(ang).astype(x.dtype)
    x1, x2 = x[..., :m], x[..., m:]
    return jnp.concatenate([x1 * cos - x2 * sin, x2 * cos + x1 * sin], axis=-1)


def rope_2d(x, ang_r, ang_c):
    half = HEAD_DIM // 2
    return jnp.concatenate([rotate_pairs(x[..., :half], ang_r), rotate_pairs(x[..., half:], ang_c)], axis=-1)


def short_conv(u, w, b):
    seq_len = u.shape[1]
    half = SHORT_CONV // 2
    up = jnp.pad(u, ((0, 0), (half, half), (0, 0)))
    out = b
    for j in range(SHORT_CONV):
        out = out + up[:, j:j + seq_len] * w[j]
    return out


def implicit_filter_spectrum(seq_len, w1, b1, w2, b2, w3, sin_freq):
    pos = jnp.arange(seq_len, dtype=jnp.float32)
    t = pos / seq_len
    bands = jnp.linspace(1e-4, HYENA_BANDS - 1, HYENA_BANDS, dtype=jnp.float32)
    ang = (2.0 * math.pi / seq_len) * pos[:, None] * bands[None, :]
    feat = jnp.concatenate([t[:, None], jnp.cos(ang), -jnp.sin(ang)], axis=-1).astype(w1.dtype)
    h = jnp.sin(sin_freq[0] * (feat @ w1 + b1))
    h = jnp.sin(sin_freq[1] * (h @ w2 + b2))
    h = (h @ w3).astype(jnp.float32).reshape(seq_len, HYENA_ORDER, 2, HYENA_W)
    max_decay = math.log(DECAY_TARGET) / FAST_DECAY_PCT
    min_decay = math.log(DECAY_TARGET) / SLOW_DECAY_PCT
    deltas = jnp.abs(jnp.linspace(min_decay, max_decay, HYENA_W, dtype=jnp.float32))
    h = h * jnp.exp(-t[:, None] * deltas[None, :])[:, None, None, :]
    fwd, bwd = h[:, :, 0], h[:, :, 1]
    kern = jnp.concatenate([fwd, jnp.zeros((1, HYENA_ORDER, HYENA_W), jnp.float32), bwd[1:][::-1]], axis=0)
    return jnp.fft.rfft(kern, axis=0)


def hyena_mixer(u, conv_w, conv_b, w1, b1, w2, b2, w3, sin_freq, skip):
    seq_len = u.shape[1]
    parts = jnp.split(short_conv(u, conv_w, conv_b), HYENA_ORDER + 1, axis=-1)
    spec = implicit_filter_spectrum(seq_len, w1, b1, w2, b2, w3, sin_freq)
    z = parts[0].astype(jnp.float32)
    for o in range(HYENA_ORDER):
        zf = jnp.fft.rfft(z, n=2 * seq_len, axis=1)
        conv = jnp.fft.irfft(zf * spec[None, :, o], n=2 * seq_len, axis=1)[:, :seq_len]
        z = parts[o + 1].astype(jnp.float32) * (conv + skip[o].astype(jnp.float32) * z)
    return z.astype(u.dtype)


def windowed_attention(q, k, v, kc, vc, sink):
    bsz, seq_len = q.shape[:2]
    n_blocks = seq_len // Q_BLOCK
    band = Q_BLOCK + 2 * WINDOW
    pad = ((0, 0), (WINDOW, WINDOW), (0, 0), (0, 0))
    k_pad = jnp.pad(k, pad)
    v_pad = jnp.pad(v, pad)
    qg = q.reshape(bsz, seq_len, N_KV_HEADS, GQA_GROUP, HEAD_DIM)
    n_ctx = kc.shape[1]
    s_sink = jnp.broadcast_to(sink.reshape(N_KV_HEADS, GQA_GROUP, 1, 1).astype(jnp.float32),
                              (bsz, N_KV_HEADS, GQA_GROUP, Q_BLOCK, 1))

    def block(i):
        q0 = i * Q_BLOCK
        qb = lax.dynamic_slice_in_dim(qg, q0, Q_BLOCK, axis=1)
        kb = lax.dynamic_slice_in_dim(k_pad, q0, band, axis=1)
        vb = lax.dynamic_slice_in_dim(v_pad, q0, band, axis=1)
        q_pos = q0 + jnp.arange(Q_BLOCK)
        k_pos = q0 - WINDOW + jnp.arange(band)
        valid = ((jnp.abs(k_pos[None, :] - q_pos[:, None]) <= WINDOW)
                 & (k_pos[None, :] >= 0) & (k_pos[None, :] < seq_len))
        s_band = jnp.einsum('bqkgd,bskd->bkgqs', qb, kb).astype(jnp.float32) * ATT_SCALE
        s_band = jnp.where(valid, s_band, NEG_INF)
        s_ctx = jnp.einsum('bqkgd,bckd->bkgqc', qb, kc).astype(jnp.float32) * ATT_SCALE
        p = jax.nn.softmax(jnp.concatenate([s_sink, s_ctx, s_band], axis=-1), axis=-1).astype(v.dtype)
        o = (jnp.einsum('bkgqc,bckd->bqkgd', p[..., 1:1 + n_ctx], vc)
             + jnp.einsum('bkgqs,bskd->bqkgd', p[..., 1 + n_ctx:], vb))
        return o.reshape(bsz, Q_BLOCK, ATT_W)

    out = lax.map(block, jnp.arange(n_blocks))
    return out.transpose(1, 0, 2, 3).reshape(bsz, seq_len, ATT_W)


def context_attention(qc, kc, vc, sink):
    bsz, n_ctx = qc.shape[:2]
    qg = qc.reshape(bsz, n_ctx, N_KV_HEADS, GQA_GROUP, HEAD_DIM)
    s = jnp.einsum('bqkgd,bckd->bkgqc', qg, kc).astype(jnp.float32) * ATT_SCALE
    s_sink = jnp.broadcast_to(sink.reshape(N_KV_HEADS, GQA_GROUP, 1, 1).astype(jnp.float32),
                              (bsz, N_KV_HEADS, GQA_GROUP, n_ctx, 1))
    p = jax.nn.softmax(jnp.concatenate([s_sink, s], axis=-1), axis=-1).astype(vc.dtype)
    o = jnp.einsum('bkgqc,bckd->bqkgd', p[..., 1:], vc)
    return o.reshape(bsz, n_ctx, ATT_W)


def hierarchical_moe(h, router_g_w, router_g_b, router_e_w, router_e_b, exp_w1, exp_w3, exp_w2):
    bsz, seq_len, d = h.shape
    n_tok = bsz * seq_len
    xt = h.reshape(n_tok, d)
    g_prob = jax.nn.softmax((xt @ router_g_w + router_g_b).astype(jnp.float32), axis=-1)
    g_val, g_idx = lax.top_k(g_prob, 1)
    e_logits = (xt @ router_e_w + router_e_b).astype(jnp.float32).reshape(n_tok, N_GROUPS, EXPERTS_PER_GROUP)
    e_logits = jnp.take_along_axis(e_logits, g_idx[:, :, None], axis=1)[:, 0]
    e_val, e_idx = lax.top_k(jax.nn.softmax(e_logits, axis=-1), TOP_K)
    gate = g_val * e_val / jnp.sum(e_val, axis=-1, keepdims=True)
    expert = g_idx * EXPERTS_PER_GROUP + e_idx
    n_assign = n_tok * TOP_K
    e_flat = expert.reshape(n_assign)
    order = jnp.argsort(e_flat)
    e_sorted = e_flat[order]
    tok_sorted = order // TOP_K
    gate_sorted = gate.reshape(n_assign)[order]
    counts = jnp.bincount(e_flat, length=N_EXPERTS)
    starts = jnp.cumsum(counts) - counts
    padded = (counts + MOE_BLOCK - 1) // MOE_BLOCK * MOE_BLOCK
    padded_end = jnp.cumsum(padded)
    padded_start = padded_end - padded
    dest = padded_start[e_sorted] + jnp.arange(n_assign) - starts[e_sorted]
    n_blocks = -(-n_assign // MOE_BLOCK) + N_EXPERTS
    buf = jnp.zeros((n_blocks * MOE_BLOCK, d), h.dtype).at[dest].set(xt[tok_sorted])
    block_expert = jnp.minimum(
        jnp.searchsorted(padded_end, jnp.arange(n_blocks) * MOE_BLOCK, side='right'), N_EXPERTS - 1)

    def expert_block(args):
        xb, e = args
        return (jax.nn.silu(xb @ exp_w1[e]) * (xb @ exp_w3[e])) @ exp_w2[e]

    y_buf = lax.map(expert_block, (buf.reshape(n_blocks, MOE_BLOCK, d), block_expert))
    y = y_buf.reshape(n_blocks * MOE_BLOCK, d)[dest] * gate_sorted[:, None].astype(h.dtype)
    out = jnp.zeros((n_tok, d), h.dtype).at[tok_sorted].add(y)
    return out.reshape(bsz, seq_len, d)


def trunk_layer(x, xc, mod_lat, mod_ctx, ang_r, ang_c, norm1_w, w_in, q_norm_w, k_norm_w, attn_sink,
                hy_conv_w, hy_conv_b, hy_w1, hy_b1, hy_w2, hy_b2, hy_w3, hy_sin_freq, hy_skip,
                group_norm_w, w_out, norm2_w, router_g_w, router_g_b, router_e_w, router_e_b,
                exp_w1, exp_w3, exp_w2, update_ctx):
    sh1, sc1, g1, sh2, sc2, g2 = jnp.split(mod_lat[:, None, :], 6, axis=-1)
    csh1, csc1, cg1, csh2, csc2, cg2 = jnp.split(mod_ctx, 6, axis=-1)
    h = modulate(rms_norm(x, norm1_w), sh1, sc1)
    hc = modulate(rms_norm(xc, norm1_w), csh1, csc1)
    proj = h @ w_in
    if update_ctx:
        proj_c = hc @ w_in
        kv_c = proj_c[..., K_OFF:HY_OFF]
    else:
        kv_c = hc @ w_in[:, K_OFF:HY_OFF]
    kc = rms_norm(split_heads(kv_c[..., :KV_W], N_KV_HEADS), k_norm_w)
    vc = split_heads(kv_c[..., KV_W:], N_KV_HEADS)
    q = rope_2d(rms_norm(split_heads(proj[..., :K_OFF], N_HEADS), q_norm_w), ang_r, ang_c)
    k = rope_2d(rms_norm(split_heads(proj[..., K_OFF:V_OFF], N_KV_HEADS), k_norm_w), ang_r, ang_c)
    v = split_heads(proj[..., V_OFF:HY_OFF], N_KV_HEADS)
    att = windowed_attention(q, k, v, kc, vc, attn_sink)
    hy = hyena_mixer(proj[..., HY_OFF:], hy_conv_w, hy_conv_b, hy_w1, hy_b1, hy_w2, hy_b2, hy_w3,
                     hy_sin_freq, hy_skip)
    mix = jnp.concatenate([rms_norm(att, group_norm_w[:ATT_W]), rms_norm(hy, group_norm_w[ATT_W:])],
                          axis=-1) @ w_out
    x = x + g1 * mix
    x = x + g2 * hierarchical_moe(modulate(rms_norm(x, norm2_w), sh2, sc2), router_g_w, router_g_b,
                                  router_e_w, router_e_b, exp_w1, exp_w3, exp_w2)
    if update_ctx:
        qc = rms_norm(split_heads(proj_c[..., :K_OFF], N_HEADS), q_norm_w)
        att_c = context_attention(qc, kc, vc, attn_sink)
        hy_c = hyena_mixer(proj_c[..., HY_OFF:], hy_conv_w, hy_conv_b, hy_w1, hy_b1, hy_w2, hy_b2, hy_w3,
                           hy_sin_freq, hy_skip)
        mix_c = jnp.concatenate([rms_norm(att_c, group_norm_w[:ATT_W]), rms_norm(hy_c, group_norm_w[ATT_W:])],
                                axis=-1) @ w_out
        xc = xc + cg1 * mix_c
        xc = xc + cg2 * hierarchical_moe(modulate(rms_norm(xc, norm2_w), csh2, csc2), router_g_w, router_g_b,
                                         router_e_w, router_e_b, exp_w1, exp_w3, exp_w2)
    return x, xc


def setup_inputs(seed: int = 0) -> dict:
    key = jax.random.key(seed)
    ks = jax.random.split(key, 30)

    def nrm(k, shape, scale):
        return jax.random.normal(k, shape, jnp.float32) * scale

    hy_out = HYENA_ORDER * 2 * HYENA_W
    return {
        'x': nrm(ks[0], (BATCH, SEQ, D_MODEL), 1.0),
        'c': nrm(ks[1], (BATCH, D_MODEL), 1.0),
        'ctx': nrm(ks[2], (BATCH, CTX_LEN, D_MODEL), 1.0),
        'c_ctx': nrm(ks[3], (D_MODEL,), 1.0),
        'ada_w': nrm(ks[4], (DEPTH, D_MODEL, 6 * D_MODEL), 0.5 * D_MODEL ** -0.5),
        'ada_b': nrm(ks[5], (DEPTH, 6 * D_MODEL), 0.02),
        'norm1_w': 1.0 + nrm(ks[6], (DEPTH, D_MODEL), 0.05),
        'w_in': nrm(ks[7], (DEPTH, D_MODEL, PROJ_W), D_MODEL ** -0.5),
        'q_norm_w': 1.0 + nrm(ks[8], (DEPTH, HEAD_DIM), 0.05),
        'k_norm_w': 1.0 + nrm(ks[9], (DEPTH, HEAD_DIM), 0.05),
        'attn_sink': nrm(ks[10], (DEPTH, N_HEADS), 0.5),
        'hy_conv_w': nrm(ks[11], (DEPTH, SHORT_CONV, HYENA_PROJ_W), SHORT_CONV ** -0.5),
        'hy_conv_b': nrm(ks[12], (DEPTH, HYENA_PROJ_W), 0.02),
        'hy_w1': nrm(ks[13], (DEPTH, HYENA_EMB, HYENA_FILTER_HIDDEN), HYENA_EMB ** -0.5),
        'hy_b1': nrm(ks[14], (DEPTH, HYENA_FILTER_HIDDEN), 0.1),
        'hy_w2': nrm(ks[15], (DEPTH, HYENA_FILTER_HIDDEN, HYENA_FILTER_HIDDEN), HYENA_FILTER_HIDDEN ** -0.5),
        'hy_b2': nrm(ks[16], (DEPTH, HYENA_FILTER_HIDDEN), 0.1),
        'hy_w3': nrm(ks[17], (DEPTH, HYENA_FILTER_HIDDEN, hy_out), 0.05 * HYENA_FILTER_HIDDEN ** -0.5),
        'hy_sin_freq': 1.0 + nrm(ks[18], (DEPTH, 2, HYENA_FILTER_HIDDEN), 0.05),
        'hy_skip': nrm(ks[19], (DEPTH, HYENA_ORDER, HYENA_W), 1.0),
        'group_norm_w': 1.0 + nrm(ks[20], (DEPTH, MIX_W), 0.05),
        'w_out': nrm(ks[21], (DEPTH, MIX_W, D_MODEL), MIX_W ** -0.5),
        'norm2_w': 1.0 + nrm(ks[22], (DEPTH, D_MODEL), 0.05),
        'router_g_w': nrm(ks[23], (DEPTH, D_MODEL, N_GROUPS), D_MODEL ** -0.5),
        'router_g_b': nrm(ks[24], (DEPTH, N_GROUPS), 0.01),
        'router_e_w': nrm(ks[25], (DEPTH, D_MODEL, N_EXPERTS), D_MODEL ** -0.5),
        'router_e_b': nrm(ks[26], (DEPTH, N_EXPERTS), 0.01),
        'exp_w1': nrm(ks[27], (DEPTH, N_EXPERTS, D_MODEL, EXPERT_HIDDEN), D_MODEL ** -0.5),
        'exp_w3': nrm(ks[28], (DEPTH, N_EXPERTS, D_MODEL, EXPERT_HIDDEN), D_MODEL ** -0.5),
        'exp_w2': nrm(ks[29], (DEPTH, N_EXPERTS, EXPERT_HIDDEN, D_MODEL), EXPERT_HIDDEN ** -0.5),
    }


def reference(x, c, ctx, c_ctx, ada_w, ada_b, norm1_w, w_in, q_norm_w, k_norm_w, attn_sink,
              hy_conv_w, hy_conv_b, hy_w1, hy_b1, hy_w2, hy_b2, hy_w3, hy_sin_freq, hy_skip,
              group_norm_w, w_out, norm2_w, router_g_w, router_g_b, router_e_w, router_e_b,
              exp_w1, exp_w3, exp_w2):
    seq_len = x.shape[1]
    n_rows = seq_len // GRID_W
    rows = jnp.repeat(jnp.arange(n_rows, dtype=jnp.float32), GRID_W)
    cols = jnp.tile(jnp.arange(GRID_W, dtype=jnp.float32), n_rows)
    inv_freq = ROPE_THETA ** (-jnp.arange(ROPE_PAIRS, dtype=jnp.float32) / ROPE_PAIRS)
    ang_r = (rows[:, None] * inv_freq[None, :])[:, None, :]
    ang_c = (cols[:, None] * inv_freq[None, :])[:, None, :]
    xc = ctx
    for layer in range(DEPTH):
        mod_lat = jax.nn.silu(c) @ ada_w[layer] + ada_b[layer]
        mod_ctx = jax.nn.silu(c_ctx) @ ada_w[layer] + ada_b[layer]
        x, xc = trunk_layer(x, xc, mod_lat, mod_ctx, ang_r, ang_c, norm1_w[layer], w_in[layer],
                            q_norm_w[layer], k_norm_w[layer], attn_sink[layer], hy_conv_w[layer],
                            hy_conv_b[layer], hy_w1[layer], hy_b1[layer], hy_w2[layer], hy_b2[layer],
                            hy_w3[layer], hy_sin_freq[layer], hy_skip[layer], group_norm_w[layer],
                            w_out[layer], norm2_w[layer], router_g_w[layer], router_g_b[layer],
                            router_e_w[layer], router_e_b[layer], exp_w1[layer], exp_w3[layer],
                            exp_w2[layer], layer < DEPTH - 1)
    return x
```

```cpp
#include <hip/hip_runtime.h>
#include <hip/hip_cooperative_groups.h>
#include <cstdio>
#include <cstdint>
namespace cg = cooperative_groups;

typedef unsigned short bf16_t;
typedef short bf16x8 __attribute__((ext_vector_type(8)));
typedef float f32x4 __attribute__((ext_vector_type(4)));
typedef unsigned u32x4 __attribute__((ext_vector_type(4)));
typedef unsigned u32x2 __attribute__((ext_vector_type(2)));

constexpr int DM = 1024, NB = 16, SEQ = 4096, NTOK = NB * SEQ, CTXL = 256, NCTX = NB * CTXL;
constexpr int PROJW = 2304, HYW = 512, HYPW = 1536, KOFF = 512, VOFF = 640, HYOFF = 768;
constexpr int NEXP = 32, EHID = 512, NCLS = 112;
constexpr float EPSN = 1e-6f;
constexpr int NTHR = 512;

constexpr size_t MiB = 1u << 20;
constexpr size_t WS_CTL = 0, WS_MOD = 1 * MiB, WS_WINT = 2 * MiB, WS_WOUTT = 7 * MiB, WS_TAPS = 9 * MiB, WS_EW13 = 41 * MiB, WS_EW2T = 105 * MiB;
constexpr size_t WS_GATE = 137 * MiB, WS_KVC = 139 * MiB, WS_HC = 141 * MiB, WS_LIST = 149 * MiB, WS_H = 177 * MiB, WS_QKV = 305 * MiB, WS_UT = 401 * MiB;
constexpr size_t WS_HYT = 593 * MiB, WS_ATTHY = 657 * MiB, WS_HID = 305 * MiB, WS_END = 785 * MiB;

struct Params {
    const float* x; const float* c; const float* ctx; const float* c_ctx; const float* ada_w; const float* ada_b; const float* norm1_w; const float* w_in;
    const float* q_norm_w; const float* k_norm_w; const float* attn_sink; const float* hy_conv_w; const float* hy_conv_b; const float* hy_w1; const float* hy_b1;
    const float* hy_w2; const float* hy_b2; const float* hy_w3; const float* hy_sin_freq; const float* hy_skip; const float* group_norm_w; const float* w_out;
    const float* norm2_w; const float* router_g_w; const float* router_g_b; const float* router_e_w; const float* router_e_b; const float* exp_w1; const float* exp_w3;
    const float* exp_w2;
    float* out; unsigned char* ws;
};

__device__ __forceinline__ unsigned f2bf(float f) { unsigned u = __builtin_bit_cast(unsigned, f); return (u + 0x7fffu + ((u >> 16) & 1u)) >> 16; }
__device__ __forceinline__ unsigned pk2(float lo, float hi) { return f2bf(lo) | (f2bf(hi) << 16); }
__device__ __forceinline__ float bf2f(unsigned short b) { return __builtin_bit_cast(float, (unsigned)b << 16); }
__device__ __forceinline__ float bflo(unsigned w) { return __builtin_bit_cast(float, w << 16); }
__device__ __forceinline__ float bfhi(unsigned w) { return __builtin_bit_cast(float, w & 0xffff0000u); }
__device__ __forceinline__ float wave_sum(float v) {
#pragma unroll
    for (int o = 1; o < 64; o <<= 1) v += __shfl_xor(v, o);
    return v;
}
__device__ __forceinline__ float siluf(float v) { return v / (1.f + __expf(-v)); }
__device__ __forceinline__ float sin_rad(float a) { float r = a * 0.15915494309189535f; r -= floorf(r); return __builtin_amdgcn_sinf(r); }
__device__ __forceinline__ float cos_rad(float a) { float r = a * 0.15915494309189535f; r -= floorf(r); return __builtin_amdgcn_cosf(r); }

template <class SrcA, class SrcB>
__device__ __forceinline__ void gemm_unit(unsigned char* lds, f32x4 (&acc)[2][2][4][2], const SrcA& srcA, const SrcB& srcB) {
    const int tid = threadIdx.x, wid = tid >> 6, lane = tid & 63, wr = wid >> 2, wc = wid & 3, fr = lane & 15, fq = lane >> 4;
#pragma unroll
    for (int a = 0; a < 2; ++a)
#pragma unroll
        for (int b = 0; b < 2; ++b)
#pragma unroll
            for (int m = 0; m < 4; ++m)
#pragma unroll
                for (int n = 0; n < 2; ++n) acc[a][b][m][n] = (f32x4){0.f, 0.f, 0.f, 0.f};
    const int r0 = tid >> 2, kc = tid & 3;
    const bf16_t* pa0 = srcA(r0) + kc * 8; const bf16_t* pa1 = srcA(r0 + 128) + kc * 8;
    u32x4 ra0, ra1, rb0, rb1;
    ra0 = *(const u32x4*)(pa0); ra1 = *(const u32x4*)(pa1);
    rb0 = *(const u32x4*)(srcB(r0, 0) + kc * 8); rb1 = *(const u32x4*)(srcB(r0 + 128, 0) + kc * 8);
    unsigned char* sA = lds; unsigned char* sB = lds + 16384;
    for (int ks = 0; ks < 32; ++ks) {
        __syncthreads();
        *(u32x4*)(sA + tid * 16) = ra0; *(u32x4*)(sA + 8192 + tid * 16) = ra1;
        *(u32x4*)(sB + tid * 16) = rb0; *(u32x4*)(sB + 8192 + tid * 16) = rb1;
        __syncthreads();
        if (ks + 1 < 32) {
            ra0 = *(const u32x4*)(pa0 + (ks + 1) * 32); ra1 = *(const u32x4*)(pa1 + (ks + 1) * 32);
            rb0 = *(const u32x4*)(srcB(r0, ks + 1) + kc * 8); rb1 = *(const u32x4*)(srcB(r0 + 128, ks + 1) + kc * 8);
        }
        bf16x8 Af[2][4], Bf[2][2];
#pragma unroll
        for (int a = 0; a < 2; ++a)
#pragma unroll
            for (int m = 0; m < 4; ++m) Af[a][m] = *(const bf16x8*)(sA + (128 * a + 64 * wr + 16 * m + fr) * 64 + fq * 16);
#pragma unroll
        for (int b = 0; b < 2; ++b)
#pragma unroll
            for (int n = 0; n < 2; ++n) Bf[b][n] = *(const bf16x8*)(sB + (128 * b + 32 * wc + 16 * n + fr) * 64 + fq * 16);
#pragma unroll
        for (int a = 0; a < 2; ++a)
#pragma unroll
            for (int b = 0; b < 2; ++b)
#pragma unroll
                for (int m = 0; m < 4; ++m)
#pragma unroll
                    for (int n = 0; n < 2; ++n) acc[a][b][m][n] = __builtin_amdgcn_mfma_f32_16x16x32_bf16(Bf[b][n], Af[a][m], acc[a][b][m][n], 0, 0, 0);
    }
}
#define ACC_FOREACH(acc, BODY) do { \
    const int _wid = threadIdx.x >> 6, _lane = threadIdx.x & 63, _wr = _wid >> 2, _wc = _wid & 3, _fr = _lane & 15, _fq = _lane >> 4; \
    _Pragma("unroll") for (int _a = 0; _a < 2; ++_a) _Pragma("unroll") for (int _m = 0; _m < 4; ++_m) _Pragma("unroll") for (int _b = 0; _b < 2; ++_b) _Pragma("unroll") for (int _n = 0; _n < 2; ++_n) { \
        const int rl = 128 * _a + 64 * _wr + 16 * _m + _fr, cl = 128 * _b + 32 * _wc + 16 * _n + 4 * _fq; const f32x4 v = acc[_a][_b][_m][_n]; BODY } } while (0)

__device__ __forceinline__ void p0_adaln(const Params& p, int it, unsigned char* lds) {
    float* S = (float*)lds;
    float* R = (float*)(lds + 17 * 1024 * 4);
    const int tid = threadIdx.x;
    __syncthreads();
    for (int i = tid; i < 17 * 1024; i += NTHR) { const int r = i >> 10, k = i & 1023; const float v = (r < 16) ? p.c[r * 1024 + k] : p.c_ctx[k]; S[i] = siluf(v); }
    __syncthreads();
    const int col = tid & 63, sl = tid >> 6, n = it * 64 + col;
    float a[17];
#pragma unroll
    for (int r = 0; r < 17; ++r) a[r] = 0.f;
    for (int k = sl * 128; k < sl * 128 + 128; ++k) {
        const float w = p.ada_w[(size_t)k * 6144 + n];
#pragma unroll
        for (int r = 0; r < 17; ++r) a[r] += S[r * 1024 + k] * w;
    }
#pragma unroll
    for (int r = 0; r < 17; ++r) R[(sl * 17 + r) * 64 + col] = a[r];
    __syncthreads();
    float* MOD = (float*)(p.ws + WS_MOD);
    for (int i = tid; i < 17 * 64; i += NTHR) { const int r = i >> 6, cc = i & 63; float s = 0.f;
#pragma unroll
        for (int q = 0; q < 8; ++q) s += R[(q * 17 + r) * 64 + cc];
        MOD[r * 6144 + it * 64 + cc] = s + p.ada_b[it * 64 + cc]; }
}

__device__ __forceinline__ void p0_taps(const Params& p, int it, unsigned char* lds) {
    float* FE = (float*)lds;
    float* H1 = FE + 16 * 36;
    float* H2 = H1 + 16 * 64;
    const int tid = threadIdx.x, p0 = it * 16;
    __syncthreads();
    if (tid < 256) { const int pp = tid >> 4, j = tid & 15; const float pos = (float)(p0 + pp);
        const float band = 1e-4f + (float)j * ((15.f - 1e-4f) / 15.f);
        float rev = pos * band * (1.f / 4096.f); rev -= floorf(rev);
        FE[pp * 36 + 1 + j] = __builtin_amdgcn_cosf(rev); FE[pp * 36 + 17 + j] = -__builtin_amdgcn_sinf(rev);
        if (j == 0) FE[pp * 36] = pos * (1.f / 4096.f); }
    __syncthreads();
    for (int i = tid; i < 1024; i += NTHR) { const int pp = i >> 6, j = i & 63; float s = p.hy_b1[j];
        for (int q = 0; q < 33; ++q) s += FE[pp * 36 + q] * p.hy_w1[q * 64 + j];
        H1[pp * 64 + j] = sin_rad(p.hy_sin_freq[j] * s); }
    __syncthreads();
    for (int i = tid; i < 1024; i += NTHR) { const int pp = i >> 6, j = i & 63; float s = p.hy_b2[j];
        for (int q = 0; q < 64; ++q) s += H1[pp * 64 + q] * p.hy_w2[q * 64 + j];
        H2[pp * 64 + j] = sin_rad(p.hy_sin_freq[64 + j] * s); }
    __syncthreads();
    float* TAPS = (float*)(p.ws + WS_TAPS);
    const float mind = -3.0701134573253945f, maxd = -15.350567286626972f;
#pragma unroll 1
    for (int q = 0; q < 4; ++q) {
        const int col = tid + 512 * q, o = col >> 10, dir = (col >> 9) & 1, c = col & 511;
        float w[64];
#pragma unroll
        for (int i = 0; i < 64; ++i) w[i] = p.hy_w3[i * 2048 + col];
        const float delta = fabsf(mind + (maxd - mind) * ((float)c / 511.f));
        float* tp = TAPS + ((size_t)(o * 512 + c)) * 8192;
#pragma unroll 1
        for (int pp = 0; pp < 16; ++pp) {
            float s = 0.f;
#pragma unroll
            for (int i = 0; i < 64; ++i) s += H2[pp * 64 + i] * w[i];
            const int pos = p0 + pp; const float t = (float)pos * (1.f / 4096.f);
            const float val = s * __expf(-t * delta);
            if (dir == 0) tp[4096 + pos] = val; else { if (pos == 0) tp[0] = 0.f; else tp[4096 - pos] = val; }
        }
    }
}

__device__ __forceinline__ void p0_transpose(const float* src, int N, int k0, int n0, bf16_t* dst, int dpitch, int mode, const float* kscale, unsigned char* lds) {
    float* T = (float*)lds;
    const int tid = threadIdx.x;
    __syncthreads();
#pragma unroll
    for (int i = 0; i < 8; ++i) { const int kk = i * 8 + (tid >> 6), nn = tid & 63; float v = src[(size_t)(k0 + kk) * N + n0 + nn]; if (kscale) v *= kscale[k0 + kk]; T[kk * 65 + nn] = v; }
    __syncthreads();
    const int n = tid >> 3, kch = tid & 7, col = n0 + n;
    int drow = col;
    if (mode == 1) drow = (col >> 7) * 256 + (col & 127);
    else if (mode == 2) drow = (col >> 7) * 256 + 128 + (col & 127);
    u32x4 o;
    o.x = pk2(T[(kch * 8 + 0) * 65 + n], T[(kch * 8 + 1) * 65 + n]); o.y = pk2(T[(kch * 8 + 2) * 65 + n], T[(kch * 8 + 3) * 65 + n]);
    o.z = pk2(T[(kch * 8 + 4) * 65 + n], T[(kch * 8 + 5) * 65 + n]); o.w = pk2(T[(kch * 8 + 6) * 65 + n], T[(kch * 8 + 7) * 65 + n]);
    *(u32x4*)(dst + (size_t)drow * dpitch + k0 + kch * 8) = o;
}

__device__ __forceinline__ void phase0(const Params& p, unsigned char* lds) {
    constexpr int I_WIN = 16 * 36, I_WOUT = 16 * 16, I_W1 = 32 * 16 * 8, I_W2 = 32 * 8 * 16;
    constexpr int NTR = I_WIN + I_WOUT + 2 * I_W1 + I_W2;
    if (blockIdx.x == 0 && threadIdx.x < 128) ((int*)(p.ws + WS_CTL))[threadIdx.x] = 0;
    for (int it = blockIdx.x; it < 96; it += gridDim.x) p0_adaln(p, it, lds);
    for (int it = (blockIdx.x + 160) % gridDim.x; it < 256; it += gridDim.x) p0_taps(p, it, lds);
    for (int it = blockIdx.x; it < NTR; it += gridDim.x) {
        int r = it; const float* src; int N, k0, n0, dpitch, mode = 0; bf16_t* dst;
        if (r < I_WIN) { src = p.w_in; N = PROJW; k0 = (r / 36) * 64; n0 = (r % 36) * 64; dst = (bf16_t*)(p.ws + WS_WINT); dpitch = 1024; }
        else if ((r -= I_WIN) < I_WOUT) { src = p.w_out; N = 1024; k0 = (r / 16) * 64; n0 = (r % 16) * 64; dst = (bf16_t*)(p.ws + WS_WOUTT); dpitch = 1024; }
        else if ((r -= I_WOUT) < 2 * I_W1) { const int w3 = r >= I_W1; if (w3) r -= I_W1; const int e = r / 128, q = r % 128; src = (w3 ? p.exp_w3 : p.exp_w1) + (size_t)e * 1024 * 512; N = 512; k0 = (q / 8) * 64; n0 = (q % 8) * 64;
            dst = (bf16_t*)(p.ws + WS_EW13) + (size_t)e * 1024 * 1024; dpitch = 1024; mode = w3 ? 2 : 1; }
        else { r -= 2 * I_W1; const int e = r / 128, q = r % 128; src = p.exp_w2 + (size_t)e * 512 * 1024; N = 1024; k0 = (q / 16) * 64; n0 = (q % 16) * 64; dst = (bf16_t*)(p.ws + WS_EW2T) + (size_t)e * 1024 * 512; dpitch = 512; }
        p0_transpose(src, N, k0, n0, dst, dpitch, mode, nullptr, lds);
    }
}

__device__ __forceinline__ void phase1(const Params& p) {
    const int lane = threadIdx.x & 63, gw = blockIdx.x * 8 + (threadIdx.x >> 6), ngw = gridDim.x * 8;
    const float* MOD = (const float*)(p.ws + WS_MOD);
    for (int row = gw; row < NTOK + NCTX; row += ngw) {
        const bool lat = row < NTOK; const int rr = lat ? row : row - NTOK;
        const float* xr = (lat ? p.x : p.ctx) + (size_t)rr * 1024;
        const float* md = MOD + (size_t)(lat ? (rr >> 12) : 16) * 6144;
        bf16_t* orow = (bf16_t*)(p.ws + (lat ? WS_H : WS_HC)) + (size_t)rr * 1024;
        f32x4 v[4]; float s = 0.f;
#pragma unroll
        for (int j = 0; j < 4; ++j) { v[j] = *(const f32x4*)(xr + 256 * j + lane * 4); s += v[j].x * v[j].x + v[j].y * v[j].y + v[j].z * v[j].z + v[j].w * v[j].w; }
        const float rstd = rsqrtf(wave_sum(s) * (1.f / 1024.f) + EPSN);
#pragma unroll
        for (int j = 0; j < 4; ++j) { const int k = 256 * j + lane * 4;
            const f32x4 nw = *(const f32x4*)(p.norm1_w + k), sh = *(const f32x4*)(md + k), sc = *(const f32x4*)(md + 1024 + k);
            const f32x4 y = (v[j] * rstd) * nw * (sc + 1.f) + sh;
            u32x2 o; o.x = pk2(y.x, y.y); o.y = pk2(y.z, y.w); *(u32x2*)(orow + k) = o; }
    }
}

__device__ __forceinline__ void phase2(const Params& p, unsigned char* lds) {
    const bf16_t* H = (const bf16_t*)(p.ws + WS_H); const bf16_t* HC = (const bf16_t*)(p.ws + WS_HC); const bf16_t* WT = (const bf16_t*)(p.ws + WS_WINT);
    bf16_t* QKV = (bf16_t*)(p.ws + WS_QKV); bf16_t* UT = (bf16_t*)(p.ws + WS_UT); bf16_t* KVC = (bf16_t*)(p.ws + WS_KVC);
    f32x4 acc[2][2][4][2];
    for (int u = blockIdx.x; u < 2320; u += gridDim.x) {
        if (u < 768) { const int pm = u / 3, pn = u % 3; const bf16_t* a0 = H + (size_t)pm * 256 * 1024; const bf16_t* b0 = WT + (size_t)pn * 256 * 1024;
            gemm_unit(lds, acc, [&](int r) { return a0 + (size_t)r * 1024; }, [&](int r, int ks) { return b0 + (size_t)r * 1024 + ks * 32; });
            ACC_FOREACH(acc, { u32x2 o; o.x = pk2(v.x, v.y); o.y = pk2(v.z, v.w); *(u32x2*)(QKV + (size_t)(pm * 256 + rl) * 768 + pn * 256 + cl) = o; });
        } else if (u < 2304) { const int vv = u - 768, pn = vv / 6, pm = vv % 6; const bf16_t* a0 = WT + (size_t)(768 + pm * 256) * 1024; const bf16_t* b0 = H + (size_t)pn * 256 * 1024;
            gemm_unit(lds, acc, [&](int r) { return a0 + (size_t)r * 1024; }, [&](int r, int ks) { return b0 + (size_t)r * 1024 + ks * 32; });
            const int tok0 = pn * 256, bb = tok0 >> 12, t0 = tok0 & 4095;
            ACC_FOREACH(acc, { u32x2 o; o.x = pk2(v.x, v.y); o.y = pk2(v.z, v.w); *(u32x2*)(UT + ((size_t)(bb * 1536 + pm * 256 + rl)) * 4096 + t0 + cl) = o; });
        } else { const int pm = u - 2304; const bf16_t* a0 = HC + (size_t)pm * 256 * 1024; const bf16_t* b0 = WT + (size_t)512 * 1024;
            gemm_unit(lds, acc, [&](int r) { return a0 + (size_t)r * 1024; }, [&](int r, int ks) { return b0 + (size_t)r * 1024 + ks * 32; });
            ACC_FOREACH(acc, { u32x2 o; o.x = pk2(v.x, v.y); o.y = pk2(v.z, v.w); *(u32x2*)(KVC + (size_t)(pm * 256 + rl) * 256 + cl) = o; });
        }
    }
}

__device__ __forceinline__ void phase3(const Params& p) {
    const int lane = threadIdx.x & 63, gw = blockIdx.x * 8 + (threadIdx.x >> 6), ngw = gridDim.x * 8;
    bf16_t* QKV = (bf16_t*)(p.ws + WS_QKV); bf16_t* KVC = (bf16_t*)(p.ws + WS_KVC);
    const float qw = p.q_norm_w[lane], kw = p.k_norm_w[lane];
    const int i16 = lane & 15; const float invf = exp2f(-(float)i16 * (13.287712379549449f / 16.f));
    for (int row = gw; row < NTOK + NCTX; row += ngw) {
        if (row < NTOK) {
            const int pos = row & 4095; const float ang = (float)((lane & 32) ? (pos & 63) : (pos >> 6)) * invf;
            const float cs = cos_rad(ang), sn = sin_rad(ang);
            bf16_t* rp = QKV + (size_t)row * 768;
#pragma unroll
            for (int hh = 0; hh < 10; ++hh) {
                const float xv = bf2f(rp[hh * 64 + lane]);
                const float rstd = rsqrtf(wave_sum(xv * xv) * (1.f / 64.f) + EPSN);
                const float y = xv * rstd * (hh < 8 ? qw : kw);
                const float pr = __shfl_xor(y, 16);
                const float o = (lane & 16) ? (y * cs + pr * sn) : (y * cs - pr * sn);
                rp[hh * 64 + lane] = (bf16_t)f2bf(o);
            }
        } else {
            bf16_t* rp = KVC + (size_t)(row - NTOK) * 256;
#pragma unroll
            for (int hh = 0; hh < 2; ++hh) {
                const float xv = bf2f(rp[hh * 64 + lane]);
                const float rstd = rsqrtf(wave_sum(xv * xv) * (1.f / 64.f) + EPSN);
                rp[hh * 64 + lane] = (bf16_t)f2bf(xv * rstd * kw);
            }
        }
    }
}

__device__ __forceinline__ void attn_unit(const Params& p, int u, unsigned char* lds) {
    const int tid = threadIdx.x, wid = tid >> 6, lane = tid & 63, fr = lane & 15, fq = lane >> 4;
    const int b = u >> 6, kvh = (u >> 5) & 1, qb = u & 31, q0 = qb * 128;
    const bf16_t* QKV = (const bf16_t*)(p.ws + WS_QKV); const bf16_t* KVC = (const bf16_t*)(p.ws + WS_KVC);
    bf16_t* ATT = (bf16_t*)(p.ws + WS_ATTHY);
    unsigned char* sK = lds;
    unsigned char* sV = lds + 64 * 144;
    const int h = kvh * 4 + (wid >> 1), qrow0 = q0 + 64 * (wid & 1);
    bf16x8 qf[4][2];
#pragma unroll
    for (int qt = 0; qt < 4; ++qt)
#pragma unroll
        for (int ks = 0; ks < 2; ++ks) qf[qt][ks] = *(const bf16x8*)(QKV + (size_t)(b * 4096 + qrow0 + 16 * qt + fr) * 768 + h * 64 + 32 * ks + 8 * fq);
    const float LOG2E = 1.4426950408889634f, SC = 0.125f * LOG2E;
    float mrow[4], lrow[4]; f32x4 ot[4][4];
    const float sink2 = p.attn_sink[h] * LOG2E;
#pragma unroll
    for (int qt = 0; qt < 4; ++qt) { mrow[qt] = sink2; lrow[qt] = (fq == 0) ? 1.f : 0.f;
#pragma unroll
        for (int dt = 0; dt < 4; ++dt) ot[dt][qt] = (f32x4){0.f, 0.f, 0.f, 0.f}; }
    for (int tile = 0; tile < 10; ++tile) {
        const bool isctx = tile < 4; const int kbase = isctx ? tile * 64 : q0 - 128 + (tile - 4) * 64;
        if (!isctx && (kbase < 0 || kbase >= SEQ)) continue;
        __syncthreads();
        {
            const int kr = tid >> 3, ch = tid & 7;
            const bf16_t* krow = isctx ? KVC + (size_t)(b * 256 + kbase + kr) * 256 + kvh * 64 : QKV + (size_t)(b * 4096 + kbase + kr) * 768 + KOFF + kvh * 64;
            const bf16_t* vrow = isctx ? KVC + (size_t)(b * 256 + kbase + kr) * 256 + 128 + kvh * 64 : QKV + (size_t)(b * 4096 + kbase + kr) * 768 + VOFF + kvh * 64;
            const u32x4 kv = *(const u32x4*)(krow + ch * 8); const u32x4 vv = *(const u32x4*)(vrow + ch * 8);
            *(u32x4*)(sK + kr * 144 + ch * 16) = kv;
            bf16_t* sv = (bf16_t*)sV;
            sv[(ch * 8 + 0) * 72 + kr] = (bf16_t)(vv.x & 0xffff); sv[(ch * 8 + 1) * 72 + kr] = (bf16_t)(vv.x >> 16);
            sv[(ch * 8 + 2) * 72 + kr] = (bf16_t)(vv.y & 0xffff); sv[(ch * 8 + 3) * 72 + kr] = (bf16_t)(vv.y >> 16);
            sv[(ch * 8 + 4) * 72 + kr] = (bf16_t)(vv.z & 0xffff); sv[(ch * 8 + 5) * 72 + kr] = (bf16_t)(vv.z >> 16);
            sv[(ch * 8 + 6) * 72 + kr] = (bf16_t)(vv.w & 0xffff); sv[(ch * 8 + 7) * 72 + kr] = (bf16_t)(vv.w >> 16);
        }
        __syncthreads();
        f32x4 st[4][4];
#pragma unroll
        for (int kt = 0; kt < 4; ++kt) {
            const bf16x8 k0 = *(const bf16x8*)(sK + (16 * kt + fr) * 144 + fq * 16), k1 = *(const bf16x8*)(sK + (16 * kt + fr) * 144 + 64 + fq * 16);
#pragma unroll
            for (int qt = 0; qt < 4; ++qt) { f32x4 z = (f32x4){0.f, 0.f, 0.f, 0.f};
                z = __builtin_amdgcn_mfma_f32_16x16x32_bf16(k0, qf[qt][0], z, 0, 0, 0); z = __builtin_amdgcn_mfma_f32_16x16x32_bf16(k1, qf[qt][1], z, 0, 0, 0); st[kt][qt] = z; }
        }
#pragma unroll
        for (int qt = 0; qt < 4; ++qt) {
            const int qpos = qrow0 + 16 * qt + fr;
            float tmax = -3.0e38f;
#pragma unroll
            for (int kt = 0; kt < 4; ++kt)
#pragma unroll
                for (int r = 0; r < 4; ++r) { float s = st[kt][qt][r] * SC;
                    if (!isctx) { const int kp = kbase + 16 * kt + 4 * fq + r; const int dd = kp - qpos; if (dd > 128 || dd < -128) s = -1e30f; }
                    st[kt][qt][r] = s; tmax = fmaxf(tmax, s); }
            tmax = fmaxf(tmax, __shfl_xor(tmax, 16)); tmax = fmaxf(tmax, __shfl_xor(tmax, 32));
            const float mnew = fmaxf(mrow[qt], tmax), alpha = exp2f(mrow[qt] - mnew);
            mrow[qt] = mnew; float ls = 0.f;
#pragma unroll
            for (int kt = 0; kt < 4; ++kt)
#pragma unroll
                for (int r = 0; r < 4; ++r) { const float pv = exp2f(st[kt][qt][r] - mnew); st[kt][qt][r] = pv; ls += pv; }
            lrow[qt] = lrow[qt] * alpha + ls;
#pragma unroll
            for (int dt = 0; dt < 4; ++dt) ot[dt][qt] = ot[dt][qt] * alpha;
        }
#pragma unroll
        for (int ks = 0; ks < 2; ++ks) {
            bf16x8 pf[4];
#pragma unroll
            for (int qt = 0; qt < 4; ++qt) { const f32x4 a = st[2 * ks][qt], c = st[2 * ks + 1][qt];
                u32x4 w; w.x = pk2(a.x, a.y); w.y = pk2(a.z, a.w); w.z = pk2(c.x, c.y); w.w = pk2(c.z, c.w); pf[qt] = __builtin_bit_cast(bf16x8, w); }
#pragma unroll
            for (int dt = 0; dt < 4; ++dt) {
                const u32x2 v0 = *(const u32x2*)(sV + (16 * dt + fr) * 144 + (32 * ks + 4 * fq) * 2), v1 = *(const u32x2*)(sV + (16 * dt + fr) * 144 + (32 * ks + 16 + 4 * fq) * 2);
                u32x4 w; w.x = v0.x; w.y = v0.y; w.z = v1.x; w.w = v1.y; const bf16x8 vf = __builtin_bit_cast(bf16x8, w);
#pragma unroll
                for (int qt = 0; qt < 4; ++qt) ot[dt][qt] = __builtin_amdgcn_mfma_f32_16x16x32_bf16(vf, pf[qt], ot[dt][qt], 0, 0, 0);
            }
        }
    }
#pragma unroll
    for (int qt = 0; qt < 4; ++qt) {
        float l = lrow[qt]; l += __shfl_xor(l, 16); l += __shfl_xor(l, 32);
        const float inv = 1.f / l;
        bf16_t* orow = ATT + (size_t)(b * 4096 + qrow0 + 16 * qt + fr) * 1024 + h * 64;
#pragma unroll
        for (int dt = 0; dt < 4; ++dt) { const f32x4 o = ot[dt][qt] * inv; u32x2 w; w.x = pk2(o.x, o.y); w.y = pk2(o.z, o.w); *(u32x2*)(orow + 16 * dt + 4 * fq) = w; }
    }
}

__device__ __forceinline__ void hyena_conv_pass(const float* Z, const float* KT, float (&o)[8], int t0) {
#pragma unroll
    for (int i = 0; i < 8; ++i) o[i] = 0.f;
    for (int sg = 0; sg < 512; ++sg) {
        const f32x4 z0 = *(const f32x4*)(Z + 8 * sg), z1 = *(const f32x4*)(Z + 8 * sg + 4);
        const float* kb = KT + (t0 - 8 * sg + 4096 - 8);
        const f32x4 k0 = *(const f32x4*)(kb), k1 = *(const f32x4*)(kb + 4), k2 = *(const f32x4*)(kb + 8), k3 = *(const f32x4*)(kb + 12);
        const float kk[16] = {k0.x, k0.y, k0.z, k0.w, k1.x, k1.y, k1.z, k1.w, k2.x, k2.y, k2.z, k2.w, k3.x, k3.y, k3.z, k3.w};
        const float zz[8] = {z0.x, z0.y, z0.z, z0.w, z1.x, z1.y, z1.z, z1.w};
#pragma unroll
        for (int i = 0; i < 8; ++i)
#pragma unroll
            for (int j = 0; j < 8; ++j) o[i] += zz[j] * kk[8 + i - j];
    }
}
__device__ __forceinline__ void hyena_item(const Params& p, int it, unsigned char* lds) {
    const int tid = threadIdx.x, b = it >> 9, c = it & 511, t0 = tid * 8;
    float* Z0 = (float*)lds; float* Z1 = Z0 + 4096; float* KT = Z1 + 4096;
    const bf16_t* UT = (const bf16_t*)(p.ws + WS_UT); const float* TAPS = (const float*)(p.ws + WS_TAPS);
    bf16_t* HYT = (bf16_t*)(p.ws + WS_HYT);
    float xg[2][8];
    __syncthreads();
#pragma unroll
    for (int part = 0; part < 3; ++part) {
        const int ch = part * 512 + c; const bf16_t* ur = UT + ((size_t)(b * 1536 + ch)) * 4096;
        const float w0 = p.hy_conv_w[ch], w1 = p.hy_conv_w[1536 + ch], w2 = p.hy_conv_w[3072 + ch], bb = p.hy_conv_b[ch];
        const u32x4 raw = *(const u32x4*)(ur + t0);
        float uv[10];
        uv[0] = (t0 > 0) ? bf2f(ur[t0 - 1]) : 0.f; uv[9] = (t0 + 8 < 4096) ? bf2f(ur[t0 + 8]) : 0.f;
        uv[1] = bflo(raw.x); uv[2] = bfhi(raw.x); uv[3] = bflo(raw.y); uv[4] = bfhi(raw.y); uv[5] = bflo(raw.z); uv[6] = bfhi(raw.z); uv[7] = bflo(raw.w); uv[8] = bfhi(raw.w);
#pragma unroll
        for (int i = 0; i < 8; ++i) { const float y = bb + uv[i] * w0 + uv[i + 1] * w1 + uv[i + 2] * w2;
            if (part == 0) Z0[t0 + i] = y; else xg[part - 1][i] = y; }
    }
    {   const float* tp = TAPS + (size_t)c * 8192;
#pragma unroll
        for (int i = 0; i < 4; ++i) *(f32x4*)(KT + (tid + 512 * i) * 4) = *(const f32x4*)(tp + (tid + 512 * i) * 4); }
    __syncthreads();
    float o[8];
    hyena_conv_pass(Z0, KT, o, t0);
    {   const float sk = p.hy_skip[c];
#pragma unroll
        for (int i = 0; i < 8; ++i) Z1[t0 + i] = xg[0][i] * (o[i] + sk * Z0[t0 + i]); }
    __syncthreads();
    {   const float* tp = TAPS + (size_t)(512 + c) * 8192;
#pragma unroll
        for (int i = 0; i < 4; ++i) *(f32x4*)(KT + (tid + 512 * i) * 4) = *(const f32x4*)(tp + (tid + 512 * i) * 4); }
    __syncthreads();
    hyena_conv_pass(Z1, KT, o, t0);
    {   const float sk = p.hy_skip[512 + c]; float z2[8];
#pragma unroll
        for (int i = 0; i < 8; ++i) z2[i] = xg[1][i] * (o[i] + sk * Z1[t0 + i]);
        u32x4 w; w.x = pk2(z2[0], z2[1]); w.y = pk2(z2[2], z2[3]); w.z = pk2(z2[4], z2[5]); w.w = pk2(z2[6], z2[7]);
        *(u32x4*)(HYT + ((size_t)(b * 512 + c)) * 4096 + t0) = w; }
}

__device__ __forceinline__ void phase5_item(const Params& p, int it, unsigned char* lds) {
    const int tid = threadIdx.x, b = it >> 6, t0 = (it & 63) * 64;
    bf16_t* TL = (bf16_t*)lds;
    float* RS = (float*)(lds + 512 * 66 * 2);
    float* RS2 = RS + 512;
    const bf16_t* HYT = (const bf16_t*)(p.ws + WS_HYT); bf16_t* AH = (bf16_t*)(p.ws + WS_ATTHY);
    __syncthreads();
    {   const bf16_t* src = HYT + ((size_t)(b * 512 + tid)) * 4096 + t0;
#pragma unroll
        for (int i = 0; i < 8; ++i) { const u32x4 v = *(const u32x4*)(src + i * 8); unsigned* d = (unsigned*)(TL + tid * 66 + i * 8); d[0] = v.x; d[1] = v.y; d[2] = v.z; d[3] = v.w; } }
    __syncthreads();
    {   const int tt = tid & 63, cg8 = tid >> 6; float s = 0.f;
        for (int cc = 0; cc < 64; ++cc) { const float v = bf2f(TL[(cg8 * 64 + cc) * 66 + tt]); s += v * v; }
        RS[cg8 * 64 + tt] = s; }
    __syncthreads();
    if (tid < 64) { float s = 0.f;
#pragma unroll
        for (int q = 0; q < 8; ++q) s += RS[q * 64 + tid];
        RS2[tid] = rsqrtf(s * (1.f / 512.f) + EPSN); }
    __syncthreads();
    {   const int tt = tid >> 3, ch = tid & 7; const float rstd = RS2[tt];
        bf16_t* orow = AH + (size_t)(b * 4096 + t0 + tt) * 1024;
#pragma unroll
        for (int g = 0; g < 8; ++g) { const int c0 = ch * 64 + g * 8; float y[8];
#pragma unroll
            for (int i = 0; i < 8; ++i) y[i] = bf2f(TL[(c0 + i) * 66 + tt]) * rstd * p.group_norm_w[512 + c0 + i];
            u32x4 w; w.x = pk2(y[0], y[1]); w.y = pk2(y[2], y[3]); w.z = pk2(y[4], y[5]); w.w = pk2(y[6], y[7]); *(u32x4*)(orow + 512 + c0) = w; }
        u32x4 av[8]; float s = 0.f;
#pragma unroll
        for (int g = 0; g < 8; ++g) { av[g] = *(const u32x4*)(orow + ch * 64 + g * 8);
            const float a0 = bflo(av[g].x), a1 = bfhi(av[g].x), a2 = bflo(av[g].y), a3 = bfhi(av[g].y), a4 = bflo(av[g].z), a5 = bfhi(av[g].z), a6 = bflo(av[g].w), a7 = bfhi(av[g].w);
            s += a0 * a0 + a1 * a1 + a2 * a2 + a3 * a3 + a4 * a4 + a5 * a5 + a6 * a6 + a7 * a7; }
        s += __shfl_xor(s, 1); s += __shfl_xor(s, 2); s += __shfl_xor(s, 4);
        const float ra = rsqrtf(s * (1.f / 512.f) + EPSN);
#pragma unroll
        for (int g = 0; g < 8; ++g) { const int c0 = ch * 64 + g * 8; const float* gw = p.group_norm_w + c0;
            u32x4 w; w.x = pk2(bflo(av[g].x) * ra * gw[0], bfhi(av[g].x) * ra * gw[1]); w.y = pk2(bflo(av[g].y) * ra * gw[2], bfhi(av[g].y) * ra * gw[3]);
            w.z = pk2(bflo(av[g].z) * ra * gw[4], bfhi(av[g].z) * ra * gw[5]); w.w = pk2(bflo(av[g].w) * ra * gw[6], bfhi(av[g].w) * ra * gw[7]);
            *(u32x4*)(orow + c0) = w; }
    }
}

__device__ __forceinline__ void phase6(const Params& p, unsigned char* lds) {
    const bf16_t* AH = (const bf16_t*)(p.ws + WS_ATTHY); const bf16_t* WT = (const bf16_t*)(p.ws + WS_WOUTT); const float* MOD = (const float*)(p.ws + WS_MOD);
    f32x4 acc[2][2][4][2];
    for (int u = blockIdx.x; u < 1024; u += gridDim.x) {
        const int pm = u >> 2, pn = u & 3; const bf16_t* a0 = AH + (size_t)pm * 256 * 1024; const bf16_t* b0 = WT + (size_t)pn * 256 * 1024;
        gemm_unit(lds, acc, [&](int r) { return a0 + (size_t)r * 1024; }, [&](int r, int ks) { return b0 + (size_t)r * 1024 + ks * 32; });
        const float* g1 = MOD + (size_t)((pm * 256) >> 12) * 6144 + 2048;
        ACC_FOREACH(acc, { const size_t off = (size_t)(pm * 256 + rl) * 1024 + pn * 256 + cl; const f32x4 xv = *(const f32x4*)(p.x + off); const f32x4 gv = *(const f32x4*)(g1 + pn * 256 + cl);
            *(f32x4*)(p.out + off) = xv + gv * v; });
    }
}

__device__ __forceinline__ int pair_index(int lo, int hi) { return lo * 8 - (lo * (lo + 1)) / 2 + (hi - lo - 1); }
__device__ __forceinline__ void phase7(const Params& p) {
    const int lane = threadIdx.x & 63, gw = blockIdx.x * 8 + (threadIdx.x >> 6), ngw = gridDim.x * 8;
    const float* MOD = (const float*)(p.ws + WS_MOD); bf16_t* H2 = (bf16_t*)(p.ws + WS_H);
    int* CNT = (int*)(p.ws + WS_CTL); int* LIST = (int*)(p.ws + WS_LIST); float* GATE = (float*)(p.ws + WS_GATE);
    for (int row = gw; row < NTOK; row += ngw) {
        const float* xr = p.out + (size_t)row * 1024; const float* md = MOD + (size_t)(row >> 12) * 6144;
        f32x4 v[4]; float s = 0.f;
#pragma unroll
        for (int j = 0; j < 4; ++j) { v[j] = *(const f32x4*)(xr + 256 * j + lane * 4); s += v[j].x * v[j].x + v[j].y * v[j].y + v[j].z * v[j].z + v[j].w * v[j].w; }
        const float rstd = rsqrtf(wave_sum(s) * (1.f / 1024.f) + EPSN);
        float gl[4] = {0.f, 0.f, 0.f, 0.f};
#pragma unroll
        for (int j = 0; j < 4; ++j) { const int k = 256 * j + lane * 4;
            const f32x4 nw = *(const f32x4*)(p.norm2_w + k), sh = *(const f32x4*)(md + 3072 + k), sc = *(const f32x4*)(md + 4096 + k);
            const f32x4 y = (v[j] * rstd) * nw * (sc + 1.f) + sh; v[j] = y;
            u32x2 o; o.x = pk2(y.x, y.y); o.y = pk2(y.z, y.w); *(u32x2*)(H2 + (size_t)row * 1024 + k) = o;
#pragma unroll
            for (int e = 0; e < 4; ++e) { const f32x4 w = *(const f32x4*)(p.router_g_w + (size_t)(k + e) * 4); const float ye = y[e]; gl[0] += ye * w.x; gl[1] += ye * w.y; gl[2] += ye * w.z; gl[3] += ye * w.w; } }
#pragma unroll
        for (int e = 0; e < 4; ++e) gl[e] = wave_sum(gl[e]) + p.router_g_b[e];
        int g = 0; float gm = gl[0];
#pragma unroll
        for (int e = 1; e < 4; ++e) if (gl[e] > gm) { gm = gl[e]; g = e; }
        float gs = 0.f;
#pragma unroll
        for (int e = 0; e < 4; ++e) gs += __expf(gl[e] - gm);
        const float gval = 1.f / gs;
        float el[8] = {0.f, 0.f, 0.f, 0.f, 0.f, 0.f, 0.f, 0.f};
#pragma unroll
        for (int j = 0; j < 4; ++j) { const int k = 256 * j + lane * 4;
#pragma unroll
            for (int e = 0; e < 4; ++e) { const float* wr = p.router_e_w + (size_t)(k + e) * 32 + g * 8; const f32x4 w0 = *(const f32x4*)wr, w1 = *(const f32x4*)(wr + 4); const float ye = v[j][e];
                el[0] += ye * w0.x; el[1] += ye * w0.y; el[2] += ye * w0.z; el[3] += ye * w0.w; el[4] += ye * w1.x; el[5] += ye * w1.y; el[6] += ye * w1.z; el[7] += ye * w1.w; } }
#pragma unroll
        for (int e = 0; e < 8; ++e) el[e] = wave_sum(el[e]) + p.router_e_b[g * 8 + e];
        int e1 = 0; float m1 = el[0];
#pragma unroll
        for (int e = 1; e < 8; ++e) if (el[e] > m1) { m1 = el[e]; e1 = e; }
        int e2 = -1; float m2 = -3.0e38f;
#pragma unroll
        for (int e = 0; e < 8; ++e) if (e != e1 && el[e] > m2) { m2 = el[e]; e2 = e; }
        const float r = __expf(m2 - m1), w1 = 1.f / (1.f + r), w2 = r / (1.f + r);
        if (lane == 0) {
            const int lo = e1 < e2 ? e1 : e2, hi = e1 < e2 ? e2 : e1;
            const float glo = gval * (e1 < e2 ? w1 : w2), ghi = gval * (e1 < e2 ? w2 : w1);
            const int cls = g * 28 + pair_index(lo, hi);
            const int rank = atomicAdd(CNT + cls, 1);
            LIST[(size_t)cls * 65536 + rank] = row;
            GATE[row * 2] = glo; GATE[row * 2 + 1] = ghi;
        }
    }
}

struct MoeMap { int ntiles; };
__device__ __forceinline__ void moe_build_map(const Params& p, int* sm  ) {
    const int* CNT = (const int*)(p.ws + WS_CTL);
    __syncthreads();
    if (threadIdx.x == 0) { int base = 0; for (int c = 0; c < NCLS; ++c) { const int n = CNT[c]; sm[c] = base; sm[128 + c] = n; base += (n + 255) >> 8; } sm[256] = base; }
    __syncthreads();
}
__device__ __forceinline__ void cls_decode(int cls, int& g, int& lo, int& hi) {
    g = cls / 28; int r = cls % 28; lo = 0; while (r >= 7 - lo) { r -= 7 - lo; ++lo; } hi = lo + 1 + r;
}
__device__ __forceinline__ int moe_find_cls(const int* sm, int mt) { int c = 0; for (int q = 1; q < NCLS; ++q) if (sm[q] <= mt) c = q; return c; }

__device__ __forceinline__ void phase8(const Params& p, unsigned char* lds) {
    int* sm = (int*)(lds + 40960);
    moe_build_map(p, sm);
    const int NT = sm[256];
    const bf16_t* H2 = (const bf16_t*)(p.ws + WS_H); const bf16_t* EW13 = (const bf16_t*)(p.ws + WS_EW13); bf16_t* HID = (bf16_t*)(p.ws + WS_HID);
    const int* LIST = (const int*)(p.ws + WS_LIST); const float* GATE = (const float*)(p.ws + WS_GATE);
    int* rowtok = (int*)(lds + 32768);
    f32x4 acc[2][2][4][2];
    for (int u = blockIdx.x; u < NT * 8; u += gridDim.x) {
        const int mt = u >> 3, nj = u & 7; const int cls = moe_find_cls(sm, mt); int g, lo, hi; cls_decode(cls, g, lo, hi);
        const int rank0 = (mt - sm[cls]) * 256, cnt = sm[128 + cls];
        __syncthreads();
        if (threadIdx.x < 256) { const int rk = rank0 + threadIdx.x; rowtok[threadIdx.x] = (rk < cnt) ? LIST[(size_t)cls * 65536 + rk] : -1; }
        __syncthreads();
        const int e = g * 8 + (nj < 4 ? lo : hi); const bf16_t* b0 = EW13 + (size_t)e * 1024 * 1024 + (size_t)(nj & 3) * 256 * 1024;
        gemm_unit(lds, acc, [&](int r) { const int t = rowtok[r]; return H2 + (size_t)(t < 0 ? 0 : t) * 1024; }, [&](int r, int ks) { return b0 + (size_t)r * 1024 + ks * 32; });
        {   const int wid = threadIdx.x >> 6, lane = threadIdx.x & 63, wr = wid >> 2, wc = wid & 3, fr = lane & 15, fq = lane >> 4;
#pragma unroll
            for (int a = 0; a < 2; ++a)
#pragma unroll
                for (int m = 0; m < 4; ++m) { const int rl = 128 * a + 64 * wr + 16 * m + fr; const int t = rowtok[rl]; const float gt = (t < 0) ? 0.f : GATE[t * 2 + (nj >> 2)];
#pragma unroll
                    for (int n = 0; n < 2; ++n) { const f32x4 va = acc[a][0][m][n], vb = acc[a][1][m][n]; f32x4 hv;
#pragma unroll
                        for (int q = 0; q < 4; ++q) hv[q] = siluf(va[q]) * vb[q] * gt;
                        u32x2 o; o.x = pk2(hv.x, hv.y); o.y = pk2(hv.z, hv.w);
                        *(u32x2*)(HID + (size_t)(mt * 256 + rl) * 1024 + (nj >> 2) * 512 + (nj & 3) * 128 + 32 * wc + 16 * n + 4 * fq) = o; } }
        }
    }
}
__device__ __forceinline__ void phase9(const Params& p, unsigned char* lds) {
    int* sm = (int*)(lds + 40960);
    moe_build_map(p, sm);
    const int NT = sm[256];
    const bf16_t* EW2T = (const bf16_t*)(p.ws + WS_EW2T); const bf16_t* HID = (const bf16_t*)(p.ws + WS_HID);
    const int* LIST = (const int*)(p.ws + WS_LIST); const float* MOD = (const float*)(p.ws + WS_MOD);
    int* rowtok = (int*)(lds + 32768);
    f32x4 acc[2][2][4][2];
    for (int u = blockIdx.x; u < NT * 4; u += gridDim.x) {
        const int mt = u >> 2, pn = u & 3; const int cls = moe_find_cls(sm, mt); int g, lo, hi; cls_decode(cls, g, lo, hi);
        const int rank0 = (mt - sm[cls]) * 256, cnt = sm[128 + cls];
        __syncthreads();
        if (threadIdx.x < 256) { const int rk = rank0 + threadIdx.x; rowtok[threadIdx.x] = (rk < cnt) ? LIST[(size_t)cls * 65536 + rk] : -1; }
        __syncthreads();
        const bf16_t* a0 = HID + (size_t)mt * 256 * 1024;
        const bf16_t* bl = EW2T + (size_t)(g * 8 + lo) * 1024 * 512 + (size_t)pn * 256 * 512; const bf16_t* bh = EW2T + (size_t)(g * 8 + hi) * 1024 * 512 + (size_t)pn * 256 * 512;
        gemm_unit(lds, acc, [&](int r) { return a0 + (size_t)r * 1024; }, [&](int r, int ks) { return (ks < 16) ? bl + (size_t)r * 512 + ks * 32 : bh + (size_t)r * 512 + (ks - 16) * 32; });
        ACC_FOREACH(acc, { const int t = rowtok[rl]; if (t >= 0) { const size_t off = (size_t)t * 1024 + pn * 256 + cl; const f32x4 g2 = *(const f32x4*)(MOD + (size_t)(t >> 12) * 6144 + 5120 + pn * 256 + cl);
            const f32x4 x1 = *(const f32x4*)(p.out + off); *(f32x4*)(p.out + off) = x1 + g2 * v; } });
    }
}

constexpr int LDS_BYTES = 112 * 1024;
__global__ void __launch_bounds__(NTHR, 2) fwd_kernel(Params p) {
    extern __shared__ __attribute__((aligned(16))) unsigned char lds[];
    cg::grid_group grid = cg::this_grid();
    phase0(p, lds);
    grid.sync();
    phase1(p);
    grid.sync();
    phase2(p, lds);
    grid.sync();
    phase3(p);
    grid.sync();
    for (int u = blockIdx.x; u < 1024; u += gridDim.x) attn_unit(p, u, lds);
    for (int it = blockIdx.x; it < NB * HYW; it += gridDim.x) hyena_item(p, it, lds);
    grid.sync();
    for (int it = blockIdx.x; it < 1024; it += gridDim.x) phase5_item(p, it, lds);
    grid.sync();
    phase6(p, lds);
    grid.sync();
    phase7(p);
    grid.sync();
    phase8(p, lds);
    grid.sync();
    phase9(p, lds);
}

extern "C" void kernel_launch(void* const* d_in, const int* in_sizes, int n_in, void* d_out, int out_size, void* d_ws, size_t ws_size, hipStream_t stream) {
    static int grid_blocks = 0;
    if (grid_blocks == 0) {
        if (n_in != 30 || out_size != NTOK * DM || ws_size < WS_END) { fprintf(stderr, "kernel_launch: unexpected shapes (n_in %d out %d ws %zu)\n", n_in, out_size, ws_size); grid_blocks = -1; return; }
        int dev = 0, cus = 0, per_cu = 0;
        hipGetDevice(&dev); hipDeviceGetAttribute(&cus, hipDeviceAttributeMultiprocessorCount, dev);
        hipFuncSetAttribute((const void*)fwd_kernel, hipFuncAttributeMaxDynamicSharedMemorySize, LDS_BYTES);
        hipOccupancyMaxActiveBlocksPerMultiprocessor(&per_cu, (const void*)fwd_kernel, NTHR, LDS_BYTES);
        if (per_cu < 1) { fprintf(stderr, "kernel_launch: occupancy query says %d blocks per CU\n", per_cu); grid_blocks = -1; return; }
        grid_blocks = cus * per_cu;
    }
    if (grid_blocks < 0) return;
    Params p{};
    const float** pp = (const float**)&p;
    for (int i = 0; i < 30; ++i) pp[i] = (const float*)d_in[i];
    p.out = (float*)d_out; p.ws = (unsigned char*)d_ws;
    void* args[] = {&p};
    hipError_t e = hipLaunchCooperativeKernel((const void*)fwd_kernel, dim3(grid_blocks), dim3(NTHR), args, LDS_BYTES, stream);
    if (e != hipSuccess) fprintf(stderr, "cooperative launch failed: %s (grid %d)\n", hipGetErrorString(e), grid_blocks);
}
```

```cpp
#include <hip/hip_runtime.h>
#include <hip/hip_cooperative_groups.h>
#include <cstdio>
#include <cstdint>
namespace cg = cooperative_groups;

typedef unsigned short bf16_t;
typedef short bf16x8 __attribute__((ext_vector_type(8)));
typedef float f32x4 __attribute__((ext_vector_type(4)));
typedef unsigned u32x4 __attribute__((ext_vector_type(4)));
typedef unsigned u32x2 __attribute__((ext_vector_type(2)));
typedef _Float16 f16x8 __attribute__((ext_vector_type(8)));
typedef _Float16 f16x4 __attribute__((ext_vector_type(4)));
typedef _Float16 f16x2 __attribute__((ext_vector_type(2)));

constexpr int DM = 1024, NB = 16, SEQ = 4096, NTOK = NB * SEQ, CTXL = 256, NCTX = NB * CTXL;
constexpr int PROJW = 2304, HYW = 512, HYPW = 1536, KOFF = 512, VOFF = 640, HYOFF = 768;
constexpr int NEXP = 32, EHID = 512, NCLS = 112;
constexpr float EPSN = 1e-6f;
constexpr int NTHR = 512;

constexpr size_t MiB = 1u << 20;
constexpr size_t WS_CTL = 0, WS_MOD = 1 * MiB, WS_WINT = 2 * MiB, WS_WOUTT = 7 * MiB, WS_TAPS = 9 * MiB, WS_EW13 = 41 * MiB, WS_EW2T = 105 * MiB;
constexpr size_t WS_GATE = 137 * MiB, WS_KVC = 139 * MiB, WS_HC = 141 * MiB, WS_LIST = 149 * MiB, WS_H = 177 * MiB, WS_QKV = 305 * MiB, WS_UT = 401 * MiB;
constexpr size_t WS_HYT = 593 * MiB, WS_ATTHY = 657 * MiB, WS_HID = 305 * MiB, WS_KH = 785 * MiB, WS_END = 817 * MiB;
constexpr size_t WS_FTAB = 65536, WS_GTAB = 81920, WS_FKTAB = 98304;

struct Params {
    const float* x; const float* c; const float* ctx; const float* c_ctx; const float* ada_w; const float* ada_b; const float* norm1_w; const float* w_in;
    const float* q_norm_w; const float* k_norm_w; const float* attn_sink; const float* hy_conv_w; const float* hy_conv_b; const float* hy_w1; const float* hy_b1;
    const float* hy_w2; const float* hy_b2; const float* hy_w3; const float* hy_sin_freq; const float* hy_skip; const float* group_norm_w; const float* w_out;
    const float* norm2_w; const float* router_g_w; const float* router_g_b; const float* router_e_w; const float* router_e_b; const float* exp_w1; const float* exp_w3;
    const float* exp_w2;
    float* out; unsigned char* ws;
};

__device__ __forceinline__ unsigned f2bf(float f) { unsigned u = __builtin_bit_cast(unsigned, f); return (u + 0x7fffu + ((u >> 16) & 1u)) >> 16; }
__device__ __forceinline__ unsigned pk2(float lo, float hi) { return f2bf(lo) | (f2bf(hi) << 16); }
__device__ __forceinline__ float bf2f(unsigned short b) { return __builtin_bit_cast(float, (unsigned)b << 16); }
__device__ __forceinline__ float bflo(unsigned w) { return __builtin_bit_cast(float, w << 16); }
__device__ __forceinline__ float bfhi(unsigned w) { return __builtin_bit_cast(float, w & 0xffff0000u); }
__device__ __forceinline__ unsigned pkh2(float lo, float hi) { f16x2 v = {(_Float16)lo, (_Float16)hi}; return __builtin_bit_cast(unsigned, v); }
__device__ __forceinline__ float h2f(unsigned short h) { return (float)__builtin_bit_cast(_Float16, h); }
__device__ __forceinline__ float hlo(unsigned w) { return h2f((unsigned short)(w & 0xffffu)); }
__device__ __forceinline__ float hhi(unsigned w) { return h2f((unsigned short)(w >> 16)); }
__device__ __forceinline__ float wave_sum(float v) {
#pragma unroll
    for (int o = 1; o < 64; o <<= 1) v += __shfl_xor(v, o);
    return v;
}
__device__ __forceinline__ float siluf(float v) { return v / (1.f + __expf(-v)); }
__device__ __forceinline__ float sin_rad(float a) { float r = a * 0.15915494309189535f; r -= floorf(r); return __builtin_amdgcn_sinf(r); }
__device__ __forceinline__ float cos_rad(float a) { float r = a * 0.15915494309189535f; r -= floorf(r); return __builtin_amdgcn_cosf(r); }

template <class SrcA, class SrcB>
__device__ __forceinline__ void gemm_unit(unsigned char* lds, f32x4 (&acc)[2][2][4][2], const SrcA& srcA, const SrcB& srcB) {
    const int tid = threadIdx.x, wid = tid >> 6, lane = tid & 63, wr = wid >> 2, wc = wid & 3, fr = lane & 15, fq = lane >> 4;
#pragma unroll
    for (int a = 0; a < 2; ++a)
#pragma unroll
        for (int b = 0; b < 2; ++b)
#pragma unroll
            for (int m = 0; m < 4; ++m)
#pragma unroll
                for (int n = 0; n < 2; ++n) acc[a][b][m][n] = (f32x4){0.f, 0.f, 0.f, 0.f};
    const int r0 = tid >> 2, kc = tid & 3;
    const bf16_t* pa0 = srcA(r0) + kc * 8; const bf16_t* pa1 = srcA(r0 + 128) + kc * 8;
    u32x4 ra0, ra1, rb0, rb1;
    ra0 = *(const u32x4*)(pa0); ra1 = *(const u32x4*)(pa1);
    rb0 = *(const u32x4*)(srcB(r0, 0) + kc * 8); rb1 = *(const u32x4*)(srcB(r0 + 128, 0) + kc * 8);
    unsigned char* sA = lds; unsigned char* sB = lds + 16384;
    for (int ks = 0; ks < 32; ++ks) {
        __syncthreads();
        *(u32x4*)(sA + tid * 16) = ra0; *(u32x4*)(sA + 8192 + tid * 16) = ra1;
        *(u32x4*)(sB + tid * 16) = rb0; *(u32x4*)(sB + 8192 + tid * 16) = rb1;
        __syncthreads();
        if (ks + 1 < 32) {
            ra0 = *(const u32x4*)(pa0 + (ks + 1) * 32); ra1 = *(const u32x4*)(pa1 + (ks + 1) * 32);
            rb0 = *(const u32x4*)(srcB(r0, ks + 1) + kc * 8); rb1 = *(const u32x4*)(srcB(r0 + 128, ks + 1) + kc * 8);
        }
        bf16x8 Af[2][4], Bf[2][2];
#pragma unroll
        for (int a = 0; a < 2; ++a)
#pragma unroll
            for (int m = 0; m < 4; ++m) Af[a][m] = *(const bf16x8*)(sA + (128 * a + 64 * wr + 16 * m + fr) * 64 + fq * 16);
#pragma unroll
        for (int b = 0; b < 2; ++b)
#pragma unroll
            for (int n = 0; n < 2; ++n) Bf[b][n] = *(const bf16x8*)(sB + (128 * b + 32 * wc + 16 * n + fr) * 64 + fq * 16);
#pragma unroll
        for (int a = 0; a < 2; ++a)
#pragma unroll
            for (int b = 0; b < 2; ++b)
#pragma unroll
                for (int m = 0; m < 4; ++m)
#pragma unroll
                    for (int n = 0; n < 2; ++n) acc[a][b][m][n] = __builtin_amdgcn_mfma_f32_16x16x32_bf16(Bf[b][n], Af[a][m], acc[a][b][m][n], 0, 0, 0);
    }
}
#define ACC_FOREACH(acc, BODY) do { \
    const int _wid = threadIdx.x >> 6, _lane = threadIdx.x & 63, _wr = _wid >> 2, _wc = _wid & 3, _fr = _lane & 15, _fq = _lane >> 4; \
    _Pragma("unroll") for (int _a = 0; _a < 2; ++_a) _Pragma("unroll") for (int _m = 0; _m < 4; ++_m) _Pragma("unroll") for (int _b = 0; _b < 2; ++_b) _Pragma("unroll") for (int _n = 0; _n < 2; ++_n) { \
        const int rl = 128 * _a + 64 * _wr + 16 * _m + _fr, cl = 128 * _b + 32 * _wc + 16 * _n + 4 * _fq; const f32x4 v = acc[_a][_b][_m][_n]; BODY } } while (0)

__device__ __forceinline__ void p0_adaln(const Params& p, int it, unsigned char* lds) {
    float* S = (float*)lds;
    float* R = (float*)(lds + 17 * 1024 * 4);
    const int tid = threadIdx.x;
    __syncthreads();
    for (int i = tid; i < 17 * 1024; i += NTHR) { const int r = i >> 10, k = i & 1023; const float v = (r < 16) ? p.c[r * 1024 + k] : p.c_ctx[k]; S[i] = siluf(v); }
    __syncthreads();
    const int col = tid & 63, sl = tid >> 6, n = it * 64 + col;
    float a[17];
#pragma unroll
    for (int r = 0; r < 17; ++r) a[r] = 0.f;
    for (int k = sl * 128; k < sl * 128 + 128; ++k) {
        const float w = p.ada_w[(size_t)k * 6144 + n];
#pragma unroll
        for (int r = 0; r < 17; ++r) a[r] += S[r * 1024 + k] * w;
    }
#pragma unroll
    for (int r = 0; r < 17; ++r) R[(sl * 17 + r) * 64 + col] = a[r];
    __syncthreads();
    float* MOD = (float*)(p.ws + WS_MOD);
    for (int i = tid; i < 17 * 64; i += NTHR) { const int r = i >> 6, cc = i & 63; float s = 0.f;
#pragma unroll
        for (int q = 0; q < 8; ++q) s += R[(q * 17 + r) * 64 + cc];
        MOD[r * 6144 + it * 64 + cc] = s + p.ada_b[it * 64 + cc]; }
}

__device__ __forceinline__ void p0_taps(const Params& p, int it, unsigned char* lds) {
    float* FE = (float*)lds;
    float* H1 = FE + 16 * 36;
    float* H2 = H1 + 16 * 64;
    const int tid = threadIdx.x, p0 = it * 16;
    __syncthreads();
    if (tid < 256) { const int pp = tid >> 4, j = tid & 15; const float pos = (float)(p0 + pp);
        const float band = 1e-4f + (float)j * ((15.f - 1e-4f) / 15.f);
        float rev = pos * band * (1.f / 4096.f); rev -= floorf(rev);
        FE[pp * 36 + 1 + j] = __builtin_amdgcn_cosf(rev); FE[pp * 36 + 17 + j] = -__builtin_amdgcn_sinf(rev);
        if (j == 0) FE[pp * 36] = pos * (1.f / 4096.f); }
    __syncthreads();
    for (int i = tid; i < 1024; i += NTHR) { const int pp = i >> 6, j = i & 63; float s = p.hy_b1[j];
        for (int q = 0; q < 33; ++q) s += FE[pp * 36 + q] * p.hy_w1[q * 64 + j];
        H1[pp * 64 + j] = sin_rad(p.hy_sin_freq[j] * s); }
    __syncthreads();
    for (int i = tid; i < 1024; i += NTHR) { const int pp = i >> 6, j = i & 63; float s = p.hy_b2[j];
        for (int q = 0; q < 64; ++q) s += H1[pp * 64 + q] * p.hy_w2[q * 64 + j];
        H2[pp * 64 + j] = sin_rad(p.hy_sin_freq[64 + j] * s); }
    __syncthreads();
    float* TAPS = (float*)(p.ws + WS_TAPS);
    const float mind = -3.0701134573253945f, maxd = -15.350567286626972f;
#pragma unroll 1
    for (int q = 0; q < 4; ++q) {
        const int col = tid + 512 * q, o = col >> 10, dir = (col >> 9) & 1, c = col & 511;
        float w[64];
#pragma unroll
        for (int i = 0; i < 64; ++i) w[i] = p.hy_w3[i * 2048 + col];
        const float delta = fabsf(mind + (maxd - mind) * ((float)c / 511.f));
        float* tp = TAPS + ((size_t)(o * 512 + c)) * 8192;
#pragma unroll 1
        for (int pp = 0; pp < 16; ++pp) {
            float s = 0.f;
#pragma unroll
            for (int i = 0; i < 64; ++i) s += H2[pp * 64 + i] * w[i];
            const int pos = p0 + pp; const float t = (float)pos * (1.f / 4096.f);
            const float val = s * __expf(-t * delta);
            if (dir == 0) tp[4096 + pos] = val; else { if (pos == 0) tp[0] = 0.f; else tp[4096 - pos] = val; }
        }
    }
}

__device__ __forceinline__ void p0_transpose(const float* src, int N, int k0, int n0, bf16_t* dst, int dpitch, int mode, const float* kscale, unsigned char* lds) {
    float* T = (float*)lds;
    const int tid = threadIdx.x;
    __syncthreads();
#pragma unroll
    for (int i = 0; i < 8; ++i) { const int kk = i * 8 + (tid >> 6), nn = tid & 63; float v = src[(size_t)(k0 + kk) * N + n0 + nn]; if (kscale) v *= kscale[k0 + kk]; T[kk * 65 + nn] = v; }
    __syncthreads();
    const int n = tid >> 3, kch = tid & 7, col = n0 + n;
    int drow = col;
    if (mode == 1) drow = (col >> 7) * 256 + (col & 127);
    else if (mode == 2) drow = (col >> 7) * 256 + 128 + (col & 127);
    u32x4 o;
    o.x = pk2(T[(kch * 8 + 0) * 65 + n], T[(kch * 8 + 1) * 65 + n]); o.y = pk2(T[(kch * 8 + 2) * 65 + n], T[(kch * 8 + 3) * 65 + n]);
    o.z = pk2(T[(kch * 8 + 4) * 65 + n], T[(kch * 8 + 5) * 65 + n]); o.w = pk2(T[(kch * 8 + 6) * 65 + n], T[(kch * 8 + 7) * 65 + n]);
    *(u32x4*)(dst + (size_t)drow * dpitch + k0 + kch * 8) = o;
}


__device__ __forceinline__ void p0_tables(const Params& p, int it) {
    const int e = it * NTHR + threadIdx.x;
    _Float16* FT = (_Float16*)(p.ws + WS_FTAB); _Float16* GT = (_Float16*)(p.ws + WS_GTAB); _Float16* FK = (_Float16*)(p.ws + WS_FKTAB);
    if (e < 8192) { const int rho = e >> 6, s1 = e & 63, f = rho >> 1; float v;
        if (rho == 0) v = 1.f; else if (rho == 1) v = (s1 & 1) ? -1.f : 1.f;
        else { const float rev = (float)((f * s1) & 127) * (1.f / 128.f); v = (rho & 1) ? -__builtin_amdgcn_sinf(rev) : __builtin_amdgcn_cosf(rev); }
        FT[e] = (_Float16)v;
    } else if (e < 16384) { const int q = e - 8192, t1 = q >> 7, rho = q & 127, f = rho >> 1; float v;
        if (rho == 0) v = 1.f / 128.f; else if (rho == 1) v = ((t1 & 1) ? -1.f : 1.f) / 128.f;
        else { const float rev = (float)((f * t1) & 127) * (1.f / 128.f); v = ((rho & 1) ? -__builtin_amdgcn_sinf(rev) : __builtin_amdgcn_cosf(rev)) * (2.f / 128.f); }
        GT[q] = (_Float16)v;
    } else { const int q = e - 16384, rho = q >> 7, dp = q & 127, d = dp - 64, f = rho >> 1; float v;
        if (rho == 0) v = 1.f; else if (rho == 1) v = (d & 1) ? -1.f : 1.f;
        else { const float rev = (float)((f * d) & 127) * (1.f / 128.f); v = (rho & 1) ? -__builtin_amdgcn_sinf(rev) : __builtin_amdgcn_cosf(rev); }
        FK[q] = (_Float16)v;
    }
}

__device__ __forceinline__ void phase0(const Params& p, unsigned char* lds) {
    constexpr int I_WIN = 16 * 36, I_WOUT = 16 * 16, I_W1 = 32 * 16 * 8, I_W2 = 32 * 8 * 16;
    constexpr int NTR = I_WIN + I_WOUT + 2 * I_W1 + I_W2;
    if (blockIdx.x == 0 && threadIdx.x < 128) ((int*)(p.ws + WS_CTL))[threadIdx.x] = 0;
    for (int it = blockIdx.x; it < 64; it += gridDim.x) p0_tables(p, it);
    for (int it = blockIdx.x; it < 96; it += gridDim.x) p0_adaln(p, it, lds);
    for (int it = (blockIdx.x + 160) % gridDim.x; it < 256; it += gridDim.x) p0_taps(p, it, lds);
    for (int it = blockIdx.x; it < NTR; it += gridDim.x) {
        int r = it; const float* src; int N, k0, n0, dpitch, mode = 0; bf16_t* dst;
        if (r < I_WIN) { src = p.w_in; N = PROJW; k0 = (r / 36) * 64; n0 = (r % 36) * 64; dst = (bf16_t*)(p.ws + WS_WINT); dpitch = 1024; }
        else if ((r -= I_WIN) < I_WOUT) { src = p.w_out; N = 1024; k0 = (r / 16) * 64; n0 = (r % 16) * 64; dst = (bf16_t*)(p.ws + WS_WOUTT); dpitch = 1024; }
        else if ((r -= I_WOUT) < 2 * I_W1) { const int w3 = r >= I_W1; if (w3) r -= I_W1; const int e = r / 128, q = r % 128; src = (w3 ? p.exp_w3 : p.exp_w1) + (size_t)e * 1024 * 512; N = 512; k0 = (q / 8) * 64; n0 = (q % 8) * 64;
            dst = (bf16_t*)(p.ws + WS_EW13) + (size_t)e * 1024 * 1024; dpitch = 1024; mode = w3 ? 2 : 1; }
        else { r -= 2 * I_W1; const int e = r / 128, q = r % 128; src = p.exp_w2 + (size_t)e * 512 * 1024; N = 1024; k0 = (q / 16) * 64; n0 = (q % 16) * 64; dst = (bf16_t*)(p.ws + WS_EW2T) + (size_t)e * 1024 * 512; dpitch = 512; }
        p0_transpose(src, N, k0, n0, dst, dpitch, mode, nullptr, lds);
    }
}

__device__ __forceinline__ void phase1(const Params& p) {
    const int lane = threadIdx.x & 63, gw = blockIdx.x * 8 + (threadIdx.x >> 6), ngw = gridDim.x * 8;
    const float* MOD = (const float*)(p.ws + WS_MOD);
    for (int row = gw; row < NTOK + NCTX; row += ngw) {
        const bool lat = row < NTOK; const int rr = lat ? row : row - NTOK;
        const float* xr = (lat ? p.x : p.ctx) + (size_t)rr * 1024;
        const float* md = MOD + (size_t)(lat ? (rr >> 12) : 16) * 6144;
        bf16_t* orow = (bf16_t*)(p.ws + (lat ? WS_H : WS_HC)) + (size_t)rr * 1024;
        f32x4 v[4]; float s = 0.f;
#pragma unroll
        for (int j = 0; j < 4; ++j) { v[j] = *(const f32x4*)(xr + 256 * j + lane * 4); s += v[j].x * v[j].x + v[j].y * v[j].y + v[j].z * v[j].z + v[j].w * v[j].w; }
        const float rstd = rsqrtf(wave_sum(s) * (1.f / 1024.f) + EPSN);
#pragma unroll
        for (int j = 0; j < 4; ++j) { const int k = 256 * j + lane * 4;
            const f32x4 nw = *(const f32x4*)(p.norm1_w + k), sh = *(const f32x4*)(md + k), sc = *(const f32x4*)(md + 1024 + k);
            const f32x4 y = (v[j] * rstd) * nw * (sc + 1.f) + sh;
            u32x2 o; o.x = pk2(y.x, y.y); o.y = pk2(y.z, y.w); *(u32x2*)(orow + k) = o; }
    }
}

__device__ __forceinline__ void phase2(const Params& p, unsigned char* lds) {
    const bf16_t* H = (const bf16_t*)(p.ws + WS_H); const bf16_t* HC = (const bf16_t*)(p.ws + WS_HC); const bf16_t* WT = (const bf16_t*)(p.ws + WS_WINT);
    bf16_t* QKV = (bf16_t*)(p.ws + WS_QKV); bf16_t* UT = (bf16_t*)(p.ws + WS_UT); bf16_t* KVC = (bf16_t*)(p.ws + WS_KVC);
    f32x4 acc[2][2][4][2];
    for (int u = blockIdx.x; u < 2320; u += gridDim.x) {
        if (u < 768) { const int pm = u / 3, pn = u % 3; const bf16_t* a0 = H + (size_t)pm * 256 * 1024; const bf16_t* b0 = WT + (size_t)pn * 256 * 1024;
            gemm_unit(lds, acc, [&](int r) { return a0 + (size_t)r * 1024; }, [&](int r, int ks) { return b0 + (size_t)r * 1024 + ks * 32; });
            ACC_FOREACH(acc, { u32x2 o; o.x = pk2(v.x, v.y); o.y = pk2(v.z, v.w); *(u32x2*)(QKV + (size_t)(pm * 256 + rl) * 768 + pn * 256 + cl) = o; });
        } else if (u < 2304) { const int vv = u - 768, pn = vv / 6, pm = vv % 6; const bf16_t* a0 = WT + (size_t)(768 + pm * 256) * 1024; const bf16_t* b0 = H + (size_t)pn * 256 * 1024;
            gemm_unit(lds, acc, [&](int r) { return a0 + (size_t)r * 1024; }, [&](int r, int ks) { return b0 + (size_t)r * 1024 + ks * 32; });
            const int tok0 = pn * 256, bb = tok0 >> 12, t0 = tok0 & 4095;
            ACC_FOREACH(acc, { u32x2 o; o.x = pkh2(v.x, v.y); o.y = pkh2(v.z, v.w); *(u32x2*)(UT + ((size_t)(bb * 1536 + pm * 256 + rl)) * 4096 + t0 + cl) = o; });
        } else { const int pm = u - 2304; const bf16_t* a0 = HC + (size_t)pm * 256 * 1024; const bf16_t* b0 = WT + (size_t)512 * 1024;
            gemm_unit(lds, acc, [&](int r) { return a0 + (size_t)r * 1024; }, [&](int r, int ks) { return b0 + (size_t)r * 1024 + ks * 32; });
            ACC_FOREACH(acc, { u32x2 o; o.x = pk2(v.x, v.y); o.y = pk2(v.z, v.w); *(u32x2*)(KVC + (size_t)(pm * 256 + rl) * 256 + cl) = o; });
        }
    }
}

__device__ __forceinline__ void phase3(const Params& p) {
    const int lane = threadIdx.x & 63, gw = blockIdx.x * 8 + (threadIdx.x >> 6), ngw = gridDim.x * 8;
    bf16_t* QKV = (bf16_t*)(p.ws + WS_QKV); bf16_t* KVC = (bf16_t*)(p.ws + WS_KVC);
    const float qw = p.q_norm_w[lane], kw = p.k_norm_w[lane];
    const int i16 = lane & 15; const float invf = exp2f(-(float)i16 * (13.287712379549449f / 16.f));
    for (int row = gw; row < NTOK + NCTX; row += ngw) {
        if (row < NTOK) {
            const int pos = row & 4095; const float ang = (float)((lane & 32) ? (pos & 63) : (pos >> 6)) * invf;
            const float cs = cos_rad(ang), sn = sin_rad(ang);
            bf16_t* rp = QKV + (size_t)row * 768;
#pragma unroll
            for (int hh = 0; hh < 10; ++hh) {
                const float xv = bf2f(rp[hh * 64 + lane]);
                const float rstd = rsqrtf(wave_sum(xv * xv) * (1.f / 64.f) + EPSN);
                const float y = xv * rstd * (hh < 8 ? qw : kw);
                const float pr = __shfl_xor(y, 16);
                const float o = (lane & 16) ? (y * cs + pr * sn) : (y * cs - pr * sn);
                rp[hh * 64 + lane] = (bf16_t)f2bf(o);
            }
        } else {
            bf16_t* rp = KVC + (size_t)(row - NTOK) * 256;
#pragma unroll
            for (int hh = 0; hh < 2; ++hh) {
                const float xv = bf2f(rp[hh * 64 + lane]);
                const float rstd = rsqrtf(wave_sum(xv * xv) * (1.f / 64.f) + EPSN);
                rp[hh * 64 + lane] = (bf16_t)f2bf(xv * rstd * kw);
            }
        }
    }
}

__device__ __forceinline__ void attn_unit(const Params& p, int u, unsigned char* lds) {
    const int tid = threadIdx.x, wid = tid >> 6, lane = tid & 63, fr = lane & 15, fq = lane >> 4;
    const int b = u >> 6, kvh = (u >> 5) & 1, qb = u & 31, q0 = qb * 128;
    const bf16_t* QKV = (const bf16_t*)(p.ws + WS_QKV); const bf16_t* KVC = (const bf16_t*)(p.ws + WS_KVC);
    bf16_t* ATT = (bf16_t*)(p.ws + WS_ATTHY);
    unsigned char* sK = lds;
    unsigned char* sV = lds + 64 * 144;
    const int h = kvh * 4 + (wid >> 1), qrow0 = q0 + 64 * (wid & 1);
    bf16x8 qf[4][2];
#pragma unroll
    for (int qt = 0; qt < 4; ++qt)
#pragma unroll
        for (int ks = 0; ks < 2; ++ks) qf[qt][ks] = *(const bf16x8*)(QKV + (size_t)(b * 4096 + qrow0 + 16 * qt + fr) * 768 + h * 64 + 32 * ks + 8 * fq);
    const float LOG2E = 1.4426950408889634f, SC = 0.125f * LOG2E;
    float mrow[4], lrow[4]; f32x4 ot[4][4];
    const float sink2 = p.attn_sink[h] * LOG2E;
#pragma unroll
    for (int qt = 0; qt < 4; ++qt) { mrow[qt] = sink2; lrow[qt] = (fq == 0) ? 1.f : 0.f;
#pragma unroll
        for (int dt = 0; dt < 4; ++dt) ot[dt][qt] = (f32x4){0.f, 0.f, 0.f, 0.f}; }
    for (int tile = 0; tile < 10; ++tile) {
        const bool isctx = tile < 4; const int kbase = isctx ? tile * 64 : q0 - 128 + (tile - 4) * 64;
        if (!isctx && (kbase < 0 || kbase >= SEQ)) continue;
        __syncthreads();
        {
            const int kr = tid >> 3, ch = tid & 7;
            const bf16_t* krow = isctx ? KVC + (size_t)(b * 256 + kbase + kr) * 256 + kvh * 64 : QKV + (size_t)(b * 4096 + kbase + kr) * 768 + KOFF + kvh * 64;
            const bf16_t* vrow = isctx ? KVC + (size_t)(b * 256 + kbase + kr) * 256 + 128 + kvh * 64 : QKV + (size_t)(b * 4096 + kbase + kr) * 768 + VOFF + kvh * 64;
            const u32x4 kv = *(const u32x4*)(krow + ch * 8); const u32x4 vv = *(const u32x4*)(vrow + ch * 8);
            *(u32x4*)(sK + kr * 144 + ch * 16) = kv;
            bf16_t* sv = (bf16_t*)sV;
            sv[(ch * 8 + 0) * 72 + kr] = (bf16_t)(vv.x & 0xffff); sv[(ch * 8 + 1) * 72 + kr] = (bf16_t)(vv.x >> 16);
            sv[(ch * 8 + 2) * 72 + kr] = (bf16_t)(vv.y & 0xffff); sv[(ch * 8 + 3) * 72 + kr] = (bf16_t)(vv.y >> 16);
            sv[(ch * 8 + 4) * 72 + kr] = (bf16_t)(vv.z & 0xffff); sv[(ch * 8 + 5) * 72 + kr] = (bf16_t)(vv.z >> 16);
            sv[(ch * 8 + 6) * 72 + kr] = (bf16_t)(vv.w & 0xffff); sv[(ch * 8 + 7) * 72 + kr] = (bf16_t)(vv.w >> 16);
        }
        __syncthreads();
        f32x4 st[4][4];
#pragma unroll
        for (int kt = 0; kt < 4; ++kt) {
            const bf16x8 k0 = *(const bf16x8*)(sK + (16 * kt + fr) * 144 + fq * 16), k1 = *(const bf16x8*)(sK + (16 * kt + fr) * 144 + 64 + fq * 16);
#pragma unroll
            for (int qt = 0; qt < 4; ++qt) { f32x4 z = (f32x4){0.f, 0.f, 0.f, 0.f};
                z = __builtin_amdgcn_mfma_f32_16x16x32_bf16(k0, qf[qt][0], z, 0, 0, 0); z = __builtin_amdgcn_mfma_f32_16x16x32_bf16(k1, qf[qt][1], z, 0, 0, 0); st[kt][qt] = z; }
        }
#pragma unroll
        for (int qt = 0; qt < 4; ++qt) {
            const int qpos = qrow0 + 16 * qt + fr;
            float tmax = -3.0e38f;
#pragma unroll
            for (int kt = 0; kt < 4; ++kt)
#pragma unroll
                for (int r = 0; r < 4; ++r) { float s = st[kt][qt][r] * SC;
                    if (!isctx) { const int kp = kbase + 16 * kt + 4 * fq + r; const int dd = kp - qpos; if (dd > 128 || dd < -128) s = -1e30f; }
                    st[kt][qt][r] = s; tmax = fmaxf(tmax, s); }
            tmax = fmaxf(tmax, __shfl_xor(tmax, 16)); tmax = fmaxf(tmax, __shfl_xor(tmax, 32));
            const float mnew = fmaxf(mrow[qt], tmax), alpha = exp2f(mrow[qt] - mnew);
            mrow[qt] = mnew; float ls = 0.f;
#pragma unroll
            for (int kt = 0; kt < 4; ++kt)
#pragma unroll
                for (int r = 0; r < 4; ++r) { const float pv = exp2f(st[kt][qt][r] - mnew); st[kt][qt][r] = pv; ls += pv; }
            lrow[qt] = lrow[qt] * alpha + ls;
#pragma unroll
            for (int dt = 0; dt < 4; ++dt) ot[dt][qt] = ot[dt][qt] * alpha;
        }
#pragma unroll
        for (int ks = 0; ks < 2; ++ks) {
            bf16x8 pf[4];
#pragma unroll
            for (int qt = 0; qt < 4; ++qt) { const f32x4 a = st[2 * ks][qt], c = st[2 * ks + 1][qt];
                u32x4 w; w.x = pk2(a.x, a.y); w.y = pk2(a.z, a.w); w.z = pk2(c.x, c.y); w.w = pk2(c.z, c.w); pf[qt] = __builtin_bit_cast(bf16x8, w); }
#pragma unroll
            for (int dt = 0; dt < 4; ++dt) {
                const u32x2 v0 = *(const u32x2*)(sV + (16 * dt + fr) * 144 + (32 * ks + 4 * fq) * 2), v1 = *(const u32x2*)(sV + (16 * dt + fr) * 144 + (32 * ks + 16 + 4 * fq) * 2);
                u32x4 w; w.x = v0.x; w.y = v0.y; w.z = v1.x; w.w = v1.y; const bf16x8 vf = __builtin_bit_cast(bf16x8, w);
#pragma unroll
                for (int qt = 0; qt < 4; ++qt) ot[dt][qt] = __builtin_amdgcn_mfma_f32_16x16x32_bf16(vf, pf[qt], ot[dt][qt], 0, 0, 0);
            }
        }
    }
#pragma unroll
    for (int qt = 0; qt < 4; ++qt) {
        float l = lrow[qt]; l += __shfl_xor(l, 16); l += __shfl_xor(l, 32);
        const float inv = 1.f / l;
        bf16_t* orow = ATT + (size_t)(b * 4096 + qrow0 + 16 * qt + fr) * 1024 + h * 64;
#pragma unroll
        for (int dt = 0; dt < 4; ++dt) { const f32x4 o = ot[dt][qt] * inv; u32x2 w; w.x = pk2(o.x, o.y); w.y = pk2(o.z, o.w); *(u32x2*)(orow + 16 * dt + 4 * fq) = w; }
    }
}

__device__ __forceinline__ void khat_item(const Params& p, int it, unsigned char* lds) {
    const int tid = threadIdx.x, wid = tid >> 6, lane = tid & 63, fr = lane & 15, fq = lane >> 4;
    _Float16* TT = (_Float16*)lds;
    const float* tp = (const float*)(p.ws + WS_TAPS) + (size_t)it * 8192;
    __syncthreads();
    for (int i = tid; i < 128 * 136 / 2; i += NTHR) ((unsigned*)lds)[i] = 0u;
    __syncthreads();
#pragma unroll
    for (int q = 0; q < 4; ++q) {
        const int i0 = tid * 16 + q * 4; const f32x4 v = *(const f32x4*)(tp + i0);
#pragma unroll
        for (int e = 0; e < 4; ++e) { const int i = i0 + e, i1 = i >> 6, i2 = i & 63; const _Float16 h = (_Float16)v[e];
            if (i1 >= 1) TT[(i2 + 63) * 136 + i1] = h;
            if (i2 >= 1 && i1 + 1 < 128) TT[(i2 - 1) * 136 + i1 + 1] = h; }
    }
    __syncthreads();
    const _Float16* FK = (const _Float16*)(p.ws + WS_FKTAB);
    f16x8 af[4];
#pragma unroll
    for (int ks = 0; ks < 4; ++ks) af[ks] = *(const f16x8*)(TT + (16 * wid + fr) * 136 + 32 * ks + 8 * fq);
    _Float16* KH = (_Float16*)(p.ws + WS_KH) + (size_t)it * (64 * 2 * 128);
#pragma unroll
    for (int nt = 0; nt < 8; ++nt) {
        f32x4 acc = (f32x4){0.f, 0.f, 0.f, 0.f};
#pragma unroll
        for (int ks = 0; ks < 4; ++ks) { const f16x8 bfv = *(const f16x8*)(FK + (16 * nt + fr) * 128 + 32 * ks + 8 * fq); acc = __builtin_amdgcn_mfma_f32_16x16x32_f16(af[ks], bfv, acc, 0, 0, 0); }
        const int rho = 16 * nt + fr; u32x2 o; o.x = pkh2(acc[3], acc[2]); o.y = pkh2(acc[1], acc[0]);
        *(u32x2*)(KH + (size_t)rho * 128 + (124 - 16 * wid - 4 * fq)) = o;
    }
}

constexpr int HY_ZB = 0, HY_ZH = 73728, HY_OH = 92160, HY_GT = 112640, HY_KC = 145408, HY_LDS_END = 145408 + 8 * 576;
__device__ __forceinline__ f16x8 neg8(f16x8 v) { u32x4 w = __builtin_bit_cast(u32x4, v); w.x ^= 0x80008000u; w.y ^= 0x80008000u; w.z ^= 0x80008000u; w.w ^= 0x80008000u; return __builtin_bit_cast(f16x8, w); }
__device__ __forceinline__ void hyena_item(const Params& p, int it, unsigned char* lds) {
    const int tid = threadIdx.x, wid = tid >> 6, lane = tid & 63, fr = lane & 15, fq = lane >> 4;
    const int c = it >> 1, b = (it & 1) * 8 + wid;
    _Float16* ZB = (_Float16*)(lds + HY_ZB) + wid * (64 * 72);
    _Float16* ZH = (_Float16*)(lds + HY_ZH);
    _Float16* OH = (_Float16*)(lds + HY_OH);
    _Float16* GTW = (_Float16*)(lds + HY_GT) + wid * 2048;
    _Float16* KC = (_Float16*)(lds + HY_KC) + wid * 288;
    const _Float16* UT = (const _Float16*)(p.ws + WS_UT); const _Float16* FT = (const _Float16*)(p.ws + WS_FTAB); const _Float16* GT = (const _Float16*)(p.ws + WS_GTAB);
    bf16_t* HYT = (bf16_t*)(p.ws + WS_HYT);
    __syncthreads();
    if (lane < 32) KC[(lane >> 4) * 144 + 128 + (lane & 15)] = (_Float16)0.f;
    {   const _Float16* ur = UT + ((size_t)(b * 1536 + c)) * 4096;
        const float w0 = p.hy_conv_w[c], w1 = p.hy_conv_w[1536 + c], w2 = p.hy_conv_w[3072 + c], bb = p.hy_conv_b[c];
#pragma unroll 2
        for (int i8 = 0; i8 < 8; ++i8) { const int t0 = 8 * (lane + 64 * i8);
            const f16x8 raw = *(const f16x8*)(ur + t0); float uv[10];
            uv[0] = (t0 > 0) ? (float)ur[t0 - 1] : 0.f; uv[9] = (t0 + 8 < 4096) ? (float)ur[t0 + 8] : 0.f;
#pragma unroll
            for (int i = 0; i < 8; ++i) uv[1 + i] = (float)raw[i];
            const int s1 = t0 >> 6, s2 = t0 & 63;
#pragma unroll
            for (int i = 0; i < 8; ++i) ZB[(s2 + i) * 72 + s1] = (_Float16)(bb + uv[i] * w0 + uv[i + 1] * w1 + uv[i + 2] * w2); }
    }
#pragma unroll 1
    for (int o = 0; o < 2; ++o) {
        f16x8 zf[4][2];
#pragma unroll
        for (int mt = 0; mt < 4; ++mt)
#pragma unroll
            for (int ks = 0; ks < 2; ++ks) zf[mt][ks] = *(const f16x8*)(ZB + (16 * mt + fr) * 72 + 32 * ks + 8 * fq);
        f32x4 accI[4][4];
#pragma unroll
        for (int mt = 0; mt < 4; ++mt)
#pragma unroll
            for (int nt = 0; nt < 4; ++nt) accI[mt][nt] = (f32x4){0.f, 0.f, 0.f, 0.f};
        const _Float16* KHo = (const _Float16*)(p.ws + WS_KH) + (size_t)(o * 512 + c) * (64 * 2 * 128);
#pragma unroll 1
        for (int j = 0; j < 8; ++j) {
            const int f = 8 * j + wid;
            if (lane < 32) *(u32x4*)(KC + (lane >> 4) * 144 + (lane & 15) * 8) = *(const u32x4*)(KHo + (size_t)f * 256 + lane * 8);
#pragma unroll
            for (int i = 0; i < 4; ++i) { const int v = lane + 64 * i, x = v >> 7, sg = (v >> 4) & 7, q = v & 15; const unsigned short* src = (const unsigned short*)(KC + x * 144 + 8 * q + sg + 1);
                u32x4 w; w.x = src[0] | ((unsigned)src[1] << 16); w.y = src[2] | ((unsigned)src[3] << 16); w.z = src[4] | ((unsigned)src[5] << 16); w.w = src[6] | ((unsigned)src[7] << 16);
                *(u32x4*)(GTW + v * 8) = w; }
            {   f16x8 ff[2];
#pragma unroll
                for (int ks = 0; ks < 2; ++ks) ff[ks] = *(const f16x8*)(FT + (16 * j + fr) * 64 + 32 * ks + 8 * fq);
#pragma unroll
                for (int mt = 0; mt < 4; ++mt) { f32x4 a = (f32x4){0.f, 0.f, 0.f, 0.f};
                    a = __builtin_amdgcn_mfma_f32_16x16x32_f16(zf[mt][0], ff[0], a, 0, 0, 0); a = __builtin_amdgcn_mfma_f32_16x16x32_f16(zf[mt][1], ff[1], a, 0, 0, 0);
                    u32x2 w; w.x = pkh2(a[0], a[1]); w.y = pkh2(a[2], a[3]);
                    *(u32x2*)(ZH + (((fr >> 1) * 8 + wid) * 2 + (fr & 1)) * 72 + 16 * mt + 4 * fq) = w; }
            }
            __syncthreads();
            {   const int bb = fr >> 1, part = fr & 1;
                f16x8 a1[2], a2[2];
#pragma unroll
                for (int ks = 0; ks < 2; ++ks) {
                    const f16x8 s1v = *(const f16x8*)(ZH + ((wid * 8 + bb) * 2 + part) * 72 + 32 * ks + 8 * fq);
                    const f16x8 s2v = *(const f16x8*)(ZH + ((wid * 8 + bb) * 2 + (1 - part)) * 72 + 32 * ks + 8 * fq);
                    const f16x8 zero = (f16x8){0, 0, 0, 0, 0, 0, 0, 0};
                    if (f == 0) { a1[ks] = part ? zero : s1v; a2[ks] = part ? s1v : zero; }
                    else { a1[ks] = s1v; a2[ks] = part ? s2v : neg8(s2v); }
                }
                const int sg = 7 - (fr & 7);
#pragma unroll
                for (int nt = 0; nt < 4; ++nt) { f32x4 a = (f32x4){0.f, 0.f, 0.f, 0.f};
                    const int qa = 7 - 2 * nt - (fr >> 3);
#pragma unroll
                    for (int ks = 0; ks < 2; ++ks) {
                        const f16x8 b1 = *(const f16x8*)(GTW + ((0 * 8 + sg) * 16 + qa + 4 * ks + fq) * 8);
                        const f16x8 b2 = *(const f16x8*)(GTW + ((1 * 8 + sg) * 16 + qa + 4 * ks + fq) * 8);
                        a = __builtin_amdgcn_mfma_f32_16x16x32_f16(a1[ks], b1, a, 0, 0, 0); a = __builtin_amdgcn_mfma_f32_16x16x32_f16(a2[ks], b2, a, 0, 0, 0); }
                    const int t2 = 16 * nt + fr;
                    *(unsigned*)(OH + ((2 * fq) * 64 + t2) * 20 + 2 * wid) = pkh2(a[0], a[1]);
                    *(unsigned*)(OH + ((2 * fq + 1) * 64 + t2) * 20 + 2 * wid) = pkh2(a[2], a[3]); }
            }
            __syncthreads();
            {   f16x4 gf[4];
#pragma unroll
                for (int nt = 0; nt < 4; ++nt) gf[nt] = *(const f16x4*)(GT + (16 * nt + fr) * 128 + 16 * j + 4 * fq);
#pragma unroll
                for (int mt = 0; mt < 4; ++mt) { const f16x4 av = *(const f16x4*)(OH + (wid * 64 + 16 * mt + fr) * 20 + 4 * fq);
#pragma unroll
                    for (int nt = 0; nt < 4; ++nt) accI[mt][nt] = __builtin_amdgcn_mfma_f32_16x16x16f16(av, gf[nt], accI[mt][nt], 0, 0, 0); }
            }
        }
        {   const int ch = (o + 1) * 512 + c; const _Float16* ur = UT + ((size_t)(b * 1536 + ch)) * 4096;
            const float w0 = p.hy_conv_w[ch], w1 = p.hy_conv_w[1536 + ch], w2 = p.hy_conv_w[3072 + ch], bb = p.hy_conv_b[ch], sk = p.hy_skip[o * 512 + c];
#pragma unroll
            for (int mt = 0; mt < 4; ++mt)
#pragma unroll
                for (int nt = 0; nt < 4; ++nt) { const int t1 = 16 * nt + fr, t2 = 16 * mt + 4 * fq, t = 64 * t1 + t2;
                    const f16x4 raw = *(const f16x4*)(ur + t); float uv[6];
                    uv[0] = (t > 0) ? (float)ur[t - 1] : 0.f; uv[5] = (t + 4 < 4096) ? (float)ur[t + 4] : 0.f;
#pragma unroll
                    for (int i = 0; i < 4; ++i) uv[1 + i] = (float)raw[i];
                    float zn[4];
#pragma unroll
                    for (int r = 0; r < 4; ++r) { const float xg = bb + uv[r] * w0 + uv[r + 1] * w1 + uv[r + 2] * w2; const float zo = (float)ZB[(t2 + r) * 72 + t1];
                        zn[r] = xg * (accI[mt][nt][r] + sk * zo); }
                    if (o == 0) {
#pragma unroll
                        for (int r = 0; r < 4; ++r) ZB[(t2 + r) * 72 + t1] = (_Float16)zn[r];
                    } else { u32x2 w; w.x = pk2(zn[0], zn[1]); w.y = pk2(zn[2], zn[3]); *(u32x2*)(HYT + ((size_t)(b * 512 + c)) * 4096 + t) = w; }
                }
        }
    }
}

__device__ __forceinline__ void phase5_item(const Params& p, int it, unsigned char* lds) {
    const int tid = threadIdx.x, b = it >> 6, t0 = (it & 63) * 64;
    bf16_t* TL = (bf16_t*)lds;
    float* RS = (float*)(lds + 512 * 66 * 2);
    float* RS2 = RS + 512;
    const bf16_t* HYT = (const bf16_t*)(p.ws + WS_HYT); bf16_t* AH = (bf16_t*)(p.ws + WS_ATTHY);
    __syncthreads();
    {   const bf16_t* src = HYT + ((size_t)(b * 512 + tid)) * 4096 + t0;
#pragma unroll
        for (int i = 0; i < 8; ++i) { const u32x4 v = *(const u32x4*)(src + i * 8); unsigned* d = (unsigned*)(TL + tid * 66 + i * 8); d[0] = v.x; d[1] = v.y; d[2] = v.z; d[3] = v.w; } }
    __syncthreads();
    {   const int tt = tid & 63, cg8 = tid >> 6; float s = 0.f;
        for (int cc = 0; cc < 64; ++cc) { const float v = bf2f(TL[(cg8 * 64 + cc) * 66 + tt]); s += v * v; }
        RS[cg8 * 64 + tt] = s; }
    __syncthreads();
    if (tid < 64) { float s = 0.f;
#pragma unroll
        for (int q = 0; q < 8; ++q) s += RS[q * 64 + tid];
        RS2[tid] = rsqrtf(s * (1.f / 512.f) + EPSN); }
    __syncthreads();
    {   const int tt = tid >> 3, ch = tid & 7; const float rstd = RS2[tt];
        bf16_t* orow = AH + (size_t)(b * 4096 + t0 + tt) * 1024;
#pragma unroll
        for (int g = 0; g < 8; ++g) { const int c0 = ch * 64 + g * 8; float y[8];
#pragma unroll
            for (int i = 0; i < 8; ++i) y[i] = bf2f(TL[(c0 + i) * 66 + tt]) * rstd * p.group_norm_w[512 + c0 + i];
            u32x4 w; w.x = pk2(y[0], y[1]); w.y = pk2(y[2], y[3]); w.z = pk2(y[4], y[5]); w.w = pk2(y[6], y[7]); *(u32x4*)(orow + 512 + c0) = w; }
        u32x4 av[8]; float s = 0.f;
#pragma unroll
        for (int g = 0; g < 8; ++g) { av[g] = *(const u32x4*)(orow + ch * 64 + g * 8);
            const float a0 = bflo(av[g].x), a1 = bfhi(av[g].x), a2 = bflo(av[g].y), a3 = bfhi(av[g].y), a4 = bflo(av[g].z), a5 = bfhi(av[g].z), a6 = bflo(av[g].w), a7 = bfhi(av[g].w);
            s += a0 * a0 + a1 * a1 + a2 * a2 + a3 * a3 + a4 * a4 + a5 * a5 + a6 * a6 + a7 * a7; }
        s += __shfl_xor(s, 1); s += __shfl_xor(s, 2); s += __shfl_xor(s, 4);
        const float ra = rsqrtf(s * (1.f / 512.f) + EPSN);
#pragma unroll
        for (int g = 0; g < 8; ++g) { const int c0 = ch * 64 + g * 8; const float* gw = p.group_norm_w + c0;
            u32x4 w; w.x = pk2(bflo(av[g].x) * ra * gw[0], bfhi(av[g].x) * ra * gw[1]); w.y = pk2(bflo(av[g].y) * ra * gw[2], bfhi(av[g].y) * ra * gw[3]);
            w.z = pk2(bflo(av[g].z) * ra * gw[4], bfhi(av[g].z) * ra * gw[5]); w.w = pk2(bflo(av[g].w) * ra * gw[6], bfhi(av[g].w) * ra * gw[7]);
            *(u32x4*)(orow + c0) = w; }
    }
}

__device__ __forceinline__ void phase6(const Params& p, unsigned char* lds) {
    const bf16_t* AH = (const bf16_t*)(p.ws + WS_ATTHY); const bf16_t* WT = (const bf16_t*)(p.ws + WS_WOUTT); const float* MOD = (const float*)(p.ws + WS_MOD);
    f32x4 acc[2][2][4][2];
    for (int u = blockIdx.x; u < 1024; u += gridDim.x) {
        const int pm = u >> 2, pn = u & 3; const bf16_t* a0 = AH + (size_t)pm * 256 * 1024; const bf16_t* b0 = WT + (size_t)pn * 256 * 1024;
        gemm_unit(lds, acc, [&](int r) { return a0 + (size_t)r * 1024; }, [&](int r, int ks) { return b0 + (size_t)r * 1024 + ks * 32; });
        const float* g1 = MOD + (size_t)((pm * 256) >> 12) * 6144 + 2048;
        ACC_FOREACH(acc, { const size_t off = (size_t)(pm * 256 + rl) * 1024 + pn * 256 + cl; const f32x4 xv = *(const f32x4*)(p.x + off); const f32x4 gv = *(const f32x4*)(g1 + pn * 256 + cl);
            *(f32x4*)(p.out + off) = xv + gv * v; });
    }
}

__device__ __forceinline__ int pair_index(int lo, int hi) { return lo * 8 - (lo * (lo + 1)) / 2 + (hi - lo - 1); }
__device__ __forceinline__ void phase7(const Params& p) {
    const int lane = threadIdx.x & 63, gw = blockIdx.x * 8 + (threadIdx.x >> 6), ngw = gridDim.x * 8;
    const float* MOD = (const float*)(p.ws + WS_MOD); bf16_t* H2 = (bf16_t*)(p.ws + WS_H);
    int* CNT = (int*)(p.ws + WS_CTL); int* LIST = (int*)(p.ws + WS_LIST); float* GATE = (float*)(p.ws + WS_GATE);
    for (int row = gw; row < NTOK; row += ngw) {
        const float* xr = p.out + (size_t)row * 1024; const float* md = MOD + (size_t)(row >> 12) * 6144;
        f32x4 v[4]; float s = 0.f;
#pragma unroll
        for (int j = 0; j < 4; ++j) { v[j] = *(const f32x4*)(xr + 256 * j + lane * 4); s += v[j].x * v[j].x + v[j].y * v[j].y + v[j].z * v[j].z + v[j].w * v[j].w; }
        const float rstd = rsqrtf(wave_sum(s) * (1.f / 1024.f) + EPSN);
        float gl[4] = {0.f, 0.f, 0.f, 0.f};
#pragma unroll
        for (int j = 0; j < 4; ++j) { const int k = 256 * j + lane * 4;
            const f32x4 nw = *(const f32x4*)(p.norm2_w + k), sh = *(const f32x4*)(md + 3072 + k), sc = *(const f32x4*)(md + 4096 + k);
            const f32x4 y = (v[j] * rstd) * nw * (sc + 1.f) + sh; v[j] = y;
            u32x2 o; o.x = pk2(y.x, y.y); o.y = pk2(y.z, y.w); *(u32x2*)(H2 + (size_t)row * 1024 + k) = o;
#pragma unroll
            for (int e = 0; e < 4; ++e) { const f32x4 w = *(const f32x4*)(p.router_g_w + (size_t)(k + e) * 4); const float ye = y[e]; gl[0] += ye * w.x; gl[1] += ye * w.y; gl[2] += ye * w.z; gl[3] += ye * w.w; } }
#pragma unroll
        for (int e = 0; e < 4; ++e) gl[e] = wave_sum(gl[e]) + p.router_g_b[e];
        int g = 0; float gm = gl[0];
#pragma unroll
        for (int e = 1; e < 4; ++e) if (gl[e] > gm) { gm = gl[e]; g = e; }
        float gs = 0.f;
#pragma unroll
        for (int e = 0; e < 4; ++e) gs += __expf(gl[e] - gm);
        const float gval = 1.f / gs;
        float el[8] = {0.f, 0.f, 0.f, 0.f, 0.f, 0.f, 0.f, 0.f};
#pragma unroll
        for (int j = 0; j < 4; ++j) { const int k = 256 * j + lane * 4;
#pragma unroll
            for (int e = 0; e < 4; ++e) { const float* wr = p.router_e_w + (size_t)(k + e) * 32 + g * 8; const f32x4 w0 = *(const f32x4*)wr, w1 = *(const f32x4*)(wr + 4); const float ye = v[j][e];
                el[0] += ye * w0.x; el[1] += ye * w0.y; el[2] += ye * w0.z; el[3] += ye * w0.w; el[4] += ye * w1.x; el[5] += ye * w1.y; el[6] += ye * w1.z; el[7] += ye * w1.w; } }
#pragma unroll
        for (int e = 0; e < 8; ++e) el[e] = wave_sum(el[e]) + p.router_e_b[g * 8 + e];
        int e1 = 0; float m1 = el[0];
#pragma unroll
        for (int e = 1; e < 8; ++e) if (el[e] > m1) { m1 = el[e]; e1 = e; }
        int e2 = -1; float m2 = -3.0e38f;
#pragma unroll
        for (int e = 0; e < 8; ++e) if (e != e1 && el[e] > m2) { m2 = el[e]; e2 = e; }
        const float r = __expf(m2 - m1), w1 = 1.f / (1.f + r), w2 = r / (1.f + r);
        if (lane == 0) {
            const int lo = e1 < e2 ? e1 : e2, hi = e1 < e2 ? e2 : e1;
            const float glo = gval * (e1 < e2 ? w1 : w2), ghi = gval * (e1 < e2 ? w2 : w1);
            const int cls = g * 28 + pair_index(lo, hi);
            const int rank = atomicAdd(CNT + cls, 1);
            LIST[(size_t)cls * 65536 + rank] = row;
            GATE[row * 2] = glo; GATE[row * 2 + 1] = ghi;
        }
    }
}

struct MoeMap { int ntiles; };
__device__ __forceinline__ void moe_build_map(const Params& p, int* sm  ) {
    const int* CNT = (const int*)(p.ws + WS_CTL);
    __syncthreads();
    if (threadIdx.x == 0) { int base = 0; for (int c = 0; c < NCLS; ++c) { const int n = CNT[c]; sm[c] = base; sm[128 + c] = n; base += (n + 255) >> 8; } sm[256] = base; }
    __syncthreads();
}
__device__ __forceinline__ void cls_decode(int cls, int& g, int& lo, int& hi) {
    g = cls / 28; int r = cls % 28; lo = 0; while (r >= 7 - lo) { r -= 7 - lo; ++lo; } hi = lo + 1 + r;
}
__device__ __forceinline__ int moe_find_cls(const int* sm, int mt) { int c = 0; for (int q = 1; q < NCLS; ++q) if (sm[q] <= mt) c = q; return c; }

__device__ __forceinline__ void phase8(const Params& p, unsigned char* lds) {
    int* sm = (int*)(lds + 40960);
    moe_build_map(p, sm);
    const int NT = sm[256];
    const bf16_t* H2 = (const bf16_t*)(p.ws + WS_H); const bf16_t* EW13 = (const bf16_t*)(p.ws + WS_EW13); bf16_t* HID = (bf16_t*)(p.ws + WS_HID);
    const int* LIST = (const int*)(p.ws + WS_LIST); const float* GATE = (const float*)(p.ws + WS_GATE);
    int* rowtok = (int*)(lds + 32768);
    f32x4 acc[2][2][4][2];
    for (int u = blockIdx.x; u < NT * 8; u += gridDim.x) {
        const int mt = u >> 3, nj = u & 7; const int cls = moe_find_cls(sm, mt); int g, lo, hi; cls_decode(cls, g, lo, hi);
        const int rank0 = (mt - sm[cls]) * 256, cnt = sm[128 + cls];
        __syncthreads();
        if (threadIdx.x < 256) { const int rk = rank0 + threadIdx.x; rowtok[threadIdx.x] = (rk < cnt) ? LIST[(size_t)cls * 65536 + rk] : -1; }
        __syncthreads();
        const int e = g * 8 + (nj < 4 ? lo : hi); const bf16_t* b0 = EW13 + (size_t)e * 1024 * 1024 + (size_t)(nj & 3) * 256 * 1024;
        gemm_unit(lds, acc, [&](int r) { const int t = rowtok[r]; return H2 + (size_t)(t < 0 ? 0 : t) * 1024; }, [&](int r, int ks) { return b0 + (size_t)r * 1024 + ks * 32; });
        {   const int wid = threadIdx.x >> 6, lane = threadIdx.x & 63, wr = wid >> 2, wc = wid & 3, fr = lane & 15, fq = lane >> 4;
#pragma unroll
            for (int a = 0; a < 2; ++a)
#pragma unroll
                for (int m = 0; m < 4; ++m) { const int rl = 128 * a + 64 * wr + 16 * m + fr; const int t = rowtok[rl]; const float gt = (t < 0) ? 0.f : GATE[t * 2 + (nj >> 2)];
#pragma unroll
                    for (int n = 0; n < 2; ++n) { const f32x4 va = acc[a][0][m][n], vb = acc[a][1][m][n]; f32x4 hv;
#pragma unroll
                        for (int q = 0; q < 4; ++q) hv[q] = siluf(va[q]) * vb[q] * gt;
                        u32x2 o; o.x = pk2(hv.x, hv.y); o.y = pk2(hv.z, hv.w);
                        *(u32x2*)(HID + (size_t)(mt * 256 + rl) * 1024 + (nj >> 2) * 512 + (nj & 3) * 128 + 32 * wc + 16 * n + 4 * fq) = o; } }
        }
    }
}
__device__ __forceinline__ void phase9(const Params& p, unsigned char* lds) {
    int* sm = (int*)(lds + 40960);
    moe_build_map(p, sm);
    const int NT = sm[256];
    const bf16_t* EW2T = (const bf16_t*)(p.ws + WS_EW2T); const bf16_t* HID = (const bf16_t*)(p.ws + WS_HID);
    const int* LIST = (const int*)(p.ws + WS_LIST); const float* MOD = (const float*)(p.ws + WS_MOD);
    int* rowtok = (int*)(lds + 32768);
    f32x4 acc[2][2][4][2];
    for (int u = blockIdx.x; u < NT * 4; u += gridDim.x) {
        const int mt = u >> 2, pn = u & 3; const int cls = moe_find_cls(sm, mt); int g, lo, hi; cls_decode(cls, g, lo, hi);
        const int rank0 = (mt - sm[cls]) * 256, cnt = sm[128 + cls];
        __syncthreads();
        if (threadIdx.x < 256) { const int rk = rank0 + threadIdx.x; rowtok[threadIdx.x] = (rk < cnt) ? LIST[(size_t)cls * 65536 + rk] : -1; }
        __syncthreads();
        const bf16_t* a0 = HID + (size_t)mt * 256 * 1024;
        const bf16_t* bl = EW2T + (size_t)(g * 8 + lo) * 1024 * 512 + (size_t)pn * 256 * 512; const bf16_t* bh = EW2T + (size_t)(g * 8 + hi) * 1024 * 512 + (size_t)pn * 256 * 512;
        gemm_unit(lds, acc, [&](int r) { return a0 + (size_t)r * 1024; }, [&](int r, int ks) { return (ks < 16) ? bl + (size_t)r * 512 + ks * 32 : bh + (size_t)r * 512 + (ks - 16) * 32; });
        ACC_FOREACH(acc, { const int t = rowtok[rl]; if (t >= 0) { const size_t off = (size_t)t * 1024 + pn * 256 + cl; const f32x4 g2 = *(const f32x4*)(MOD + (size_t)(t >> 12) * 6144 + 5120 + pn * 256 + cl);
            const f32x4 x1 = *(const f32x4*)(p.out + off); *(f32x4*)(p.out + off) = x1 + g2 * v; } });
    }
}

constexpr int LDS_BYTES = 150 * 1024;
__global__ void __launch_bounds__(NTHR, 2) fwd_kernel(Params p) {
    extern __shared__ __attribute__((aligned(16))) unsigned char lds[];
    cg::grid_group grid = cg::this_grid();
    phase0(p, lds);
    grid.sync();
    phase1(p);
    for (int it = blockIdx.x; it < 1024; it += gridDim.x) khat_item(p, it, lds);
    grid.sync();
    phase2(p, lds);
    grid.sync();
    phase3(p);
    grid.sync();
    for (int u = blockIdx.x; u < 1024; u += gridDim.x) attn_unit(p, u, lds);
    for (int it = blockIdx.x; it < 1024; it += gridDim.x) hyena_item(p, it, lds);
    grid.sync();
    for (int it = blockIdx.x; it < 1024; it += gridDim.x) phase5_item(p, it, lds);
    grid.sync();
    phase6(p, lds);
    grid.sync();
    phase7(p);
    grid.sync();
    phase8(p, lds);
    grid.sync();
    phase9(p, lds);
}

extern "C" void kernel_launch(void* const* d_in, const int* in_sizes, int n_in, void* d_out, int out_size, void* d_ws, size_t ws_size, hipStream_t stream) {
    static int grid_blocks = 0;
    if (grid_blocks == 0) {
        if (n_in != 30 || out_size != NTOK * DM || ws_size < WS_END) { fprintf(stderr, "kernel_launch: unexpected shapes (n_in %d out %d ws %zu)\n", n_in, out_size, ws_size); grid_blocks = -1; return; }
        int dev = 0, cus = 0, per_cu = 0;
        hipGetDevice(&dev); hipDeviceGetAttribute(&cus, hipDeviceAttributeMultiprocessorCount, dev);
        hipFuncSetAttribute((const void*)fwd_kernel, hipFuncAttributeMaxDynamicSharedMemorySize, LDS_BYTES);
        hipOccupancyMaxActiveBlocksPerMultiprocessor(&per_cu, (const void*)fwd_kernel, NTHR, LDS_BYTES);
        if (per_cu < 1) { fprintf(stderr, "kernel_launch: occupancy query says %d blocks per CU\n", per_cu); grid_blocks = -1; return; }
        grid_blocks = cus * per_cu;
    }
    if (grid_blocks < 0) return;
    Params p{};
    const float** pp = (const float**)&p;
    for (int i = 0; i < 30; ++i) pp[i] = (const float*)d_in[i];
    p.out = (float*)d_out; p.ws = (unsigned char*)d_ws;
    void* args[] = {&p};
    hipError_t e = hipLaunchCooperativeKernel((const void*)fwd_kernel, dim3(grid_blocks), dim3(NTHR), args, LDS_BYTES, stream);
    if (e != hipSuccess) fprintf(stderr, "cooperative launch failed: %s (grid %d)\n", hipGetErrorString(e), grid_blocks);
}
```

```cpp
#include <hip/hip_runtime.h>
#include <hip/hip_cooperative_groups.h>
#include <cstdio>
#include <cstdint>
namespace cg = cooperative_groups;

typedef unsigned short bf16_t;
typedef short bf16x8 __attribute__((ext_vector_type(8)));
typedef float f32x4 __attribute__((ext_vector_type(4)));
typedef unsigned u32x4 __attribute__((ext_vector_type(4)));
typedef unsigned u32x2 __attribute__((ext_vector_type(2)));
typedef _Float16 f16x8 __attribute__((ext_vector_type(8)));
typedef _Float16 f16x4 __attribute__((ext_vector_type(4)));
typedef _Float16 f16x2 __attribute__((ext_vector_type(2)));

constexpr int DM = 1024, NB = 16, SEQ = 4096, NTOK = NB * SEQ, CTXL = 256, NCTX = NB * CTXL;
constexpr int PROJW = 2304, HYW = 512, HYPW = 1536, KOFF = 512, VOFF = 640, HYOFF = 768;
constexpr int NEXP = 32, EHID = 512, NCLS = 112;
constexpr float EPSN = 1e-6f;
constexpr int NTHR = 512;

constexpr size_t MiB = 1u << 20;
constexpr size_t WS_CTL = 0, WS_MOD = 1 * MiB, WS_WINT = 2 * MiB, WS_WOUTT = 7 * MiB, WS_TAPS = 9 * MiB, WS_EW13 = 41 * MiB, WS_EW2T = 105 * MiB;
constexpr size_t WS_GATE = 137 * MiB, WS_KVC = 139 * MiB, WS_HC = 141 * MiB, WS_LIST = 149 * MiB, WS_H = 177 * MiB, WS_QKV = 305 * MiB, WS_UT = 401 * MiB;
constexpr size_t WS_HYT = 593 * MiB, WS_ATTHY = 657 * MiB, WS_HID = 305 * MiB, WS_KH = 785 * MiB, WS_END = 817 * MiB;
constexpr size_t WS_FTAB = 65536, WS_GTAB = 81920, WS_FKTAB = 98304;

struct Params {
    const float* x; const float* c; const float* ctx; const float* c_ctx; const float* ada_w; const float* ada_b; const float* norm1_w; const float* w_in;
    const float* q_norm_w; const float* k_norm_w; const float* attn_sink; const float* hy_conv_w; const float* hy_conv_b; const float* hy_w1; const float* hy_b1;
    const float* hy_w2; const float* hy_b2; const float* hy_w3; const float* hy_sin_freq; const float* hy_skip; const float* group_norm_w; const float* w_out;
    const float* norm2_w; const float* router_g_w; const float* router_g_b; const float* router_e_w; const float* router_e_b; const float* exp_w1; const float* exp_w3;
    const float* exp_w2;
    float* out; unsigned char* ws;
};

__device__ __forceinline__ unsigned f2bf(float f) { unsigned u = __builtin_bit_cast(unsigned, f); return (u + 0x7fffu + ((u >> 16) & 1u)) >> 16; }
__device__ __forceinline__ unsigned pk2(float lo, float hi) { return f2bf(lo) | (f2bf(hi) << 16); }
__device__ __forceinline__ float bf2f(unsigned short b) { return __builtin_bit_cast(float, (unsigned)b << 16); }
__device__ __forceinline__ float bflo(unsigned w) { return __builtin_bit_cast(float, w << 16); }
__device__ __forceinline__ float bfhi(unsigned w) { return __builtin_bit_cast(float, w & 0xffff0000u); }
__device__ __forceinline__ unsigned pkh2(float lo, float hi) { f16x2 v = {(_Float16)lo, (_Float16)hi}; return __builtin_bit_cast(unsigned, v); }
__device__ __forceinline__ float h2f(unsigned short h) { return (float)__builtin_bit_cast(_Float16, h); }
__device__ __forceinline__ float hlo(unsigned w) { return h2f((unsigned short)(w & 0xffffu)); }
__device__ __forceinline__ float hhi(unsigned w) { return h2f((unsigned short)(w >> 16)); }
__device__ __forceinline__ float wave_sum(float v) {
#pragma unroll
    for (int o = 1; o < 64; o <<= 1) v += __shfl_xor(v, o);
    return v;
}
__device__ __forceinline__ int otid() { int t = threadIdx.x; asm volatile("" : "+v"(t)); return t; }
__device__ __forceinline__ float siluf(float v) { return v / (1.f + __expf(-v)); }
__device__ __forceinline__ float sin_rad(float a) { float r = a * 0.15915494309189535f; r -= floorf(r); return __builtin_amdgcn_sinf(r); }
__device__ __forceinline__ float cos_rad(float a) { float r = a * 0.15915494309189535f; r -= floorf(r); return __builtin_amdgcn_cosf(r); }

template <class SrcA, class SrcB>
__device__ __forceinline__ void gemm_unit(unsigned char* lds, f32x4 (&acc)[2][2][4][2], const SrcA& srcA, const SrcB& srcB) {
    const int tid = otid(), wid = tid >> 6, lane = tid & 63, wr = wid >> 2, wc = wid & 3, fr = lane & 15, fq = lane >> 4;
#pragma unroll
    for (int a = 0; a < 2; ++a)
#pragma unroll
        for (int b = 0; b < 2; ++b)
#pragma unroll
            for (int m = 0; m < 4; ++m)
#pragma unroll
                for (int n = 0; n < 2; ++n) acc[a][b][m][n] = (f32x4){0.f, 0.f, 0.f, 0.f};
    const int r0 = tid >> 2, kc = tid & 3;
    const bf16_t* pa0 = srcA(r0) + kc * 8; const bf16_t* pa1 = srcA(r0 + 128) + kc * 8;
    u32x4 ra0, ra1, rb0, rb1;
    ra0 = *(const u32x4*)(pa0); ra1 = *(const u32x4*)(pa1);
    rb0 = *(const u32x4*)(srcB(r0, 0) + kc * 8); rb1 = *(const u32x4*)(srcB(r0 + 128, 0) + kc * 8);
    unsigned char* sA = lds; unsigned char* sB = lds + 16384;
    for (int ks = 0; ks < 32; ++ks) {
        __syncthreads();
        *(u32x4*)(sA + tid * 16) = ra0; *(u32x4*)(sA + 8192 + tid * 16) = ra1;
        *(u32x4*)(sB + tid * 16) = rb0; *(u32x4*)(sB + 8192 + tid * 16) = rb1;
        __syncthreads();
        if (ks + 1 < 32) {
            ra0 = *(const u32x4*)(pa0 + (ks + 1) * 32); ra1 = *(const u32x4*)(pa1 + (ks + 1) * 32);
            rb0 = *(const u32x4*)(srcB(r0, ks + 1) + kc * 8); rb1 = *(const u32x4*)(srcB(r0 + 128, ks + 1) + kc * 8);
        }
        bf16x8 Af[2][4], Bf[2][2];
#pragma unroll
        for (int a = 0; a < 2; ++a)
#pragma unroll
            for (int m = 0; m < 4; ++m) Af[a][m] = *(const bf16x8*)(sA + (128 * a + 64 * wr + 16 * m + fr) * 64 + fq * 16);
#pragma unroll
        for (int b = 0; b < 2; ++b)
#pragma unroll
            for (int n = 0; n < 2; ++n) Bf[b][n] = *(const bf16x8*)(sB + (128 * b + 32 * wc + 16 * n + fr) * 64 + fq * 16);
#pragma unroll
        for (int a = 0; a < 2; ++a)
#pragma unroll
            for (int b = 0; b < 2; ++b)
#pragma unroll
                for (int m = 0; m < 4; ++m)
#pragma unroll
                    for (int n = 0; n < 2; ++n) acc[a][b][m][n] = __builtin_amdgcn_mfma_f32_16x16x32_bf16(Bf[b][n], Af[a][m], acc[a][b][m][n], 0, 0, 0);
    }
}
#define ACC_FOREACH(acc, BODY) do { \
    const int _wid = threadIdx.x >> 6, _lane = threadIdx.x & 63, _wr = _wid >> 2, _wc = _wid & 3, _fr = _lane & 15, _fq = _lane >> 4; \
    _Pragma("unroll") for (int _a = 0; _a < 2; ++_a) _Pragma("unroll") for (int _m = 0; _m < 4; ++_m) _Pragma("unroll") for (int _b = 0; _b < 2; ++_b) _Pragma("unroll") for (int _n = 0; _n < 2; ++_n) { \
        const int rl = 128 * _a + 64 * _wr + 16 * _m + _fr, cl = 128 * _b + 32 * _wc + 16 * _n + 4 * _fq; const f32x4 v = acc[_a][_b][_m][_n]; BODY } } while (0)


#define LAS __attribute__((address_space(3)))
namespace pg {
constexpr int HTB = 16384;
__device__ __forceinline__ int lds_byte(int r, int c) { const int st = (r >> 4) * 2 + (c >> 5), rr = r & 15, cc = c & 31, ob = rr * 64 + cc * 2; return st * 1024 + (ob ^ (((ob >> 9) & 1) << 5)); }
__device__ __forceinline__ void stage_rc(int b, int& R, int& C) { const int st = b / 1024, sb = b % 1024, swz = sb ^ (((sb >> 9) & 1) << 5); R = (st >> 1) * 16 + swz / 64; C = (st & 1) * 32 + (swz % 64) / 2; }
__device__ __forceinline__ int perm32(int rho) { const int n = rho >> 4, i = rho & 15; return 8 * (i >> 2) + 4 * n + (i & 3); }
struct UDesc { const char* A; const char* B0; const char* B1; int i0, i1, i2, i3; };
template <bool GATHER, bool PERM, class Sched, class Epi>
__device__ __forceinline__ void gemm_stream(LAS unsigned char* lds, const int KA, const int KB, const Sched& S, const Epi& E) {
    const int tid = otid(), wid = __builtin_amdgcn_readfirstlane(tid >> 6), lane = tid & 63, wr = wid >> 2, wc = wid & 3, fr = lane & 15, fq = lane >> 4;
    constexpr int nt = 16;
    unsigned voffA[2], voffB[2]; int rowA[2]; unsigned colA[2];
#pragma unroll
    for (int i = 0; i < 2; ++i) { int R, C; stage_rc(tid * 16 + i * 8192, R, C); const int Rb = PERM ? ((R & ~31) + perm32(R & 31)) : R;
        voffA[i] = (unsigned)(R * KA + C) * 2u; voffB[i] = (unsigned)(Rb * KB + C) * 2u; rowA[i] = R; colA[i] = (unsigned)C * 2u; }
    const size_t hstepA = (size_t)128 * KA * 2, hstepB = (size_t)128 * KB * 2;
    const unsigned ldsw = (unsigned)wid * 1024u;
    const int aoff = lds_byte(wr * 64 + fr, fq * 8), boff = lds_byte(wc * 32 + fr, fq * 8);
#define PG_SA(b, h) (((b) * 2 + (h)) * pg::HTB)
#define PG_SB(b, h) ((4 + (b) * 2 + (h)) * pg::HTB)
#define PG_LD2(bufoff, p0, p1) do { __builtin_amdgcn_global_load_lds((const unsigned*)(p0), (LAS unsigned*)(lds + (bufoff) + ldsw), 16, 0, 0); \
        __builtin_amdgcn_global_load_lds((const unsigned*)(p1), (LAS unsigned*)(lds + (bufoff) + ldsw + 8192), 16, 0, 0); } while (0)
#define PG_STA(bufoff, pa, VA, h) do { if (GATHER) PG_LD2(bufoff, (pa) + ((h) ? VA##10 : VA##00), (pa) + ((h) ? VA##11 : VA##01)); else { const char* _b = (pa) + (h) * hstepA; PG_LD2(bufoff, _b + voffA[0], _b + voffA[1]); } } while (0)
#define PG_STB(bufoff, pb, h) do { const char* _b = (pb) + (h) * hstepB; PG_LD2(bufoff, _b + voffB[0], _b + voffB[1]); } while (0)
#define PG_LDA(dst, b, h) do { _Pragma("unroll") for (int m = 0; m < 4; ++m) _Pragma("unroll") for (int k = 0; k < 2; ++k) dst[m][k] = *(const LAS bf16x8*)(lds + PG_SA(b, h) + aoff + m * 2048 + k * 1024); } while (0)
#define PG_LDB(dst, b, h) do { _Pragma("unroll") for (int n = 0; n < 2; ++n) _Pragma("unroll") for (int k = 0; k < 2; ++k) dst[n][k] = *(const LAS bf16x8*)(lds + PG_SB(b, h) + boff + n * 2048 + k * 1024); } while (0)
#define PG_MMA(ai, bj, At, Bt) do { __builtin_amdgcn_s_setprio(1); _Pragma("unroll") for (int m = 0; m < 4; ++m) _Pragma("unroll") for (int n = 0; n < 2; ++n) _Pragma("unroll") for (int k = 0; k < 2; ++k) \
        acc[ai][bj][m][n] = __builtin_amdgcn_mfma_f32_16x16x32_bf16(Bt[n][k], At[m][k], acc[ai][bj][m][n], 0, 0, 0); __builtin_amdgcn_s_setprio(0); } while (0)
#define PG_WAIT_V(n) asm volatile("s_waitcnt vmcnt(" #n ")" ::: "memory")
#define PG_WAIT_L(n) asm volatile("s_waitcnt lgkmcnt(" #n ")" ::: "memory")
#define PG_BAR __builtin_amdgcn_s_barrier()
#define PG_SCHED __builtin_amdgcn_sched_barrier(0)
    UDesc cur, nxt; int ui = 0;
    unsigned cva00 = 0, cva01 = 0, cva10 = 0, cva11 = 0, nva00 = 0, nva01 = 0, nva10 = 0, nva11 = 0;
    if (!S.next(0, cur)) return;
    if (GATHER) { cva00 = S.rowoff(cur, rowA[0]) + colA[0]; cva01 = S.rowoff(cur, rowA[1]) + colA[1]; cva10 = S.rowoff(cur, 128 + rowA[0]) + colA[0]; cva11 = S.rowoff(cur, 128 + rowA[1]) + colA[1]; }
    f32x4 acc[2][2][4][2];
#pragma unroll
    for (int a = 0; a < 2; ++a)
#pragma unroll
        for (int b = 0; b < 2; ++b)
#pragma unroll
            for (int m = 0; m < 4; ++m)
#pragma unroll
                for (int n = 0; n < 2; ++n) acc[a][b][m][n] = (f32x4){0.f, 0.f, 0.f, 0.f};
    bf16x8 At[4][2], B0[2][2], B1[2][2];
    PG_STB(PG_SB(0, 0), cur.B0, 0); PG_STB(PG_SB(0, 1), cur.B0, 1); PG_STA(PG_SA(0, 0), cur.A, cva, 0); PG_STA(PG_SA(0, 1), cur.A, cva, 1);
    if (wr == 1) PG_BAR;
    PG_WAIT_V(2); PG_BAR;
    PG_STB(PG_SB(1, 0), cur.B0 + 128, 0); PG_STA(PG_SA(1, 0), cur.A + 128, cva, 0); PG_STB(PG_SB(1, 1), cur.B0 + 128, 1);
    PG_WAIT_V(6); PG_BAR;
    for (;;) {
        const bool has_next = S.next(ui + 1, nxt);
        if (!has_next) nxt = cur;
        if (GATHER) { if (has_next) { nva00 = S.rowoff(nxt, rowA[0]) + colA[0]; nva01 = S.rowoff(nxt, rowA[1]) + colA[1]; nva10 = S.rowoff(nxt, 128 + rowA[0]) + colA[0]; nva11 = S.rowoff(nxt, 128 + rowA[1]) + colA[1]; }
            else { nva00 = cva00; nva01 = cva01; nva10 = cva10; nva11 = cva11; } }
        for (int t = 0; t < nt; t += 2) {
            const bool last = (t == nt - 2);
            const char* a1 = cur.A + (size_t)(t + 1) * 128;
            const char* a2 = last ? nxt.A : cur.A + (size_t)(t + 2) * 128;
            const char* b2 = last ? nxt.B0 : ((t + 2 < 8) ? cur.B0 + (size_t)(t + 2) * 128 : cur.B1 + (size_t)(t + 2 - 8) * 128);
            const char* a3 = a2 + 128; const char* b3 = b2 + 128;
            unsigned va200 = cva00, va201 = cva01, va210 = cva10, va211 = cva11;
            if (GATHER && last) { va200 = nva00; va201 = nva01; va210 = nva10; va211 = nva11; }
            PG_LDB(B0, 0, 0); PG_LDB(B1, 0, 1); PG_SCHED; PG_LDA(At, 0, 0); PG_STA(PG_SA(1, 1), a1, cva, 1);
            PG_WAIT_V(8); PG_WAIT_L(0); PG_BAR; PG_MMA(0, 0, At, B0); PG_MMA(0, 1, At, B1); PG_BAR; PG_SCHED;
            PG_LDA(At, 0, 1); PG_STB(PG_SB(0, 0), b2, 0); PG_STB(PG_SB(0, 1), b2, 1); PG_STA(PG_SA(0, 0), a2, va2, 0);
            PG_WAIT_V(8); PG_WAIT_L(0); PG_BAR; PG_MMA(1, 0, At, B0); PG_MMA(1, 1, At, B1); PG_BAR; PG_SCHED;
            PG_LDB(B0, 1, 0); PG_LDB(B1, 1, 1); PG_SCHED; PG_LDA(At, 1, 0); PG_STA(PG_SA(0, 1), a2, va2, 1);
            PG_WAIT_V(8); PG_WAIT_L(0); PG_BAR; PG_MMA(0, 0, At, B0); PG_MMA(0, 1, At, B1); PG_BAR; PG_SCHED;
            PG_LDA(At, 1, 1); PG_STB(PG_SB(1, 0), b3, 0); PG_STB(PG_SB(1, 1), b3, 1); PG_STA(PG_SA(1, 0), a3, va2, 0);
            PG_WAIT_V(8); PG_WAIT_L(0); PG_BAR; PG_MMA(1, 0, At, B0); PG_MMA(1, 1, At, B1); PG_BAR; PG_SCHED;
        }
        if (wr == 0) PG_BAR;
        E(acc, cur, wr, wc, fr, fq);
        if (!has_next) break;
#pragma unroll
        for (int a = 0; a < 2; ++a)
#pragma unroll
            for (int b = 0; b < 2; ++b)
#pragma unroll
                for (int m = 0; m < 4; ++m)
#pragma unroll
                    for (int n = 0; n < 2; ++n) acc[a][b][m][n] = (f32x4){0.f, 0.f, 0.f, 0.f};
        cur = nxt; ++ui;
        if (GATHER) { cva00 = nva00; cva01 = nva01; cva10 = nva10; cva11 = nva11; }
        if (wr == 1) PG_BAR;
    }
    PG_WAIT_V(0);
    PG_BAR;
#undef PG_SA
#undef PG_SB
#undef PG_LD2
#undef PG_STA
#undef PG_STB
#undef PG_LDA
#undef PG_LDB
#undef PG_MMA
#undef PG_WAIT_V
#undef PG_WAIT_L
#undef PG_BAR
#undef PG_SCHED
}
}
#define ACCP_FOREACH(acc, wr, wc, fr, fq, BODY) do { \
    _Pragma("unroll") for (int _a = 0; _a < 2; ++_a) _Pragma("unroll") for (int _m = 0; _m < 4; ++_m) _Pragma("unroll") for (int _b = 0; _b < 2; ++_b) { \
        const int rl = 128 * _a + 64 * (wr) + 16 * _m + (fr), cl = 128 * _b + 32 * (wc) + 8 * (fq); const f32x4 v0 = acc[_a][_b][_m][0], v1 = acc[_a][_b][_m][1]; BODY } } while (0)
#define ACCN_FOREACH(acc, wr, wc, fr, fq, BODY) do { \
    _Pragma("unroll") for (int _a = 0; _a < 2; ++_a) _Pragma("unroll") for (int _m = 0; _m < 4; ++_m) _Pragma("unroll") for (int _b = 0; _b < 2; ++_b) _Pragma("unroll") for (int _n = 0; _n < 2; ++_n) { \
        const int rl = 128 * _a + 64 * (wr) + 16 * _m + (fr), cl = 128 * _b + 32 * (wc) + 16 * _n + 4 * (fq); const f32x4 v = acc[_a][_b][_m][_n]; BODY } } while (0)
__device__ __forceinline__ int vcu_of(int bx, int G) { return (G % 8 == 0) ? (bx % 8) * (G / 8) + bx / 8 : bx; }

__device__ __forceinline__ void p0_adaln(const Params& p, int it, unsigned char* lds) {
    float* S = (float*)lds;
    float* R = (float*)(lds + 17 * 1024 * 4);
    const int tid = otid();
    __syncthreads();
    for (int i = tid; i < 17 * 1024; i += NTHR) { const int r = i >> 10, k = i & 1023; const float v = (r < 16) ? p.c[r * 1024 + k] : p.c_ctx[k]; S[i] = siluf(v); }
    __syncthreads();
    const int col = tid & 63, sl = tid >> 6, n = it * 64 + col;
    float a[17];
#pragma unroll
    for (int r = 0; r < 17; ++r) a[r] = 0.f;
    for (int k = sl * 128; k < sl * 128 + 128; ++k) {
        const float w = p.ada_w[(size_t)k * 6144 + n];
#pragma unroll
        for (int r = 0; r < 17; ++r) a[r] += S[r * 1024 + k] * w;
    }
#pragma unroll
    for (int r = 0; r < 17; ++r) R[(sl * 17 + r) * 64 + col] = a[r];
    __syncthreads();
    float* MOD = (float*)(p.ws + WS_MOD);
    for (int i = tid; i < 17 * 64; i += NTHR) { const int r = i >> 6, cc = i & 63; float s = 0.f;
#pragma unroll
        for (int q = 0; q < 8; ++q) s += R[(q * 17 + r) * 64 + cc];
        MOD[r * 6144 + it * 64 + cc] = s + p.ada_b[it * 64 + cc]; }
}

__device__ __forceinline__ void p0_taps(const Params& p, int it, unsigned char* lds) {
    float* FE = (float*)lds;
    float* H1 = FE + 16 * 36;
    float* H2 = H1 + 16 * 64;
    const int tid = otid(), p0 = it * 16;
    __syncthreads();
    if (tid < 256) { const int pp = tid >> 4, j = tid & 15; const float pos = (float)(p0 + pp);
        const float band = 1e-4f + (float)j * ((15.f - 1e-4f) / 15.f);
        float rev = pos * band * (1.f / 4096.f); rev -= floorf(rev);
        FE[pp * 36 + 1 + j] = __builtin_amdgcn_cosf(rev); FE[pp * 36 + 17 + j] = -__builtin_amdgcn_sinf(rev);
        if (j == 0) FE[pp * 36] = pos * (1.f / 4096.f); }
    __syncthreads();
    for (int i = tid; i < 1024; i += NTHR) { const int pp = i >> 6, j = i & 63; float s = p.hy_b1[j];
        for (int q = 0; q < 33; ++q) s += FE[pp * 36 + q] * p.hy_w1[q * 64 + j];
        H1[pp * 64 + j] = sin_rad(p.hy_sin_freq[j] * s); }
    __syncthreads();
    for (int i = tid; i < 1024; i += NTHR) { const int pp = i >> 6, j = i & 63; float s = p.hy_b2[j];
        for (int q = 0; q < 64; ++q) s += H1[pp * 64 + q] * p.hy_w2[q * 64 + j];
        H2[pp * 64 + j] = sin_rad(p.hy_sin_freq[64 + j] * s); }
    __syncthreads();
    float* TAPS = (float*)(p.ws + WS_TAPS);
    const float mind = -3.0701134573253945f, maxd = -15.350567286626972f;
#pragma unroll 1
    for (int q = 0; q < 4; ++q) {
        const int col = tid + 512 * q, o = col >> 10, dir = (col >> 9) & 1, c = col & 511;
        float w[64];
#pragma unroll
        for (int i = 0; i < 64; ++i) w[i] = p.hy_w3[i * 2048 + col];
        const float delta = fabsf(mind + (maxd - mind) * ((float)c / 511.f));
        float* tp = TAPS + ((size_t)(o * 512 + c)) * 8192;
#pragma unroll 1
        for (int pp = 0; pp < 16; ++pp) {
            float s = 0.f;
#pragma unroll
            for (int i = 0; i < 64; ++i) s += H2[pp * 64 + i] * w[i];
            const int pos = p0 + pp; const float t = (float)pos * (1.f / 4096.f);
            const float val = s * __expf(-t * delta);
            if (dir == 0) tp[4096 + pos] = val; else { if (pos == 0) tp[0] = 0.f; else tp[4096 - pos] = val; }
        }
    }
}

__device__ __forceinline__ void p0_transpose(const float* src, int N, int k0, int n0, bf16_t* dst, int dpitch, int mode, const float* kscale, unsigned char* lds) {
    float* T = (float*)lds;
    const int tid = otid();
    __syncthreads();
#pragma unroll
    for (int i = 0; i < 8; ++i) { const int kk = i * 8 + (tid >> 6), nn = tid & 63; float v = src[(size_t)(k0 + kk) * N + n0 + nn]; if (kscale) v *= kscale[k0 + kk]; T[kk * 65 + nn] = v; }
    __syncthreads();
    const int n = tid >> 3, kch = tid & 7, col = n0 + n;
    int drow = col;
    if (mode == 1) drow = (col >> 7) * 256 + (col & 127);
    else if (mode == 2) drow = (col >> 7) * 256 + 128 + (col & 127);
    u32x4 o;
    o.x = pk2(T[(kch * 8 + 0) * 65 + n], T[(kch * 8 + 1) * 65 + n]); o.y = pk2(T[(kch * 8 + 2) * 65 + n], T[(kch * 8 + 3) * 65 + n]);
    o.z = pk2(T[(kch * 8 + 4) * 65 + n], T[(kch * 8 + 5) * 65 + n]); o.w = pk2(T[(kch * 8 + 6) * 65 + n], T[(kch * 8 + 7) * 65 + n]);
    *(u32x4*)(dst + (size_t)drow * dpitch + k0 + kch * 8) = o;
}


__device__ __forceinline__ void p0_tables(const Params& p, int it) {
    const int e = it * NTHR + threadIdx.x;
    _Float16* FT = (_Float16*)(p.ws + WS_FTAB); _Float16* GT = (_Float16*)(p.ws + WS_GTAB); _Float16* FK = (_Float16*)(p.ws + WS_FKTAB);
    if (e < 8192) { const int rho = e >> 6, s1 = e & 63, f = rho >> 1; float v;
        if (rho == 0) v = 1.f; else if (rho == 1) v = (s1 & 1) ? -1.f : 1.f;
        else { const float rev = (float)((f * s1) & 127) * (1.f / 128.f); v = (rho & 1) ? -__builtin_amdgcn_sinf(rev) : __builtin_amdgcn_cosf(rev); }
        FT[e] = (_Float16)v;
    } else if (e < 16384) { const int q = e - 8192, t1 = q >> 7, rho = q & 127, f = rho >> 1; float v;
        if (rho == 0) v = 1.f / 128.f; else if (rho == 1) v = ((t1 & 1) ? -1.f : 1.f) / 128.f;
        else { const float rev = (float)((f * t1) & 127) * (1.f / 128.f); v = ((rho & 1) ? -__builtin_amdgcn_sinf(rev) : __builtin_amdgcn_cosf(rev)) * (2.f / 128.f); }
        GT[q] = (_Float16)v;
    } else { const int q = e - 16384, rho = q >> 7, dp = q & 127, d = dp - 64, f = rho >> 1; float v;
        if (rho == 0) v = 1.f; else if (rho == 1) v = (d & 1) ? -1.f : 1.f;
        else { const float rev = (float)((f * d) & 127) * (1.f / 128.f); v = (rho & 1) ? -__builtin_amdgcn_sinf(rev) : __builtin_amdgcn_cosf(rev); }
        FK[q] = (_Float16)v;
    }
}

__device__ __forceinline__ void phase0(const Params& p, unsigned char* lds) {
    constexpr int I_WIN = 16 * 36, I_WOUT = 16 * 16, I_W1 = 32 * 16 * 8, I_W2 = 32 * 8 * 16;
    constexpr int NTR = I_WIN + I_WOUT + 2 * I_W1 + I_W2;
    if (blockIdx.x == 0 && threadIdx.x < 128) ((int*)(p.ws + WS_CTL))[threadIdx.x] = 0;
    for (int it = blockIdx.x; it < 64; it += gridDim.x) p0_tables(p, it);
    for (int it = blockIdx.x; it < 96; it += gridDim.x) p0_adaln(p, it, lds);
    for (int it = (blockIdx.x + 160) % gridDim.x; it < 256; it += gridDim.x) p0_taps(p, it, lds);
    for (int it = blockIdx.x; it < NTR; it += gridDim.x) {
        int r = it; const float* src; int N, k0, n0, dpitch, mode = 0; bf16_t* dst;
        if (r < I_WIN) { src = p.w_in; N = PROJW; k0 = (r / 36) * 64; n0 = (r % 36) * 64; dst = (bf16_t*)(p.ws + WS_WINT); dpitch = 1024; }
        else if ((r -= I_WIN) < I_WOUT) { src = p.w_out; N = 1024; k0 = (r / 16) * 64; n0 = (r % 16) * 64; dst = (bf16_t*)(p.ws + WS_WOUTT); dpitch = 1024; }
        else if ((r -= I_WOUT) < 2 * I_W1) { const int w3 = r >= I_W1; if (w3) r -= I_W1; const int e = r / 128, q = r % 128; src = (w3 ? p.exp_w3 : p.exp_w1) + (size_t)e * 1024 * 512; N = 512; k0 = (q / 8) * 64; n0 = (q % 8) * 64;
            dst = (bf16_t*)(p.ws + WS_EW13) + (size_t)e * 1024 * 1024; dpitch = 1024; mode = w3 ? 2 : 1; }
        else { r -= 2 * I_W1; const int e = r / 128, q = r % 128; src = p.exp_w2 + (size_t)e * 512 * 1024; N = 1024; k0 = (q / 16) * 64; n0 = (q % 16) * 64; dst = (bf16_t*)(p.ws + WS_EW2T) + (size_t)e * 1024 * 512; dpitch = 512; }
        p0_transpose(src, N, k0, n0, dst, dpitch, mode, nullptr, lds);
    }
}

__device__ __forceinline__ void norm_row(const Params& p, const float* xr, const float* md, bf16_t* orow, int lane) {
    f32x4 v[4]; float s = 0.f;
#pragma unroll
    for (int j = 0; j < 4; ++j) { v[j] = *(const f32x4*)(xr + 256 * j + lane * 4); s += v[j].x * v[j].x + v[j].y * v[j].y + v[j].z * v[j].z + v[j].w * v[j].w; }
    const float rstd = rsqrtf(wave_sum(s) * (1.f / 1024.f) + EPSN);
#pragma unroll
    for (int j = 0; j < 4; ++j) { const int k = 256 * j + lane * 4;
        const f32x4 nw = *(const f32x4*)(p.norm1_w + k), sh = *(const f32x4*)(md + k), sc = *(const f32x4*)(md + 1024 + k);
        const f32x4 y = (v[j] * rstd) * nw * (sc + 1.f) + sh;
        u32x2 o; o.x = pk2(y.x, y.y); o.y = pk2(y.z, y.w); *(u32x2*)(orow + k) = o; }
}
__device__ __forceinline__ void phase1(const Params& p, unsigned char* lds) {
    const int tidq = otid(), lane = tidq & 63, wid = tidq >> 6;
    const float* MOD = (const float*)(p.ws + WS_MOD);
    const bool split = gridDim.x > 32;
    for (int pm = blockIdx.x; pm < 16; pm += gridDim.x) {
        bf16_t* HC = (bf16_t*)(p.ws + WS_HC); const bf16_t* WT = (const bf16_t*)(p.ws + WS_WINT); bf16_t* KVC = (bf16_t*)(p.ws + WS_KVC);
        for (int r = wid; r < 256; r += 8) { const int row = pm * 256 + r; norm_row(p, p.ctx + (size_t)row * 1024, MOD + (size_t)16 * 6144, HC + (size_t)row * 1024, lane); }
        __threadfence(); __syncthreads();
        f32x4 acc[2][2][4][2];
        const bf16_t* a0 = HC + (size_t)pm * 256 * 1024; const bf16_t* b0 = WT + (size_t)512 * 1024;
        gemm_unit(lds, acc, [&](int r) { return a0 + (size_t)r * 1024; }, [&](int r, int ks) { return b0 + (size_t)r * 1024 + ks * 32; });
        ACC_FOREACH(acc, { u32x2 o; o.x = pk2(v.x, v.y); o.y = pk2(v.z, v.w); *(u32x2*)(KVC + (size_t)(pm * 256 + rl) * 256 + cl) = o; });
        __syncthreads();
    }
    if (!split || blockIdx.x >= 16) {
        const int nb = split ? gridDim.x - 16 : gridDim.x, bi = split ? blockIdx.x - 16 : blockIdx.x;
        for (int row = bi * 8 + wid; row < NTOK; row += nb * 8)
            norm_row(p, p.x + (size_t)row * 1024, MOD + (size_t)(row >> 12) * 6144, (bf16_t*)(p.ws + WS_H) + (size_t)row * 1024, lane);
    }
}

struct P2Sched { const char* H; const char* WT; int G, c;
    __device__ __forceinline__ bool next(int i, pg::UDesc& u) const { const int q = i * G + c; if (q >= 2304) return false;
        if (q < 768) { const int pm = q / 3, pn = q - 3 * pm; u.A = H + (size_t)pm * 256 * 2048; u.B0 = WT + (size_t)pn * 256 * 2048; u.i0 = 0; u.i1 = pm; u.i2 = pn; }
        else { const int v = q - 768, pn = v / 6, pm = v - 6 * pn; u.A = WT + (size_t)(768 + pm * 256) * 2048; u.B0 = H + (size_t)pn * 256 * 2048; u.i0 = 1; u.i1 = pm; u.i2 = pn; }
        u.B1 = u.B0 + 8 * 128; u.i3 = 0; return true; }
    __device__ __forceinline__ unsigned rowoff(const pg::UDesc&, int) const { return 0u; }
};
__device__ __forceinline__ void phase2(const Params& p, unsigned char* lds) {
    bf16_t* QKV = (bf16_t*)(p.ws + WS_QKV); _Float16* UT = (_Float16*)(p.ws + WS_UT);
    P2Sched S{(const char*)(p.ws + WS_H), (const char*)(p.ws + WS_WINT), (int)gridDim.x, vcu_of(blockIdx.x, gridDim.x)};
    auto E = [&](const f32x4 (&acc)[2][2][4][2], const pg::UDesc& u, int wr, int wc, int fr, int fq) {
        const int tok0 = u.i2 * 256, bb = tok0 >> 12, t0 = tok0 & 4095;
        unsigned short* base = u.i0 ? (unsigned short*)UT + ((size_t)(bb * 1536 + u.i1 * 256)) * 4096 + t0 : (unsigned short*)QKV + (size_t)(u.i1 * 256) * 768 + u.i2 * 256;
        const size_t pitch = u.i0 ? 4096 : 768; const bool f16o = u.i0 != 0;
        ACCP_FOREACH(acc, wr, wc, fr, fq, { u32x4 o;
            if (f16o) { o.x = pkh2(v0.x, v0.y); o.y = pkh2(v0.z, v0.w); o.z = pkh2(v1.x, v1.y); o.w = pkh2(v1.z, v1.w); }
            else { o.x = pk2(v0.x, v0.y); o.y = pk2(v0.z, v0.w); o.z = pk2(v1.x, v1.y); o.w = pk2(v1.z, v1.w); }
            *(u32x4*)(base + (size_t)rl * pitch + cl) = o; });
    };
    pg::gemm_stream<false, true>((LAS unsigned char*)lds, 1024, 1024, S, E);
}

__device__ __forceinline__ void phase3(const Params& p) {
    const int tidq = otid(), lane = tidq & 63, gw = blockIdx.x * 8 + (tidq >> 6), ngw = gridDim.x * 8;
    bf16_t* QKV = (bf16_t*)(p.ws + WS_QKV); bf16_t* KVC = (bf16_t*)(p.ws + WS_KVC);
    const float qw = p.q_norm_w[lane], kw = p.k_norm_w[lane];
    const int i16 = lane & 15; const float invf = exp2f(-(float)i16 * (13.287712379549449f / 16.f));
    for (int row = gw; row < NTOK + NCTX; row += ngw) {
        if (row < NTOK) {
            const int pos = row & 4095; const float ang = (float)((lane & 32) ? (pos & 63) : (pos >> 6)) * invf;
            const float cs = cos_rad(ang), sn = sin_rad(ang);
            bf16_t* rp = QKV + (size_t)row * 768;
#pragma unroll
            for (int hh = 0; hh < 10; ++hh) {
                const float xv = bf2f(rp[hh * 64 + lane]);
                const float rstd = rsqrtf(wave_sum(xv * xv) * (1.f / 64.f) + EPSN);
                const float y = xv * rstd * (hh < 8 ? qw : kw);
                const float pr = __shfl_xor(y, 16);
                const float o = (lane & 16) ? (y * cs + pr * sn) : (y * cs - pr * sn);
                rp[hh * 64 + lane] = (bf16_t)f2bf(o);
            }
        } else {
            bf16_t* rp = KVC + (size_t)(row - NTOK) * 256;
#pragma unroll
            for (int hh = 0; hh < 2; ++hh) {
                const float xv = bf2f(rp[hh * 64 + lane]);
                const float rstd = rsqrtf(wave_sum(xv * xv) * (1.f / 64.f) + EPSN);
                rp[hh * 64 + lane] = (bf16_t)f2bf(xv * rstd * kw);
            }
        }
    }
}

__device__ __forceinline__ void attn_unit(const Params& p, int u, unsigned char* lds) {
    const int tid = otid(), wid = tid >> 6, lane = tid & 63, fr = lane & 15, fq = lane >> 4;
    const int b = u >> 6, kvh = (u >> 5) & 1, qb = u & 31, q0 = qb * 128;
    const bf16_t* QKV = (const bf16_t*)(p.ws + WS_QKV); const bf16_t* KVC = (const bf16_t*)(p.ws + WS_KVC);
    bf16_t* ATT = (bf16_t*)(p.ws + WS_ATTHY);
    unsigned char* sK = lds;
    unsigned char* sV = lds + 64 * 144;
    const int h = kvh * 4 + (wid >> 1), qrow0 = q0 + 64 * (wid & 1);
    bf16x8 qf[4][2];
#pragma unroll
    for (int qt = 0; qt < 4; ++qt)
#pragma unroll
        for (int ks = 0; ks < 2; ++ks) qf[qt][ks] = *(const bf16x8*)(QKV + (size_t)(b * 4096 + qrow0 + 16 * qt + fr) * 768 + h * 64 + 32 * ks + 8 * fq);
    const float LOG2E = 1.4426950408889634f, SC = 0.125f * LOG2E;
    float mrow[4], lrow[4]; f32x4 ot[4][4];
    const float sink2 = p.attn_sink[h] * LOG2E;
#pragma unroll
    for (int qt = 0; qt < 4; ++qt) { mrow[qt] = sink2; lrow[qt] = (fq == 0) ? 1.f : 0.f;
#pragma unroll
        for (int dt = 0; dt < 4; ++dt) ot[dt][qt] = (f32x4){0.f, 0.f, 0.f, 0.f}; }
    for (int tile = 0; tile < 10; ++tile) {
        const bool isctx = tile < 4; const int kbase = isctx ? tile * 64 : q0 - 128 + (tile - 4) * 64;
        if (!isctx && (kbase < 0 || kbase >= SEQ)) continue;
        __syncthreads();
        {
            const int kr = tid >> 3, ch = tid & 7;
            const bf16_t* krow = isctx ? KVC + (size_t)(b * 256 + kbase + kr) * 256 + kvh * 64 : QKV + (size_t)(b * 4096 + kbase + kr) * 768 + KOFF + kvh * 64;
            const bf16_t* vrow = isctx ? KVC + (size_t)(b * 256 + kbase + kr) * 256 + 128 + kvh * 64 : QKV + (size_t)(b * 4096 + kbase + kr) * 768 + VOFF + kvh * 64;
            const u32x4 kv = *(const u32x4*)(krow + ch * 8); const u32x4 vv = *(const u32x4*)(vrow + ch * 8);
            *(u32x4*)(sK + kr * 144 + ch * 16) = kv;
            bf16_t* sv = (bf16_t*)sV;
            sv[(ch * 8 + 0) * 72 + kr] = (bf16_t)(vv.x & 0xffff); sv[(ch * 8 + 1) * 72 + kr] = (bf16_t)(vv.x >> 16);
            sv[(ch * 8 + 2) * 72 + kr] = (bf16_t)(vv.y & 0xffff); sv[(ch * 8 + 3) * 72 + kr] = (bf16_t)(vv.y >> 16);
            sv[(ch * 8 + 4) * 72 + kr] = (bf16_t)(vv.z & 0xffff); sv[(ch * 8 + 5) * 72 + kr] = (bf16_t)(vv.z >> 16);
            sv[(ch * 8 + 6) * 72 + kr] = (bf16_t)(vv.w & 0xffff); sv[(ch * 8 + 7) * 72 + kr] = (bf16_t)(vv.w >> 16);
        }
        __syncthreads();
        f32x4 st[4][4];
#pragma unroll
        for (int kt = 0; kt < 4; ++kt) {
            const bf16x8 k0 = *(const bf16x8*)(sK + (16 * kt + fr) * 144 + fq * 16), k1 = *(const bf16x8*)(sK + (16 * kt + fr) * 144 + 64 + fq * 16);
#pragma unroll
            for (int qt = 0; qt < 4; ++qt) { f32x4 z = (f32x4){0.f, 0.f, 0.f, 0.f};
                z = __builtin_amdgcn_mfma_f32_16x16x32_bf16(k0, qf[qt][0], z, 0, 0, 0); z = __builtin_amdgcn_mfma_f32_16x16x32_bf16(k1, qf[qt][1], z, 0, 0, 0); st[kt][qt] = z; }
        }
#pragma unroll
        for (int qt = 0; qt < 4; ++qt) {
            const int qpos = qrow0 + 16 * qt + fr;
            float tmax = -3.0e38f;
#pragma unroll
            for (int kt = 0; kt < 4; ++kt)
#pragma unroll
                for (int r = 0; r < 4; ++r) { float s = st[kt][qt][r] * SC;
                    if (!isctx) { const int kp = kbase + 16 * kt + 4 * fq + r; const int dd = kp - qpos; if (dd > 128 || dd < -128) s = -1e30f; }
                    st[kt][qt][r] = s; tmax = fmaxf(tmax, s); }
            tmax = fmaxf(tmax, __shfl_xor(tmax, 16)); tmax = fmaxf(tmax, __shfl_xor(tmax, 32));
            const float mnew = fmaxf(mrow[qt], tmax), alpha = exp2f(mrow[qt] - mnew);
            mrow[qt] = mnew; float ls = 0.f;
#pragma unroll
            for (int kt = 0; kt < 4; ++kt)
#pragma unroll
                for (int r = 0; r < 4; ++r) { const float pv = exp2f(st[kt][qt][r] - mnew); st[kt][qt][r] = pv; ls += pv; }
            lrow[qt] = lrow[qt] * alpha + ls;
#pragma unroll
            for (int dt = 0; dt < 4; ++dt) ot[dt][qt] = ot[dt][qt] * alpha;
        }
#pragma unroll
        for (int ks = 0; ks < 2; ++ks) {
            bf16x8 pf[4];
#pragma unroll
            for (int qt = 0; qt < 4; ++qt) { const f32x4 a = st[2 * ks][qt], c = st[2 * ks + 1][qt];
                u32x4 w; w.x = pk2(a.x, a.y); w.y = pk2(a.z, a.w); w.z = pk2(c.x, c.y); w.w = pk2(c.z, c.w); pf[qt] = __builtin_bit_cast(bf16x8, w); }
#pragma unroll
            for (int dt = 0; dt < 4; ++dt) {
                const u32x2 v0 = *(const u32x2*)(sV + (16 * dt + fr) * 144 + (32 * ks + 4 * fq) * 2), v1 = *(const u32x2*)(sV + (16 * dt + fr) * 144 + (32 * ks + 16 + 4 * fq) * 2);
                u32x4 w; w.x = v0.x; w.y = v0.y; w.z = v1.x; w.w = v1.y; const bf16x8 vf = __builtin_bit_cast(bf16x8, w);
#pragma unroll
                for (int qt = 0; qt < 4; ++qt) ot[dt][qt] = __builtin_amdgcn_mfma_f32_16x16x32_bf16(vf, pf[qt], ot[dt][qt], 0, 0, 0);
            }
        }
    }
#pragma unroll
    for (int qt = 0; qt < 4; ++qt) {
        float l = lrow[qt]; l += __shfl_xor(l, 16); l += __shfl_xor(l, 32);
        const float inv = 1.f / l;
        bf16_t* orow = ATT + (size_t)(b * 4096 + qrow0 + 16 * qt + fr) * 1024 + h * 64;
#pragma unroll
        for (int dt = 0; dt < 4; ++dt) { const f32x4 o = ot[dt][qt] * inv; u32x2 w; w.x = pk2(o.x, o.y); w.y = pk2(o.z, o.w); *(u32x2*)(orow + 16 * dt + 4 * fq) = w; }
    }
}

__device__ __forceinline__ void khat_item(const Params& p, int it, unsigned char* lds) {
    const int tid = otid(), wid = tid >> 6, lane = tid & 63, fr = lane & 15, fq = lane >> 4;
    _Float16* TT = (_Float16*)lds;
    const float* tp = (const float*)(p.ws + WS_TAPS) + (size_t)it * 8192;
    __syncthreads();
    for (int i = tid; i < 128 * 136 / 2; i += NTHR) ((unsigned*)lds)[i] = 0u;
    __syncthreads();
#pragma unroll
    for (int q = 0; q < 4; ++q) {
        const int i0 = tid * 16 + q * 4; const f32x4 v = *(const f32x4*)(tp + i0);
#pragma unroll
        for (int e = 0; e < 4; ++e) { const int i = i0 + e, i1 = i >> 6, i2 = i & 63; const _Float16 h = (_Float16)v[e];
            if (i1 >= 1) TT[(i2 + 63) * 136 + i1] = h;
            if (i2 >= 1 && i1 + 1 < 128) TT[(i2 - 1) * 136 + i1 + 1] = h; }
    }
    __syncthreads();
    const _Float16* FK = (const _Float16*)(p.ws + WS_FKTAB);
    f16x8 af[4];
#pragma unroll
    for (int ks = 0; ks < 4; ++ks) af[ks] = *(const f16x8*)(TT + (16 * wid + fr) * 136 + 32 * ks + 8 * fq);
    _Float16* KH = (_Float16*)(p.ws + WS_KH) + (size_t)it * (64 * 2 * 128);
#pragma unroll
    for (int nt = 0; nt < 8; ++nt) {
        f32x4 acc = (f32x4){0.f, 0.f, 0.f, 0.f};
#pragma unroll
        for (int ks = 0; ks < 4; ++ks) { const f16x8 bfv = *(const f16x8*)(FK + (16 * nt + fr) * 128 + 32 * ks + 8 * fq); acc = __builtin_amdgcn_mfma_f32_16x16x32_f16(af[ks], bfv, acc, 0, 0, 0); }
        const int rho = 16 * nt + fr; u32x2 o; o.x = pkh2(acc[3], acc[2]); o.y = pkh2(acc[1], acc[0]);
        *(u32x2*)(KH + (size_t)rho * 128 + (124 - 16 * wid - 4 * fq)) = o;
    }
}

constexpr int HY_ZB = 0, HY_ZH = 73728, HY_OH = 92160, HY_GT = 112640, HY_KC = 145408, HY_LDS_END = 145408 + 8 * 576;
__device__ __forceinline__ f16x8 neg8(f16x8 v) { u32x4 w = __builtin_bit_cast(u32x4, v); w.x ^= 0x80008000u; w.y ^= 0x80008000u; w.z ^= 0x80008000u; w.w ^= 0x80008000u; return __builtin_bit_cast(f16x8, w); }
__device__ __forceinline__ void hyena_item(const Params& p, int it, unsigned char* lds) {
    const int tid = otid(), wid = tid >> 6, lane = tid & 63, fr = lane & 15, fq = lane >> 4;
    const int c = it >> 1, b = (it & 1) * 8 + wid;
    _Float16* ZB = (_Float16*)(lds + HY_ZB) + wid * (64 * 72);
    _Float16* ZH = (_Float16*)(lds + HY_ZH);
    _Float16* OH = (_Float16*)(lds + HY_OH);
    _Float16* GTW = (_Float16*)(lds + HY_GT) + wid * 2048;
    _Float16* KC = (_Float16*)(lds + HY_KC) + wid * 288;
    const _Float16* UT = (const _Float16*)(p.ws + WS_UT); const _Float16* FT = (const _Float16*)(p.ws + WS_FTAB); const _Float16* GT = (const _Float16*)(p.ws + WS_GTAB);
    bf16_t* HYT = (bf16_t*)(p.ws + WS_HYT);
    __syncthreads();
    if (lane < 32) KC[(lane >> 4) * 144 + 128 + (lane & 15)] = (_Float16)0.f;
    {   const _Float16* ur = UT + ((size_t)(b * 1536 + c)) * 4096;
        const float w0 = p.hy_conv_w[c], w1 = p.hy_conv_w[1536 + c], w2 = p.hy_conv_w[3072 + c], bb = p.hy_conv_b[c];
#pragma unroll 2
        for (int i8 = 0; i8 < 8; ++i8) { const int t0 = 8 * (lane + 64 * i8);
            const f16x8 raw = *(const f16x8*)(ur + t0); float uv[10];
            uv[0] = (t0 > 0) ? (float)ur[t0 - 1] : 0.f; uv[9] = (t0 + 8 < 4096) ? (float)ur[t0 + 8] : 0.f;
#pragma unroll
            for (int i = 0; i < 8; ++i) uv[1 + i] = (float)raw[i];
            const int s1 = t0 >> 6, s2 = t0 & 63;
#pragma unroll
            for (int i = 0; i < 8; ++i) ZB[(s2 + i) * 72 + s1] = (_Float16)(bb + uv[i] * w0 + uv[i + 1] * w1 + uv[i + 2] * w2); }
    }
#pragma unroll 1
    for (int o = 0; o < 2; ++o) {
        f16x8 zf[4][2];
#pragma unroll
        for (int mt = 0; mt < 4; ++mt)
#pragma unroll
            for (int ks = 0; ks < 2; ++ks) zf[mt][ks] = *(const f16x8*)(ZB + (16 * mt + fr) * 72 + 32 * ks + 8 * fq);
        f32x4 accI[4][4];
#pragma unroll
        for (int mt = 0; mt < 4; ++mt)
#pragma unroll
            for (int nt = 0; nt < 4; ++nt) accI[mt][nt] = (f32x4){0.f, 0.f, 0.f, 0.f};
        const _Float16* KHo = (const _Float16*)(p.ws + WS_KH) + (size_t)(o * 512 + c) * (64 * 2 * 128);
#pragma unroll 1
        for (int j = 0; j < 8; ++j) {
            const int f = 8 * j + wid;
            if (lane < 32) *(u32x4*)(KC + (lane >> 4) * 144 + (lane & 15) * 8) = *(const u32x4*)(KHo + (size_t)f * 256 + lane * 8);
#pragma unroll
            for (int i = 0; i < 4; ++i) { const int v = lane + 64 * i, x = v >> 7, sg = (v >> 4) & 7, q = v & 15; const unsigned short* src = (const unsigned short*)(KC + x * 144 + 8 * q + sg + 1);
                u32x4 w; w.x = src[0] | ((unsigned)src[1] << 16); w.y = src[2] | ((unsigned)src[3] << 16); w.z = src[4] | ((unsigned)src[5] << 16); w.w = src[6] | ((unsigned)src[7] << 16);
                *(u32x4*)(GTW + v * 8) = w; }
            {   f16x8 ff[2];
#pragma unroll
                for (int ks = 0; ks < 2; ++ks) ff[ks] = *(const f16x8*)(FT + (16 * j + fr) * 64 + 32 * ks + 8 * fq);
#pragma unroll
                for (int mt = 0; mt < 4; ++mt) { f32x4 a = (f32x4){0.f, 0.f, 0.f, 0.f};
                    a = __builtin_amdgcn_mfma_f32_16x16x32_f16(zf[mt][0], ff[0], a, 0, 0, 0); a = __builtin_amdgcn_mfma_f32_16x16x32_f16(zf[mt][1], ff[1], a, 0, 0, 0);
                    u32x2 w; w.x = pkh2(a[0], a[1]); w.y = pkh2(a[2], a[3]);
                    *(u32x2*)(ZH + (((fr >> 1) * 8 + wid) * 2 + (fr & 1)) * 72 + 16 * mt + 4 * fq) = w; }
            }
            __syncthreads();
            {   const int bb = fr >> 1, part = fr & 1;
                f16x8 a1[2], a2[2];
#pragma unroll
                for (int ks = 0; ks < 2; ++ks) {
                    const f16x8 s1v = *(const f16x8*)(ZH + ((wid * 8 + bb) * 2 + part) * 72 + 32 * ks + 8 * fq);
                    const f16x8 s2v = *(const f16x8*)(ZH + ((wid * 8 + bb) * 2 + (1 - part)) * 72 + 32 * ks + 8 * fq);
                    const f16x8 zero = (f16x8){0, 0, 0, 0, 0, 0, 0, 0};
                    if (f == 0) { a1[ks] = part ? zero : s1v; a2[ks] = part ? s1v : zero; }
                    else { a1[ks] = s1v; a2[ks] = part ? s2v : neg8(s2v); }
                }
                const int sg = 7 - (fr & 7);
#pragma unroll
                for (int nt = 0; nt < 4; ++nt) { f32x4 a = (f32x4){0.f, 0.f, 0.f, 0.f};
                    const int qa = 7 - 2 * nt - (fr >> 3);
#pragma unroll
                    for (int ks = 0; ks < 2; ++ks) {
                        const f16x8 b1 = *(const f16x8*)(GTW + ((0 * 8 + sg) * 16 + qa + 4 * ks + fq) * 8);
                        const f16x8 b2 = *(const f16x8*)(GTW + ((1 * 8 + sg) * 16 + qa + 4 * ks + fq) * 8);
                        a = __builtin_amdgcn_mfma_f32_16x16x32_f16(a1[ks], b1, a, 0, 0, 0); a = __builtin_amdgcn_mfma_f32_16x16x32_f16(a2[ks], b2, a, 0, 0, 0); }
                    const int t2 = 16 * nt + fr;
                    *(unsigned*)(OH + ((2 * fq) * 64 + t2) * 20 + 2 * wid) = pkh2(a[0], a[1]);
                    *(unsigned*)(OH + ((2 * fq + 1) * 64 + t2) * 20 + 2 * wid) = pkh2(a[2], a[3]); }
            }
            __syncthreads();
            {   f16x4 gf[4];
#pragma unroll
                for (int nt = 0; nt < 4; ++nt) gf[nt] = *(const f16x4*)(GT + (16 * nt + fr) * 128 + 16 * j + 4 * fq);
#pragma unroll
                for (int mt = 0; mt < 4; ++mt) { const f16x4 av = *(const f16x4*)(OH + (wid * 64 + 16 * mt + fr) * 20 + 4 * fq);
#pragma unroll
                    for (int nt = 0; nt < 4; ++nt) accI[mt][nt] = __builtin_amdgcn_mfma_f32_16x16x16f16(av, gf[nt], accI[mt][nt], 0, 0, 0); }
            }
        }
        {   const int ch = (o + 1) * 512 + c; const _Float16* ur = UT + ((size_t)(b * 1536 + ch)) * 4096;
            const float w0 = p.hy_conv_w[ch], w1 = p.hy_conv_w[1536 + ch], w2 = p.hy_conv_w[3072 + ch], bb = p.hy_conv_b[ch], sk = p.hy_skip[o * 512 + c];
#pragma unroll
            for (int mt = 0; mt < 4; ++mt)
#pragma unroll
                for (int nt = 0; nt < 4; ++nt) { const int t1 = 16 * nt + fr, t2 = 16 * mt + 4 * fq, t = 64 * t1 + t2;
                    const f16x4 raw = *(const f16x4*)(ur + t); float uv[6];
                    uv[0] = (t > 0) ? (float)ur[t - 1] : 0.f; uv[5] = (t + 4 < 4096) ? (float)ur[t + 4] : 0.f;
#pragma unroll
                    for (int i = 0; i < 4; ++i) uv[1 + i] = (float)raw[i];
                    float zn[4];
#pragma unroll
                    for (int r = 0; r < 4; ++r) { const float xg = bb + uv[r] * w0 + uv[r + 1] * w1 + uv[r + 2] * w2; const float zo = (float)ZB[(t2 + r) * 72 + t1];
                        zn[r] = xg * (accI[mt][nt][r] + sk * zo); }
                    if (o == 0) {
#pragma unroll
                        for (int r = 0; r < 4; ++r) ZB[(t2 + r) * 72 + t1] = (_Float16)zn[r];
                    } else { u32x2 w; w.x = pk2(zn[0], zn[1]); w.y = pk2(zn[2], zn[3]); *(u32x2*)(HYT + ((size_t)(b * 512 + c)) * 4096 + t) = w; }
                }
        }
    }
}

__device__ __forceinline__ void phase5_item(const Params& p, int it, unsigned char* lds) {
    const int tid = otid(), b = it >> 6, t0 = (it & 63) * 64;
    bf16_t* TL = (bf16_t*)lds;
    float* RS = (float*)(lds + 512 * 66 * 2);
    float* RS2 = RS + 512;
    const bf16_t* HYT = (const bf16_t*)(p.ws + WS_HYT); bf16_t* AH = (bf16_t*)(p.ws + WS_ATTHY);
    __syncthreads();
    {   const bf16_t* src = HYT + ((size_t)(b * 512 + tid)) * 4096 + t0;
#pragma unroll
        for (int i = 0; i < 8; ++i) { const u32x4 v = *(const u32x4*)(src + i * 8); unsigned* d = (unsigned*)(TL + tid * 66 + i * 8); d[0] = v.x; d[1] = v.y; d[2] = v.z; d[3] = v.w; } }
    __syncthreads();
    {   const int tt = tid & 63, cg8 = tid >> 6; float s = 0.f;
        for (int cc = 0; cc < 64; ++cc) { const float v = bf2f(TL[(cg8 * 64 + cc) * 66 + tt]); s += v * v; }
        RS[cg8 * 64 + tt] = s; }
    __syncthreads();
    if (tid < 64) { float s = 0.f;
#pragma unroll
        for (int q = 0; q < 8; ++q) s += RS[q * 64 + tid];
        RS2[tid] = rsqrtf(s * (1.f / 512.f) + EPSN); }
    __syncthreads();
    {   const int tt = tid >> 3, ch = tid & 7; const float rstd = RS2[tt];
        bf16_t* orow = AH + (size_t)(b * 4096 + t0 + tt) * 1024;
#pragma unroll
        for (int g = 0; g < 8; ++g) { const int c0 = ch * 64 + g * 8; float y[8];
#pragma unroll
            for (int i = 0; i < 8; ++i) y[i] = bf2f(TL[(c0 + i) * 66 + tt]) * rstd * p.group_norm_w[512 + c0 + i];
            u32x4 w; w.x = pk2(y[0], y[1]); w.y = pk2(y[2], y[3]); w.z = pk2(y[4], y[5]); w.w = pk2(y[6], y[7]); *(u32x4*)(orow + 512 + c0) = w; }
        u32x4 av[8]; float s = 0.f;
#pragma unroll
        for (int g = 0; g < 8; ++g) { av[g] = *(const u32x4*)(orow + ch * 64 + g * 8);
            const float a0 = bflo(av[g].x), a1 = bfhi(av[g].x), a2 = bflo(av[g].y), a3 = bfhi(av[g].y), a4 = bflo(av[g].z), a5 = bfhi(av[g].z), a6 = bflo(av[g].w), a7 = bfhi(av[g].w);
            s += a0 * a0 + a1 * a1 + a2 * a2 + a3 * a3 + a4 * a4 + a5 * a5 + a6 * a6 + a7 * a7; }
        s += __shfl_xor(s, 1); s += __shfl_xor(s, 2); s += __shfl_xor(s, 4);
        const float ra = rsqrtf(s * (1.f / 512.f) + EPSN);
#pragma unroll
        for (int g = 0; g < 8; ++g) { const int c0 = ch * 64 + g * 8; const float* gw = p.group_norm_w + c0;
            u32x4 w; w.x = pk2(bflo(av[g].x) * ra * gw[0], bfhi(av[g].x) * ra * gw[1]); w.y = pk2(bflo(av[g].y) * ra * gw[2], bfhi(av[g].y) * ra * gw[3]);
            w.z = pk2(bflo(av[g].z) * ra * gw[4], bfhi(av[g].z) * ra * gw[5]); w.w = pk2(bflo(av[g].w) * ra * gw[6], bfhi(av[g].w) * ra * gw[7]);
            *(u32x4*)(orow + c0) = w; }
    }
}

struct P6Sched { const char* AH; const char* WT; int G, c;
    __device__ __forceinline__ bool next(int i, pg::UDesc& u) const { const int q = i * G + c; if (q >= 1024) return false; const int pm = q >> 2, pn = q & 3;
        u.A = AH + (size_t)pm * 256 * 2048; u.B0 = WT + (size_t)pn * 256 * 2048; u.B1 = u.B0 + 8 * 128; u.i0 = 0; u.i1 = pm; u.i2 = pn; u.i3 = 0; return true; }
    __device__ __forceinline__ unsigned rowoff(const pg::UDesc&, int) const { return 0u; }
};
__device__ __forceinline__ void phase6(const Params& p, unsigned char* lds) {
    const float* MOD = (const float*)(p.ws + WS_MOD);
    P6Sched S{(const char*)(p.ws + WS_ATTHY), (const char*)(p.ws + WS_WOUTT), (int)gridDim.x, vcu_of(blockIdx.x, gridDim.x)};
    auto E = [&](const f32x4 (&acc)[2][2][4][2], const pg::UDesc& u, int wr, int wc, int fr, int fq) {
        const float* g1 = MOD + (size_t)((u.i1 * 256) >> 12) * 6144 + 2048 + u.i2 * 256;
        ACCN_FOREACH(acc, wr, wc, fr, fq, { const size_t off = (size_t)(u.i1 * 256 + rl) * 1024 + u.i2 * 256 + cl; const f32x4 xv = *(const f32x4*)(p.x + off); const f32x4 gv = *(const f32x4*)(g1 + cl);
            *(f32x4*)(p.out + off) = xv + gv * v; });
    };
    pg::gemm_stream<false, false>((LAS unsigned char*)lds, 1024, 1024, S, E);
}

__device__ __forceinline__ int pair_index(int lo, int hi) { return lo * 8 - (lo * (lo + 1)) / 2 + (hi - lo - 1); }
__device__ __forceinline__ void phase7(const Params& p) {
    const int tidq = otid(), lane = tidq & 63, gw = blockIdx.x * 8 + (tidq >> 6), ngw = gridDim.x * 8;
    const float* MOD = (const float*)(p.ws + WS_MOD); bf16_t* H2 = (bf16_t*)(p.ws + WS_H);
    int* CNT = (int*)(p.ws + WS_CTL); int* LIST = (int*)(p.ws + WS_LIST); float* GATE = (float*)(p.ws + WS_GATE);
    for (int row = gw; row < NTOK; row += ngw) {
        const float* xr = p.out + (size_t)row * 1024; const float* md = MOD + (size_t)(row >> 12) * 6144;
        f32x4 v[4]; float s = 0.f;
#pragma unroll
        for (int j = 0; j < 4; ++j) { v[j] = *(const f32x4*)(xr + 256 * j + lane * 4); s += v[j].x * v[j].x + v[j].y * v[j].y + v[j].z * v[j].z + v[j].w * v[j].w; }
        const float rstd = rsqrtf(wave_sum(s) * (1.f / 1024.f) + EPSN);
        float gl[4] = {0.f, 0.f, 0.f, 0.f};
#pragma unroll
        for (int j = 0; j < 4; ++j) { const int k = 256 * j + lane * 4;
            const f32x4 nw = *(const f32x4*)(p.norm2_w + k), sh = *(const f32x4*)(md + 3072 + k), sc = *(const f32x4*)(md + 4096 + k);
            const f32x4 y = (v[j] * rstd) * nw * (sc + 1.f) + sh; v[j] = y;
            u32x2 o; o.x = pk2(y.x, y.y); o.y = pk2(y.z, y.w); *(u32x2*)(H2 + (size_t)row * 1024 + k) = o;
#pragma unroll
            for (int e = 0; e < 4; ++e) { const f32x4 w = *(const f32x4*)(p.router_g_w + (size_t)(k + e) * 4); const float ye = y[e]; gl[0] += ye * w.x; gl[1] += ye * w.y; gl[2] += ye * w.z; gl[3] += ye * w.w; } }
#pragma unroll
        for (int e = 0; e < 4; ++e) gl[e] = wave_sum(gl[e]) + p.router_g_b[e];
        int g = 0; float gm = gl[0];
#pragma unroll
        for (int e = 1; e < 4; ++e) if (gl[e] > gm) { gm = gl[e]; g = e; }
        float gs = 0.f;
#pragma unroll
        for (int e = 0; e < 4; ++e) gs += __expf(gl[e] - gm);
        const float gval = 1.f / gs;
        float el[8] = {0.f, 0.f, 0.f, 0.f, 0.f, 0.f, 0.f, 0.f};
#pragma unroll
        for (int j = 0; j < 4; ++j) { const int k = 256 * j + lane * 4;
#pragma unroll
            for (int e = 0; e < 4; ++e) { const float* wr = p.router_e_w + (size_t)(k + e) * 32 + g * 8; const f32x4 w0 = *(const f32x4*)wr, w1 = *(const f32x4*)(wr + 4); const float ye = v[j][e];
                el[0] += ye * w0.x; el[1] += ye * w0.y; el[2] += ye * w0.z; el[3] += ye * w0.w; el[4] += ye * w1.x; el[5] += ye * w1.y; el[6] += ye * w1.z; el[7] += ye * w1.w; } }
#pragma unroll
        for (int e = 0; e < 8; ++e) el[e] = wave_sum(el[e]) + p.router_e_b[g * 8 + e];
        int e1 = 0; float m1 = el[0];
#pragma unroll
        for (int e = 1; e < 8; ++e) if (el[e] > m1) { m1 = el[e]; e1 = e; }
        int e2 = -1; float m2 = -3.0e38f;
#pragma unroll
        for (int e = 0; e < 8; ++e) if (e != e1 && el[e] > m2) { m2 = el[e]; e2 = e; }
        const float r = __expf(m2 - m1), w1 = 1.f / (1.f + r), w2 = r / (1.f + r);
        if (lane == 0) {
            const int lo = e1 < e2 ? e1 : e2, hi = e1 < e2 ? e2 : e1;
            const float glo = gval * (e1 < e2 ? w1 : w2), ghi = gval * (e1 < e2 ? w2 : w1);
            const int cls = g * 28 + pair_index(lo, hi);
            const int rank = atomicAdd(CNT + cls, 1);
            LIST[(size_t)cls * 65536 + rank] = row;
            GATE[row * 2] = glo; GATE[row * 2 + 1] = ghi;
        }
    }
}

constexpr int MOE_SM = 131072;
__device__ __forceinline__ void cls_decode(int cls, int& g, int& lo, int& hi) {
    g = cls / 28; int r = cls % 28; lo = 0; while (r >= 7 - lo) { r -= 7 - lo; ++lo; } hi = lo + 1 + r;
}
__device__ __forceinline__ void moe_build_map(const Params& p, int* sm) {
    const int* CNT = (const int*)(p.ws + WS_CTL);
    __syncthreads();
    if (threadIdx.x == 0) { int base = 0; for (int c = 0; c < NCLS; ++c) { const int n = CNT[c]; sm[c] = base; sm[128 + c] = n; base += (n + 255) >> 8; } sm[256] = base; }
    __syncthreads();
    if (threadIdx.x < NCLS) { const int c = threadIdx.x, b0 = sm[c], nt = (sm[128 + c] + 255) >> 8; for (int q = 0; q < nt; ++q) sm[384 + b0 + q] = c; }
    __syncthreads();
}
struct P8Sched { const char* H2; const char* EW13; const int* LIST; const int* sm; int G, c, NU;
    __device__ __forceinline__ bool next(int i, pg::UDesc& u) const { const int q = i * G + c; if (q >= NU) return false; const int mt = q >> 3, nj = q & 7, cls = sm[384 + mt]; int g, lo, hi; cls_decode(cls, g, lo, hi);
        const int e = g * 8 + (nj < 4 ? lo : hi);
        u.A = H2; u.B0 = EW13 + ((size_t)e * 1024 + (size_t)(nj & 3) * 256) * 2048; u.B1 = u.B0 + 8 * 128; u.i0 = cls; u.i1 = mt; u.i2 = nj; u.i3 = (mt - sm[cls]) * 256; return true; }
    __device__ __forceinline__ unsigned rowoff(const pg::UDesc& u, int r) const { const int rk = u.i3 + r; const int t = (rk < sm[128 + u.i0]) ? LIST[(size_t)u.i0 * 65536 + rk] : 0; return (unsigned)t * 2048u; }
};
__device__ __forceinline__ void phase8(const Params& p, unsigned char* lds) {
    int* sm = (int*)(lds + MOE_SM);
    moe_build_map(p, sm);
    bf16_t* HID = (bf16_t*)(p.ws + WS_HID); const int* LIST = (const int*)(p.ws + WS_LIST); const float* GATE = (const float*)(p.ws + WS_GATE);
    P8Sched S{(const char*)(p.ws + WS_H), (const char*)(p.ws + WS_EW13), LIST, sm, (int)gridDim.x, vcu_of(blockIdx.x, gridDim.x), sm[256] * 8};
    auto E = [&](const f32x4 (&acc)[2][2][4][2], const pg::UDesc& u, int wr, int wc, int fr, int fq) {
        const int cnt = sm[128 + u.i0], xh = u.i2 >> 2;
#pragma unroll
        for (int a = 0; a < 2; ++a)
#pragma unroll
            for (int m = 0; m < 4; ++m) { const int rl = 128 * a + 64 * wr + 16 * m + fr, rk = u.i3 + rl; float gt = 0.f;
                if (rk < cnt) { const int t = LIST[(size_t)u.i0 * 65536 + rk]; gt = GATE[t * 2 + xh]; }
                float hv[8];
#pragma unroll
                for (int n = 0; n < 2; ++n)
#pragma unroll
                    for (int q = 0; q < 4; ++q) hv[4 * n + q] = siluf(acc[a][0][m][n][q]) * acc[a][1][m][n][q] * gt;
                u32x4 o; o.x = pk2(hv[0], hv[1]); o.y = pk2(hv[2], hv[3]); o.z = pk2(hv[4], hv[5]); o.w = pk2(hv[6], hv[7]);
                *(u32x4*)(HID + (size_t)(u.i1 * 256 + rl) * 1024 + xh * 512 + (u.i2 & 3) * 128 + 32 * wc + 8 * fq) = o; }
    };
    pg::gemm_stream<true, true>((LAS unsigned char*)lds, 1024, 1024, S, E);
}
struct P9Sched { const char* HID; const char* EW2T; const int* sm; int G, c, NU;
    __device__ __forceinline__ bool next(int i, pg::UDesc& u) const { const int q = i * G + c; if (q >= NU) return false; const int mt = q >> 2, pn = q & 3, cls = sm[384 + mt]; int g, lo, hi; cls_decode(cls, g, lo, hi);
        u.A = HID + (size_t)mt * 256 * 2048; u.B0 = EW2T + ((size_t)(g * 8 + lo) * 1024 + (size_t)pn * 256) * 1024; u.B1 = EW2T + ((size_t)(g * 8 + hi) * 1024 + (size_t)pn * 256) * 1024;
        u.i0 = cls; u.i1 = mt; u.i2 = pn; u.i3 = (mt - sm[cls]) * 256; return true; }
    __device__ __forceinline__ unsigned rowoff(const pg::UDesc&, int) const { return 0u; }
};
__device__ __forceinline__ void phase9(const Params& p, unsigned char* lds) {
    int* sm = (int*)(lds + MOE_SM);
    moe_build_map(p, sm);
    const int* LIST = (const int*)(p.ws + WS_LIST); const float* MOD = (const float*)(p.ws + WS_MOD);
    P9Sched S{(const char*)(p.ws + WS_HID), (const char*)(p.ws + WS_EW2T), sm, (int)gridDim.x, vcu_of(blockIdx.x, gridDim.x), sm[256] * 4};
    auto E = [&](const f32x4 (&acc)[2][2][4][2], const pg::UDesc& u, int wr, int wc, int fr, int fq) {
        const int cnt = sm[128 + u.i0];
#pragma unroll
        for (int a = 0; a < 2; ++a)
#pragma unroll
            for (int m = 0; m < 4; ++m) { const int rl = 128 * a + 64 * wr + 16 * m + fr, rk = u.i3 + rl;
                if (rk < cnt) { const int t = LIST[(size_t)u.i0 * 65536 + rk]; const float* g2 = MOD + (size_t)(t >> 12) * 6144 + 5120 + u.i2 * 256; float* orow = p.out + (size_t)t * 1024 + u.i2 * 256;
#pragma unroll
                    for (int b = 0; b < 2; ++b)
#pragma unroll
                        for (int n = 0; n < 2; ++n) { const int cl = 128 * b + 32 * wc + 16 * n + 4 * fq; const f32x4 x1 = *(const f32x4*)(orow + cl); const f32x4 gv = *(const f32x4*)(g2 + cl);
                            *(f32x4*)(orow + cl) = x1 + gv * acc[a][b][m][n]; } } }
    };
    pg::gemm_stream<false, false>((LAS unsigned char*)lds, 1024, 512, S, E);
}

constexpr int LDS_BYTES = 150 * 1024;
__global__ void __launch_bounds__(NTHR, 2) fwd_kernel(Params p) {
    extern __shared__ __attribute__((aligned(16))) unsigned char lds[];
    cg::grid_group grid = cg::this_grid();
    phase0(p, lds);
    grid.sync();
    phase1(p, lds);
    for (int it = blockIdx.x; it < 1024; it += gridDim.x) khat_item(p, it, lds);
    grid.sync();
    phase2(p, lds);
    grid.sync();
    phase3(p);
    grid.sync();
    for (int u = blockIdx.x; u < 1024; u += gridDim.x) attn_unit(p, u, lds);
    for (int it = blockIdx.x; it < 1024; it += gridDim.x) hyena_item(p, it, lds);
    grid.sync();
    for (int it = blockIdx.x; it < 1024; it += gridDim.x) phase5_item(p, it, lds);
    grid.sync();
    phase6(p, lds);
    grid.sync();
    phase7(p);
    grid.sync();
    phase8(p, lds);
    grid.sync();
    phase9(p, lds);
}

extern "C" void kernel_launch(void* const* d_in, const int* in_sizes, int n_in, void* d_out, int out_size, void* d_ws, size_t ws_size, hipStream_t stream) {
    static int grid_blocks = 0;
    if (grid_blocks == 0) {
        if (n_in != 30 || out_size != NTOK * DM || ws_size < WS_END) { fprintf(stderr, "kernel_launch: unexpected shapes (n_in %d out %d ws %zu)\n", n_in, out_size, ws_size); grid_blocks = -1; return; }
        int dev = 0, cus = 0, per_cu = 0;
        hipGetDevice(&dev); hipDeviceGetAttribute(&cus, hipDeviceAttributeMultiprocessorCount, dev);
        hipFuncSetAttribute((const void*)fwd_kernel, hipFuncAttributeMaxDynamicSharedMemorySize, LDS_BYTES);
        hipOccupancyMaxActiveBlocksPerMultiprocessor(&per_cu, (const void*)fwd_kernel, NTHR, LDS_BYTES);
        if (per_cu < 1) { fprintf(stderr, "kernel_launch: occupancy query says %d blocks per CU\n", per_cu); grid_blocks = -1; return; }
        grid_blocks = cus * per_cu;
    }
    if (grid_blocks < 0) return;
    Params p{};
    const float** pp = (const float**)&p;
    for (int i = 0; i < 30; ++i) pp[i] = (const float*)d_in[i];
    p.out = (float*)d_out; p.ws = (unsigned char*)d_ws;
    void* args[] = {&p};
    hipError_t e = hipLaunchCooperativeKernel((const void*)fwd_kernel, dim3(grid_blocks), dim3(NTHR), args, LDS_BYTES, stream);
    if (e != hipSuccess) fprintf(stderr, "cooperative launch failed: %s (grid %d)\n", hipGetErrorString(e), grid_blocks);
}
```

```cpp
#include <hip/hip_runtime.h>
#include <hip/hip_cooperative_groups.h>
#include <cstdio>
#include <cstdint>
namespace cg = cooperative_groups;

typedef unsigned short bf16_t;
typedef short bf16x8 __attribute__((ext_vector_type(8)));
typedef float f32x4 __attribute__((ext_vector_type(4)));
typedef unsigned u32x4 __attribute__((ext_vector_type(4)));
typedef unsigned u32x2 __attribute__((ext_vector_type(2)));
typedef _Float16 f16x8 __attribute__((ext_vector_type(8)));
typedef _Float16 f16x4 __attribute__((ext_vector_type(4)));
typedef _Float16 f16x2 __attribute__((ext_vector_type(2)));

constexpr int DM = 1024, NB = 16, SEQ = 4096, NTOK = NB * SEQ, CTXL = 256, NCTX = NB * CTXL;
constexpr int PROJW = 2304, HYW = 512, HYPW = 1536, KOFF = 512, VOFF = 640, HYOFF = 768;
constexpr int NEXP = 32, EHID = 512, NCLS = 112;
constexpr float EPSN = 1e-6f;
constexpr int NTHR = 512;

constexpr size_t MiB = 1u << 20;
constexpr size_t WS_CTL = 0, WS_MOD = 1 * MiB, WS_WINT = 2 * MiB, WS_WOUTT = 7 * MiB, WS_TAPS = 9 * MiB, WS_EW13 = 41 * MiB, WS_EW2T = 105 * MiB;
constexpr size_t WS_GATE = 137 * MiB, WS_KVC = 139 * MiB, WS_HC = 141 * MiB, WS_LIST = 149 * MiB, WS_H = 177 * MiB, WS_QKV = 305 * MiB, WS_UT = 401 * MiB;
constexpr size_t WS_HYT = 593 * MiB, WS_ATTHY = 657 * MiB, WS_HID = 305 * MiB, WS_KH = 785 * MiB, WS_END = 1003 * MiB;
constexpr size_t WS_BAR = 16384;
constexpr size_t WS_GSLOT = 945 * MiB;
constexpr size_t WS_D1 = 817 * MiB;
constexpr size_t WS_FTAB = 65536, WS_GTAB = 81920, WS_FKTAB = 98304;

struct Params {
    const float* x; const float* c; const float* ctx; const float* c_ctx; const float* ada_w; const float* ada_b; const float* norm1_w; const float* w_in;
    const float* q_norm_w; const float* k_norm_w; const float* attn_sink; const float* hy_conv_w; const float* hy_conv_b; const float* hy_w1; const float* hy_b1;
    const float* hy_w2; const float* hy_b2; const float* hy_w3; const float* hy_sin_freq; const float* hy_skip; const float* group_norm_w; const float* w_out;
    const float* norm2_w; const float* router_g_w; const float* router_g_b; const float* router_e_w; const float* router_e_b; const float* exp_w1; const float* exp_w3;
    const float* exp_w2;
    float* out; unsigned char* ws;
};

__device__ __forceinline__ unsigned f2bf(float f) { unsigned u = __builtin_bit_cast(unsigned, f); return (u + 0x7fffu + ((u >> 16) & 1u)) >> 16; }
typedef float f32x2_t __attribute__((ext_vector_type(2))); typedef __bf16 bf16x2_t __attribute__((ext_vector_type(2)));
__device__ __forceinline__ unsigned pk2(float lo, float hi) { f32x2_t v = {lo, hi}; bf16x2_t b = __builtin_convertvector(v, bf16x2_t); return __builtin_bit_cast(unsigned, b); }
__device__ __forceinline__ float bf2f(unsigned short b) { return __builtin_bit_cast(float, (unsigned)b << 16); }
__device__ __forceinline__ float bflo(unsigned w) { return __builtin_bit_cast(float, w << 16); }
__device__ __forceinline__ float bfhi(unsigned w) { return __builtin_bit_cast(float, w & 0xffff0000u); }
__device__ __forceinline__ unsigned pkh2(float lo, float hi) { f16x2 v = {(_Float16)lo, (_Float16)hi}; return __builtin_bit_cast(unsigned, v); }
__device__ __forceinline__ float h2f(unsigned short h) { return (float)__builtin_bit_cast(_Float16, h); }
__device__ __forceinline__ float hlo(unsigned w) { return h2f((unsigned short)(w & 0xffffu)); }
__device__ __forceinline__ float hhi(unsigned w) { return h2f((unsigned short)(w >> 16)); }
#define dpp_f(v, ctrl) __builtin_bit_cast(float, __builtin_amdgcn_update_dpp(0, __builtin_bit_cast(int, (float)(v)), (ctrl), 0xf, 0xf, false))
#define DPP_XOR1 0xB1
#define DPP_XOR2 0x4E
#define DPP_HMIRROR 0x141
#define DPP_MIRROR 0x140
__device__ __forceinline__ float xor16_sum(float v) { const unsigned u = __builtin_bit_cast(unsigned, v); auto r = __builtin_amdgcn_permlane16_swap(u, u, false, false); return __builtin_bit_cast(float, (unsigned)r[0]) + __builtin_bit_cast(float, (unsigned)r[1]); }
__device__ __forceinline__ float xor32_sum(float v) { const unsigned u = __builtin_bit_cast(unsigned, v); auto r = __builtin_amdgcn_permlane32_swap(u, u, false, false); return __builtin_bit_cast(float, (unsigned)r[0]) + __builtin_bit_cast(float, (unsigned)r[1]); }
__device__ __forceinline__ float wave_sum(float v) {
    v += dpp_f(v, DPP_XOR1); v += dpp_f(v, DPP_XOR2); v += dpp_f(v, DPP_HMIRROR); v += dpp_f(v, DPP_MIRROR);
    v = xor16_sum(v); v = xor32_sum(v);
    return v;
}
__device__ __forceinline__ int otid() { int t = threadIdx.x; asm volatile("" : "+v"(t)); return t; }
__device__ __forceinline__ float exp2_raw(float x) { float r; asm volatile("v_exp_f32 %0, %1\n\ts_nop 1" : "=v"(r) : "v"(x)); return r; }
__device__ __forceinline__ float max_fq(float m) { const unsigned u = __builtin_bit_cast(unsigned, m);
    auto r16 = __builtin_amdgcn_permlane16_swap(u, u, false, false); float a = fmaxf(__builtin_bit_cast(float, (unsigned)r16[0]), __builtin_bit_cast(float, (unsigned)r16[1]));
    const unsigned ua = __builtin_bit_cast(unsigned, a); auto r32 = __builtin_amdgcn_permlane32_swap(ua, ua, false, false); return fmaxf(__builtin_bit_cast(float, (unsigned)r32[0]), __builtin_bit_cast(float, (unsigned)r32[1])); }
__device__ __forceinline__ float siluf(float v) { return v / (1.f + __expf(-v)); }
__device__ __forceinline__ float rcp_raw(float x) { float r; asm volatile("v_rcp_f32 %0, %1\n\ts_nop 1" : "=v"(r) : "v"(x)); return r; }
__device__ __forceinline__ float silu_fast(float v) { return v * rcp_raw(1.f + exp2_raw(v * -1.4426950408889634f)); }
__device__ __forceinline__ float sin_rad(float a) { float r = a * 0.15915494309189535f; r -= floorf(r); return __builtin_amdgcn_sinf(r); }
__device__ __forceinline__ float cos_rad(float a) { float r = a * 0.15915494309189535f; r -= floorf(r); return __builtin_amdgcn_cosf(r); }

template <class SrcA, class SrcB>
__device__ __forceinline__ void gemm_unit(unsigned char* lds, f32x4 (&acc)[2][2][4][2], const SrcA& srcA, const SrcB& srcB) {
    const int tid = otid(), wid = tid >> 6, lane = tid & 63, wr = wid >> 2, wc = wid & 3, fr = lane & 15, fq = lane >> 4;
#pragma unroll
    for (int a = 0; a < 2; ++a)
#pragma unroll
        for (int b = 0; b < 2; ++b)
#pragma unroll
            for (int m = 0; m < 4; ++m)
#pragma unroll
                for (int n = 0; n < 2; ++n) acc[a][b][m][n] = (f32x4){0.f, 0.f, 0.f, 0.f};
    const int r0 = tid >> 2, kc = tid & 3;
    const bf16_t* pa0 = srcA(r0) + kc * 8; const bf16_t* pa1 = srcA(r0 + 128) + kc * 8;
    u32x4 ra0, ra1, rb0, rb1;
    ra0 = *(const u32x4*)(pa0); ra1 = *(const u32x4*)(pa1);
    rb0 = *(const u32x4*)(srcB(r0, 0) + kc * 8); rb1 = *(const u32x4*)(srcB(r0 + 128, 0) + kc * 8);
    unsigned char* sA = lds; unsigned char* sB = lds + 16384;
    for (int ks = 0; ks < 32; ++ks) {
        __syncthreads();
        *(u32x4*)(sA + tid * 16) = ra0; *(u32x4*)(sA + 8192 + tid * 16) = ra1;
        *(u32x4*)(sB + tid * 16) = rb0; *(u32x4*)(sB + 8192 + tid * 16) = rb1;
        __syncthreads();
        if (ks + 1 < 32) {
            ra0 = *(const u32x4*)(pa0 + (ks + 1) * 32); ra1 = *(const u32x4*)(pa1 + (ks + 1) * 32);
            rb0 = *(const u32x4*)(srcB(r0, ks + 1) + kc * 8); rb1 = *(const u32x4*)(srcB(r0 + 128, ks + 1) + kc * 8);
        }
        bf16x8 Af[2][4], Bf[2][2];
#pragma unroll
        for (int a = 0; a < 2; ++a)
#pragma unroll
            for (int m = 0; m < 4; ++m) Af[a][m] = *(const bf16x8*)(sA + (128 * a + 64 * wr + 16 * m + fr) * 64 + fq * 16);
#pragma unroll
        for (int b = 0; b < 2; ++b)
#pragma unroll
            for (int n = 0; n < 2; ++n) Bf[b][n] = *(const bf16x8*)(sB + (128 * b + 32 * wc + 16 * n + fr) * 64 + fq * 16);
#pragma unroll
        for (int a = 0; a < 2; ++a)
#pragma unroll
            for (int b = 0; b < 2; ++b)
#pragma unroll
                for (int m = 0; m < 4; ++m)
#pragma unroll
                    for (int n = 0; n < 2; ++n) acc[a][b][m][n] = __builtin_amdgcn_mfma_f32_16x16x32_bf16(Bf[b][n], Af[a][m], acc[a][b][m][n], 0, 0, 0);
    }
}
#define ACC_FOREACH(acc, BODY) do { \
    const int _wid = threadIdx.x >> 6, _lane = threadIdx.x & 63, _wr = _wid >> 2, _wc = _wid & 3, _fr = _lane & 15, _fq = _lane >> 4; \
    _Pragma("unroll") for (int _a = 0; _a < 2; ++_a) _Pragma("unroll") for (int _m = 0; _m < 4; ++_m) _Pragma("unroll") for (int _b = 0; _b < 2; ++_b) _Pragma("unroll") for (int _n = 0; _n < 2; ++_n) { \
        const int rl = 128 * _a + 64 * _wr + 16 * _m + _fr, cl = 128 * _b + 32 * _wc + 16 * _n + 4 * _fq; const f32x4 v = acc[_a][_b][_m][_n]; BODY } } while (0)


#define LAS __attribute__((address_space(3)))
namespace pg {
constexpr int HTB = 16384;
__device__ __forceinline__ int lds_byte(int r, int c) { const int st = (r >> 4) * 2 + (c >> 5), rr = r & 15, cc = c & 31, ob = rr * 64 + cc * 2; return st * 1024 + (ob ^ (((ob >> 9) & 1) << 5)); }
__device__ __forceinline__ void stage_rc(int b, int& R, int& C) { const int st = b / 1024, sb = b % 1024, swz = sb ^ (((sb >> 9) & 1) << 5); R = (st >> 1) * 16 + swz / 64; C = (st & 1) * 32 + (swz % 64) / 2; }
__device__ __forceinline__ int perm32(int rho) { const int n = rho >> 4, i = rho & 15; return 8 * (i >> 2) + 4 * n + (i & 3); }
struct UDesc { const char* A; const char* B0; const char* B1; int i0, i1, i2, i3; };
typedef int v8i_t __attribute__((ext_vector_type(8)));
template <bool GATHER, bool PERM, bool FP8, class Sched, class Epi>
__device__ __forceinline__ void gemm_stream(LAS unsigned char* lds, const int KA, const int KB, const Sched& S, const Epi& E) {
    const int tid = otid(), wid = __builtin_amdgcn_readfirstlane(tid >> 6), lane = tid & 63, wr = wid >> 2, wc = wid & 3, fr = lane & 15, fq = lane >> 4;
    constexpr int nt = FP8 ? 8 : 16, nth = nt / 2;
    unsigned voffA[2], voffB[2]; int rowA[2]; unsigned colA[2];
#pragma unroll
    for (int i = 0; i < 2; ++i) { int R, C; stage_rc(tid * 16 + i * 8192, R, C); const int Rb = PERM ? ((R & ~31) + perm32(R & 31)) : R;
        voffA[i] = (unsigned)(R * KA + C * 2); voffB[i] = (unsigned)(Rb * KB + C * 2); rowA[i] = R; colA[i] = (unsigned)C * 2u; }
    const size_t hstepA = (size_t)128 * KA, hstepB = (size_t)128 * KB;
    const unsigned ldsw = (unsigned)wid * 1024u;
    const int aoff = lds_byte(wr * 64 + fr, fq * 8), boff = lds_byte(wc * 32 + fr, fq * 8);
    const int aoff8a = lds_byte(wr * 64 + fr, fq * 16), aoff8b = aoff8a + 16, boff8a = lds_byte(wc * 32 + fr, fq * 16), boff8b = boff8a + 16;
#define PG_SA(b, h) (((b) * 2 + (h)) * pg::HTB)
#define PG_SB(b, h) ((4 + (b) * 2 + (h)) * pg::HTB)
#define PG_LD2(bufoff, p0, p1) do { __builtin_amdgcn_global_load_lds((const unsigned*)(p0), (LAS unsigned*)(lds + (bufoff) + ldsw), 16, 0, 0); \
        __builtin_amdgcn_global_load_lds((const unsigned*)(p1), (LAS unsigned*)(lds + (bufoff) + ldsw + 8192), 16, 0, 0); } while (0)
#define PG_STA(bufoff, pa, VA, h) do { if (GATHER) PG_LD2(bufoff, (pa) + ((h) ? VA##10 : VA##00), (pa) + ((h) ? VA##11 : VA##01)); else { const char* _b = (pa) + (h) * hstepA; PG_LD2(bufoff, _b + voffA[0], _b + voffA[1]); } } while (0)
#define PG_STB(bufoff, pb, h) do { const char* _b = (pb) + (h) * hstepB; PG_LD2(bufoff, _b + voffB[0], _b + voffB[1]); } while (0)
#define PG_LD8(p0, p1) __builtin_bit_cast(v8i_t, __builtin_shufflevector(*(const LAS bf16x8*)(p0), *(const LAS bf16x8*)(p1), 0, 1, 2, 3, 4, 5, 6, 7, 8, 9, 10, 11, 12, 13, 14, 15))
#define PG_LDA(dst, b, h) do { _Pragma("unroll") for (int m = 0; m < 4; ++m) { if (FP8) dst##8[m] = PG_LD8(lds + PG_SA(b, h) + aoff8a + m * 2048, lds + PG_SA(b, h) + aoff8b + m * 2048); \
        else { _Pragma("unroll") for (int k = 0; k < 2; ++k) dst[m][k] = *(const LAS bf16x8*)(lds + PG_SA(b, h) + aoff + m * 2048 + k * 1024); } } } while (0)
#define PG_LDB(dst, b, h) do { _Pragma("unroll") for (int n = 0; n < 2; ++n) { if (FP8) dst##8[n] = PG_LD8(lds + PG_SB(b, h) + boff8a + n * 2048, lds + PG_SB(b, h) + boff8b + n * 2048); \
        else { _Pragma("unroll") for (int k = 0; k < 2; ++k) dst[n][k] = *(const LAS bf16x8*)(lds + PG_SB(b, h) + boff + n * 2048 + k * 1024); } } } while (0)
#define PG_MMA(ai, bj, At, Bt) do { __builtin_amdgcn_s_setprio(1); _Pragma("unroll") for (int m = 0; m < 4; ++m) _Pragma("unroll") for (int n = 0; n < 2; ++n) { \
        if (FP8) asm volatile("v_mfma_f32_16x16x128_f8f6f4 %0, %1, %2, %0" : "+v"(acc[ai][bj][m][n]) : "v"(Bt##8[n]), "v"(At##8[m])); \
        else { _Pragma("unroll") for (int k = 0; k < 2; ++k) acc[ai][bj][m][n] = __builtin_amdgcn_mfma_f32_16x16x32_bf16(Bt[n][k], At[m][k], acc[ai][bj][m][n], 0, 0, 0); } } __builtin_amdgcn_s_setprio(0); } while (0)
#define PG_WAIT_V(n) asm volatile("s_waitcnt vmcnt(" #n ")" ::: "memory")
#define PG_WAIT_L(n) asm volatile("s_waitcnt lgkmcnt(" #n ")" ::: "memory")
#define PG_BAR __builtin_amdgcn_s_barrier()
#define PG_SCHED __builtin_amdgcn_sched_barrier(0)
    UDesc cur, nxt; int ui = 0;
    unsigned cva00 = 0, cva01 = 0, cva10 = 0, cva11 = 0, nva00 = 0, nva01 = 0, nva10 = 0, nva11 = 0;
    if (!S.next(0, cur)) return;
    if (GATHER) { int R0, C0, R1, C1; stage_rc(otid() * 16, R0, C0); stage_rc(otid() * 16 + 8192, R1, C1);
        cva00 = S.rowoff(cur, R0) + C0 * 2; cva01 = S.rowoff(cur, R1) + C1 * 2; cva10 = S.rowoff(cur, 128 + R0) + C0 * 2; cva11 = S.rowoff(cur, 128 + R1) + C1 * 2; }
    f32x4 acc[2][2][4][2];
#pragma unroll
    for (int a = 0; a < 2; ++a)
#pragma unroll
        for (int b = 0; b < 2; ++b)
#pragma unroll
            for (int m = 0; m < 4; ++m)
#pragma unroll
                for (int n = 0; n < 2; ++n) acc[a][b][m][n] = (f32x4){0.f, 0.f, 0.f, 0.f};
    bf16x8 At[4][2], B0[2][2], B1[2][2]; v8i_t At8[4], B08[2], B18[2];
    PG_STB(PG_SB(0, 0), cur.B0, 0); PG_STB(PG_SB(0, 1), cur.B0, 1); PG_STA(PG_SA(0, 0), cur.A, cva, 0); PG_STA(PG_SA(0, 1), cur.A, cva, 1);
    if (wr == 1) PG_BAR;
    PG_WAIT_V(2); PG_BAR;
    PG_STB(PG_SB(1, 0), cur.B0 + 128, 0); PG_STA(PG_SA(1, 0), cur.A + 128, cva, 0); PG_STB(PG_SB(1, 1), cur.B0 + 128, 1);
    PG_WAIT_V(6); PG_BAR;
    for (;;) {
        const bool has_next = S.next(ui + 1, nxt);
        if (!has_next) nxt = cur;
        if (GATHER) { if (has_next) { int R0, C0, R1, C1; stage_rc(otid() * 16, R0, C0); stage_rc(otid() * 16 + 8192, R1, C1);
                nva00 = S.rowoff(nxt, R0) + C0 * 2; nva01 = S.rowoff(nxt, R1) + C1 * 2; nva10 = S.rowoff(nxt, 128 + R0) + C0 * 2; nva11 = S.rowoff(nxt, 128 + R1) + C1 * 2; }
            else { nva00 = cva00; nva01 = cva01; nva10 = cva10; nva11 = cva11; } }
        for (int t = 0; t < nt; t += 2) {
            const bool last = (t == nt - 2);
            const char* a1 = cur.A + (size_t)(t + 1) * 128;
            const char* a2 = last ? nxt.A : cur.A + (size_t)(t + 2) * 128;
            const char* b2 = last ? nxt.B0 : ((t + 2 < nth) ? cur.B0 + (size_t)(t + 2) * 128 : cur.B1 + (size_t)(t + 2 - nth) * 128);
            const char* a3 = a2 + 128; const char* b3 = b2 + 128;
            PG_LDB(B0, 0, 0); PG_LDB(B1, 0, 1); PG_SCHED; PG_LDA(At, 0, 0); PG_STA(PG_SA(1, 1), a1, cva, 1);
            if (GATHER && last) { cva00 = nva00; cva01 = nva01; cva10 = nva10; cva11 = nva11; }
            PG_WAIT_V(8); PG_WAIT_L(0); PG_BAR; PG_MMA(0, 0, At, B0); PG_MMA(0, 1, At, B1); PG_BAR; PG_SCHED;
            PG_LDA(At, 0, 1); PG_STB(PG_SB(0, 0), b2, 0); PG_STB(PG_SB(0, 1), b2, 1); PG_STA(PG_SA(0, 0), a2, cva, 0);
            PG_WAIT_V(8); PG_WAIT_L(0); PG_BAR; PG_MMA(1, 0, At, B0); PG_MMA(1, 1, At, B1); PG_BAR; PG_SCHED;
            PG_LDB(B0, 1, 0); PG_LDB(B1, 1, 1); PG_SCHED; PG_LDA(At, 1, 0); PG_STA(PG_SA(0, 1), a2, cva, 1);
            PG_WAIT_V(8); PG_WAIT_L(0); PG_BAR; PG_MMA(0, 0, At, B0); PG_MMA(0, 1, At, B1); PG_BAR; PG_SCHED;
            PG_LDA(At, 1, 1); PG_STB(PG_SB(1, 0), b3, 0); PG_STB(PG_SB(1, 1), b3, 1); PG_STA(PG_SA(1, 0), a3, cva, 0);
            PG_WAIT_V(8); PG_WAIT_L(0); PG_BAR; PG_MMA(1, 0, At, B0); PG_MMA(1, 1, At, B1); PG_BAR; PG_SCHED;
        }
        if (wr == 0) PG_BAR;
        if (FP8) asm volatile("s_nop 15\n\ts_nop 15" ::: "memory");
        E(acc, cur, wr, wc, fr, fq);
        if (!has_next) break;
#pragma unroll
        for (int a = 0; a < 2; ++a)
#pragma unroll
            for (int b = 0; b < 2; ++b)
#pragma unroll
                for (int m = 0; m < 4; ++m)
#pragma unroll
                    for (int n = 0; n < 2; ++n) acc[a][b][m][n] = (f32x4){0.f, 0.f, 0.f, 0.f};
        cur = nxt; ++ui;
        if (wr == 1) PG_BAR;
    }
    PG_WAIT_V(0);
    PG_BAR;
#undef PG_SA
#undef PG_SB
#undef PG_LD2
#undef PG_STA
#undef PG_STB
#undef PG_LDA
#undef PG_LDB
#undef PG_MMA
#undef PG_WAIT_V
#undef PG_WAIT_L
#undef PG_BAR
#undef PG_SCHED
}
}
#define ACCP_FOREACH(acc, wr, wc, fr, fq, BODY) do { \
    _Pragma("unroll") for (int _a = 0; _a < 2; ++_a) _Pragma("unroll") for (int _m = 0; _m < 4; ++_m) _Pragma("unroll") for (int _b = 0; _b < 2; ++_b) { \
        const int rl = 128 * _a + 64 * (wr) + 16 * _m + (fr), cl = 128 * _b + 32 * (wc) + 8 * (fq); const f32x4 v0 = acc[_a][_b][_m][0], v1 = acc[_a][_b][_m][1]; BODY } } while (0)
#define ACCN_FOREACH(acc, wr, wc, fr, fq, BODY) do { \
    _Pragma("unroll") for (int _a = 0; _a < 2; ++_a) _Pragma("unroll") for (int _m = 0; _m < 4; ++_m) _Pragma("unroll") for (int _b = 0; _b < 2; ++_b) _Pragma("unroll") for (int _n = 0; _n < 2; ++_n) { \
        const int rl = 128 * _a + 64 * (wr) + 16 * _m + (fr), cl = 128 * _b + 32 * (wc) + 16 * _n + 4 * (fq); const f32x4 v = acc[_a][_b][_m][_n]; BODY } } while (0)
__device__ __forceinline__ int vcu_of(int bx, int G) { return (G % 8 == 0) ? (bx % 8) * (G / 8) + bx / 8 : bx; }

__device__ __forceinline__ void p0_adaln(const Params& p, int it, unsigned char* lds) {
    float* S = (float*)lds;
    float* R = (float*)(lds + 17 * 1024 * 4);
    const int tid = otid();
    __syncthreads();
    {   float cv[34];
#pragma unroll
        for (int q = 0; q < 34; ++q) { const int i = tid + NTHR * q, r = i >> 10, k = i & 1023; cv[q] = (r < 16) ? p.c[r * 1024 + k] : p.c_ctx[k]; }
#pragma unroll
        for (int q = 0; q < 34; ++q) S[tid + NTHR * q] = siluf(cv[q]); }
    __syncthreads();
    const int col = tid & 63, sl = tid >> 6, n = it * 64 + col;
    float a[17];
#pragma unroll
    for (int r = 0; r < 17; ++r) a[r] = 0.f;
#pragma unroll 1
    for (int k0 = sl * 128; k0 < sl * 128 + 128; k0 += 16) {
        float w[16];
#pragma unroll
        for (int q = 0; q < 16; ++q) w[q] = p.ada_w[(size_t)(k0 + q) * 6144 + n];
#pragma unroll
        for (int q = 0; q < 16; ++q)
#pragma unroll
            for (int r = 0; r < 17; ++r) a[r] += S[r * 1024 + k0 + q] * w[q];
    }
#pragma unroll
    for (int r = 0; r < 17; ++r) R[(sl * 17 + r) * 64 + col] = a[r];
    __syncthreads();
    float* MOD = (float*)(p.ws + WS_MOD);
    for (int i = tid; i < 17 * 64; i += NTHR) { const int r = i >> 6, cc = i & 63; float s = 0.f;
#pragma unroll
        for (int q = 0; q < 8; ++q) s += R[(q * 17 + r) * 64 + cc];
        MOD[r * 6144 + it * 64 + cc] = s + p.ada_b[it * 64 + cc]; }
}

__device__ __forceinline__ void p0_taps(const Params& p, int it, unsigned char* lds) {
    float* FE = (float*)lds;
    float* H1 = FE + 16 * 36;
    float* H2 = H1 + 16 * 64;
    const int tid = otid(), p0 = it * 16;
    __syncthreads();
    if (tid < 256) { const int pp = tid >> 4, j = tid & 15; const float pos = (float)(p0 + pp);
        const float band = 1e-4f + (float)j * ((15.f - 1e-4f) / 15.f);
        float rev = pos * band * (1.f / 4096.f); rev -= floorf(rev);
        FE[pp * 36 + 1 + j] = __builtin_amdgcn_cosf(rev); FE[pp * 36 + 17 + j] = -__builtin_amdgcn_sinf(rev);
        if (j == 0) FE[pp * 36] = pos * (1.f / 4096.f); }
    __syncthreads();
    for (int i = tid; i < 1024; i += NTHR) { const int pp = i >> 6, j = i & 63; float s = p.hy_b1[j];
#pragma unroll
        for (int q = 0; q < 33; ++q) s += FE[pp * 36 + q] * p.hy_w1[q * 64 + j];
        H1[pp * 64 + j] = sin_rad(p.hy_sin_freq[j] * s); }
    __syncthreads();
    for (int i = tid; i < 1024; i += NTHR) { const int pp = i >> 6, j = i & 63; float s = p.hy_b2[j];
#pragma unroll
        for (int q = 0; q < 64; ++q) s += H1[pp * 64 + q] * p.hy_w2[q * 64 + j];
        H2[pp * 64 + j] = sin_rad(p.hy_sin_freq[64 + j] * s); ((_Float16*)(H2 + 1024))[pp * 72 + j] = (_Float16)H2[pp * 64 + j]; }
    __syncthreads();
    float* TAPS = (float*)(p.ws + WS_TAPS);
    const float mind = -3.0701134573253945f, maxd = -15.350567286626972f;
    const int wid = tid >> 6, lane = tid & 63, fr = lane & 15, fq = lane >> 4;
    const _Float16* H2h = (const _Float16*)(H2 + 1024);
    const f16x8 a0 = *(const f16x8*)(H2h + fr * 72 + 8 * fq), a1 = *(const f16x8*)(H2h + fr * 72 + 32 + 8 * fq);
#pragma unroll 2
    for (int j = 0; j < 16; ++j) {
        const int col = 256 * wid + 16 * j + fr, o = col >> 10, dir = (col >> 9) & 1, c = col & 511;
        float wv[16];
#pragma unroll
        for (int e = 0; e < 8; ++e) { wv[e] = p.hy_w3[(size_t)(8 * fq + e) * 2048 + col]; wv[8 + e] = p.hy_w3[(size_t)(32 + 8 * fq + e) * 2048 + col]; }
        f16x8 b0, b1;
#pragma unroll
        for (int e = 0; e < 8; ++e) { b0[e] = (_Float16)wv[e]; b1[e] = (_Float16)wv[8 + e]; }
        f32x4 acc = (f32x4){0.f, 0.f, 0.f, 0.f};
        acc = __builtin_amdgcn_mfma_f32_16x16x32_f16(a0, b0, acc, 0, 0, 0); acc = __builtin_amdgcn_mfma_f32_16x16x32_f16(a1, b1, acc, 0, 0, 0);
        const float delta = fabsf(mind + (maxd - mind) * ((float)c / 511.f));
        float* tp = TAPS + ((size_t)(o * 512 + c)) * 8192;
        const int P = p0 + 4 * fq; f32x4 val;
#pragma unroll
        for (int r = 0; r < 4; ++r) val[r] = acc[r] * __expf(-(float)(P + r) * (1.f / 4096.f) * delta);
        if (dir == 0) *(f32x4*)(tp + 4096 + P) = val;
        else {
#pragma unroll
            for (int r = 0; r < 4; ++r) { if (P + r == 0) tp[0] = 0.f; else tp[4096 - (P + r)] = val[r]; } }
    }
}

__device__ __forceinline__ unsigned pk4_fp8(float a, float b, float c, float d) { int w = 0; w = __builtin_amdgcn_cvt_pk_fp8_f32(a, b, w, false); w = __builtin_amdgcn_cvt_pk_fp8_f32(c, d, w, true); return (unsigned)w; }
constexpr float FP8_WSCALE = 64.f, FP8_XSCALE = 4.f, FP8_HSCALE = 16.f;
__device__ __forceinline__ void p0_transpose_w(const float* src, int N, int k0, int n0, bf16_t* dst, int dpitch, int mode, float* scr  , int lane, bool fp8 = false) {
    float v[32];
#pragma unroll
    for (int i = 0; i < 32; ++i) v[i] = src[(size_t)(k0 + 2 * i + (lane >> 5)) * N + n0 + (lane & 31)];
#pragma unroll
    for (int i = 0; i < 32; ++i) scr[(2 * i + (lane >> 5)) * 33 + (lane & 31)] = v[i];
    asm volatile("s_waitcnt lgkmcnt(0)" ::: "memory");
    const int c = lane & 7;
#pragma unroll
    for (int j = 0; j < 4; ++j) { const int n = (lane >> 3) + 8 * j, col = n0 + n; const float* sp = scr + (8 * c) * 33 + n;
        int drow = col;
        if (mode == 1) drow = (col >> 7) * 256 + (col & 127); else if (mode == 2) drow = (col >> 7) * 256 + 128 + (col & 127);
        if (fp8) { u32x2 o; o.x = pk4_fp8(sp[0] * FP8_WSCALE, sp[33] * FP8_WSCALE, sp[66] * FP8_WSCALE, sp[99] * FP8_WSCALE); o.y = pk4_fp8(sp[132] * FP8_WSCALE, sp[165] * FP8_WSCALE, sp[198] * FP8_WSCALE, sp[231] * FP8_WSCALE);
            *(u32x2*)((unsigned char*)dst + (size_t)drow * dpitch + k0 + 8 * c) = o; }
        else { u32x4 o; o.x = pk2(sp[0], sp[33]); o.y = pk2(sp[66], sp[99]); o.z = pk2(sp[132], sp[165]); o.w = pk2(sp[198], sp[231]);
            *(u32x4*)(dst + (size_t)drow * dpitch + k0 + 8 * c) = o; } }
    asm volatile("s_waitcnt lgkmcnt(0)" ::: "memory");
}

__device__ __forceinline__ void p0_tables(const Params& p, int it) {
    const int e = it * NTHR + threadIdx.x;
    _Float16* FT = (_Float16*)(p.ws + WS_FTAB); _Float16* GT = (_Float16*)(p.ws + WS_GTAB); _Float16* FK = (_Float16*)(p.ws + WS_FKTAB);
    if (e < 8192) { const int rho = e >> 6, s1 = e & 63, f = rho >> 1; float v;
        if (rho == 0) v = 1.f; else if (rho == 1) v = (s1 & 1) ? -1.f : 1.f;
        else { const float rev = (float)((f * s1) & 127) * (1.f / 128.f); v = (rho & 1) ? -__builtin_amdgcn_sinf(rev) : __builtin_amdgcn_cosf(rev); }
        FT[e] = (_Float16)v;
    } else if (e < 16384) { const int q = e - 8192, t1 = q >> 7, rho = q & 127, f = rho >> 1; float v;
        if (rho == 0) v = 1.f / 128.f; else if (rho == 1) v = ((t1 & 1) ? -1.f : 1.f) / 128.f;
        else { const float rev = (float)((f * t1) & 127) * (1.f / 128.f); v = ((rho & 1) ? -__builtin_amdgcn_sinf(rev) : __builtin_amdgcn_cosf(rev)) * (2.f / 128.f); }
        GT[q] = (_Float16)v;
    } else { const int q = e - 16384, rho = q >> 7, dp = q & 127, d = dp - 64, f = rho >> 1; float v;
        if (rho == 0) v = 1.f; else if (rho == 1) v = (d & 1) ? -1.f : 1.f;
        else { const float rev = (float)((f * d) & 127) * (1.f / 128.f); v = (rho & 1) ? -__builtin_amdgcn_sinf(rev) : __builtin_amdgcn_cosf(rev); }
        FK[q] = (_Float16)v;
    }
}

__device__ __forceinline__ void phase0(const Params& p, unsigned char* lds) {
    constexpr int I_WIN = 16 * 72, I_WOUT = 16 * 32, I_W1 = 32 * 16 * 16, I_W2 = 32 * 8 * 32;
    constexpr int NTR = I_WIN + I_WOUT + 2 * I_W1 + I_W2;
    for (int it = blockIdx.x; it < 64; it += gridDim.x) p0_tables(p, it);
    for (int it = blockIdx.x; it < 96; it += gridDim.x) p0_adaln(p, it, lds);
    for (int it = (blockIdx.x + 160) % gridDim.x; it < 256; it += gridDim.x) p0_taps(p, it, lds);
    __syncthreads();
    const int tidq = otid(), lane = tidq & 63, wid = tidq >> 6;
    float* scr = (float*)lds + wid * (64 * 33);
    constexpr int NA = 14720;
    const bool lightwg = blockIdx.x < 96 && gridDim.x > 96;
    const int nb2 = (gridDim.x > 96) ? (int)gridDim.x - 96 : (int)gridDim.x, bi2 = (gridDim.x > 96) ? (int)blockIdx.x - 96 : (int)blockIdx.x;
    for (int pass = 0; pass < 2; ++pass)
    for (int it = (pass == 0) ? (int)blockIdx.x * 8 + wid : NA + bi2 * 8 + wid; it < ((pass == 0) ? NA : NTR); it += ((pass == 0) ? (int)gridDim.x : nb2) * 8) {
        if (pass == 1 && lightwg) break;
        int r = it; const float* src; int N, k0, n0, dpitch, mode = 0; bf16_t* dst; bool f8 = false;
        if (r < I_WIN) { src = p.w_in; N = PROJW; k0 = (r / 72) * 64; n0 = (r % 72) * 32; dst = (bf16_t*)(p.ws + WS_WINT); dpitch = 1024; }
        else if ((r -= I_WIN) < I_WOUT) { src = p.w_out; N = 1024; k0 = (r / 32) * 64; n0 = (r % 32) * 32; dst = (bf16_t*)(p.ws + WS_WOUTT); dpitch = 1024; }
        else if ((r -= I_WOUT) < 2 * I_W1) { const int w3 = r >= I_W1; if (w3) r -= I_W1; const int e = r / 256, q = r % 256; src = (w3 ? p.exp_w3 : p.exp_w1) + (size_t)e * 1024 * 512; N = 512; k0 = (q / 16) * 64; n0 = (q % 16) * 32;
            dst = (bf16_t*)(p.ws + WS_EW13 + (size_t)e * 1024 * 1024); dpitch = 1024; mode = w3 ? 2 : 1; f8 = true; }
        else { r -= 2 * I_W1; const int e = r / 256, q = r % 256; src = p.exp_w2 + (size_t)e * 512 * 1024; N = 1024; k0 = (q / 32) * 64; n0 = (q % 32) * 32; dst = (bf16_t*)(p.ws + WS_EW2T + (size_t)e * 1024 * 512); dpitch = 512; f8 = true; }
        p0_transpose_w(src, N, k0, n0, dst, dpitch, mode, scr, lane, f8);
    }
}

__device__ __forceinline__ void norm_row(const Params& p, const float* xr, const float* md, bf16_t* orow, int lane) {
    f32x4 v[4]; float s = 0.f;
#pragma unroll
    for (int j = 0; j < 4; ++j) { v[j] = *(const f32x4*)(xr + 256 * j + lane * 4); s += v[j].x * v[j].x + v[j].y * v[j].y + v[j].z * v[j].z + v[j].w * v[j].w; }
    const float rstd = rsqrtf(wave_sum(s) * (1.f / 1024.f) + EPSN);
#pragma unroll
    for (int j = 0; j < 4; ++j) { const int k = 256 * j + lane * 4;
        const f32x4 nw = *(const f32x4*)(p.norm1_w + k), sh = *(const f32x4*)(md + k), sc = *(const f32x4*)(md + 1024 + k);
        const f32x4 y = (v[j] * rstd) * nw * (sc + 1.f) + sh;
        u32x2 o; o.x = pk2(y.x, y.y); o.y = pk2(y.z, y.w); *(u32x2*)(orow + k) = o; }
}
__device__ __forceinline__ void phase1(const Params& p, unsigned char* lds) {
    const int tidq = otid(), lane = tidq & 63, wid = tidq >> 6;
    const float* MOD = (const float*)(p.ws + WS_MOD);
    const int fr = lane & 15, fq = lane >> 4;
    for (int ct = blockIdx.x; ct < NCTX / 16; ct += gridDim.x) {
        bf16_t* As = (bf16_t*)lds;
        const bf16_t* WT = (const bf16_t*)(p.ws + WS_WINT); bf16_t* KVC = (bf16_t*)(p.ws + WS_KVC);
        __syncthreads();
        {   const float* md = MOD + (size_t)16 * 6144; f32x4 v[2][4]; float ss[2];
#pragma unroll
            for (int r = 0; r < 2; ++r)
#pragma unroll
                for (int j = 0; j < 4; ++j) v[r][j] = *(const f32x4*)(p.ctx + (size_t)(ct * 16 + 2 * wid + r) * 1024 + 256 * j + lane * 4);
#pragma unroll
            for (int r = 0; r < 2; ++r) { float q = 0.f;
#pragma unroll
                for (int j = 0; j < 4; ++j) q += v[r][j].x * v[r][j].x + v[r][j].y * v[r][j].y + v[r][j].z * v[r][j].z + v[r][j].w * v[r][j].w;
                ss[r] = wave_sum(q); }
#pragma unroll
            for (int j = 0; j < 4; ++j) { const int k = 256 * j + lane * 4;
                const f32x4 nw = *(const f32x4*)(p.norm1_w + k), sh = *(const f32x4*)(md + k), sc = *(const f32x4*)(md + 1024 + k); const f32x4 g = nw * (sc + 1.f);
#pragma unroll
                for (int r = 0; r < 2; ++r) { const float rstd = rsqrtf(ss[r] * (1.f / 1024.f) + EPSN); const f32x4 y = (v[r][j] * rstd) * g + sh;
                    u32x2 o; o.x = pk2(y.x, y.y); o.y = pk2(y.z, y.w); *(u32x2*)(As + (2 * wid + r) * 1032 + k) = o; } }
        }
        __syncthreads();
        f32x4 acc0 = (f32x4){0.f, 0.f, 0.f, 0.f}, acc1 = acc0;
        const bf16_t* b0 = WT + (size_t)(512 + 32 * wid + fr) * 1024 + 8 * fq; const bf16_t* b1 = b0 + 16 * 1024;
#pragma unroll 8
        for (int ks = 0; ks < 32; ++ks) {
            const bf16x8 af = *(const bf16x8*)(As + fr * 1032 + 32 * ks + 8 * fq);
            const bf16x8 bf0 = *(const bf16x8*)(b0 + 32 * ks), bf1 = *(const bf16x8*)(b1 + 32 * ks);
            acc0 = __builtin_amdgcn_mfma_f32_16x16x32_bf16(bf0, af, acc0, 0, 0, 0); acc1 = __builtin_amdgcn_mfma_f32_16x16x32_bf16(bf1, af, acc1, 0, 0, 0);
        }
        {   bf16_t* orow = KVC + (size_t)(ct * 16 + fr) * 256 + 32 * wid + 4 * fq;
            u32x2 o; o.x = pk2(acc0.x, acc0.y); o.y = pk2(acc0.z, acc0.w); *(u32x2*)(orow) = o;
            o.x = pk2(acc1.x, acc1.y); o.y = pk2(acc1.z, acc1.w); *(u32x2*)(orow + 16) = o; }
    }
    {
        const int nb = gridDim.x, bi = blockIdx.x;
        bf16_t* H = (bf16_t*)(p.ws + WS_H);
        for (int tq = bi * 8; tq < (NTOK / 256) * 8; tq += nb * 8) for (int row0 = (tq >> 3) * 256 + wid * 32 + (tq & 7) * 0; row0 < (tq >> 3) * 256 + wid * 32 + 32; row0 += 4) {
            f32x4 v[4][4]; float ss[4];
#pragma unroll
            for (int r = 0; r < 4; ++r)
#pragma unroll
                for (int j = 0; j < 4; ++j) v[r][j] = *(const f32x4*)(p.x + (size_t)(row0 + r) * 1024 + 256 * j + lane * 4);
#pragma unroll
            for (int r = 0; r < 4; ++r) { float s = 0.f;
#pragma unroll
                for (int j = 0; j < 4; ++j) s += v[r][j].x * v[r][j].x + v[r][j].y * v[r][j].y + v[r][j].z * v[r][j].z + v[r][j].w * v[r][j].w;
                ss[r] = s; }
#pragma unroll
            for (int r = 0; r < 4; ++r) ss[r] = wave_sum(ss[r]);
            const float* md = MOD + (size_t)(row0 >> 12) * 6144;
#pragma unroll
            for (int j = 0; j < 4; ++j) { const int k = 256 * j + lane * 4;
                const f32x4 nw = *(const f32x4*)(p.norm1_w + k), sh = *(const f32x4*)(md + k), sc = *(const f32x4*)(md + 1024 + k); const f32x4 g = nw * (sc + 1.f);
#pragma unroll
                for (int r = 0; r < 4; ++r) { const float rstd = rsqrtf(ss[r] * (1.f / 1024.f) + EPSN); const f32x4 y = (v[r][j] * rstd) * g + sh;
                    u32x2 o; o.x = pk2(y.x, y.y); o.y = pk2(y.z, y.w); *(u32x2*)(H + (size_t)(row0 + r) * 1024 + k) = o; } }
        }
    }
}

struct P2Sched { const char* H; const char* WT; int G, c;
    __device__ __forceinline__ bool next(int i, pg::UDesc& u) const { const int q = i * G + c; if (q >= 2304) return false;
        if (q < 768) { const int pm = q / 3, pn = q - 3 * pm; u.A = H + (size_t)pm * 256 * 2048; u.B0 = WT + (size_t)pn * 256 * 2048; u.i0 = 0; u.i1 = pm; u.i2 = pn; }
        else { const int v = q - 768, pn = v / 6, pm = v - 6 * pn; u.A = WT + (size_t)(768 + pm * 256) * 2048; u.B0 = H + (size_t)pn * 256 * 2048; u.i0 = 1; u.i1 = pm; u.i2 = pn; }
        u.B1 = u.B0 + 8 * 128; u.i3 = 0; return true; }
    __device__ __forceinline__ unsigned rowoff(const pg::UDesc&, int) const { return 0u; }
};
__device__ __forceinline__ void phase2(const Params& p, unsigned char* lds) {
    bf16_t* QKV = (bf16_t*)(p.ws + WS_QKV); _Float16* UT = (_Float16*)(p.ws + WS_UT);
    P2Sched S{(const char*)(p.ws + WS_H), (const char*)(p.ws + WS_WINT), (int)gridDim.x, vcu_of(blockIdx.x, gridDim.x)};
    auto E = [&](const f32x4 (&acc)[2][2][4][2], const pg::UDesc& u, int wr, int wc, int fr, int fq) {
        const int tok0 = u.i2 * 256, bb = tok0 >> 12, t0 = tok0 & 4095;
        unsigned short* base = u.i0 ? (unsigned short*)UT + ((size_t)(bb * 1536 + u.i1 * 256)) * 4096 + t0 : (unsigned short*)QKV + (size_t)(u.i1 * 256) * 768 + u.i2 * 256;
        const size_t pitch = u.i0 ? 4096 : 768; const bool f16o = u.i0 != 0;
        ACCP_FOREACH(acc, wr, wc, fr, fq, { u32x4 o;
            if (f16o) { o.x = pkh2(v0.x, v0.y); o.y = pkh2(v0.z, v0.w); o.z = pkh2(v1.x, v1.y); o.w = pkh2(v1.z, v1.w); }
            else { o.x = pk2(v0.x, v0.y); o.y = pk2(v0.z, v0.w); o.z = pk2(v1.x, v1.y); o.w = pk2(v1.z, v1.w); }
            *(u32x4*)(base + (size_t)rl * pitch + cl) = o; });
    };
    pg::gemm_stream<false, true, false>((LAS unsigned char*)lds, 2048, 2048, S, E);
}

__device__ __forceinline__ void phase3(const Params& p) {
    const int tidq = otid(), lane = tidq & 63, gw = blockIdx.x * 8 + (tidq >> 6), ngw = gridDim.x * 8;
    bf16_t* QKV = (bf16_t*)(p.ws + WS_QKV); bf16_t* KVC = (bf16_t*)(p.ws + WS_KVC);
    const float qw = p.q_norm_w[lane], kw = p.k_norm_w[lane];
    const int i16 = lane & 15; const float invf = exp2f(-(float)i16 * (13.287712379549449f / 16.f));
    float xn[10];
    if (gw < NTOK) {
#pragma unroll
        for (int hh = 0; hh < 10; ++hh) xn[hh] = bf2f(QKV[(size_t)gw * 768 + hh * 64 + lane]); }
    for (int row = gw; row < NTOK; row += ngw) {
        const int pos = row & 4095; const float ang = (float)((lane & 32) ? (pos & 63) : (pos >> 6)) * invf;
        const float cs = cos_rad(ang), sn = sin_rad(ang);
        bf16_t* rp = QKV + (size_t)row * 768;
        float xv[10], ss[10];
#pragma unroll
        for (int hh = 0; hh < 10; ++hh) { xv[hh] = xn[hh]; ss[hh] = xv[hh] * xv[hh]; }
        {   const int rn = (row + ngw < NTOK) ? row + ngw : row;
#pragma unroll
            for (int hh = 0; hh < 10; ++hh) xn[hh] = bf2f(QKV[(size_t)rn * 768 + hh * 64 + lane]); }
#pragma unroll
        for (int hh = 0; hh < 10; ++hh) ss[hh] = wave_sum(ss[hh]);
#pragma unroll
        for (int hh = 0; hh < 10; ++hh) {
            const float y = xv[hh] * rsqrtf(ss[hh] * (1.f / 64.f) + EPSN) * (hh < 8 ? qw : kw);
            const float pr = [&] { const unsigned uy = __builtin_bit_cast(unsigned, y); auto rr = __builtin_amdgcn_permlane16_swap(uy, uy, false, false); return (lane & 16) ? __builtin_bit_cast(float, (unsigned)rr[0]) : __builtin_bit_cast(float, (unsigned)rr[1]); }();
            const float o = (lane & 16) ? (y * cs + pr * sn) : (y * cs - pr * sn);
            rp[hh * 64 + lane] = (bf16_t)f2bf(hh < 8 ? o * (0.125f * 1.4426950408889634f) : o);
        }
    }
    for (int row = gw; row < NCTX; row += ngw) {
        bf16_t* rp = KVC + (size_t)row * 256;
        const float x0 = bf2f(rp[lane]), x1 = bf2f(rp[64 + lane]);
        const float r0 = rsqrtf(wave_sum(x0 * x0) * (1.f / 64.f) + EPSN), r1 = rsqrtf(wave_sum(x1 * x1) * (1.f / 64.f) + EPSN);
        rp[lane] = (bf16_t)f2bf(x0 * r0 * kw); rp[64 + lane] = (bf16_t)f2bf(x1 * r1 * kw);
    }
}

__device__ __forceinline__ void attn_unit(const Params& p, int u, unsigned char* lds) {
    const int tid = otid(), wid = tid >> 6, lane = tid & 63, fr = lane & 15, fq = lane >> 4;
    const int b = u >> 6, kvh = (u >> 5) & 1, qb = u & 31, q0 = qb * 128;
    const bf16_t* QKV = (const bf16_t*)(p.ws + WS_QKV); const bf16_t* KVC = (const bf16_t*)(p.ws + WS_KVC);
    bf16_t* ATT = (bf16_t*)(p.ws + WS_ATTHY);
    const int h = kvh * 4 + (wid >> 1), half = wid & 1, qrow0 = q0 + 64 * half;
    bf16x8 qf[4][2];
#pragma unroll
    for (int qt = 0; qt < 4; ++qt)
#pragma unroll
        for (int ks = 0; ks < 2; ++ks) qf[qt][ks] = *(const bf16x8*)(QKV + (size_t)(b * 4096 + qrow0 + 16 * qt + fr) * 768 + h * 64 + 32 * ks + 8 * fq);
    float mrow[4], lrow[4]; f32x4 ot[4][4];
    const float sink2 = p.attn_sink[h] * 1.4426950408889634f;
#pragma unroll
    for (int qt = 0; qt < 4; ++qt) { mrow[qt] = sink2; lrow[qt] = (fq == 0) ? 1.f : 0.f;
#pragma unroll
        for (int dt = 0; dt < 4; ++dt) ot[dt][qt] = (f32x4){0.f, 0.f, 0.f, 0.f}; }
    const int jlo = (qb == 0) ? 2 : 0, jhi = (qb == 31) ? 3 : 5, ntile = 4 + (jhi - jlo + 1);
    const int kr = tid >> 3, ch = tid & 7;
    auto krow_of = [&](int ti) -> const bf16_t* { return (ti < 4) ? KVC + (size_t)(b * 256 + ti * 64 + kr) * 256 + kvh * 64 + ch * 8 : QKV + (size_t)(b * 4096 + q0 - 128 + (ti - 4 + jlo) * 64 + kr) * 768 + KOFF + kvh * 64 + ch * 8; };
    u32x4 kreg = *(const u32x4*)krow_of(0), vreg = *(const u32x4*)(krow_of(0) + ((0 < 4) ? 128 : 128));
#pragma unroll 1
    for (int ti = 0; ti < ntile; ++ti) {
        const bool isctx = ti < 4; const int jb = ti - 4 + jlo;
        unsigned char* sK = lds + (ti & 1) * 18432;
        unsigned char* sV = sK + 64 * 144;
        {   *(u32x4*)(sK + kr * 144 + ch * 16) = kreg;
            bf16_t* sv = (bf16_t*)sV;
            sv[(ch * 8 + 0) * 72 + kr] = (bf16_t)(vreg.x & 0xffff); sv[(ch * 8 + 1) * 72 + kr] = (bf16_t)(vreg.x >> 16);
            sv[(ch * 8 + 2) * 72 + kr] = (bf16_t)(vreg.y & 0xffff); sv[(ch * 8 + 3) * 72 + kr] = (bf16_t)(vreg.y >> 16);
            sv[(ch * 8 + 4) * 72 + kr] = (bf16_t)(vreg.z & 0xffff); sv[(ch * 8 + 5) * 72 + kr] = (bf16_t)(vreg.z >> 16);
            sv[(ch * 8 + 6) * 72 + kr] = (bf16_t)(vreg.w & 0xffff); sv[(ch * 8 + 7) * 72 + kr] = (bf16_t)(vreg.w >> 16); }
        if (ti + 1 < ntile) { const bf16_t* kp = krow_of(ti + 1); kreg = *(const u32x4*)kp; vreg = *(const u32x4*)(kp + 128); }
        __syncthreads();
        const int rel = jb - 2 - half;
        const bool skip = !isctx && (rel < -2 || rel > 2), partial = !isctx && (rel == -2 || rel == 2);
        if (!skip) {
            f32x4 st[4][4];
#pragma unroll
            for (int kt = 0; kt < 4; ++kt) {
                const bf16x8 k0 = *(const bf16x8*)(sK + (16 * kt + fr) * 144 + fq * 16), k1 = *(const bf16x8*)(sK + (16 * kt + fr) * 144 + 64 + fq * 16);
#pragma unroll
                for (int qt = 0; qt < 4; ++qt) { f32x4 z = (f32x4){0.f, 0.f, 0.f, 0.f};
                    z = __builtin_amdgcn_mfma_f32_16x16x32_bf16(k0, qf[qt][0], z, 0, 0, 0); z = __builtin_amdgcn_mfma_f32_16x16x32_bf16(k1, qf[qt][1], z, 0, 0, 0); st[kt][qt] = z; }
            }
            if (partial) {
                const int kbase = q0 - 128 + 64 * jb;
#pragma unroll
                for (int qt = 0; qt < 4; ++qt) { const int qpos = qrow0 + 16 * qt + fr;
#pragma unroll
                    for (int kt = 0; kt < 4; ++kt)
#pragma unroll
                        for (int r = 0; r < 4; ++r) { const int dd = kbase + 16 * kt + 4 * fq + r - qpos; if (dd > 128 || dd < -128) st[kt][qt][r] = -1e30f; } }
            }
            float alpha[4]; bool grew = false;
#pragma unroll
            for (int qt = 0; qt < 4; ++qt) {
                float t0 = fmaxf(fmaxf(st[0][qt][0], st[0][qt][1]), fmaxf(st[0][qt][2], st[0][qt][3]));
#pragma unroll
                for (int kt = 1; kt < 4; ++kt) t0 = fmaxf(t0, fmaxf(fmaxf(st[kt][qt][0], st[kt][qt][1]), fmaxf(st[kt][qt][2], st[kt][qt][3])));
                t0 = max_fq(t0);
                const float mnew = fmaxf(mrow[qt], t0); alpha[qt] = exp2_raw(mrow[qt] - mnew); grew = grew || (mnew > mrow[qt]); mrow[qt] = mnew;
                float ls = 0.f;
#pragma unroll
                for (int kt = 0; kt < 4; ++kt)
#pragma unroll
                    for (int r = 0; r < 4; ++r) { const float pv = exp2_raw(st[kt][qt][r] - mnew); st[kt][qt][r] = pv; ls += pv; }
                lrow[qt] = lrow[qt] * alpha[qt] + ls;
            }
            if (__any(grew)) {
#pragma unroll
                for (int qt = 0; qt < 4; ++qt)
#pragma unroll
                    for (int dt = 0; dt < 4; ++dt) ot[dt][qt] = ot[dt][qt] * alpha[qt];
            }
#pragma unroll
            for (int ks = 0; ks < 2; ++ks) {
                bf16x8 pf[4];
#pragma unroll
                for (int qt = 0; qt < 4; ++qt) { const f32x4 a = st[2 * ks][qt], c = st[2 * ks + 1][qt];
                    u32x4 w; w.x = pk2(a.x, a.y); w.y = pk2(a.z, a.w); w.z = pk2(c.x, c.y); w.w = pk2(c.z, c.w); pf[qt] = __builtin_bit_cast(bf16x8, w); }
#pragma unroll
                for (int dt = 0; dt < 4; ++dt) {
                    const u32x2 v0 = *(const u32x2*)(sV + (16 * dt + fr) * 144 + (32 * ks + 4 * fq) * 2), v1 = *(const u32x2*)(sV + (16 * dt + fr) * 144 + (32 * ks + 16 + 4 * fq) * 2);
                    u32x4 w; w.x = v0.x; w.y = v0.y; w.z = v1.x; w.w = v1.y; const bf16x8 vf = __builtin_bit_cast(bf16x8, w);
#pragma unroll
                    for (int qt = 0; qt < 4; ++qt) ot[dt][qt] = __builtin_amdgcn_mfma_f32_16x16x32_bf16(vf, pf[qt], ot[dt][qt], 0, 0, 0);
                }
            }
        }
    }
#pragma unroll
    for (int qt = 0; qt < 4; ++qt) {
        float l = lrow[qt]; l += __shfl_xor(l, 16); l += __shfl_xor(l, 32);
        const float inv = 1.f / l;
        bf16_t* orow = ATT + (size_t)(b * 4096 + qrow0 + 16 * qt + fr) * 1024 + h * 64;
#pragma unroll
        for (int dt = 0; dt < 4; ++dt) { const f32x4 o = ot[dt][qt] * inv; u32x2 w; w.x = pk2(o.x, o.y); w.y = pk2(o.z, o.w); *(u32x2*)(orow + 16 * dt + 4 * fq) = w; }
    }
    __syncthreads();
}

__device__ __forceinline__ void khat_items(const Params& p, unsigned char* lds) {
    const int tid = otid(), wid = tid >> 6, lane = tid & 63, fr = lane & 15, fq = lane >> 4;
    _Float16* TT = (_Float16*)lds;
    _Float16* FKL = (_Float16*)(lds + 34816);
    const _Float16* FK = (const _Float16*)(p.ws + WS_FKTAB);
    __syncthreads();
    for (int i = tid; i < 128 * 136 / 2; i += NTHR) ((unsigned*)lds)[i] = 0u;
    for (int i = tid; i < 128 * 16; i += NTHR) { const int r = i >> 4, c8 = i & 15; *(u32x4*)(FKL + r * 136 + c8 * 8) = *(const u32x4*)(FK + r * 128 + c8 * 8); }
    int it = blockIdx.x;
    f32x4 tv[4];
    if (it < 1024) {
#pragma unroll
        for (int q = 0; q < 4; ++q) tv[q] = *(const f32x4*)((const float*)(p.ws + WS_TAPS) + (size_t)it * 8192 + tid * 16 + q * 4); }
    __syncthreads();
    for (; it < 1024; it += gridDim.x) {
#pragma unroll
        for (int q = 0; q < 4; ++q) { const int i0 = tid * 16 + q * 4;
#pragma unroll
            for (int e = 0; e < 4; ++e) { const int i = i0 + e, i1 = i >> 6, i2 = i & 63; const _Float16 h = (_Float16)tv[q][e];
                if (i1 >= 1) TT[(i2 + 63) * 136 + i1] = h;
                if (i2 >= 1 && i1 + 1 < 128) TT[(i2 - 1) * 136 + i1 + 1] = h; } }
        {   const int itn = (it + (int)gridDim.x < 1024) ? it + (int)gridDim.x : it;
#pragma unroll
            for (int q = 0; q < 4; ++q) tv[q] = *(const f32x4*)((const float*)(p.ws + WS_TAPS) + (size_t)itn * 8192 + tid * 16 + q * 4); }
        __syncthreads();
        f16x8 af[4];
#pragma unroll
        for (int ks = 0; ks < 4; ++ks) af[ks] = *(const f16x8*)(TT + (16 * wid + fr) * 136 + 32 * ks + 8 * fq);
        _Float16* KH = (_Float16*)(p.ws + WS_KH) + (size_t)it * (64 * 2 * 128);
#pragma unroll
        for (int nt = 0; nt < 8; ++nt) {
            f32x4 acc = (f32x4){0.f, 0.f, 0.f, 0.f};
#pragma unroll
            for (int ks = 0; ks < 4; ++ks) { const f16x8 bfv = *(const f16x8*)(FKL + (16 * nt + fr) * 136 + 32 * ks + 8 * fq); acc = __builtin_amdgcn_mfma_f32_16x16x32_f16(af[ks], bfv, acc, 0, 0, 0); }
            const int rho = 16 * nt + fr; u32x2 o; o.x = pkh2(acc[3], acc[2]); o.y = pkh2(acc[1], acc[0]);
            *(u32x2*)(KH + (size_t)rho * 128 + (124 - 16 * wid - 4 * fq)) = o;
        }
        __syncthreads();
    }
}

constexpr int HY_ZB = 0, HY_ZH = 73728, HY_ZHF = 1160  , HY_OH = HY_ZH + 8 * HY_ZHF * 2, HY_GT = HY_OH + 8 * 65 * 40  , HY_KC = HY_GT + 8 * 4608, HY_LDS_END = HY_KC + 8 * 576;
__device__ __forceinline__ f16x8 neg8(f16x8 v) { u32x4 w = __builtin_bit_cast(u32x4, v); w.x ^= 0x80008000u; w.y ^= 0x80008000u; w.z ^= 0x80008000u; w.w ^= 0x80008000u; return __builtin_bit_cast(f16x8, w); }
__device__ __forceinline__ void hyena_item(const Params& p, int it, unsigned char* lds) {
    const int tid = otid(), wid = tid >> 6, lane = tid & 63, fr = lane & 15, fq = lane >> 4;
    const int c = it >> 1, b = (it & 1) * 8 + wid;
    _Float16* ZB = (_Float16*)(lds + HY_ZB) + wid * (64 * 72);
    _Float16* ZH = (_Float16*)(lds + HY_ZH);
    _Float16* OH = (_Float16*)(lds + HY_OH);
    _Float16* GTW = (_Float16*)(lds + HY_GT) + wid * 2304;
    _Float16* KC = (_Float16*)(lds + HY_KC) + wid * 288;
    const _Float16* UT = (const _Float16*)(p.ws + WS_UT); const _Float16* FT = (const _Float16*)(p.ws + WS_FTAB); const _Float16* GT = (const _Float16*)(p.ws + WS_GTAB);
    bf16_t* HYT = (bf16_t*)(p.ws + WS_HYT);
    __syncthreads();
    if (lane < 32) KC[(lane >> 4) * 144 + 128 + (lane & 15)] = (_Float16)0.f;
    {   const _Float16* ur = UT + ((size_t)(b * 1536 + c)) * 4096;
        const float w0 = p.hy_conv_w[c], w1 = p.hy_conv_w[1536 + c], w2 = p.hy_conv_w[3072 + c], bb = p.hy_conv_b[c];
#pragma unroll
        for (int i8 = 0; i8 < 8; ++i8) { const int t0 = 8 * (lane + 64 * i8);
            const f16x8 raw = *(const f16x8*)(ur + t0); float uv[10];
            { const float hl = (float)ur[t0 > 0 ? t0 - 1 : 0], hh = (float)ur[t0 + 8 < 4096 ? t0 + 8 : 4095]; uv[0] = (t0 > 0) ? hl : 0.f; uv[9] = (t0 + 8 < 4096) ? hh : 0.f; }
#pragma unroll
            for (int i = 0; i < 8; ++i) uv[1 + i] = (float)raw[i];
            const int s1 = t0 >> 6, s2 = t0 & 63;
#pragma unroll
            for (int i = 0; i < 8; ++i) ZB[(s2 + i) * 72 + s1] = (_Float16)(bb + uv[i] * w0 + uv[i + 1] * w1 + uv[i + 2] * w2); }
    }
#pragma unroll 1
    for (int o = 0; o < 2; ++o) {
        f16x8 zf[4][2];
#pragma unroll
        for (int mt = 0; mt < 4; ++mt)
#pragma unroll
            for (int ks = 0; ks < 2; ++ks) zf[mt][ks] = *(const f16x8*)(ZB + (16 * mt + fr) * 72 + 32 * ks + 8 * fq);
        f32x4 accI[4][4];
#pragma unroll
        for (int mt = 0; mt < 4; ++mt)
#pragma unroll
            for (int nt = 0; nt < 4; ++nt) accI[mt][nt] = (f32x4){0.f, 0.f, 0.f, 0.f};
        const _Float16* KHo = (const _Float16*)(p.ws + WS_KH) + (size_t)(o * 512 + c) * (64 * 2 * 128);
        const int chg = (o + 1) * 512 + c; const _Float16* urg = UT + ((size_t)(b * 1536 + chg)) * 4096;
        u32x4 kcn = (u32x4){0u, 0u, 0u, 0u}; f16x8 ffn[2];
        if (lane < 32) kcn = *(const u32x4*)(KHo + (size_t)wid * 256 + lane * 8);
#pragma unroll
        for (int ks = 0; ks < 2; ++ks) ffn[ks] = *(const f16x8*)(FT + fr * 64 + 32 * ks + 8 * fq);
#pragma unroll 1
        for (int j = 0; j < 8; ++j) {
            const int f = 8 * j + wid;
            const u32x4 kcc = kcn; f16x8 ff[2]; f16x4 gf[4];
#pragma unroll
            for (int ks = 0; ks < 2; ++ks) ff[ks] = ffn[ks];
#pragma unroll
            for (int nt = 0; nt < 4; ++nt) gf[nt] = *(const f16x4*)(GT + (16 * nt + fr) * 128 + 16 * j + 4 * fq);
            if (j < 7) {
                if (lane < 32) kcn = *(const u32x4*)(KHo + (size_t)(f + 8) * 256 + lane * 8);
#pragma unroll
                for (int ks = 0; ks < 2; ++ks) ffn[ks] = *(const f16x8*)(FT + (16 * (j + 1) + fr) * 64 + 32 * ks + 8 * fq);
            }
            if (lane < 32) *(u32x4*)(KC + (lane >> 4) * 144 + (lane & 15) * 8) = kcc;
            {   const int x = lane >> 5, q = (lane >> 1) & 15, sh = lane & 1;
                const u32x2* src = (const u32x2*)(KC + x * 144 + 8 * q + 4 * sh);
                const u32x2 r0 = src[0], r1 = src[1], r2 = src[2];
                const unsigned d0 = r0.x, d1 = r0.y, d2 = r1.x, d3 = r1.y, d4 = r2.x, d5 = r2.y;
                const unsigned a0 = __builtin_amdgcn_alignbit(d1, d0, 16), a1 = __builtin_amdgcn_alignbit(d2, d1, 16), a2 = __builtin_amdgcn_alignbit(d3, d2, 16), a3 = __builtin_amdgcn_alignbit(d4, d3, 16), a4 = __builtin_amdgcn_alignbit(d5, d4, 16);
                _Float16* dst = GTW + ((x * 8 + 4 * sh) * 18 + q) * 8;
                *(u32x4*)(dst) = (u32x4){a0, a1, a2, a3}; *(u32x4*)(dst + 144) = (u32x4){d1, d2, d3, d4};
                *(u32x4*)(dst + 288) = (u32x4){a1, a2, a3, a4}; *(u32x4*)(dst + 432) = (u32x4){d2, d3, d4, d5}; }
            {
#pragma unroll
                for (int mt = 0; mt < 4; ++mt) { f32x4 a = (f32x4){0.f, 0.f, 0.f, 0.f};
                    a = __builtin_amdgcn_mfma_f32_16x16x32_f16(zf[mt][0], ff[0], a, 0, 0, 0); a = __builtin_amdgcn_mfma_f32_16x16x32_f16(zf[mt][1], ff[1], a, 0, 0, 0);
                    u32x2 w; w.x = pkh2(a[0], a[1]); w.y = pkh2(a[2], a[3]);
                    *(u32x2*)(ZH + (fr >> 1) * HY_ZHF + (wid * 2 + (fr & 1)) * 72 + 16 * mt + 4 * fq) = w; }
            }
            __syncthreads();
            {   const int bb = fr >> 1, part = fr & 1;
                f16x8 a1[2], a2[2];
#pragma unroll
                for (int ks = 0; ks < 2; ++ks) {
                    const f16x8 s1v = *(const f16x8*)(ZH + wid * HY_ZHF + (bb * 2 + part) * 72 + 32 * ks + 8 * fq);
                    const f16x8 s2v = *(const f16x8*)(ZH + wid * HY_ZHF + (bb * 2 + (1 - part)) * 72 + 32 * ks + 8 * fq);
                    const f16x8 zero = (f16x8){0, 0, 0, 0, 0, 0, 0, 0};
                    if (f == 0) { a1[ks] = part ? zero : s1v; a2[ks] = part ? s1v : zero; }
                    else { a1[ks] = s1v; a2[ks] = part ? s2v : neg8(s2v); }
                }
                const int sg = 7 - (fr & 7), qb = 7 - (fr >> 3) + fq;
                f32x4 am[4];
#pragma unroll
                for (int nt = 0; nt < 4; ++nt) am[nt] = (f32x4){0.f, 0.f, 0.f, 0.f};
#pragma unroll
                for (int wi = 0; wi < 6; ++wi) { const int w = 2 * wi - 6;
                    const f16x8 b1 = *(const f16x8*)(GTW + ((0 * 8 + sg) * 18 + qb + w) * 8);
                    const f16x8 b2 = *(const f16x8*)(GTW + ((1 * 8 + sg) * 18 + qb + w) * 8);
#pragma unroll
                    for (int ks = 0; ks < 2; ++ks) { const int nt = (4 * ks - w) / 2;
                        if (nt >= 0 && nt < 4) { am[nt] = __builtin_amdgcn_mfma_f32_16x16x32_f16(a1[ks], b1, am[nt], 0, 0, 0); am[nt] = __builtin_amdgcn_mfma_f32_16x16x32_f16(a2[ks], b2, am[nt], 0, 0, 0); } } }
#pragma unroll
                for (int nt = 0; nt < 4; ++nt) { const int t2 = 16 * nt + fr;
                    *(unsigned*)(OH + ((2 * fq) * 65 + t2) * 20 + 2 * wid) = pkh2(am[nt][0], am[nt][1]);
                    *(unsigned*)(OH + ((2 * fq + 1) * 65 + t2) * 20 + 2 * wid) = pkh2(am[nt][2], am[nt][3]); }
            }
            __syncthreads();
            {
#pragma unroll
                for (int mt = 0; mt < 4; ++mt) { const f16x4 av = *(const f16x4*)(OH + (wid * 65 + 16 * mt + fr) * 20 + 4 * fq);
#pragma unroll
                    for (int nt = 0; nt < 4; ++nt) accI[mt][nt] = __builtin_amdgcn_mfma_f32_16x16x16f16(av, gf[nt], accI[mt][nt], 0, 0, 0); }
            }
        }
        {   const int ch = chg;
            const float w0 = p.hy_conv_w[ch], w1 = p.hy_conv_w[1536 + ch], w2 = p.hy_conv_w[3072 + ch], bb = p.hy_conv_b[ch], sk = p.hy_skip[o * 512 + c];
#pragma unroll
            for (int mt = 0; mt < 4; ++mt)
#pragma unroll
                for (int nt = 0; nt < 4; ++nt) { const int t1 = 16 * nt + fr, t2 = 16 * mt + 4 * fq, t = 64 * t1 + t2;
                    const f16x4 raw = *(const f16x4*)(urg + t); float uv[6];
                    { const float hl = (float)urg[t > 0 ? t - 1 : 0], hh = (float)urg[t + 4 < 4096 ? t + 4 : 4095]; uv[0] = (t > 0) ? hl : 0.f; uv[5] = (t + 4 < 4096) ? hh : 0.f; }
#pragma unroll
                    for (int i = 0; i < 4; ++i) uv[1 + i] = (float)raw[i];
                    float zn[4];
#pragma unroll
                    for (int r = 0; r < 4; ++r) { const float xg = bb + uv[r] * w0 + uv[r + 1] * w1 + uv[r + 2] * w2; const float zo = (float)ZB[(t2 + r) * 72 + t1];
                        zn[r] = xg * (accI[mt][nt][r] + sk * zo); }
                    if (o == 0) {
#pragma unroll
                        for (int r = 0; r < 4; ++r) ZB[(t2 + r) * 72 + t1] = (_Float16)zn[r];
                    } else { u32x2 w; w.x = pk2(zn[0], zn[1]); w.y = pk2(zn[2], zn[3]); *(u32x2*)(HYT + ((size_t)(b * 512 + c)) * 4096 + t) = w; }
                }
        }
    }
}

__device__ __forceinline__ void phase5_item(const Params& p, int it, unsigned char* lds, u32x4 (&hv)[8], const int itn) {
    const int tid = otid(), b = it >> 6, t0 = (it & 63) * 64;
    bf16_t* TL = (bf16_t*)lds;
    float* RS = (float*)(lds + 512 * 66 * 2);
    float* RS2 = RS + 512;
    const bf16_t* HYT = (const bf16_t*)(p.ws + WS_HYT); bf16_t* AH = (bf16_t*)(p.ws + WS_ATTHY);
    __syncthreads();
    {
#pragma unroll
        for (int i = 0; i < 8; ++i) { const u32x4 v = hv[i]; unsigned* d = (unsigned*)(TL + tid * 66 + i * 8); d[0] = v.x; d[1] = v.y; d[2] = v.z; d[3] = v.w; }
        const bf16_t* srcn = HYT + ((size_t)((itn >> 6) * 512 + tid)) * 4096 + (itn & 63) * 64;
#pragma unroll
        for (int i = 0; i < 8; ++i) hv[i] = *(const u32x4*)(srcn + i * 8); }
    __syncthreads();
    {   const int tt = tid & 63, cg8 = tid >> 6; float s = 0.f;
#pragma unroll 16
        for (int cc = 0; cc < 64; ++cc) { const float v = bf2f(TL[(cg8 * 64 + cc) * 66 + tt]); s += v * v; }
        RS[cg8 * 64 + tt] = s; }
    __syncthreads();
    if (tid < 64) { float s = 0.f;
#pragma unroll
        for (int q = 0; q < 8; ++q) s += RS[q * 64 + tid];
        RS2[tid] = rsqrtf(s * (1.f / 512.f) + EPSN); }
    __syncthreads();
    {   const int tt = tid >> 3, ch = tid & 7; const float rstd = RS2[tt];
        bf16_t* orow = AH + (size_t)(b * 4096 + t0 + tt) * 1024;
        u32x4 av[8]; float s = 0.f;
#pragma unroll
        for (int g = 0; g < 8; ++g) av[g] = *(const u32x4*)(orow + g * 64 + ch * 8);
#pragma unroll
        for (int g = 0; g < 8; ++g) { const int c0 = g * 64 + ch * 8; float y[8]; const f32x4 gw0 = *(const f32x4*)(p.group_norm_w + 512 + c0), gw1 = *(const f32x4*)(p.group_norm_w + 512 + c0 + 4);
#pragma unroll
            for (int i = 0; i < 8; ++i) y[i] = bf2f(TL[(c0 + i) * 66 + tt]) * rstd * (i < 4 ? gw0[i] : gw1[i - 4]);
            u32x4 w; w.x = pk2(y[0], y[1]); w.y = pk2(y[2], y[3]); w.z = pk2(y[4], y[5]); w.w = pk2(y[6], y[7]); *(u32x4*)(orow + 512 + c0) = w; }
#pragma unroll
        for (int g = 0; g < 8; ++g) {
            const float a0 = bflo(av[g].x), a1 = bfhi(av[g].x), a2 = bflo(av[g].y), a3 = bfhi(av[g].y), a4 = bflo(av[g].z), a5 = bfhi(av[g].z), a6 = bflo(av[g].w), a7 = bfhi(av[g].w);
            s += a0 * a0 + a1 * a1 + a2 * a2 + a3 * a3 + a4 * a4 + a5 * a5 + a6 * a6 + a7 * a7; }
        s += dpp_f(s, DPP_XOR1); s += dpp_f(s, DPP_XOR2); s += dpp_f(s, DPP_HMIRROR);
        const float ra = rsqrtf(s * (1.f / 512.f) + EPSN);
#pragma unroll
        for (int g = 0; g < 8; ++g) { const int c0 = g * 64 + ch * 8; const f32x4 gw0 = *(const f32x4*)(p.group_norm_w + c0), gw1 = *(const f32x4*)(p.group_norm_w + c0 + 4);
            u32x4 w; w.x = pk2(bflo(av[g].x) * ra * gw0[0], bfhi(av[g].x) * ra * gw0[1]); w.y = pk2(bflo(av[g].y) * ra * gw0[2], bfhi(av[g].y) * ra * gw0[3]);
            w.z = pk2(bflo(av[g].z) * ra * gw1[0], bfhi(av[g].z) * ra * gw1[1]); w.w = pk2(bflo(av[g].w) * ra * gw1[2], bfhi(av[g].w) * ra * gw1[3]);
            *(u32x4*)(orow + c0) = w; }
    }
}

struct P6Sched { const char* AH; const char* WT; int G, c;
    __device__ __forceinline__ bool next(int i, pg::UDesc& u) const { const int q = i * G + c; if (q >= 1024) return false; const int pm = q >> 2, pn = q & 3;
        u.A = AH + (size_t)pm * 256 * 2048; u.B0 = WT + (size_t)pn * 256 * 2048; u.B1 = u.B0 + 8 * 128; u.i0 = 0; u.i1 = pm; u.i2 = pn; u.i3 = 0; return true; }
    __device__ __forceinline__ unsigned rowoff(const pg::UDesc&, int) const { return 0u; }
};
__device__ __forceinline__ void phase6(const Params& p, unsigned char* lds) {
    const float* MOD = (const float*)(p.ws + WS_MOD);
    P6Sched S{(const char*)(p.ws + WS_ATTHY), (const char*)(p.ws + WS_WOUTT), (int)gridDim.x, vcu_of(blockIdx.x, gridDim.x)};
    auto E = [&](const f32x4 (&acc)[2][2][4][2], const pg::UDesc& u, int wr, int wc, int fr, int fq) {
        const float* g1 = MOD + (size_t)((u.i1 * 256) >> 12) * 6144 + 2048 + u.i2 * 256 + 32 * wc + 8 * fq;
        f32x4 gv[2][2];
#pragma unroll
        for (int b = 0; b < 2; ++b)
#pragma unroll
            for (int n = 0; n < 2; ++n) gv[b][n] = *(const f32x4*)(g1 + 128 * b + 4 * n);
        bf16_t* D1 = (bf16_t*)(p.ws + WS_D1);
#pragma unroll
        for (int a = 0; a < 2; ++a)
#pragma unroll
            for (int m = 0; m < 4; ++m)
#pragma unroll
                for (int b = 0; b < 2; ++b) { const f32x4 v0 = acc[a][b][m][0] * gv[b][0], v1 = acc[a][b][m][1] * gv[b][1];
                    u32x4 o; o.x = pk2(v0.x, v0.y); o.y = pk2(v0.z, v0.w); o.z = pk2(v1.x, v1.y); o.w = pk2(v1.z, v1.w);
                    *(u32x4*)(D1 + (size_t)(u.i1 * 256 + 128 * a + 64 * wr + 16 * m + fr) * 1024 + u.i2 * 256 + 128 * b + 32 * wc + 8 * fq) = o; }
    };
    pg::gemm_stream<false, true, false>((LAS unsigned char*)lds, 2048, 2048, S, E);
}

__device__ __forceinline__ int pair_index(int lo, int hi) { return lo * 8 - (lo * (lo + 1)) / 2 + (hi - lo - 1); }
constexpr int P7_RW = 0, P7_HIST = 147456, P7_BASE = 147456 + 512, P7_TCLS = 147456 + 1024, P7_TRNK = 147456 + 2048, P7_TG = 147456 + 3072;
__device__ __forceinline__ void phase7(const Params& p, unsigned char* lds) {
    const int tid = otid(), lane = tid & 63, wid = tid >> 6;
    const float* MOD = (const float*)(p.ws + WS_MOD); bf16_t* H2 = (bf16_t*)(p.ws + WS_H);
    int* CNT = (int*)(p.ws + WS_CTL); int* LIST = (int*)(p.ws + WS_LIST); float* GATE = (float*)(p.ws + WS_GATE);
    float* RW = (float*)(lds + P7_RW); int* HIST = (int*)(lds + P7_HIST); int* BASE = (int*)(lds + P7_BASE); int* TCLS = (int*)(lds + P7_TCLS); int* TRNK = (int*)(lds + P7_TRNK);
    __syncthreads();
    {   float t[8];
#pragma unroll
        for (int q = 0; q < 8; ++q) t[q] = p.router_g_w[tid + NTHR * q];
#pragma unroll
        for (int q = 0; q < 8; ++q) { const int i = tid + NTHR * q, k = i >> 2, j = i & 3; RW[((k & 3) * 256 + (k >> 2)) * 36 + j] = t[q]; }
#pragma unroll 1
        for (int i0 = 0; i0 < 1024 * 32; i0 += NTHR * 16) { float u[16];
#pragma unroll
            for (int q = 0; q < 16; ++q) u[q] = p.router_e_w[i0 + tid + NTHR * q];
#pragma unroll
            for (int q = 0; q < 16; ++q) { const int i = i0 + tid + NTHR * q, k = i >> 5, j = i & 31; RW[((k & 3) * 256 + (k >> 2)) * 36 + 4 + j] = u[q]; } }
    }
    for (int tile = blockIdx.x; tile < NTOK / 256; tile += gridDim.x) {
        __syncthreads();
        if (tid < 128) HIST[tid] = 0;
        __syncthreads();
        f32x4 gk[4], shk[4];
#pragma unroll
        for (int j = 0; j < 4; ++j) { const int k = 256 * j + lane * 4; const float* md = MOD + (size_t)((tile * 256) >> 12) * 6144;
            gk[j] = *(const f32x4*)(p.norm2_w + k) * (*(const f32x4*)(md + 4096 + k) + 1.f); shk[j] = *(const f32x4*)(md + 3072 + k); }
        constexpr int RB = 2;
        const bf16_t* D1 = (const bf16_t*)(p.ws + WS_D1);
        f32x4 vn[RB][4]; u32x2 dn[RB][4];
#pragma unroll
        for (int q = 0; q < RB; ++q)
#pragma unroll
            for (int j = 0; j < 4; ++j) { const size_t o = (size_t)(tile * 256 + wid * 32 + q) * 1024 + 256 * j + lane * 4; vn[q][j] = *(const f32x4*)(p.x + o); dn[q][j] = *(const u32x2*)(D1 + o); }
#pragma unroll 1
        for (int rr = 0; rr < 32; rr += RB) {
            const int rl0 = wid * 32 + rr, row0 = tile * 256 + rl0;
            f32x4 v[RB][4]; float ss[RB];
#pragma unroll
            for (int q = 0; q < RB; ++q) { float s = 0.f;
#pragma unroll
                for (int j = 0; j < 4; ++j) { const f32x4 dl = (f32x4){bflo(dn[q][j].x), bfhi(dn[q][j].x), bflo(dn[q][j].y), bfhi(dn[q][j].y)}; v[q][j] = vn[q][j] + dl;
                    { u32x2 xb; xb.x = pk2(v[q][j].x, v[q][j].y); xb.y = pk2(v[q][j].z, v[q][j].w); *(u32x2*)((bf16_t*)(p.ws + WS_D1) + (size_t)(row0 + q) * 1024 + 256 * j + lane * 4) = xb; }
                    s += v[q][j].x * v[q][j].x + v[q][j].y * v[q][j].y + v[q][j].z * v[q][j].z + v[q][j].w * v[q][j].w; }
                ss[q] = s; }
            {   const int rp = (rr + RB < 32) ? row0 + RB : row0;
#pragma unroll
                for (int q = 0; q < RB; ++q)
#pragma unroll
                    for (int j = 0; j < 4; ++j) { const size_t o = (size_t)(rp + q) * 1024 + 256 * j + lane * 4; vn[q][j] = *(const f32x4*)(p.x + o); dn[q][j] = *(const u32x2*)(D1 + o); } }
#pragma unroll
            for (int q = 0; q < RB; ++q) ss[q] = wave_sum(ss[q]);
            float gl[RB][4];
#pragma unroll
            for (int q = 0; q < RB; ++q) { const float rstd = rsqrtf(ss[q] * (1.f / 1024.f) + EPSN);
#pragma unroll
                for (int e = 0; e < 4; ++e) gl[q][e] = 0.f;
#pragma unroll
                for (int j = 0; j < 4; ++j) { const int k = 256 * j + lane * 4;
                    const f32x4 y = (v[q][j] * rstd) * gk[j] + shk[j]; v[q][j] = y;
                    *(unsigned*)((unsigned char*)H2 + (size_t)(row0 + q) * 1024 + k) = pk4_fp8(fminf(fmaxf(y.x * FP8_XSCALE, -440.f), 440.f), fminf(fmaxf(y.y * FP8_XSCALE, -440.f), 440.f), fminf(fmaxf(y.z * FP8_XSCALE, -440.f), 440.f), fminf(fmaxf(y.w * FP8_XSCALE, -440.f), 440.f)); } }
#pragma unroll
            for (int j = 0; j < 4; ++j)
#pragma unroll
                for (int e = 0; e < 4; ++e) { const f32x4 w = *(const f32x4*)(RW + (e * 256 + 64 * j + lane) * 36);
#pragma unroll
                    for (int q = 0; q < RB; ++q) { const float ye = v[q][j][e]; gl[q][0] += ye * w.x; gl[q][1] += ye * w.y; gl[q][2] += ye * w.z; gl[q][3] += ye * w.w; } }
#pragma unroll
            for (int q = 0; q < RB; ++q)
#pragma unroll
                for (int e = 0; e < 4; ++e) gl[q][e] = wave_sum(gl[q][e]);
            int gsel[RB]; float gval[RB];
#pragma unroll
            for (int q = 0; q < RB; ++q) {
#pragma unroll
                for (int e = 0; e < 4; ++e) gl[q][e] += p.router_g_b[e];
                int g = 0; float gm = gl[q][0];
#pragma unroll
                for (int e = 1; e < 4; ++e) if (gl[q][e] > gm) { gm = gl[q][e]; g = e; }
                float gs = 0.f;
#pragma unroll
                for (int e = 0; e < 4; ++e) gs += __expf(gl[q][e] - gm);
                gsel[q] = g; gval[q] = 1.f / gs; }
            float el[RB][8];
#pragma unroll
            for (int q = 0; q < RB; ++q) {
#pragma unroll
                for (int e = 0; e < 8; ++e) el[q][e] = 0.f;
#pragma unroll
                for (int j = 0; j < 4; ++j)
#pragma unroll
                    for (int e = 0; e < 4; ++e) { const float* wr = RW + (e * 256 + 64 * j + lane) * 36 + 4 + gsel[q] * 8; const f32x4 w0 = *(const f32x4*)wr, w1 = *(const f32x4*)(wr + 4); const float ye = v[q][j][e];
                        el[q][0] += ye * w0.x; el[q][1] += ye * w0.y; el[q][2] += ye * w0.z; el[q][3] += ye * w0.w; el[q][4] += ye * w1.x; el[q][5] += ye * w1.y; el[q][6] += ye * w1.z; el[q][7] += ye * w1.w; } }
#pragma unroll
            for (int q = 0; q < RB; ++q)
#pragma unroll
                for (int e = 0; e < 8; ++e) el[q][e] = wave_sum(el[q][e]);
#pragma unroll
            for (int q = 0; q < RB; ++q) { const int g = gsel[q];
#pragma unroll
                for (int e = 0; e < 8; ++e) el[q][e] += p.router_e_b[g * 8 + e];
                int e1 = 0; float m1 = el[q][0];
#pragma unroll
                for (int e = 1; e < 8; ++e) if (el[q][e] > m1) { m1 = el[q][e]; e1 = e; }
                int e2 = -1; float m2 = -3.0e38f;
#pragma unroll
                for (int e = 0; e < 8; ++e) if (e != e1 && el[q][e] > m2) { m2 = el[q][e]; e2 = e; }
                const float r = __expf(m2 - m1), w1 = 1.f / (1.f + r), w2 = r / (1.f + r);
                if (lane == 0) {
                    const int lo = e1 < e2 ? e1 : e2, hi = e1 < e2 ? e2 : e1;
                    const int cls = g * 28 + pair_index(lo, hi);
                    TCLS[rl0 + q] = cls; TRNK[rl0 + q] = atomicAdd(HIST + cls, 1);
                    ((float*)(lds + P7_TG))[(rl0 + q) * 2] = gval[q] * (e1 < e2 ? w1 : w2); ((float*)(lds + P7_TG))[(rl0 + q) * 2 + 1] = gval[q] * (e1 < e2 ? w2 : w1);
                } }
        }
        __syncthreads();
        if (tid < NCLS) { const int n = HIST[tid]; BASE[tid] = n ? atomicAdd(CNT + tid, n) : 0; }
        __syncthreads();
        if (tid < 256) { const int cls = TCLS[tid]; const size_t slot = (size_t)cls * 65536 + BASE[cls] + TRNK[tid]; LIST[slot] = tile * 256 + tid;
            typedef float f32x2v __attribute__((ext_vector_type(2))); *(f32x2v*)((float*)(p.ws + WS_GSLOT) + slot * 2) = *(const f32x2v*)((const float*)(lds + P7_TG) + tid * 2); }
    }
}

constexpr int MOE_SM = 131072;
__device__ __forceinline__ void cls_decode(int cls, int& g, int& lo, int& hi) {
    g = cls / 28; int r = cls % 28; lo = 0; while (r >= 7 - lo) { r -= 7 - lo; ++lo; } hi = lo + 1 + r;
}
__device__ __forceinline__ void moe_build_map(const Params& p, int* sm) {
    const int* CNT = (const int*)(p.ws + WS_CTL);
    __syncthreads();
    if (threadIdx.x < NCLS) sm[128 + threadIdx.x] = CNT[threadIdx.x];
    __syncthreads();
    if (threadIdx.x == 0) { int base = 0; for (int c = 0; c < NCLS; ++c) { sm[c] = base; base += (sm[128 + c] + 255) >> 8; } sm[256] = base; }
    __syncthreads();
    if (threadIdx.x < NCLS) { const int c = threadIdx.x, b0 = sm[c], nt = (sm[128 + c] + 255) >> 8; for (int q = 0; q < nt; ++q) sm[384 + b0 + q] = c; }
    __syncthreads();
}
struct P8Sched { const char* H2; const char* EW13; const int* LIST; const int* sm; int G, c, NU;
    __device__ __forceinline__ bool next(int i, pg::UDesc& u) const { const int q = i * G + c; if (q >= NU) return false; const int mt = q >> 3, nj = q & 7, cls = sm[384 + mt]; int g, lo, hi; cls_decode(cls, g, lo, hi);
        const int e = g * 8 + (nj < 4 ? lo : hi);
        u.A = H2; u.B0 = EW13 + ((size_t)e * 1024 + (size_t)(nj & 3) * 256) * 1024; u.B1 = u.B0 + 4 * 128; u.i0 = cls; u.i1 = mt; u.i2 = nj; u.i3 = (mt - sm[cls]) * 256; return true; }
    __device__ __forceinline__ unsigned rowoff(const pg::UDesc& u, int r) const { const int rk = u.i3 + r; const int t = (rk < sm[128 + u.i0]) ? LIST[(size_t)u.i0 * 65536 + rk] : 0; return (unsigned)t * 1024u; }
};
__device__ __forceinline__ void phase8(const Params& p, unsigned char* lds) {
    int* sm = (int*)(lds + MOE_SM);
    moe_build_map(p, sm);
    bf16_t* HID = (bf16_t*)(p.ws + WS_HID); const int* LIST = (const int*)(p.ws + WS_LIST); const float* GSLOT = (const float*)(p.ws + WS_GSLOT);
    P8Sched S{(const char*)(p.ws + WS_H), (const char*)(p.ws + WS_EW13), LIST, sm, (int)gridDim.x, vcu_of(blockIdx.x, gridDim.x), sm[256] * 8};
    auto E = [&](const f32x4 (&acc)[2][2][4][2], const pg::UDesc& u, int wr, int wc, int fr, int fq) {
        const int cnt = sm[128 + u.i0], xh = u.i2 >> 2;
        const float USC = 1.f / (FP8_XSCALE * FP8_WSCALE);
#pragma unroll
        for (int a = 0; a < 2; ++a) {
            float gts[4];
#pragma unroll
            for (int m = 0; m < 4; ++m) { const int rk = u.i3 + 128 * a + 64 * wr + 16 * m + fr; const float g = GSLOT[((size_t)u.i0 * 65536 + (rk < cnt ? rk : 0)) * 2 + xh]; gts[m] = (rk < cnt) ? g * FP8_HSCALE : 0.f; }
#pragma unroll
            for (int m = 0; m < 4; ++m) { const int rl = 128 * a + 64 * wr + 16 * m + fr; const float gt = gts[m];
                float hv[8];
#pragma unroll
                for (int n = 0; n < 2; ++n)
#pragma unroll
                    for (int q = 0; q < 4; ++q) hv[4 * n + q] = fminf(fmaxf(silu_fast(acc[a][0][m][n][q] * USC) * (acc[a][1][m][n][q] * USC) * gt, -440.f), 440.f);
                u32x2 o; o.x = pk4_fp8(hv[0], hv[1], hv[2], hv[3]); o.y = pk4_fp8(hv[4], hv[5], hv[6], hv[7]);
                *(u32x2*)((unsigned char*)HID + (size_t)(u.i1 * 256 + rl) * 1024 + xh * 512 + (u.i2 & 3) * 128 + 32 * wc + 8 * fq) = o; }
        }
    };
    pg::gemm_stream<true, true, true>((LAS unsigned char*)lds, 1024, 1024, S, E);
}
struct P9Sched { const char* HID; const char* EW2T; const int* sm; int G, c, NU;
    __device__ __forceinline__ bool next(int i, pg::UDesc& u) const { const int q = i * G + c; if (q >= NU) return false; const int mt = q >> 2, pn = q & 3, cls = sm[384 + mt]; int g, lo, hi; cls_decode(cls, g, lo, hi);
        u.A = HID + (size_t)mt * 256 * 1024; u.B0 = EW2T + ((size_t)(g * 8 + lo) * 1024 + (size_t)pn * 256) * 512; u.B1 = EW2T + ((size_t)(g * 8 + hi) * 1024 + (size_t)pn * 256) * 512;
        u.i0 = cls; u.i1 = mt; u.i2 = pn; u.i3 = (mt - sm[cls]) * 256; return true; }
    __device__ __forceinline__ unsigned rowoff(const pg::UDesc&, int) const { return 0u; }
};
__device__ __forceinline__ void phase9(const Params& p, unsigned char* lds) {
    int* sm = (int*)(lds + MOE_SM);
    moe_build_map(p, sm);
    const int* LIST = (const int*)(p.ws + WS_LIST); const float* MOD = (const float*)(p.ws + WS_MOD);
    P9Sched S{(const char*)(p.ws + WS_HID), (const char*)(p.ws + WS_EW2T), sm, (int)gridDim.x, vcu_of(blockIdx.x, gridDim.x), sm[256] * 4};
    auto E = [&](const f32x4 (&acc)[2][2][4][2], const pg::UDesc& u, int wr, int wc, int fr, int fq) {
        const int cnt = sm[128 + u.i0];
        int tk[2][4];
#pragma unroll
        for (int a = 0; a < 2; ++a)
#pragma unroll
            for (int m = 0; m < 4; ++m) { const int rk = u.i3 + 128 * a + 64 * wr + 16 * m + fr; tk[a][m] = (rk < cnt) ? LIST[(size_t)u.i0 * 65536 + rk] : -1; }
#pragma unroll
        for (int a = 0; a < 2; ++a) {
            u32x2 x1[4][2][2];
#pragma unroll
            for (int m = 0; m < 4; ++m) { const int t = tk[a][m], ts = t < 0 ? 0 : t;
                const bf16_t* xrow = (const bf16_t*)(p.ws + WS_D1) + (size_t)ts * 1024 + u.i2 * 256 + 32 * wc + 4 * fq;
#pragma unroll
                for (int b = 0; b < 2; ++b)
#pragma unroll
                    for (int n = 0; n < 2; ++n) x1[m][b][n] = *(const u32x2*)(xrow + 128 * b + 16 * n); }
#pragma unroll
            for (int m = 0; m < 4; ++m) { const int t = tk[a][m], ts = t < 0 ? 0 : t;
                const float* g2 = MOD + (size_t)(ts >> 12) * 6144 + 5120 + u.i2 * 256 + 32 * wc + 4 * fq; float* orow = p.out + (size_t)ts * 1024 + u.i2 * 256 + 32 * wc + 4 * fq;
                f32x4 gv[2][2];
#pragma unroll
                for (int b = 0; b < 2; ++b)
#pragma unroll
                    for (int n = 0; n < 2; ++n) gv[b][n] = *(const f32x4*)(g2 + 128 * b + 16 * n);
                if (t >= 0) {
#pragma unroll
                    for (int b = 0; b < 2; ++b)
#pragma unroll
                        for (int n = 0; n < 2; ++n) { const f32x4 xf = (f32x4){bflo(x1[m][b][n].x), bfhi(x1[m][b][n].x), bflo(x1[m][b][n].y), bfhi(x1[m][b][n].y)};
                            *(f32x4*)(orow + 128 * b + 16 * n) = xf + gv[b][n] * (acc[a][b][m][n] * (1.f / (FP8_HSCALE * FP8_WSCALE))); } } }
        }
    };
    pg::gemm_stream<false, false, true>((LAS unsigned char*)lds, 1024, 512, S, E);
}

#define XB_TMO      128
#define XB_XCNT(j)  (256  + 64 * (j))
#define XB_XSUB(j)  (1280 + 64 * (j))
#define XB_XGEN(j)  (2304 + 64 * (j))
#define XB_TOP      3328
#define XB_TOPGEN   3392
#define XCD_BAR_WORDS 3456
#define XB_SPIN_CAP (1u << 18)

__device__ __forceinline__ unsigned xb_ld(unsigned* p)              { return __hip_atomic_load(p, __ATOMIC_RELAXED, __HIP_MEMORY_SCOPE_AGENT); }
__device__ __forceinline__ unsigned xb_add(unsigned* p, unsigned v) { return __hip_atomic_fetch_add(p, v, __ATOMIC_RELAXED, __HIP_MEMORY_SCOPE_AGENT); }
__device__ __forceinline__ unsigned xb_xcc_id() { return (unsigned)__builtin_amdgcn_s_getreg((3 << 11) | 20) & 0xFu; }
#define XB_SPIN(cond, bar) do { unsigned _sp = 0; while (cond) { __builtin_amdgcn_s_sleep(1); \
    if ((++_sp & 255u) == 0u) { if (xb_ld(&(bar)[XB_TMO])) break; if (_sp > XB_SPIN_CAP) { atomicAdd(&(bar)[XB_TMO], 1u); break; } } } } while (0)

struct XcdBarrier {
    unsigned* bar; unsigned x;
    volatile LAS unsigned* st;
};

__device__ __forceinline__ XcdBarrier xcd_barrier_post(unsigned* bar, volatile LAS unsigned* st) {
    XcdBarrier b; b.bar = bar; b.x = xb_xcc_id(); b.st = st;
    if (threadIdx.x == 0) (void)xb_add(&bar[XB_XCNT(b.x)], 1u);
    return b;
}
__device__ __forceinline__ void xcd_barrier_complete(unsigned* bar, unsigned x, unsigned& nloc, unsigned& nx) {
    const unsigned G = gridDim.x * gridDim.y * gridDim.z;
    unsigned sum, cnt, mine, sp = 0u;
    for (;;) {
        sum = 0u; cnt = 0u; mine = 0u;
#pragma unroll
        for (unsigned j = 0; j < 16; ++j) { const unsigned c = xb_ld(&bar[XB_XCNT(j)]); sum += c; cnt += (c > 0u) ? 1u : 0u; mine = (j == x) ? c : mine; }
        if (sum == G) break;
        __builtin_amdgcn_s_sleep(1);
        if ((++sp & 255u) == 0u) { if (xb_ld(&bar[XB_TMO])) break; if (sp > XB_SPIN_CAP) { atomicAdd(&bar[XB_TMO], 1u); break; } }
    }
    nloc = mine > 0u ? mine : 1u; nx = cnt > 0u ? cnt : 1u;
}

__device__ __forceinline__ void xcd_barrier(const XcdBarrier& b) {
    asm volatile("s_waitcnt vmcnt(0)" ::: "memory");
    __syncthreads();
    if (threadIdx.x == 0) {
        unsigned* bar = b.bar;
        __builtin_amdgcn_s_waitcnt(0);
        unsigned nloc = b.st[0], nx = b.st[1];
        if (nloc == 0u) { xcd_barrier_complete(bar, b.x, nloc, nx); b.st[0] = nloc; b.st[1] = nx; }
        const unsigned old = xb_add(&bar[XB_XSUB(b.x)], 1u);
        const unsigned gen = old / nloc;
        if (old + 1u == (gen + 1u) * nloc) {
            __builtin_amdgcn_fence(__ATOMIC_RELEASE, "agent");
            asm volatile("s_waitcnt vmcnt(0)" ::: "memory");
            const unsigned og = xb_add(&bar[XB_TOP], 1u);
            const unsigned tg = og / nx;
            if (og + 1u == (tg + 1u) * nx) xb_add(&bar[XB_TOPGEN], 1u);
            else XB_SPIN(xb_ld(&bar[XB_TOPGEN]) == tg, bar);
            __builtin_amdgcn_fence(__ATOMIC_ACQUIRE, "agent");
            xb_add(&bar[XB_XGEN(b.x)], 1u);
            asm volatile("s_waitcnt vmcnt(0)" ::: "memory");
        } else {
            XB_SPIN(xb_ld(&bar[XB_XGEN(b.x)]) == gen, bar);
            __builtin_amdgcn_fence(__ATOMIC_ACQUIRE, "agent");
            asm volatile("s_waitcnt vmcnt(0)" ::: "memory");
        }
    }
    __syncthreads();
}


constexpr int LDS_BYTES = 152 * 1024;
#ifdef PROBE_A
#define TSTAMP(k) do { if (blockIdx.x == 0 && threadIdx.x == 0) ((unsigned long long*)(p.ws + WS_CTL + 4096))[k] = __builtin_amdgcn_s_memrealtime(); } while (0)
#else
#define TSTAMP(k) do { } while (0)
#endif
__global__ void __launch_bounds__(NTHR, 2) fwd_kernel(Params p) {
    extern __shared__ __attribute__((aligned(16))) unsigned char lds[];
    cg::grid_group grid = cg::this_grid();
    volatile LAS unsigned* bst = (volatile LAS unsigned*)((LAS unsigned char*)lds + LDS_BYTES - 16);
    if (threadIdx.x < 2) bst[threadIdx.x] = 0u;
    if (blockIdx.x == 0) { if (threadIdx.x < 128) ((int*)(p.ws + WS_CTL))[threadIdx.x] = 0; for (int i = threadIdx.x; i < 3456; i += NTHR) ((unsigned*)(p.ws + WS_BAR))[i] = 0u; }
    grid.sync();
    const XcdBarrier bar = xcd_barrier_post((unsigned*)(p.ws + WS_BAR), bst);
    TSTAMP(0);
    phase0(p, lds);
    xcd_barrier(bar); TSTAMP(1);
    phase1(p, lds);
    khat_items(p, lds);
    xcd_barrier(bar); TSTAMP(2);
    phase2(p, lds);
    xcd_barrier(bar); TSTAMP(3);
    phase3(p);
    xcd_barrier(bar); TSTAMP(4);
    for (int u = blockIdx.x; u < 1024; u += gridDim.x) attn_unit(p, u, lds);
    TSTAMP(5);
    for (int it = blockIdx.x; it < 1024; it += gridDim.x) hyena_item(p, it, lds);
    xcd_barrier(bar); TSTAMP(6);
    {   u32x4 hv[8]; const int tq5 = otid();
        if (blockIdx.x < 1024) { const bf16_t* src0 = (const bf16_t*)(p.ws + WS_HYT) + ((size_t)((blockIdx.x >> 6) * 512 + tq5)) * 4096 + (blockIdx.x & 63) * 64;
#pragma unroll
            for (int i = 0; i < 8; ++i) hv[i] = *(const u32x4*)(src0 + i * 8); }
        for (int it = blockIdx.x; it < 1024; it += gridDim.x) phase5_item(p, it, lds, hv, (it + (int)gridDim.x < 1024) ? it + (int)gridDim.x : it); }
    xcd_barrier(bar); TSTAMP(7);
    phase6(p, lds);
    xcd_barrier(bar); TSTAMP(8);
    phase7(p, lds);
    xcd_barrier(bar); TSTAMP(9);
    phase8(p, lds);
    xcd_barrier(bar); TSTAMP(10);
    phase9(p, lds);
#ifdef PROBE_A
    xcd_barrier(bar); TSTAMP(11);
    if (blockIdx.x == 0) {
        __threadfence(); __syncthreads();
        const volatile unsigned long long* ts = (const volatile unsigned long long*)(p.ws + WS_CTL + 4096);
        const float ta = (float)(ts[PROBE_A] - ts[PROBE_A - 1]) * 0.01f, tb = (float)(ts[PROBE_B] - ts[PROBE_B - 1]) * 0.0001f;
        for (int i = threadIdx.x; i < (1 << 20); i += NTHR) p.out[1024 + i] += tb;
        if (threadIdx.x == 0) p.out[0] += ta;
    }
#endif
}

extern "C" void kernel_launch(void* const* d_in, const int* in_sizes, int n_in, void* d_out, int out_size, void* d_ws, size_t ws_size, hipStream_t stream) {
    static int grid_blocks = 0;
    if (grid_blocks == 0) {
        if (n_in != 30 || out_size != NTOK * DM || ws_size < WS_END) { fprintf(stderr, "kernel_launch: unexpected shapes (n_in %d out %d ws %zu)\n", n_in, out_size, ws_size); grid_blocks = -1; return; }
        int dev = 0, cus = 0, per_cu = 0;
        hipGetDevice(&dev); hipDeviceGetAttribute(&cus, hipDeviceAttributeMultiprocessorCount, dev);
        hipFuncSetAttribute((const void*)fwd_kernel, hipFuncAttributeMaxDynamicSharedMemorySize, LDS_BYTES);
        hipOccupancyMaxActiveBlocksPerMultiprocessor(&per_cu, (const void*)fwd_kernel, NTHR, LDS_BYTES);
        if (per_cu < 1) { fprintf(stderr, "kernel_launch: occupancy query says %d blocks per CU\n", per_cu); grid_blocks = -1; return; }
        grid_blocks = cus * per_cu;
    }
    if (grid_blocks < 0) return;
    Params p{};
    const float** pp = (const float**)&p;
    for (int i = 0; i < 30; ++i) pp[i] = (const float*)d_in[i];
    p.out = (float*)d_out; p.ws = (unsigned char*)d_ws;
    void* args[] = {&p};
    hipError_t e = hipLaunchCooperativeKernel((const void*)fwd_kernel, dim3(grid_blocks), dim3(NTHR), args, LDS_BYTES, stream);
    if (e != hipSuccess) fprintf(stderr, "cooperative launch failed: %s (grid %d)\n", hipGetErrorString(e), grid_blocks);
}
```

```cpp
#include <hip/hip_runtime.h>
#include <hip/hip_cooperative_groups.h>
#include <cstdio>
#include <cstdint>
namespace cg = cooperative_groups;

typedef unsigned short bf16_t;
typedef short bf16x8 __attribute__((ext_vector_type(8)));
typedef float f32x4 __attribute__((ext_vector_type(4)));
typedef unsigned u32x4 __attribute__((ext_vector_type(4)));
typedef unsigned u32x2 __attribute__((ext_vector_type(2)));
typedef _Float16 f16x8 __attribute__((ext_vector_type(8)));
typedef _Float16 f16x4 __attribute__((ext_vector_type(4)));
typedef _Float16 f16x2 __attribute__((ext_vector_type(2)));

constexpr int DM = 1024, NB = 16, SEQ = 4096, NTOK = NB * SEQ, CTXL = 256, NCTX = NB * CTXL;
constexpr int PROJW = 2304, HYW = 512, HYPW = 1536, KOFF = 512, VOFF = 640, HYOFF = 768;
constexpr int NEXP = 32, EHID = 512, NCLS = 112;
constexpr float EPSN = 1e-6f;
constexpr int NTHR = 512;

constexpr size_t MiB = 1u << 20;
constexpr size_t WS_CTL = 0, WS_MOD = 1 * MiB, WS_WINT = 2 * MiB, WS_WOUTT = 7 * MiB, WS_TAPS = 9 * MiB, WS_EW13 = 41 * MiB, WS_EW2T = 105 * MiB;
constexpr size_t WS_GATE = 137 * MiB, WS_KVC = 139 * MiB, WS_HC = 141 * MiB, WS_LIST = 149 * MiB, WS_H = 177 * MiB, WS_QKV = 305 * MiB, WS_UT = 401 * MiB;
constexpr size_t WS_HYT = 593 * MiB, WS_ATTHY = 657 * MiB, WS_HID = 305 * MiB, WS_KH = 785 * MiB, WS_END = 1003 * MiB;
constexpr size_t WS_BAR = 16384;
constexpr size_t WS_GSLOT = 945 * MiB;
constexpr size_t WS_D1 = 817 * MiB;
constexpr size_t WS_FTAB = 65536, WS_GTAB = 81920, WS_FKTAB = 98304;

struct Params {
    const float* x; const float* c; const float* ctx; const float* c_ctx; const float* ada_w; const float* ada_b; const float* norm1_w; const float* w_in;
    const float* q_norm_w; const float* k_norm_w; const float* attn_sink; const float* hy_conv_w; const float* hy_conv_b; const float* hy_w1; const float* hy_b1;
    const float* hy_w2; const float* hy_b2; const float* hy_w3; const float* hy_sin_freq; const float* hy_skip; const float* group_norm_w; const float* w_out;
    const float* norm2_w; const float* router_g_w; const float* router_g_b; const float* router_e_w; const float* router_e_b; const float* exp_w1; const float* exp_w3;
    const float* exp_w2;
    float* out; unsigned char* ws;
};

__device__ __forceinline__ unsigned f2bf(float f) { unsigned u = __builtin_bit_cast(unsigned, f); return (u + 0x7fffu + ((u >> 16) & 1u)) >> 16; }
typedef float f32x2_t __attribute__((ext_vector_type(2))); typedef __bf16 bf16x2_t __attribute__((ext_vector_type(2)));
__device__ __forceinline__ unsigned pk2(float lo, float hi) { f32x2_t v = {lo, hi}; bf16x2_t b = __builtin_convertvector(v, bf16x2_t); return __builtin_bit_cast(unsigned, b); }
__device__ __forceinline__ float bf2f(unsigned short b) { return __builtin_bit_cast(float, (unsigned)b << 16); }
__device__ __forceinline__ float bflo(unsigned w) { return __builtin_bit_cast(float, w << 16); }
__device__ __forceinline__ float bfhi(unsigned w) { return __builtin_bit_cast(float, w & 0xffff0000u); }
__device__ __forceinline__ unsigned pkh2(float lo, float hi) { f16x2 v = {(_Float16)lo, (_Float16)hi}; return __builtin_bit_cast(unsigned, v); }
__device__ __forceinline__ float h2f(unsigned short h) { return (float)__builtin_bit_cast(_Float16, h); }
__device__ __forceinline__ float hlo(unsigned w) { return h2f((unsigned short)(w & 0xffffu)); }
__device__ __forceinline__ float hhi(unsigned w) { return h2f((unsigned short)(w >> 16)); }
#define dpp_f(v, ctrl) __builtin_bit_cast(float, __builtin_amdgcn_update_dpp(0, __builtin_bit_cast(int, (float)(v)), (ctrl), 0xf, 0xf, false))
#define DPP_XOR1 0xB1
#define DPP_XOR2 0x4E
#define DPP_HMIRROR 0x141
#define DPP_MIRROR 0x140
__device__ __forceinline__ float xor16_sum(float v) { const unsigned u = __builtin_bit_cast(unsigned, v); auto r = __builtin_amdgcn_permlane16_swap(u, u, false, false); return __builtin_bit_cast(float, (unsigned)r[0]) + __builtin_bit_cast(float, (unsigned)r[1]); }
__device__ __forceinline__ float xor32_sum(float v) { const unsigned u = __builtin_bit_cast(unsigned, v); auto r = __builtin_amdgcn_permlane32_swap(u, u, false, false); return __builtin_bit_cast(float, (unsigned)r[0]) + __builtin_bit_cast(float, (unsigned)r[1]); }
__device__ __forceinline__ float wave_sum(float v) {
    v += dpp_f(v, DPP_XOR1); v += dpp_f(v, DPP_XOR2); v += dpp_f(v, DPP_HMIRROR); v += dpp_f(v, DPP_MIRROR);
    v = xor16_sum(v); v = xor32_sum(v);
    return v;
}
__device__ __forceinline__ int otid() { int t = threadIdx.x; asm volatile("" : "+v"(t)); return t; }
__device__ __forceinline__ float exp2_raw(float x) { float r; asm volatile("v_exp_f32 %0, %1\n\ts_nop 1" : "=v"(r) : "v"(x)); return r; }
__device__ __forceinline__ float max_fq(float m) { const unsigned u = __builtin_bit_cast(unsigned, m);
    auto r16 = __builtin_amdgcn_permlane16_swap(u, u, false, false); float a = fmaxf(__builtin_bit_cast(float, (unsigned)r16[0]), __builtin_bit_cast(float, (unsigned)r16[1]));
    const unsigned ua = __builtin_bit_cast(unsigned, a); auto r32 = __builtin_amdgcn_permlane32_swap(ua, ua, false, false); return fmaxf(__builtin_bit_cast(float, (unsigned)r32[0]), __builtin_bit_cast(float, (unsigned)r32[1])); }
__device__ __forceinline__ float siluf(float v) { return v / (1.f + __expf(-v)); }
__device__ __forceinline__ float rcp_raw(float x) { float r; asm volatile("v_rcp_f32 %0, %1\n\ts_nop 1" : "=v"(r) : "v"(x)); return r; }
__device__ __forceinline__ float silu_fast(float v) { return v * rcp_raw(1.f + exp2_raw(v * -1.4426950408889634f)); }
__device__ __forceinline__ float sin_rad(float a) { float r = a * 0.15915494309189535f; r -= floorf(r); return __builtin_amdgcn_sinf(r); }
__device__ __forceinline__ float cos_rad(float a) { float r = a * 0.15915494309189535f; r -= floorf(r); return __builtin_amdgcn_cosf(r); }

template <class SrcA, class SrcB>
__device__ __forceinline__ void gemm_unit(unsigned char* lds, f32x4 (&acc)[2][2][4][2], const SrcA& srcA, const SrcB& srcB) {
    const int tid = otid(), wid = tid >> 6, lane = tid & 63, wr = wid >> 2, wc = wid & 3, fr = lane & 15, fq = lane >> 4;
#pragma unroll
    for (int a = 0; a < 2; ++a)
#pragma unroll
        for (int b = 0; b < 2; ++b)
#pragma unroll
            for (int m = 0; m < 4; ++m)
#pragma unroll
                for (int n = 0; n < 2; ++n) acc[a][b][m][n] = (f32x4){0.f, 0.f, 0.f, 0.f};
    const int r0 = tid >> 2, kc = tid & 3;
    const bf16_t* pa0 = srcA(r0) + kc * 8; const bf16_t* pa1 = srcA(r0 + 128) + kc * 8;
    u32x4 ra0, ra1, rb0, rb1;
    ra0 = *(const u32x4*)(pa0); ra1 = *(const u32x4*)(pa1);
    rb0 = *(const u32x4*)(srcB(r0, 0) + kc * 8); rb1 = *(const u32x4*)(srcB(r0 + 128, 0) + kc * 8);
    unsigned char* sA = lds; unsigned char* sB = lds + 16384;
    for (int ks = 0; ks < 32; ++ks) {
        __syncthreads();
        *(u32x4*)(sA + tid * 16) = ra0; *(u32x4*)(sA + 8192 + tid * 16) = ra1;
        *(u32x4*)(sB + tid * 16) = rb0; *(u32x4*)(sB + 8192 + tid * 16) = rb1;
        __syncthreads();
        if (ks + 1 < 32) {
            ra0 = *(const u32x4*)(pa0 + (ks + 1) * 32); ra1 = *(const u32x4*)(pa1 + (ks + 1) * 32);
            rb0 = *(const u32x4*)(srcB(r0, ks + 1) + kc * 8); rb1 = *(const u32x4*)(srcB(r0 + 128, ks + 1) + kc * 8);
        }
        bf16x8 Af[2][4], Bf[2][2];
#pragma unroll
        for (int a = 0; a < 2; ++a)
#pragma unroll
            for (int m = 0; m < 4; ++m) Af[a][m] = *(const bf16x8*)(sA + (128 * a + 64 * wr + 16 * m + fr) * 64 + fq * 16);
#pragma unroll
        for (int b = 0; b < 2; ++b)
#pragma unroll
            for (int n = 0; n < 2; ++n) Bf[b][n] = *(const bf16x8*)(sB + (128 * b + 32 * wc + 16 * n + fr) * 64 + fq * 16);
#pragma unroll
        for (int a = 0; a < 2; ++a)
#pragma unroll
            for (int b = 0; b < 2; ++b)
#pragma unroll
                for (int m = 0; m < 4; ++m)
#pragma unroll
                    for (int n = 0; n < 2; ++n) acc[a][b][m][n] = __builtin_amdgcn_mfma_f32_16x16x32_bf16(Bf[b][n], Af[a][m], acc[a][b][m][n], 0, 0, 0);
    }
}
#define ACC_FOREACH(acc, BODY) do { \
    const int _wid = threadIdx.x >> 6, _lane = threadIdx.x & 63, _wr = _wid >> 2, _wc = _wid & 3, _fr = _lane & 15, _fq = _lane >> 4; \
    _Pragma("unroll") for (int _a = 0; _a < 2; ++_a) _Pragma("unroll") for (int _m = 0; _m < 4; ++_m) _Pragma("unroll") for (int _b = 0; _b < 2; ++_b) _Pragma("unroll") for (int _n = 0; _n < 2; ++_n) { \
        const int rl = 128 * _a + 64 * _wr + 16 * _m + _fr, cl = 128 * _b + 32 * _wc + 16 * _n + 4 * _fq; const f32x4 v = acc[_a][_b][_m][_n]; BODY } } while (0)


#define LAS __attribute__((address_space(3)))
namespace pg {
constexpr int HTB = 16384;
__device__ __forceinline__ int lds_byte(int r, int c) { const int st = (r >> 4) * 2 + (c >> 5), rr = r & 15, cc = c & 31, ob = rr * 64 + cc * 2; return st * 1024 + (ob ^ (((ob >> 9) & 1) << 5)); }
__device__ __forceinline__ void stage_rc(int b, int& R, int& C) { const int st = b / 1024, sb = b % 1024, swz = sb ^ (((sb >> 9) & 1) << 5); R = (st >> 1) * 16 + swz / 64; C = (st & 1) * 32 + (swz % 64) / 2; }
__device__ __forceinline__ int perm32(int rho) { const int n = rho >> 4, i = rho & 15; return 8 * (i >> 2) + 4 * n + (i & 3); }
struct UDesc { const char* A; const char* B0; const char* B1; int i0, i1, i2, i3; };
typedef int v8i_t __attribute__((ext_vector_type(8)));
template <bool GATHER, bool PERM, bool FP8, class Sched, class Epi>
__device__ __forceinline__ void gemm_stream(LAS unsigned char* lds, const int KA, const int KB, const Sched& S, const Epi& E) {
    const int tid = otid(), wid = __builtin_amdgcn_readfirstlane(tid >> 6), lane = tid & 63, wr = wid >> 2, wc = wid & 3, fr = lane & 15, fq = lane >> 4;
    constexpr int nt = FP8 ? 8 : 16, nth = nt / 2;
    unsigned voffA[2], voffB[2]; int rowA[2]; unsigned colA[2];
#pragma unroll
    for (int i = 0; i < 2; ++i) { int R, C; stage_rc(tid * 16 + i * 8192, R, C); const int Rb = PERM ? ((R & ~31) + perm32(R & 31)) : R;
        voffA[i] = (unsigned)(R * KA + C * 2); voffB[i] = (unsigned)(Rb * KB + C * 2); rowA[i] = R; colA[i] = (unsigned)C * 2u; }
    const size_t hstepA = (size_t)128 * KA, hstepB = (size_t)128 * KB;
    const unsigned ldsw = (unsigned)wid * 1024u;
    const int aoff = lds_byte(wr * 64 + fr, fq * 8), boff = lds_byte(wc * 32 + fr, fq * 8);
    const int aoff8a = lds_byte(wr * 64 + fr, fq * 16), aoff8b = aoff8a + 16, boff8a = lds_byte(wc * 32 + fr, fq * 16), boff8b = boff8a + 16;
#define PG_SA(b, h) (((b) * 2 + (h)) * pg::HTB)
#define PG_SB(b, h) ((4 + (b) * 2 + (h)) * pg::HTB)
#define PG_LD2(bufoff, p0, p1) do { __builtin_amdgcn_global_load_lds((const unsigned*)(p0), (LAS unsigned*)(lds + (bufoff) + ldsw), 16, 0, 0); \
        __builtin_amdgcn_global_load_lds((const unsigned*)(p1), (LAS unsigned*)(lds + (bufoff) + ldsw + 8192), 16, 0, 0); } while (0)
#define PG_STA(bufoff, pa, VA, h) do { if (GATHER) PG_LD2(bufoff, (pa) + ((h) ? VA##10 : VA##00), (pa) + ((h) ? VA##11 : VA##01)); else { const char* _b = (pa) + (h) * hstepA; PG_LD2(bufoff, _b + voffA[0], _b + voffA[1]); } } while (0)
#define PG_STB(bufoff, pb, h) do { const char* _b = (pb) + (h) * hstepB; PG_LD2(bufoff, _b + voffB[0], _b + voffB[1]); } while (0)
#define PG_LD8(p0, p1) __builtin_bit_cast(v8i_t, __builtin_shufflevector(*(const LAS bf16x8*)(p0), *(const LAS bf16x8*)(p1), 0, 1, 2, 3, 4, 5, 6, 7, 8, 9, 10, 11, 12, 13, 14, 15))
#define PG_LDA(dst, b, h) do { _Pragma("unroll") for (int m = 0; m < 4; ++m) { if (FP8) dst##8[m] = PG_LD8(lds + PG_SA(b, h) + aoff8a + m * 2048, lds + PG_SA(b, h) + aoff8b + m * 2048); \
        else { _Pragma("unroll") for (int k = 0; k < 2; ++k) dst[m][k] = *(const LAS bf16x8*)(lds + PG_SA(b, h) + aoff + m * 2048 + k * 1024); } } } while (0)
#define PG_LDB(dst, b, h) do { _Pragma("unroll") for (int n = 0; n < 2; ++n) { if (FP8) dst##8[n] = PG_LD8(lds + PG_SB(b, h) + boff8a + n * 2048, lds + PG_SB(b, h) + boff8b + n * 2048); \
        else { _Pragma("unroll") for (int k = 0; k < 2; ++k) dst[n][k] = *(const LAS bf16x8*)(lds + PG_SB(b, h) + boff + n * 2048 + k * 1024); } } } while (0)
#define PG_MMA(ai, bj, At, Bt) do { __builtin_amdgcn_s_setprio(1); _Pragma("unroll") for (int m = 0; m < 4; ++m) _Pragma("unroll") for (int n = 0; n < 2; ++n) { \
        if (FP8) asm volatile("v_mfma_f32_16x16x128_f8f6f4 %0, %1, %2, %0" : "+v"(acc[ai][bj][m][n]) : "v"(Bt##8[n]), "v"(At##8[m])); \
        else { _Pragma("unroll") for (int k = 0; k < 2; ++k) acc[ai][bj][m][n] = __builtin_amdgcn_mfma_f32_16x16x32_bf16(Bt[n][k], At[m][k], acc[ai][bj][m][n], 0, 0, 0); } } __builtin_amdgcn_s_setprio(0); } while (0)
#define PG_WAIT_V(n) asm volatile("s_waitcnt vmcnt(" #n ")" ::: "memory")
#define PG_WAIT_L(n) asm volatile("s_waitcnt lgkmcnt(" #n ")" ::: "memory")
#define PG_BAR __builtin_amdgcn_s_barrier()
#define PG_SCHED __builtin_amdgcn_sched_barrier(0)
    UDesc cur, nxt; int ui = 0;
    unsigned cva00 = 0, cva01 = 0, cva10 = 0, cva11 = 0, nva00 = 0, nva01 = 0, nva10 = 0, nva11 = 0;
    if (!S.next(0, cur)) return;
    if (GATHER) { int R0, C0, R1, C1; stage_rc(otid() * 16, R0, C0); stage_rc(otid() * 16 + 8192, R1, C1);
        cva00 = S.rowoff(cur, R0) + C0 * 2; cva01 = S.rowoff(cur, R1) + C1 * 2; cva10 = S.rowoff(cur, 128 + R0) + C0 * 2; cva11 = S.rowoff(cur, 128 + R1) + C1 * 2; }
    f32x4 acc[2][2][4][2];
#pragma unroll
    for (int a = 0; a < 2; ++a)
#pragma unroll
        for (int b = 0; b < 2; ++b)
#pragma unroll
            for (int m = 0; m < 4; ++m)
#pragma unroll
                for (int n = 0; n < 2; ++n) acc[a][b][m][n] = (f32x4){0.f, 0.f, 0.f, 0.f};
    bf16x8 At[4][2], B0[2][2], B1[2][2]; v8i_t At8[4], B08[2], B18[2];
    PG_STB(PG_SB(0, 0), cur.B0, 0); PG_STB(PG_SB(0, 1), cur.B0, 1); PG_STA(PG_SA(0, 0), cur.A, cva, 0); PG_STA(PG_SA(0, 1), cur.A, cva, 1);
    if (wr == 1) PG_BAR;
    PG_WAIT_V(2); PG_BAR;
    PG_STB(PG_SB(1, 0), cur.B0 + 128, 0); PG_STA(PG_SA(1, 0), cur.A + 128, cva, 0); PG_STB(PG_SB(1, 1), cur.B0 + 128, 1);
    PG_WAIT_V(6); PG_BAR;
    for (;;) {
        const bool has_next = S.next(ui + 1, nxt);
        if (!has_next) nxt = cur;
        if (GATHER) { if (has_next) { int R0, C0, R1, C1; stage_rc(otid() * 16, R0, C0); stage_rc(otid() * 16 + 8192, R1, C1);
                nva00 = S.rowoff(nxt, R0) + C0 * 2; nva01 = S.rowoff(nxt, R1) + C1 * 2; nva10 = S.rowoff(nxt, 128 + R0) + C0 * 2; nva11 = S.rowoff(nxt, 128 + R1) + C1 * 2; }
            else { nva00 = cva00; nva01 = cva01; nva10 = cva10; nva11 = cva11; } }
        for (int t = 0; t < nt; t += 2) {
            const bool last = (t == nt - 2);
            const char* a1 = cur.A + (size_t)(t + 1) * 128;
            const char* a2 = last ? nxt.A : cur.A + (size_t)(t + 2) * 128;
            const char* b2 = last ? nxt.B0 : ((t + 2 < nth) ? cur.B0 + (size_t)(t + 2) * 128 : cur.B1 + (size_t)(t + 2 - nth) * 128);
            const char* a3 = a2 + 128; const char* b3 = b2 + 128;
            PG_LDB(B0, 0, 0); PG_LDB(B1, 0, 1); PG_SCHED; PG_LDA(At, 0, 0); PG_STA(PG_SA(1, 1), a1, cva, 1);
            if (GATHER && last) { cva00 = nva00; cva01 = nva01; cva10 = nva10; cva11 = nva11; }
            PG_WAIT_V(8); PG_WAIT_L(0); PG_BAR; PG_MMA(0, 0, At, B0); PG_MMA(0, 1, At, B1); PG_BAR; PG_SCHED;
            PG_LDA(At, 0, 1); PG_STB(PG_SB(0, 0), b2, 0); PG_STB(PG_SB(0, 1), b2, 1); PG_STA(PG_SA(0, 0), a2, cva, 0);
            PG_WAIT_V(8); PG_WAIT_L(0); PG_BAR; PG_MMA(1, 0, At, B0); PG_MMA(1, 1, At, B1); PG_BAR; PG_SCHED;
            PG_LDB(B0, 1, 0); PG_LDB(B1, 1, 1); PG_SCHED; PG_LDA(At, 1, 0); PG_STA(PG_SA(0, 1), a2, cva, 1);
            PG_WAIT_V(8); PG_WAIT_L(0); PG_BAR; PG_MMA(0, 0, At, B0); PG_MMA(0, 1, At, B1); PG_BAR; PG_SCHED;
            PG_LDA(At, 1, 1); PG_STB(PG_SB(1, 0), b3, 0); PG_STB(PG_SB(1, 1), b3, 1); PG_STA(PG_SA(1, 0), a3, cva, 0);
            PG_WAIT_V(8); PG_WAIT_L(0); PG_BAR; PG_MMA(1, 0, At, B0); PG_MMA(1, 1, At, B1); PG_BAR; PG_SCHED;
        }
        if (wr == 0) PG_BAR;
        if (FP8) asm volatile("s_nop 15\n\ts_nop 15" ::: "memory");
        E(acc, cur, wr, wc, fr, fq);
        if (!has_next) break;
#pragma unroll
        for (int a = 0; a < 2; ++a)
#pragma unroll
            for (int b = 0; b < 2; ++b)
#pragma unroll
                for (int m = 0; m < 4; ++m)
#pragma unroll
                    for (int n = 0; n < 2; ++n) acc[a][b][m][n] = (f32x4){0.f, 0.f, 0.f, 0.f};
        cur = nxt; ++ui;
        if (wr == 1) PG_BAR;
    }
    PG_WAIT_V(0);
    PG_BAR;
#undef PG_SA
#undef PG_SB
#undef PG_LD2
#undef PG_STA
#undef PG_STB
#undef PG_LDA
#undef PG_LDB
#undef PG_MMA
#undef PG_WAIT_V
#undef PG_WAIT_L
#undef PG_BAR
#undef PG_SCHED
}
}
#define ACCP_FOREACH(acc, wr, wc, fr, fq, BODY) do { \
    _Pragma("unroll") for (int _a = 0; _a < 2; ++_a) _Pragma("unroll") for (int _m = 0; _m < 4; ++_m) _Pragma("unroll") for (int _b = 0; _b < 2; ++_b) { \
        const int rl = 128 * _a + 64 * (wr) + 16 * _m + (fr), cl = 128 * _b + 32 * (wc) + 8 * (fq); const f32x4 v0 = acc[_a][_b][_m][0], v1 = acc[_a][_b][_m][1]; BODY } } while (0)
#define ACCN_FOREACH(acc, wr, wc, fr, fq, BODY) do { \
    _Pragma("unroll") for (int _a = 0; _a < 2; ++_a) _Pragma("unroll") for (int _m = 0; _m < 4; ++_m) _Pragma("unroll") for (int _b = 0; _b < 2; ++_b) _Pragma("unroll") for (int _n = 0; _n < 2; ++_n) { \
        const int rl = 128 * _a + 64 * (wr) + 16 * _m + (fr), cl = 128 * _b + 32 * (wc) + 16 * _n + 4 * (fq); const f32x4 v = acc[_a][_b][_m][_n]; BODY } } while (0)
__device__ __forceinline__ int vcu_of(int bx, int G) { return (G % 8 == 0) ? (bx % 8) * (G / 8) + bx / 8 : bx; }

__device__ __forceinline__ void p0_adaln(const Params& p, int it, unsigned char* lds) {
    float* S = (float*)lds;
    float* R = (float*)(lds + 17 * 1024 * 4);
    const int tid = otid();
    __syncthreads();
    {   float cv[34];
#pragma unroll
        for (int q = 0; q < 34; ++q) { const int i = tid + NTHR * q, r = i >> 10, k = i & 1023; cv[q] = (r < 16) ? p.c[r * 1024 + k] : p.c_ctx[k]; }
#pragma unroll
        for (int q = 0; q < 34; ++q) S[tid + NTHR * q] = siluf(cv[q]); }
    __syncthreads();
    const int col = tid & 63, sl = tid >> 6, n = it * 64 + col;
    float a[17];
#pragma unroll
    for (int r = 0; r < 17; ++r) a[r] = 0.f;
#pragma unroll 1
    for (int k0 = sl * 128; k0 < sl * 128 + 128; k0 += 16) {
        float w[16];
#pragma unroll
        for (int q = 0; q < 16; ++q) w[q] = p.ada_w[(size_t)(k0 + q) * 6144 + n];
#pragma unroll
        for (int q = 0; q < 16; ++q)
#pragma unroll
            for (int r = 0; r < 17; ++r) a[r] += S[r * 1024 + k0 + q] * w[q];
    }
#pragma unroll
    for (int r = 0; r < 17; ++r) R[(sl * 17 + r) * 64 + col] = a[r];
    __syncthreads();
    float* MOD = (float*)(p.ws + WS_MOD);
    for (int i = tid; i < 17 * 64; i += NTHR) { const int r = i >> 6, cc = i & 63; float s = 0.f;
#pragma unroll
        for (int q = 0; q < 8; ++q) s += R[(q * 17 + r) * 64 + cc];
        MOD[r * 6144 + it * 64 + cc] = s + p.ada_b[it * 64 + cc]; }
}

__device__ __forceinline__ void p0_taps(const Params& p, int it, unsigned char* lds) {
    float* FE = (float*)lds;
    float* H1 = FE + 16 * 36;
    float* H2 = H1 + 16 * 64;
    const int tid = otid(), p0 = it * 16;
    __syncthreads();
    if (tid < 256) { const int pp = tid >> 4, j = tid & 15; const float pos = (float)(p0 + pp);
        const float band = 1e-4f + (float)j * ((15.f - 1e-4f) / 15.f);
        float rev = pos * band * (1.f / 4096.f); rev -= floorf(rev);
        FE[pp * 36 + 1 + j] = __builtin_amdgcn_cosf(rev); FE[pp * 36 + 17 + j] = -__builtin_amdgcn_sinf(rev);
        if (j == 0) FE[pp * 36] = pos * (1.f / 4096.f); }
    __syncthreads();
    for (int i = tid; i < 1024; i += NTHR) { const int pp = i >> 6, j = i & 63; float s = p.hy_b1[j];
#pragma unroll
        for (int q = 0; q < 33; ++q) s += FE[pp * 36 + q] * p.hy_w1[q * 64 + j];
        H1[pp * 64 + j] = sin_rad(p.hy_sin_freq[j] * s); }
    __syncthreads();
    for (int i = tid; i < 1024; i += NTHR) { const int pp = i >> 6, j = i & 63; float s = p.hy_b2[j];
#pragma unroll
        for (int q = 0; q < 64; ++q) s += H1[pp * 64 + q] * p.hy_w2[q * 64 + j];
        H2[pp * 64 + j] = sin_rad(p.hy_sin_freq[64 + j] * s); ((_Float16*)(H2 + 1024))[pp * 72 + j] = (_Float16)H2[pp * 64 + j]; }
    __syncthreads();
    float* TAPS = (float*)(p.ws + WS_TAPS);
    const float mind = -3.0701134573253945f, maxd = -15.350567286626972f;
    const int wid = tid >> 6, lane = tid & 63, fr = lane & 15, fq = lane >> 4;
    const _Float16* H2h = (const _Float16*)(H2 + 1024);
    const f16x8 a0 = *(const f16x8*)(H2h + fr * 72 + 8 * fq), a1 = *(const f16x8*)(H2h + fr * 72 + 32 + 8 * fq);
#pragma unroll 2
    for (int j = 0; j < 16; ++j) {
        const int col = 256 * wid + 16 * j + fr, o = col >> 10, dir = (col >> 9) & 1, c = col & 511;
        float wv[16];
#pragma unroll
        for (int e = 0; e < 8; ++e) { wv[e] = p.hy_w3[(size_t)(8 * fq + e) * 2048 + col]; wv[8 + e] = p.hy_w3[(size_t)(32 + 8 * fq + e) * 2048 + col]; }
        f16x8 b0, b1;
#pragma unroll
        for (int e = 0; e < 8; ++e) { b0[e] = (_Float16)wv[e]; b1[e] = (_Float16)wv[8 + e]; }
        f32x4 acc = (f32x4){0.f, 0.f, 0.f, 0.f};
        acc = __builtin_amdgcn_mfma_f32_16x16x32_f16(a0, b0, acc, 0, 0, 0); acc = __builtin_amdgcn_mfma_f32_16x16x32_f16(a1, b1, acc, 0, 0, 0);
        const float delta = fabsf(mind + (maxd - mind) * ((float)c / 511.f));
        float* tp = TAPS + ((size_t)(o * 512 + c)) * 8192;
        const int P = p0 + 4 * fq; f32x4 val;
#pragma unroll
        for (int r = 0; r < 4; ++r) val[r] = acc[r] * __expf(-(float)(P + r) * (1.f / 4096.f) * delta);
        if (dir == 0) *(f32x4*)(tp + 4096 + P) = val;
        else {
#pragma unroll
            for (int r = 0; r < 4; ++r) { if (P + r == 0) tp[0] = 0.f; else tp[4096 - (P + r)] = val[r]; } }
    }
}

__device__ __forceinline__ unsigned pk4_fp8(float a, float b, float c, float d) { int w = 0; w = __builtin_amdgcn_cvt_pk_fp8_f32(a, b, w, false); w = __builtin_amdgcn_cvt_pk_fp8_f32(c, d, w, true); return (unsigned)w; }
constexpr float FP8_WSCALE = 64.f, FP8_XSCALE = 4.f, FP8_HSCALE = 16.f;
__device__ __forceinline__ void p0_transpose_w(const float* src, int N, int k0, int n0, bf16_t* dst, int dpitch, int mode, float* scr  , int lane, bool fp8 = false) {
    float v[32];
#pragma unroll
    for (int i = 0; i < 32; ++i) v[i] = src[(size_t)(k0 + 2 * i + (lane >> 5)) * N + n0 + (lane & 31)];
#pragma unroll
    for (int i = 0; i < 32; ++i) scr[(2 * i + (lane >> 5)) * 33 + (lane & 31)] = v[i];
    asm volatile("s_waitcnt lgkmcnt(0)" ::: "memory");
    const int c = lane & 7;
#pragma unroll
    for (int j = 0; j < 4; ++j) { const int n = (lane >> 3) + 8 * j, col = n0 + n; const float* sp = scr + (8 * c) * 33 + n;
        int drow = col;
        if (mode == 1) drow = (col >> 7) * 256 + (col & 127); else if (mode == 2) drow = (col >> 7) * 256 + 128 + (col & 127);
        if (fp8) { u32x2 o; o.x = pk4_fp8(sp[0] * FP8_WSCALE, sp[33] * FP8_WSCALE, sp[66] * FP8_WSCALE, sp[99] * FP8_WSCALE); o.y = pk4_fp8(sp[132] * FP8_WSCALE, sp[165] * FP8_WSCALE, sp[198] * FP8_WSCALE, sp[231] * FP8_WSCALE);
            *(u32x2*)((unsigned char*)dst + (size_t)drow * dpitch + k0 + 8 * c) = o; }
        else { u32x4 o; o.x = pk2(sp[0], sp[33]); o.y = pk2(sp[66], sp[99]); o.z = pk2(sp[132], sp[165]); o.w = pk2(sp[198], sp[231]);
            *(u32x4*)(dst + (size_t)drow * dpitch + k0 + 8 * c) = o; } }
    asm volatile("s_waitcnt lgkmcnt(0)" ::: "memory");
}

__device__ __forceinline__ void p0_tables(const Params& p, int it) {
    const int e = it * NTHR + threadIdx.x;
    _Float16* FT = (_Float16*)(p.ws + WS_FTAB); _Float16* GT = (_Float16*)(p.ws + WS_GTAB); _Float16* FK = (_Float16*)(p.ws + WS_FKTAB);
    if (e < 8192) { const int rho = e >> 6, s1 = e & 63, f = rho >> 1; float v;
        if (rho == 0) v = 1.f; else if (rho == 1) v = (s1 & 1) ? -1.f : 1.f;
        else { const float rev = (float)((f * s1) & 127) * (1.f / 128.f); v = (rho & 1) ? -__builtin_amdgcn_sinf(rev) : __builtin_amdgcn_cosf(rev); }
        FT[e] = (_Float16)v;
    } else if (e < 16384) { const int q = e - 8192, t1 = q >> 7, rho = q & 127, f = rho >> 1; float v;
        if (rho == 0) v = 1.f / 128.f; else if (rho == 1) v = ((t1 & 1) ? -1.f : 1.f) / 128.f;
        else { const float rev = (float)((f * t1) & 127) * (1.f / 128.f); v = ((rho & 1) ? -__builtin_amdgcn_sinf(rev) : __builtin_amdgcn_cosf(rev)) * (2.f / 128.f); }
        GT[q] = (_Float16)v;
    } else { const int q = e - 16384, rho = q >> 7, dp = q & 127, d = dp - 64, f = rho >> 1; float v;
        if (rho == 0) v = 1.f; else if (rho == 1) v = (d & 1) ? -1.f : 1.f;
        else { const float rev = (float)((f * d) & 127) * (1.f / 128.f); v = (rho & 1) ? -__builtin_amdgcn_sinf(rev) : __builtin_amdgcn_cosf(rev); }
        FK[q] = (_Float16)v;
    }
}

__device__ __forceinline__ void phase0(const Params& p, unsigned char* lds) {
    constexpr int I_WIN = 16 * 72, I_WOUT = 16 * 32, I_W1 = 32 * 16 * 16, I_W2 = 32 * 8 * 32;
    constexpr int NTR = I_WIN + I_WOUT + 2 * I_W1 + I_W2;
    for (int it = blockIdx.x; it < 64; it += gridDim.x) p0_tables(p, it);
    for (int it = blockIdx.x; it < 96; it += gridDim.x) p0_adaln(p, it, lds);
    for (int it = (blockIdx.x + 160) % gridDim.x; it < 256; it += gridDim.x) p0_taps(p, it, lds);
    __syncthreads();
    const int tidq = otid(), lane = tidq & 63, wid = tidq >> 6;
    float* scr = (float*)lds + wid * (64 * 33);
    constexpr int NA = 14720;
    const bool lightwg = blockIdx.x < 96 && gridDim.x > 96;
    const int nb2 = (gridDim.x > 96) ? (int)gridDim.x - 96 : (int)gridDim.x, bi2 = (gridDim.x > 96) ? (int)blockIdx.x - 96 : (int)blockIdx.x;
    for (int pass = 0; pass < 2; ++pass)
    for (int it = (pass == 0) ? (int)blockIdx.x * 8 + wid : NA + bi2 * 8 + wid; it < ((pass == 0) ? NA : NTR); it += ((pass == 0) ? (int)gridDim.x : nb2) * 8) {
        if (pass == 1 && lightwg) break;
        int r = it; const float* src; int N, k0, n0, dpitch, mode = 0; bf16_t* dst; bool f8 = false;
        if (r < I_WIN) { src = p.w_in; N = PROJW; k0 = (r / 72) * 64; n0 = (r % 72) * 32; dst = (bf16_t*)(p.ws + WS_WINT); dpitch = 1024; }
        else if ((r -= I_WIN) < I_WOUT) { src = p.w_out; N = 1024; k0 = (r / 32) * 64; n0 = (r % 32) * 32; dst = (bf16_t*)(p.ws + WS_WOUTT); dpitch = 1024; }
        else if ((r -= I_WOUT) < 2 * I_W1) { const int w3 = r >= I_W1; if (w3) r -= I_W1; const int e = r / 256, q = r % 256; src = (w3 ? p.exp_w3 : p.exp_w1) + (size_t)e * 1024 * 512; N = 512; k0 = (q / 16) * 64; n0 = (q % 16) * 32;
            dst = (bf16_t*)(p.ws + WS_EW13 + (size_t)e * 1024 * 1024); dpitch = 1024; mode = w3 ? 2 : 1; f8 = true; }
        else { r -= 2 * I_W1; const int e = r / 256, q = r % 256; src = p.exp_w2 + (size_t)e * 512 * 1024; N = 1024; k0 = (q / 32) * 64; n0 = (q % 32) * 32; dst = (bf16_t*)(p.ws + WS_EW2T + (size_t)e * 1024 * 512); dpitch = 512; f8 = true; }
        p0_transpose_w(src, N, k0, n0, dst, dpitch, mode, scr, lane, f8);
    }
}

__device__ __forceinline__ void norm_row(const Params& p, const float* xr, const float* md, bf16_t* orow, int lane) {
    f32x4 v[4]; float s = 0.f;
#pragma unroll
    for (int j = 0; j < 4; ++j) { v[j] = *(const f32x4*)(xr + 256 * j + lane * 4); s += v[j].x * v[j].x + v[j].y * v[j].y + v[j].z * v[j].z + v[j].w * v[j].w; }
    const float rstd = rsqrtf(wave_sum(s) * (1.f / 1024.f) + EPSN);
#pragma unroll
    for (int j = 0; j < 4; ++j) { const int k = 256 * j + lane * 4;
        const f32x4 nw = *(const f32x4*)(p.norm1_w + k), sh = *(const f32x4*)(md + k), sc = *(const f32x4*)(md + 1024 + k);
        const f32x4 y = (v[j] * rstd) * nw * (sc + 1.f) + sh;
        u32x2 o; o.x = pk2(y.x, y.y); o.y = pk2(y.z, y.w); *(u32x2*)(orow + k) = o; }
}
__device__ __forceinline__ void phase1(const Params& p, unsigned char* lds) {
    const int tidq = otid(), lane = tidq & 63, wid = tidq >> 6;
    const float* MOD = (const float*)(p.ws + WS_MOD);
    const int fr = lane & 15, fq = lane >> 4;
    for (int ct = blockIdx.x; ct < NCTX / 16; ct += gridDim.x) {
        bf16_t* As = (bf16_t*)lds;
        const bf16_t* WT = (const bf16_t*)(p.ws + WS_WINT); bf16_t* KVC = (bf16_t*)(p.ws + WS_KVC);
        __syncthreads();
        {   const float* md = MOD + (size_t)16 * 6144; f32x4 v[2][4]; float ss[2];
#pragma unroll
            for (int r = 0; r < 2; ++r)
#pragma unroll
                for (int j = 0; j < 4; ++j) v[r][j] = *(const f32x4*)(p.ctx + (size_t)(ct * 16 + 2 * wid + r) * 1024 + 256 * j + lane * 4);
#pragma unroll
            for (int r = 0; r < 2; ++r) { float q = 0.f;
#pragma unroll
                for (int j = 0; j < 4; ++j) q += v[r][j].x * v[r][j].x + v[r][j].y * v[r][j].y + v[r][j].z * v[r][j].z + v[r][j].w * v[r][j].w;
                ss[r] = wave_sum(q); }
#pragma unroll
            for (int j = 0; j < 4; ++j) { const int k = 256 * j + lane * 4;
                const f32x4 nw = *(const f32x4*)(p.norm1_w + k), sh = *(const f32x4*)(md + k), sc = *(const f32x4*)(md + 1024 + k); const f32x4 g = nw * (sc + 1.f);
#pragma unroll
                for (int r = 0; r < 2; ++r) { const float rstd = rsqrtf(ss[r] * (1.f / 1024.f) + EPSN); const f32x4 y = (v[r][j] * rstd) * g + sh;
                    u32x2 o; o.x = pk2(y.x, y.y); o.y = pk2(y.z, y.w); *(u32x2*)(As + (2 * wid + r) * 1032 + k) = o; } }
        }
        __syncthreads();
        f32x4 acc0 = (f32x4){0.f, 0.f, 0.f, 0.f}, acc1 = acc0;
        const bf16_t* b0 = WT + (size_t)(512 + 32 * wid + fr) * 1024 + 8 * fq; const bf16_t* b1 = b0 + 16 * 1024;
#pragma unroll 8
        for (int ks = 0; ks < 32; ++ks) {
            const bf16x8 af = *(const bf16x8*)(As + fr * 1032 + 32 * ks + 8 * fq);
            const bf16x8 bf0 = *(const bf16x8*)(b0 + 32 * ks), bf1 = *(const bf16x8*)(b1 + 32 * ks);
            acc0 = __builtin_amdgcn_mfma_f32_16x16x32_bf16(bf0, af, acc0, 0, 0, 0); acc1 = __builtin_amdgcn_mfma_f32_16x16x32_bf16(bf1, af, acc1, 0, 0, 0);
        }
        {   bf16_t* orow = KVC + (size_t)(ct * 16 + fr) * 256 + 32 * wid + 4 * fq;
            u32x2 o; o.x = pk2(acc0.x, acc0.y); o.y = pk2(acc0.z, acc0.w); *(u32x2*)(orow) = o;
            o.x = pk2(acc1.x, acc1.y); o.y = pk2(acc1.z, acc1.w); *(u32x2*)(orow + 16) = o; }
    }
    {
        const int nb = gridDim.x, bi = blockIdx.x;
        bf16_t* H = (bf16_t*)(p.ws + WS_H);
        for (int tq = bi * 8; tq < (NTOK / 256) * 8; tq += nb * 8) for (int row0 = (tq >> 3) * 256 + wid * 32 + (tq & 7) * 0; row0 < (tq >> 3) * 256 + wid * 32 + 32; row0 += 4) {
            f32x4 v[4][4]; float ss[4];
#pragma unroll
            for (int r = 0; r < 4; ++r)
#pragma unroll
                for (int j = 0; j < 4; ++j) v[r][j] = *(const f32x4*)(p.x + (size_t)(row0 + r) * 1024 + 256 * j + lane * 4);
#pragma unroll
            for (int r = 0; r < 4; ++r) { float s = 0.f;
#pragma unroll
                for (int j = 0; j < 4; ++j) s += v[r][j].x * v[r][j].x + v[r][j].y * v[r][j].y + v[r][j].z * v[r][j].z + v[r][j].w * v[r][j].w;
                ss[r] = s; }
#pragma unroll
            for (int r = 0; r < 4; ++r) ss[r] = wave_sum(ss[r]);
            const float* md = MOD + (size_t)(row0 >> 12) * 6144;
#pragma unroll
            for (int j = 0; j < 4; ++j) { const int k = 256 * j + lane * 4;
                const f32x4 nw = *(const f32x4*)(p.norm1_w + k), sh = *(const f32x4*)(md + k), sc = *(const f32x4*)(md + 1024 + k); const f32x4 g = nw * (sc + 1.f);
#pragma unroll
                for (int r = 0; r < 4; ++r) { const float rstd = rsqrtf(ss[r] * (1.f / 1024.f) + EPSN); const f32x4 y = (v[r][j] * rstd) * g + sh;
                    u32x2 o; o.x = pk2(y.x, y.y); o.y = pk2(y.z, y.w); *(u32x2*)(H + (size_t)(row0 + r) * 1024 + k) = o; } }
        }
    }
}

struct P2Sched { const char* H; const char* WT; int G, c;
    __device__ __forceinline__ bool next(int i, pg::UDesc& u) const { const int q = i * G + c; if (q >= 2304) return false;
        if (q < 768) { const int pm = q / 3, pn = q - 3 * pm; u.A = H + (size_t)pm * 256 * 2048; u.B0 = WT + (size_t)pn * 256 * 2048; u.i0 = 0; u.i1 = pm; u.i2 = pn; }
        else { const int v = q - 768, pn = v / 6, pm = v - 6 * pn; u.A = WT + (size_t)(768 + pm * 256) * 2048; u.B0 = H + (size_t)pn * 256 * 2048; u.i0 = 1; u.i1 = pm; u.i2 = pn; }
        u.B1 = u.B0 + 8 * 128; u.i3 = 0; return true; }
    __device__ __forceinline__ unsigned rowoff(const pg::UDesc&, int) const { return 0u; }
};
__device__ __forceinline__ void phase2(const Params& p, unsigned char* lds) {
    bf16_t* QKV = (bf16_t*)(p.ws + WS_QKV); _Float16* UT = (_Float16*)(p.ws + WS_UT);
    P2Sched S{(const char*)(p.ws + WS_H), (const char*)(p.ws + WS_WINT), (int)gridDim.x, vcu_of(blockIdx.x, gridDim.x)};
    auto E = [&](const f32x4 (&acc)[2][2][4][2], const pg::UDesc& u, int wr, int wc, int fr, int fq) {
        const int tok0 = u.i2 * 256, bb = tok0 >> 12, t0 = tok0 & 4095;
        unsigned short* base = u.i0 ? (unsigned short*)UT + ((size_t)(bb * 1536 + u.i1 * 256)) * 4096 + t0 : (unsigned short*)QKV + (size_t)(u.i1 * 256) * 768 + u.i2 * 256;
        const size_t pitch = u.i0 ? 4096 : 768; const bool f16o = u.i0 != 0;
        ACCP_FOREACH(acc, wr, wc, fr, fq, { u32x4 o;
            if (f16o) { o.x = pkh2(v0.x, v0.y); o.y = pkh2(v0.z, v0.w); o.z = pkh2(v1.x, v1.y); o.w = pkh2(v1.z, v1.w); }
            else { o.x = pk2(v0.x, v0.y); o.y = pk2(v0.z, v0.w); o.z = pk2(v1.x, v1.y); o.w = pk2(v1.z, v1.w); }
            *(u32x4*)(base + (size_t)rl * pitch + cl) = o; });
    };
    pg::gemm_stream<false, true, false>((LAS unsigned char*)lds, 2048, 2048, S, E);
}

__device__ __forceinline__ void phase3(const Params& p) {
    const int tidq = otid(), lane = tidq & 63, gw = blockIdx.x * 8 + (tidq >> 6), ngw = gridDim.x * 8;
    bf16_t* QKV = (bf16_t*)(p.ws + WS_QKV); bf16_t* KVC = (bf16_t*)(p.ws + WS_KVC);
    const float qw = p.q_norm_w[lane], kw = p.k_norm_w[lane];
    const int i16 = lane & 15; const float invf = exp2f(-(float)i16 * (13.287712379549449f / 16.f));
    float xn[10];
    if (gw < NTOK) {
#pragma unroll
        for (int hh = 0; hh < 10; ++hh) xn[hh] = bf2f(QKV[(size_t)gw * 768 + hh * 64 + lane]); }
    for (int row = gw; row < NTOK; row += ngw) {
        const int pos = row & 4095; const float ang = (float)((lane & 32) ? (pos & 63) : (pos >> 6)) * invf;
        const float cs = cos_rad(ang), sn = sin_rad(ang);
        bf16_t* rp = QKV + (size_t)row * 768;
        float xv[10], ss[10];
#pragma unroll
        for (int hh = 0; hh < 10; ++hh) { xv[hh] = xn[hh]; ss[hh] = xv[hh] * xv[hh]; }
        {   const int rn = (row + ngw < NTOK) ? row + ngw : row;
#pragma unroll
            for (int hh = 0; hh < 10; ++hh) xn[hh] = bf2f(QKV[(size_t)rn * 768 + hh * 64 + lane]); }
#pragma unroll
        for (int hh = 0; hh < 10; ++hh) ss[hh] = wave_sum(ss[hh]);
#pragma unroll
        for (int hh = 0; hh < 10; ++hh) {
            const float y = xv[hh] * rsqrtf(ss[hh] * (1.f / 64.f) + EPSN) * (hh < 8 ? qw : kw);
            const float pr = [&] { const unsigned uy = __builtin_bit_cast(unsigned, y); auto rr = __builtin_amdgcn_permlane16_swap(uy, uy, false, false); return (lane & 16) ? __builtin_bit_cast(float, (unsigned)rr[0]) : __builtin_bit_cast(float, (unsigned)rr[1]); }();
            const float o = (lane & 16) ? (y * cs + pr * sn) : (y * cs - pr * sn);
            rp[hh * 64 + lane] = (bf16_t)f2bf(hh < 8 ? o * (0.125f * 1.4426950408889634f) : o);
        }
    }
    for (int row = gw; row < NCTX; row += ngw) {
        bf16_t* rp = KVC + (size_t)row * 256;
        const float x0 = bf2f(rp[lane]), x1 = bf2f(rp[64 + lane]);
        const float r0 = rsqrtf(wave_sum(x0 * x0) * (1.f / 64.f) + EPSN), r1 = rsqrtf(wave_sum(x1 * x1) * (1.f / 64.f) + EPSN);
        rp[lane] = (bf16_t)f2bf(x0 * r0 * kw); rp[64 + lane] = (bf16_t)f2bf(x1 * r1 * kw);
    }
}

__device__ __forceinline__ void attn_unit(const Params& p, int u, unsigned char* lds) {
    const int tid = otid(), wid = tid >> 6, lane = tid & 63, fr = lane & 15, fq = lane >> 4;
    const int b = u >> 6, kvh = (u >> 5) & 1, qb = u & 31, q0 = qb * 128;
    const bf16_t* QKV = (const bf16_t*)(p.ws + WS_QKV); const bf16_t* KVC = (const bf16_t*)(p.ws + WS_KVC);
    bf16_t* ATT = (bf16_t*)(p.ws + WS_ATTHY);
    const int h = kvh * 4 + (wid >> 1), half = wid & 1, qrow0 = q0 + 64 * half;
    bf16x8 qf[4][2];
#pragma unroll
    for (int qt = 0; qt < 4; ++qt)
#pragma unroll
        for (int ks = 0; ks < 2; ++ks) qf[qt][ks] = *(const bf16x8*)(QKV + (size_t)(b * 4096 + qrow0 + 16 * qt + fr) * 768 + h * 64 + 32 * ks + 8 * fq);
    float mrow[4], lrow[4]; f32x4 ot[4][4];
    const float sink2 = p.attn_sink[h] * 1.4426950408889634f;
#pragma unroll
    for (int qt = 0; qt < 4; ++qt) { mrow[qt] = sink2; lrow[qt] = (fq == 0) ? 1.f : 0.f;
#pragma unroll
        for (int dt = 0; dt < 4; ++dt) ot[dt][qt] = (f32x4){0.f, 0.f, 0.f, 0.f}; }
    const int jlo = (qb == 0) ? 2 : 0, jhi = (qb == 31) ? 3 : 5, ntile = 4 + (jhi - jlo + 1);
    const int kr = tid >> 3, ch = tid & 7;
    auto krow_of = [&](int ti) -> const bf16_t* { return (ti < 4) ? KVC + (size_t)(b * 256 + ti * 64 + kr) * 256 + kvh * 64 + ch * 8 : QKV + (size_t)(b * 4096 + q0 - 128 + (ti - 4 + jlo) * 64 + kr) * 768 + KOFF + kvh * 64 + ch * 8; };
    u32x4 kreg = *(const u32x4*)krow_of(0), vreg = *(const u32x4*)(krow_of(0) + ((0 < 4) ? 128 : 128));
#pragma unroll 1
    for (int ti = 0; ti < ntile; ++ti) {
        const bool isctx = ti < 4; const int jb = ti - 4 + jlo;
        unsigned char* sK = lds + (ti & 1) * 18432;
        unsigned char* sV = sK + 64 * 144;
        {   *(u32x4*)(sK + kr * 144 + ch * 16) = kreg;
            bf16_t* sv = (bf16_t*)sV;
            sv[(ch * 8 + 0) * 72 + kr] = (bf16_t)(vreg.x & 0xffff); sv[(ch * 8 + 1) * 72 + kr] = (bf16_t)(vreg.x >> 16);
            sv[(ch * 8 + 2) * 72 + kr] = (bf16_t)(vreg.y & 0xffff); sv[(ch * 8 + 3) * 72 + kr] = (bf16_t)(vreg.y >> 16);
            sv[(ch * 8 + 4) * 72 + kr] = (bf16_t)(vreg.z & 0xffff); sv[(ch * 8 + 5) * 72 + kr] = (bf16_t)(vreg.z >> 16);
            sv[(ch * 8 + 6) * 72 + kr] = (bf16_t)(vreg.w & 0xffff); sv[(ch * 8 + 7) * 72 + kr] = (bf16_t)(vreg.w >> 16); }
        if (ti + 1 < ntile) { const bf16_t* kp = krow_of(ti + 1); kreg = *(const u32x4*)kp; vreg = *(const u32x4*)(kp + 128); }
        __syncthreads();
        const int rel = jb - 2 - half;
        const bool skip = !isctx && (rel < -2 || rel > 2), partial = !isctx && (rel == -2 || rel == 2);
        if (!skip) {
            f32x4 st[4][4];
#pragma unroll
            for (int kt = 0; kt < 4; ++kt) {
                const bf16x8 k0 = *(const bf16x8*)(sK + (16 * kt + fr) * 144 + fq * 16), k1 = *(const bf16x8*)(sK + (16 * kt + fr) * 144 + 64 + fq * 16);
#pragma unroll
                for (int qt = 0; qt < 4; ++qt) { f32x4 z = (f32x4){0.f, 0.f, 0.f, 0.f};
                    z = __builtin_amdgcn_mfma_f32_16x16x32_bf16(k0, qf[qt][0], z, 0, 0, 0); z = __builtin_amdgcn_mfma_f32_16x16x32_bf16(k1, qf[qt][1], z, 0, 0, 0); st[kt][qt] = z; }
            }
            if (partial) {
                const int kbase = q0 - 128 + 64 * jb;
#pragma unroll
                for (int qt = 0; qt < 4; ++qt) { const int qpos = qrow0 + 16 * qt + fr;
#pragma unroll
                    for (int kt = 0; kt < 4; ++kt)
#pragma unroll
                        for (int r = 0; r < 4; ++r) { const int dd = kbase + 16 * kt + 4 * fq + r - qpos; if (dd > 128 || dd < -128) st[kt][qt][r] = -1e30f; } }
            }
            float alpha[4]; bool grew = false;
#pragma unroll
            for (int qt = 0; qt < 4; ++qt) {
                float t0 = fmaxf(fmaxf(st[0][qt][0], st[0][qt][1]), fmaxf(st[0][qt][2], st[0][qt][3]));
#pragma unroll
                for (int kt = 1; kt < 4; ++kt) t0 = fmaxf(t0, fmaxf(fmaxf(st[kt][qt][0], st[kt][qt][1]), fmaxf(st[kt][qt][2], st[kt][qt][3])));
                t0 = max_fq(t0);
                const float mnew = fmaxf(mrow[qt], t0); alpha[qt] = exp2_raw(mrow[qt] - mnew); grew = grew || (mnew > mrow[qt]); mrow[qt] = mnew;
                float ls = 0.f;
#pragma unroll
                for (int kt = 0; kt < 4; ++kt)
#pragma unroll
                    for (int r = 0; r < 4; ++r) { const float pv = exp2_raw(st[kt][qt][r] - mnew); st[kt][qt][r] = pv; ls += pv; }
                lrow[qt] = lrow[qt] * alpha[qt] + ls;
            }
            if (__any(grew)) {
#pragma unroll
                for (int qt = 0; qt < 4; ++qt)
#pragma unroll
                    for (int dt = 0; dt < 4; ++dt) ot[dt][qt] = ot[dt][qt] * alpha[qt];
            }
#pragma unroll
            for (int ks = 0; ks < 2; ++ks) {
                bf16x8 pf[4];
#pragma unroll
                for (int qt = 0; qt < 4; ++qt) { const f32x4 a = st[2 * ks][qt], c = st[2 * ks + 1][qt];
                    u32x4 w; w.x = pk2(a.x, a.y); w.y = pk2(a.z, a.w); w.z = pk2(c.x, c.y); w.w = pk2(c.z, c.w); pf[qt] = __builtin_bit_cast(bf16x8, w); }
#pragma unroll
                for (int dt = 0; dt < 4; ++dt) {
                    const u32x2 v0 = *(const u32x2*)(sV + (16 * dt + fr) * 144 + (32 * ks + 4 * fq) * 2), v1 = *(const u32x2*)(sV + (16 * dt + fr) * 144 + (32 * ks + 16 + 4 * fq) * 2);
                    u32x4 w; w.x = v0.x; w.y = v0.y; w.z = v1.x; w.w = v1.y; const bf16x8 vf = __builtin_bit_cast(bf16x8, w);
#pragma unroll
                    for (int qt = 0; qt < 4; ++qt) ot[dt][qt] = __builtin_amdgcn_mfma_f32_16x16x32_bf16(vf, pf[qt], ot[dt][qt], 0, 0, 0);
                }
            }
        }
    }
#pragma unroll
    for (int qt = 0; qt < 4; ++qt) {
        float l = lrow[qt]; l += __shfl_xor(l, 16); l += __shfl_xor(l, 32);
        const float inv = 1.f / l;
        bf16_t* orow = ATT + (size_t)(b * 4096 + qrow0 + 16 * qt + fr) * 1024 + h * 64;
#pragma unroll
        for (int dt = 0; dt < 4; ++dt) { const f32x4 o = ot[dt][qt] * inv; u32x2 w; w.x = pk2(o.x, o.y); w.y = pk2(o.z, o.w); *(u32x2*)(orow + 16 * dt + 4 * fq) = w; }
    }
    __syncthreads();
}

__device__ __forceinline__ void khat_items(const Params& p, unsigned char* lds) {
    const int tid = otid(), wid = tid >> 6, lane = tid & 63, fr = lane & 15, fq = lane >> 4;
    _Float16* TT = (_Float16*)lds;
    _Float16* FKL = (_Float16*)(lds + 34816);
    const _Float16* FK = (const _Float16*)(p.ws + WS_FKTAB);
    __syncthreads();
    for (int i = tid; i < 128 * 136 / 2; i += NTHR) ((unsigned*)lds)[i] = 0u;
    for (int i = tid; i < 128 * 16; i += NTHR) { const int r = i >> 4, c8 = i & 15; *(u32x4*)(FKL + r * 136 + c8 * 8) = *(const u32x4*)(FK + r * 128 + c8 * 8); }
    int it = blockIdx.x;
    f32x4 tv[4];
    if (it < 1024) {
#pragma unroll
        for (int q = 0; q < 4; ++q) tv[q] = *(const f32x4*)((const float*)(p.ws + WS_TAPS) + (size_t)it * 8192 + tid * 16 + q * 4); }
    __syncthreads();
    for (; it < 1024; it += gridDim.x) {
#pragma unroll
        for (int q = 0; q < 4; ++q) { const int i0 = tid * 16 + q * 4;
#pragma unroll
            for (int e = 0; e < 4; ++e) { const int i = i0 + e, i1 = i >> 6, i2 = i & 63; const _Float16 h = (_Float16)tv[q][e];
                if (i1 >= 1) TT[(i2 + 63) * 136 + i1] = h;
                if (i2 >= 1 && i1 + 1 < 128) TT[(i2 - 1) * 136 + i1 + 1] = h; } }
        {   const int itn = (it + (int)gridDim.x < 1024) ? it + (int)gridDim.x : it;
#pragma unroll
            for (int q = 0; q < 4; ++q) tv[q] = *(const f32x4*)((const float*)(p.ws + WS_TAPS) + (size_t)itn * 8192 + tid * 16 + q * 4); }
        __syncthreads();
        f16x8 af[4];
#pragma unroll
        for (int ks = 0; ks < 4; ++ks) af[ks] = *(const f16x8*)(TT + (16 * wid + fr) * 136 + 32 * ks + 8 * fq);
        _Float16* KH = (_Float16*)(p.ws + WS_KH) + (size_t)it * (64 * 2 * 128);
#pragma unroll
        for (int nt = 0; nt < 8; ++nt) {
            f32x4 acc = (f32x4){0.f, 0.f, 0.f, 0.f};
#pragma unroll
            for (int ks = 0; ks < 4; ++ks) { const f16x8 bfv = *(const f16x8*)(FKL + (16 * nt + fr) * 136 + 32 * ks + 8 * fq); acc = __builtin_amdgcn_mfma_f32_16x16x32_f16(af[ks], bfv, acc, 0, 0, 0); }
            const int rho = 16 * nt + fr; u32x2 o; o.x = pkh2(acc[3], acc[2]); o.y = pkh2(acc[1], acc[0]);
            *(u32x2*)(KH + (size_t)rho * 128 + (124 - 16 * wid - 4 * fq)) = o;
        }
        __syncthreads();
    }
}

constexpr int HY_ZB = 0, HY_ZH = 73728, HY_ZHF = 1160  , HY_OH = HY_ZH + 8 * HY_ZHF * 2, HY_GT = HY_OH + 8 * 65 * 40  , HY_KC = HY_GT + 8 * 4608, HY_LDS_END = HY_KC + 8 * 576;
struct __attribute__((aligned(4))) hq4 { unsigned a, b, c, d; };
__device__ __forceinline__ f16x8 neg8(f16x8 v) { u32x4 w = __builtin_bit_cast(u32x4, v); w.x ^= 0x80008000u; w.y ^= 0x80008000u; w.z ^= 0x80008000u; w.w ^= 0x80008000u; return __builtin_bit_cast(f16x8, w); }
__device__ __forceinline__ void hy_stage_row(const _Float16* ur, const float w0, const float w1, const float w2, const float bb, _Float16* XG, const int lane) {
    f16x8 raw[8]; _Float16 hl[8], hh[8];
#pragma unroll
    for (int i8 = 0; i8 < 8; ++i8) { const int t0 = 8 * (lane + 64 * i8);
        raw[i8] = *(const f16x8*)(ur + t0); hl[i8] = ur[t0 > 0 ? t0 - 1 : 0]; hh[i8] = ur[t0 + 8 < 4096 ? t0 + 8 : 4095]; }
#pragma unroll
    for (int i8 = 0; i8 < 8; ++i8) { const int t0 = 8 * (lane + 64 * i8); float uv[10];
        uv[0] = (t0 > 0) ? (float)hl[i8] : 0.f; uv[9] = (t0 + 8 < 4096) ? (float)hh[i8] : 0.f;
#pragma unroll
        for (int i = 0; i < 8; ++i) uv[1 + i] = (float)raw[i8][i];
        float y[8];
#pragma unroll
        for (int i = 0; i < 8; ++i) y[i] = bb + uv[i] * w0 + uv[i + 1] * w1 + uv[i + 2] * w2;
        u32x4 w; w.x = pkh2(y[0], y[1]); w.y = pkh2(y[2], y[3]); w.z = pkh2(y[4], y[5]); w.w = pkh2(y[6], y[7]);
        *(u32x4*)(XG + (t0 >> 6) * 72 + (t0 & 63)) = w; }
}
__device__ __forceinline__ void hyena_item(const Params& p, int it, unsigned char* lds) {
    const int tid = otid(), wid = tid >> 6, lane = tid & 63, fr = lane & 15, fq = lane >> 4;
    const int c = it >> 1, b = (it & 1) * 8 + wid;
    _Float16* XG = (_Float16*)(lds + HY_ZB) + wid * (64 * 72);
    _Float16* ZH = (_Float16*)(lds + HY_ZH);
    _Float16* OH = (_Float16*)(lds + HY_OH);
    _Float16* GTW = (_Float16*)(lds + HY_GT) + wid * 2304;
    _Float16* KC = (_Float16*)(lds + HY_KC) + wid * 288;
    const _Float16* UT = (const _Float16*)(p.ws + WS_UT); const _Float16* FT = (const _Float16*)(p.ws + WS_FTAB); const _Float16* GT = (const _Float16*)(p.ws + WS_GTAB);
    bf16_t* HYT = (bf16_t*)(p.ws + WS_HYT);
    __syncthreads();
    if (lane < 32) KC[(lane >> 4) * 144 + 128 + (lane & 15)] = (_Float16)0.f;
    f16x4 id16;
#pragma unroll
    for (int i = 0; i < 4; ++i) id16[i] = (4 * fq + i == fr) ? (_Float16)1.f : (_Float16)0.f;
    u32x4 zf[4][2];
    hy_stage_row(UT + ((size_t)(b * 1536 + c)) * 4096, p.hy_conv_w[c], p.hy_conv_w[1536 + c], p.hy_conv_w[3072 + c], p.hy_conv_b[c], XG, lane);
#pragma unroll
    for (int mt = 0; mt < 4; ++mt)
#pragma unroll
        for (int nt = 0; nt < 4; ++nt) { const u32x2 v = *(const u32x2*)(XG + (16 * nt + fr) * 72 + 16 * mt + 4 * fq);
            const f32x4 cT = __builtin_amdgcn_mfma_f32_16x16x16f16(__builtin_bit_cast(f16x4, v), id16, (f32x4){0.f, 0.f, 0.f, 0.f}, 0, 0, 0);
            if (nt & 1) { zf[mt][nt >> 1].z = pkh2(cT[0], cT[1]); zf[mt][nt >> 1].w = pkh2(cT[2], cT[3]); } else { zf[mt][nt >> 1].x = pkh2(cT[0], cT[1]); zf[mt][nt >> 1].y = pkh2(cT[2], cT[3]); }
        }
#pragma unroll 1
    for (int o = 0; o < 2; ++o) {
        {   const int chs = (o + 1) * 512 + c;
            hy_stage_row(UT + ((size_t)(b * 1536 + chs)) * 4096, p.hy_conv_w[chs], p.hy_conv_w[1536 + chs], p.hy_conv_w[3072 + chs], p.hy_conv_b[chs], XG, lane); }
        f32x4 accI[4][4];
#pragma unroll
        for (int mt = 0; mt < 4; ++mt)
#pragma unroll
            for (int nt = 0; nt < 4; ++nt) accI[mt][nt] = (f32x4){0.f, 0.f, 0.f, 0.f};
        const _Float16* KHo = (const _Float16*)(p.ws + WS_KH) + (size_t)(o * 512 + c) * (64 * 2 * 128);
        u32x4 kcn = (u32x4){0u, 0u, 0u, 0u}; f16x8 ffn[2];
        if (lane < 32) kcn = *(const u32x4*)(KHo + (size_t)wid * 256 + lane * 8);
#pragma unroll
        for (int ks = 0; ks < 2; ++ks) { const f16x4 lo = *(const f16x4*)(FT + fr * 64 + 32 * ks + 4 * fq), hi = *(const f16x4*)(FT + fr * 64 + 32 * ks + 16 + 4 * fq); ffn[ks] = __builtin_shufflevector(lo, hi, 0, 1, 2, 3, 4, 5, 6, 7); }
#pragma unroll 1
        for (int j = 0; j < 8; ++j) {
            const int f = 8 * j + wid;
            const u32x4 kcc = kcn; f16x8 ff[2]; f16x4 gf[4];
#pragma unroll
            for (int ks = 0; ks < 2; ++ks) ff[ks] = ffn[ks];
#pragma unroll
            for (int nt = 0; nt < 4; ++nt) gf[nt] = *(const f16x4*)(GT + (16 * nt + fr) * 128 + 16 * j + 4 * fq);
            if (j < 7) {
                if (lane < 32) kcn = *(const u32x4*)(KHo + (size_t)(f + 8) * 256 + lane * 8);
#pragma unroll
                for (int ks = 0; ks < 2; ++ks) { const f16x4 lo = *(const f16x4*)(FT + (16 * (j + 1) + fr) * 64 + 32 * ks + 4 * fq), hi = *(const f16x4*)(FT + (16 * (j + 1) + fr) * 64 + 32 * ks + 16 + 4 * fq); ffn[ks] = __builtin_shufflevector(lo, hi, 0, 1, 2, 3, 4, 5, 6, 7); }
            }
            if (lane < 32) *(u32x4*)(KC + (lane >> 4) * 144 + (lane & 15) * 8) = kcc;
            {   const int x = lane >> 5, q = (lane >> 1) & 15, sh = lane & 1;
                const u32x2* src = (const u32x2*)(KC + x * 144 + 8 * q + 4 * sh);
                const u32x2 r0 = src[0], r1 = src[1], r2 = src[2];
                const unsigned d0 = r0.x, d1 = r0.y, d2 = r1.x, d3 = r1.y, d4 = r2.x, d5 = r2.y;
                const unsigned a0 = __builtin_amdgcn_alignbit(d1, d0, 16), a1 = __builtin_amdgcn_alignbit(d2, d1, 16), a2 = __builtin_amdgcn_alignbit(d3, d2, 16), a3 = __builtin_amdgcn_alignbit(d4, d3, 16), a4 = __builtin_amdgcn_alignbit(d5, d4, 16);
                _Float16* dst = GTW + ((x * 8 + 4 * sh) * 18 + q) * 8;
                *(u32x4*)(dst) = (u32x4){a0, a1, a2, a3}; *(u32x4*)(dst + 144) = (u32x4){d1, d2, d3, d4};
                *(u32x4*)(dst + 288) = (u32x4){a1, a2, a3, a4}; *(u32x4*)(dst + 432) = (u32x4){d2, d3, d4, d5}; }
            {
#pragma unroll
                for (int mt = 0; mt < 4; ++mt) { f32x4 a = (f32x4){0.f, 0.f, 0.f, 0.f};
                    a = __builtin_amdgcn_mfma_f32_16x16x32_f16(__builtin_bit_cast(f16x8, zf[mt][0]), ff[0], a, 0, 0, 0); a = __builtin_amdgcn_mfma_f32_16x16x32_f16(__builtin_bit_cast(f16x8, zf[mt][1]), ff[1], a, 0, 0, 0);
                    u32x2 w; w.x = pkh2(a[0], a[1]); w.y = pkh2(a[2], a[3]);
                    *(u32x2*)(ZH + (fr >> 1) * HY_ZHF + (wid * 2 + (fr & 1)) * 72 + 16 * mt + 4 * fq) = w; }
            }
            __syncthreads();
            {   const int bb = fr >> 1, part = fr & 1;
                f16x8 a1[2], a2[2];
#pragma unroll
                for (int ks = 0; ks < 2; ++ks) {
                    const f16x8 s1v = *(const f16x8*)(ZH + wid * HY_ZHF + (bb * 2 + part) * 72 + 32 * ks + 8 * fq);
                    const f16x8 s2v = *(const f16x8*)(ZH + wid * HY_ZHF + (bb * 2 + (1 - part)) * 72 + 32 * ks + 8 * fq);
                    const f16x8 zero = (f16x8){0, 0, 0, 0, 0, 0, 0, 0};
                    if (f == 0) { a1[ks] = part ? zero : s1v; a2[ks] = part ? s1v : zero; }
                    else { a1[ks] = s1v; a2[ks] = part ? s2v : neg8(s2v); }
                }
                const int sg = 7 - (fr & 7), qb = 7 - (fr >> 3) + fq;
                f32x4 am[4];
#pragma unroll
                for (int nt = 0; nt < 4; ++nt) am[nt] = (f32x4){0.f, 0.f, 0.f, 0.f};
#pragma unroll
                for (int wi = 0; wi < 6; ++wi) { const int w = 2 * wi - 6;
                    const f16x8 b1 = *(const f16x8*)(GTW + ((0 * 8 + sg) * 18 + qb + w) * 8);
                    const f16x8 b2 = *(const f16x8*)(GTW + ((1 * 8 + sg) * 18 + qb + w) * 8);
#pragma unroll
                    for (int ks = 0; ks < 2; ++ks) { const int nt = (4 * ks - w) / 2;
                        if (nt >= 0 && nt < 4) { am[nt] = __builtin_amdgcn_mfma_f32_16x16x32_f16(a1[ks], b1, am[nt], 0, 0, 0); am[nt] = __builtin_amdgcn_mfma_f32_16x16x32_f16(a2[ks], b2, am[nt], 0, 0, 0); } } }
#pragma unroll
                for (int nt = 0; nt < 4; ++nt) { const int t2 = 16 * nt + fr;
                    *(unsigned*)(OH + ((2 * fq) * 65 + t2) * 20 + 2 * wid) = pkh2(am[nt][0], am[nt][1]);
                    *(unsigned*)(OH + ((2 * fq + 1) * 65 + t2) * 20 + 2 * wid) = pkh2(am[nt][2], am[nt][3]); }
            }
            __syncthreads();
            {
#pragma unroll
                for (int mt = 0; mt < 4; ++mt) { const f16x4 av = *(const f16x4*)(OH + (wid * 65 + 16 * mt + fr) * 20 + 4 * fq);
#pragma unroll
                    for (int nt = 0; nt < 4; ++nt) accI[mt][nt] = __builtin_amdgcn_mfma_f32_16x16x16f16(av, gf[nt], accI[mt][nt], 0, 0, 0); }
            }
        }
        {   const float sk = p.hy_skip[o * 512 + c];
#pragma unroll
            for (int mt = 0; mt < 4; ++mt)
#pragma unroll
                for (int nt = 0; nt < 4; ++nt) {
                    _Float16* xp = XG + (16 * nt + fr) * 72 + 16 * mt + 4 * fq;
                    const u32x2 xr = *(const u32x2*)xp;
                    u32x2 zw; if (nt & 1) { zw.x = zf[mt][nt >> 1].z; zw.y = zf[mt][nt >> 1].w; } else { zw.x = zf[mt][nt >> 1].x; zw.y = zf[mt][nt >> 1].y; }
                    const f32x4 zo = __builtin_amdgcn_mfma_f32_16x16x16f16(__builtin_bit_cast(f16x4, zw), id16, (f32x4){0.f, 0.f, 0.f, 0.f}, 0, 0, 0);
                    float zn[4];
                    zn[0] = hlo(xr.x) * (accI[mt][nt][0] + sk * zo[0]); zn[1] = hhi(xr.x) * (accI[mt][nt][1] + sk * zo[1]);
                    zn[2] = hlo(xr.y) * (accI[mt][nt][2] + sk * zo[2]); zn[3] = hhi(xr.y) * (accI[mt][nt][3] + sk * zo[3]);
                    if (o == 0) {
                        u32x2 v; v.x = pkh2(zn[0], zn[1]); v.y = pkh2(zn[2], zn[3]);
                        const f32x4 cT = __builtin_amdgcn_mfma_f32_16x16x16f16(__builtin_bit_cast(f16x4, v), id16, (f32x4){0.f, 0.f, 0.f, 0.f}, 0, 0, 0);
                        if (nt & 1) { zf[mt][nt >> 1].z = pkh2(cT[0], cT[1]); zf[mt][nt >> 1].w = pkh2(cT[2], cT[3]); } else { zf[mt][nt >> 1].x = pkh2(cT[0], cT[1]); zf[mt][nt >> 1].y = pkh2(cT[2], cT[3]); }
                    } else { u32x2 w; w.x = pk2(zn[0], zn[1]); w.y = pk2(zn[2], zn[3]); *(u32x2*)xp = w; }
                }
            if (o == 1) {
                bf16_t* orow = HYT + ((size_t)(b * 512 + c)) * 4096;
#pragma unroll
                for (int i8 = 0; i8 < 8; ++i8) { const int t0 = 8 * (lane + 64 * i8); *(u32x4*)(orow + t0) = *(const u32x4*)(XG + (t0 >> 6) * 72 + (t0 & 63)); }
            }
        }
    }
}

__device__ __forceinline__ void phase5_item(const Params& p, int it, unsigned char* lds, u32x4 (&hv)[8], const int itn) {
    const int tid = otid(), b = it >> 6, t0 = (it & 63) * 64;
    bf16_t* TL = (bf16_t*)lds;
    float* RS = (float*)(lds + 512 * 66 * 2);
    float* RS2 = RS + 512;
    const bf16_t* HYT = (const bf16_t*)(p.ws + WS_HYT); bf16_t* AH = (bf16_t*)(p.ws + WS_ATTHY);
    __syncthreads();
    {
#pragma unroll
        for (int i = 0; i < 8; ++i) { const u32x4 v = hv[i]; unsigned* d = (unsigned*)(TL + tid * 66 + i * 8); d[0] = v.x; d[1] = v.y; d[2] = v.z; d[3] = v.w; }
        const bf16_t* srcn = HYT + ((size_t)((itn >> 6) * 512 + tid)) * 4096 + (itn & 63) * 64;
#pragma unroll
        for (int i = 0; i < 8; ++i) hv[i] = *(const u32x4*)(srcn + i * 8); }
    __syncthreads();
    {   const int tt = tid & 63, cg8 = tid >> 6; float s = 0.f;
#pragma unroll 16
        for (int cc = 0; cc < 64; ++cc) { const float v = bf2f(TL[(cg8 * 64 + cc) * 66 + tt]); s += v * v; }
        RS[cg8 * 64 + tt] = s; }
    __syncthreads();
    if (tid < 64) { float s = 0.f;
#pragma unroll
        for (int q = 0; q < 8; ++q) s += RS[q * 64 + tid];
        RS2[tid] = rsqrtf(s * (1.f / 512.f) + EPSN); }
    __syncthreads();
    {   const int tt = tid >> 3, ch = tid & 7; const float rstd = RS2[tt];
        bf16_t* orow = AH + (size_t)(b * 4096 + t0 + tt) * 1024;
        u32x4 av[8]; float s = 0.f;
#pragma unroll
        for (int g = 0; g < 8; ++g) av[g] = *(const u32x4*)(orow + g * 64 + ch * 8);
#pragma unroll
        for (int g = 0; g < 8; ++g) { const int c0 = g * 64 + ch * 8; float y[8]; const f32x4 gw0 = *(const f32x4*)(p.group_norm_w + 512 + c0), gw1 = *(const f32x4*)(p.group_norm_w + 512 + c0 + 4);
#pragma unroll
            for (int i = 0; i < 8; ++i) y[i] = bf2f(TL[(c0 + i) * 66 + tt]) * rstd * (i < 4 ? gw0[i] : gw1[i - 4]);
            u32x4 w; w.x = pk2(y[0], y[1]); w.y = pk2(y[2], y[3]); w.z = pk2(y[4], y[5]); w.w = pk2(y[6], y[7]); *(u32x4*)(orow + 512 + c0) = w; }
#pragma unroll
        for (int g = 0; g < 8; ++g) {
            const float a0 = bflo(av[g].x), a1 = bfhi(av[g].x), a2 = bflo(av[g].y), a3 = bfhi(av[g].y), a4 = bflo(av[g].z), a5 = bfhi(av[g].z), a6 = bflo(av[g].w), a7 = bfhi(av[g].w);
            s += a0 * a0 + a1 * a1 + a2 * a2 + a3 * a3 + a4 * a4 + a5 * a5 + a6 * a6 + a7 * a7; }
        s += dpp_f(s, DPP_XOR1); s += dpp_f(s, DPP_XOR2); s += dpp_f(s, DPP_HMIRROR);
        const float ra = rsqrtf(s * (1.f / 512.f) + EPSN);
#pragma unroll
        for (int g = 0; g < 8; ++g) { const int c0 = g * 64 + ch * 8; const f32x4 gw0 = *(const f32x4*)(p.group_norm_w + c0), gw1 = *(const f32x4*)(p.group_norm_w + c0 + 4);
            u32x4 w; w.x = pk2(bflo(av[g].x) * ra * gw0[0], bfhi(av[g].x) * ra * gw0[1]); w.y = pk2(bflo(av[g].y) * ra * gw0[2], bfhi(av[g].y) * ra * gw0[3]);
            w.z = pk2(bflo(av[g].z) * ra * gw1[0], bfhi(av[g].z) * ra * gw1[1]); w.w = pk2(bflo(av[g].w) * ra * gw1[2], bfhi(av[g].w) * ra * gw1[3]);
            *(u32x4*)(orow + c0) = w; }
    }
}

struct P6Sched { const char* AH; const char* WT; int G, c;
    __device__ __forceinline__ bool next(int i, pg::UDesc& u) const { const int q = i * G + c; if (q >= 1024) return false; const int pm = q >> 2, pn = q & 3;
        u.A = AH + (size_t)pm * 256 * 2048; u.B0 = WT + (size_t)pn * 256 * 2048; u.B1 = u.B0 + 8 * 128; u.i0 = 0; u.i1 = pm; u.i2 = pn; u.i3 = 0; return true; }
    __device__ __forceinline__ unsigned rowoff(const pg::UDesc&, int) const { return 0u; }
};
__device__ __forceinline__ void phase6(const Params& p, unsigned char* lds) {
    const float* MOD = (const float*)(p.ws + WS_MOD);
    P6Sched S{(const char*)(p.ws + WS_ATTHY), (const char*)(p.ws + WS_WOUTT), (int)gridDim.x, vcu_of(blockIdx.x, gridDim.x)};
    auto E = [&](const f32x4 (&acc)[2][2][4][2], const pg::UDesc& u, int wr, int wc, int fr, int fq) {
        const float* g1 = MOD + (size_t)((u.i1 * 256) >> 12) * 6144 + 2048 + u.i2 * 256 + 32 * wc + 8 * fq;
        f32x4 gv[2][2];
#pragma unroll
        for (int b = 0; b < 2; ++b)
#pragma unroll
            for (int n = 0; n < 2; ++n) gv[b][n] = *(const f32x4*)(g1 + 128 * b + 4 * n);
        bf16_t* D1 = (bf16_t*)(p.ws + WS_D1);
#pragma unroll
        for (int a = 0; a < 2; ++a)
#pragma unroll
            for (int m = 0; m < 4; ++m)
#pragma unroll
                for (int b = 0; b < 2; ++b) { const f32x4 v0 = acc[a][b][m][0] * gv[b][0], v1 = acc[a][b][m][1] * gv[b][1];
                    u32x4 o; o.x = pk2(v0.x, v0.y); o.y = pk2(v0.z, v0.w); o.z = pk2(v1.x, v1.y); o.w = pk2(v1.z, v1.w);
                    *(u32x4*)(D1 + (size_t)(u.i1 * 256 + 128 * a + 64 * wr + 16 * m + fr) * 1024 + u.i2 * 256 + 128 * b + 32 * wc + 8 * fq) = o; }
    };
    pg::gemm_stream<false, true, false>((LAS unsigned char*)lds, 2048, 2048, S, E);
}

__device__ __forceinline__ int pair_index(int lo, int hi) { return lo * 8 - (lo * (lo + 1)) / 2 + (hi - lo - 1); }
constexpr int P7_RW = 0, P7_HIST = 147456, P7_BASE = 147456 + 512, P7_TCLS = 147456 + 1024, P7_TRNK = 147456 + 2048, P7_TG = 147456 + 3072;
__device__ __forceinline__ void phase7(const Params& p, unsigned char* lds) {
    const int tid = otid(), lane = tid & 63, wid = tid >> 6;
    const float* MOD = (const float*)(p.ws + WS_MOD); bf16_t* H2 = (bf16_t*)(p.ws + WS_H);
    int* CNT = (int*)(p.ws + WS_CTL); int* LIST = (int*)(p.ws + WS_LIST); float* GATE = (float*)(p.ws + WS_GATE);
    float* RW = (float*)(lds + P7_RW); int* HIST = (int*)(lds + P7_HIST); int* BASE = (int*)(lds + P7_BASE); int* TCLS = (int*)(lds + P7_TCLS); int* TRNK = (int*)(lds + P7_TRNK);
    __syncthreads();
    {   float t[8];
#pragma unroll
        for (int q = 0; q < 8; ++q) t[q] = p.router_g_w[tid + NTHR * q];
#pragma unroll
        for (int q = 0; q < 8; ++q) { const int i = tid + NTHR * q, k = i >> 2, j = i & 3; RW[((k & 3) * 256 + (k >> 2)) * 36 + j] = t[q]; }
#pragma unroll 1
        for (int i0 = 0; i0 < 1024 * 32; i0 += NTHR * 16) { float u[16];
#pragma unroll
            for (int q = 0; q < 16; ++q) u[q] = p.router_e_w[i0 + tid + NTHR * q];
#pragma unroll
            for (int q = 0; q < 16; ++q) { const int i = i0 + tid + NTHR * q, k = i >> 5, j = i & 31; RW[((k & 3) * 256 + (k >> 2)) * 36 + 4 + j] = u[q]; } }
    }
    for (int tile = blockIdx.x; tile < NTOK / 256; tile += gridDim.x) {
        __syncthreads();
        if (tid < 128) HIST[tid] = 0;
        __syncthreads();
        f32x4 gk[4], shk[4];
#pragma unroll
        for (int j = 0; j < 4; ++j) { const int k = 256 * j + lane * 4; const float* md = MOD + (size_t)((tile * 256) >> 12) * 6144;
            gk[j] = *(const f32x4*)(p.norm2_w + k) * (*(const f32x4*)(md + 4096 + k) + 1.f); shk[j] = *(const f32x4*)(md + 3072 + k); }
        constexpr int RB = 2;
        const bf16_t* D1 = (const bf16_t*)(p.ws + WS_D1);
        f32x4 vn[RB][4]; u32x2 dn[RB][4];
#pragma unroll
        for (int q = 0; q < RB; ++q)
#pragma unroll
            for (int j = 0; j < 4; ++j) { const size_t o = (size_t)(tile * 256 + wid * 32 + q) * 1024 + 256 * j + lane * 4; vn[q][j] = *(const f32x4*)(p.x + o); dn[q][j] = *(const u32x2*)(D1 + o); }
#pragma unroll 1
        for (int rr = 0; rr < 32; rr += RB) {
            const int rl0 = wid * 32 + rr, row0 = tile * 256 + rl0;
            f32x4 v[RB][4]; float ss[RB];
#pragma unroll
            for (int q = 0; q < RB; ++q) { float s = 0.f;
#pragma unroll
                for (int j = 0; j < 4; ++j) { const f32x4 dl = (f32x4){bflo(dn[q][j].x), bfhi(dn[q][j].x), bflo(dn[q][j].y), bfhi(dn[q][j].y)}; v[q][j] = vn[q][j] + dl;
                    { u32x2 xb; xb.x = pk2(v[q][j].x, v[q][j].y); xb.y = pk2(v[q][j].z, v[q][j].w); *(u32x2*)((bf16_t*)(p.ws + WS_D1) + (size_t)(row0 + q) * 1024 + 256 * j + lane * 4) = xb; }
                    s += v[q][j].x * v[q][j].x + v[q][j].y * v[q][j].y + v[q][j].z * v[q][j].z + v[q][j].w * v[q][j].w; }
                ss[q] = s; }
            {   const int rp = (rr + RB < 32) ? row0 + RB : row0;
#pragma unroll
                for (int q = 0; q < RB; ++q)
#pragma unroll
                    for (int j = 0; j < 4; ++j) { const size_t o = (size_t)(rp + q) * 1024 + 256 * j + lane * 4; vn[q][j] = *(const f32x4*)(p.x + o); dn[q][j] = *(const u32x2*)(D1 + o); } }
#pragma unroll
            for (int q = 0; q < RB; ++q) ss[q] = wave_sum(ss[q]);
            float gl[RB][4];
#pragma unroll
            for (int q = 0; q < RB; ++q) { const float rstd = rsqrtf(ss[q] * (1.f / 1024.f) + EPSN);
#pragma unroll
                for (int e = 0; e < 4; ++e) gl[q][e] = 0.f;
#pragma unroll
                for (int j = 0; j < 4; ++j) { const int k = 256 * j + lane * 4;
                    const f32x4 y = (v[q][j] * rstd) * gk[j] + shk[j]; v[q][j] = y;
                    *(unsigned*)((unsigned char*)H2 + (size_t)(row0 + q) * 1024 + k) = pk4_fp8(fminf(fmaxf(y.x * FP8_XSCALE, -440.f), 440.f), fminf(fmaxf(y.y * FP8_XSCALE, -440.f), 440.f), fminf(fmaxf(y.z * FP8_XSCALE, -440.f), 440.f), fminf(fmaxf(y.w * FP8_XSCALE, -440.f), 440.f)); } }
#pragma unroll
            for (int j = 0; j < 4; ++j)
#pragma unroll
                for (int e = 0; e < 4; ++e) { const f32x4 w = *(const f32x4*)(RW + (e * 256 + 64 * j + lane) * 36);
#pragma unroll
                    for (int q = 0; q < RB; ++q) { const float ye = v[q][j][e]; gl[q][0] += ye * w.x; gl[q][1] += ye * w.y; gl[q][2] += ye * w.z; gl[q][3] += ye * w.w; } }
#pragma unroll
            for (int q = 0; q < RB; ++q)
#pragma unroll
                for (int e = 0; e < 4; ++e) gl[q][e] = wave_sum(gl[q][e]);
            int gsel[RB]; float gval[RB];
#pragma unroll
            for (int q = 0; q < RB; ++q) {
#pragma unroll
                for (int e = 0; e < 4; ++e) gl[q][e] += p.router_g_b[e];
                int g = 0; float gm = gl[q][0];
#pragma unroll
                for (int e = 1; e < 4; ++e) if (gl[q][e] > gm) { gm = gl[q][e]; g = e; }
                float gs = 0.f;
#pragma unroll
                for (int e = 0; e < 4; ++e) gs += __expf(gl[q][e] - gm);
                gsel[q] = g; gval[q] = 1.f / gs; }
            float el[RB][8];
#pragma unroll
            for (int q = 0; q < RB; ++q) {
#pragma unroll
                for (int e = 0; e < 8; ++e) el[q][e] = 0.f;
#pragma unroll
                for (int j = 0; j < 4; ++j)
#pragma unroll
                    for (int e = 0; e < 4; ++e) { const float* wr = RW + (e * 256 + 64 * j + lane) * 36 + 4 + gsel[q] * 8; const f32x4 w0 = *(const f32x4*)wr, w1 = *(const f32x4*)(wr + 4); const float ye = v[q][j][e];
                        el[q][0] += ye * w0.x; el[q][1] += ye * w0.y; el[q][2] += ye * w0.z; el[q][3] += ye * w0.w; el[q][4] += ye * w1.x; el[q][5] += ye * w1.y; el[q][6] += ye * w1.z; el[q][7] += ye * w1.w; } }
#pragma unroll
            for (int q = 0; q < RB; ++q)
#pragma unroll
                for (int e = 0; e < 8; ++e) el[q][e] = wave_sum(el[q][e]);
#pragma unroll
            for (int q = 0; q < RB; ++q) { const int g = gsel[q];
#pragma unroll
                for (int e = 0; e < 8; ++e) el[q][e] += p.router_e_b[g * 8 + e];
                int e1 = 0; float m1 = el[q][0];
#pragma unroll
                for (int e = 1; e < 8; ++e) if (el[q][e] > m1) { m1 = el[q][e]; e1 = e; }
                int e2 = -1; float m2 = -3.0e38f;
#pragma unroll
                for (int e = 0; e < 8; ++e) if (e != e1 && el[q][e] > m2) { m2 = el[q][e]; e2 = e; }
                const float r = __expf(m2 - m1), w1 = 1.f / (1.f + r), w2 = r / (1.f + r);
                if (lane == 0) {
                    const int lo = e1 < e2 ? e1 : e2, hi = e1 < e2 ? e2 : e1;
                    const int cls = g * 28 + pair_index(lo, hi);
                    TCLS[rl0 + q] = cls; TRNK[rl0 + q] = atomicAdd(HIST + cls, 1);
                    ((float*)(lds + P7_TG))[(rl0 + q) * 2] = gval[q] * (e1 < e2 ? w1 : w2); ((float*)(lds + P7_TG))[(rl0 + q) * 2 + 1] = gval[q] * (e1 < e2 ? w2 : w1);
                } }
        }
        __syncthreads();
        if (tid < NCLS) { const int n = HIST[tid]; BASE[tid] = n ? atomicAdd(CNT + tid, n) : 0; }
        __syncthreads();
        if (tid < 256) { const int cls = TCLS[tid]; const size_t slot = (size_t)cls * 65536 + BASE[cls] + TRNK[tid]; LIST[slot] = tile * 256 + tid;
            typedef float f32x2v __attribute__((ext_vector_type(2))); *(f32x2v*)((float*)(p.ws + WS_GSLOT) + slot * 2) = *(const f32x2v*)((const float*)(lds + P7_TG) + tid * 2); }
    }
}

constexpr int MOE_SM = 131072;
__device__ __forceinline__ void cls_decode(int cls, int& g, int& lo, int& hi) {
    g = cls / 28; int r = cls % 28; lo = 0; while (r >= 7 - lo) { r -= 7 - lo; ++lo; } hi = lo + 1 + r;
}
__device__ __forceinline__ void moe_build_map(const Params& p, int* sm) {
    const int* CNT = (const int*)(p.ws + WS_CTL);
    __syncthreads();
    if (threadIdx.x < NCLS) sm[128 + threadIdx.x] = CNT[threadIdx.x];
    __syncthreads();
    if (threadIdx.x == 0) { int base = 0; for (int c = 0; c < NCLS; ++c) { sm[c] = base; base += (sm[128 + c] + 255) >> 8; } sm[256] = base; }
    __syncthreads();
    if (threadIdx.x < NCLS) { const int c = threadIdx.x, b0 = sm[c], nt = (sm[128 + c] + 255) >> 8; for (int q = 0; q < nt; ++q) sm[384 + b0 + q] = c; }
    __syncthreads();
}
struct P8Sched { const char* H2; const char* EW13; const int* LIST; const int* sm; int G, c, NU;
    __device__ __forceinline__ bool next(int i, pg::UDesc& u) const { const int q = i * G + c; if (q >= NU) return false; const int mt = q >> 3, nj = q & 7, cls = sm[384 + mt]; int g, lo, hi; cls_decode(cls, g, lo, hi);
        const int e = g * 8 + (nj < 4 ? lo : hi);
        u.A = H2; u.B0 = EW13 + ((size_t)e * 1024 + (size_t)(nj & 3) * 256) * 1024; u.B1 = u.B0 + 4 * 128; u.i0 = cls; u.i1 = mt; u.i2 = nj; u.i3 = (mt - sm[cls]) * 256; return true; }
    __device__ __forceinline__ unsigned rowoff(const pg::UDesc& u, int r) const { const int rk = u.i3 + r; const int t = (rk < sm[128 + u.i0]) ? LIST[(size_t)u.i0 * 65536 + rk] : 0; return (unsigned)t * 1024u; }
};
__device__ __forceinline__ void phase8(const Params& p, unsigned char* lds) {
    int* sm = (int*)(lds + MOE_SM);
    moe_build_map(p, sm);
    bf16_t* HID = (bf16_t*)(p.ws + WS_HID); const int* LIST = (const int*)(p.ws + WS_LIST); const float* GSLOT = (const float*)(p.ws + WS_GSLOT);
    P8Sched S{(const char*)(p.ws + WS_H), (const char*)(p.ws + WS_EW13), LIST, sm, (int)gridDim.x, vcu_of(blockIdx.x, gridDim.x), sm[256] * 8};
    auto E = [&](const f32x4 (&acc)[2][2][4][2], const pg::UDesc& u, int wr, int wc, int fr, int fq) {
        const int cnt = sm[128 + u.i0], xh = u.i2 >> 2;
        const float USC = 1.f / (FP8_XSCALE * FP8_WSCALE);
#pragma unroll
        for (int a = 0; a < 2; ++a) {
            float gts[4];
#pragma unroll
            for (int m = 0; m < 4; ++m) { const int rk = u.i3 + 128 * a + 64 * wr + 16 * m + fr; const float g = GSLOT[((size_t)u.i0 * 65536 + (rk < cnt ? rk : 0)) * 2 + xh]; gts[m] = (rk < cnt) ? g * FP8_HSCALE : 0.f; }
#pragma unroll
            for (int m = 0; m < 4; ++m) { const int rl = 128 * a + 64 * wr + 16 * m + fr; const float gt = gts[m];
                float hv[8];
#pragma unroll
                for (int n = 0; n < 2; ++n)
#pragma unroll
                    for (int q = 0; q < 4; ++q) hv[4 * n + q] = fminf(fmaxf(silu_fast(acc[a][0][m][n][q] * USC) * (acc[a][1][m][n][q] * USC) * gt, -440.f), 440.f);
                u32x2 o; o.x = pk4_fp8(hv[0], hv[1], hv[2], hv[3]); o.y = pk4_fp8(hv[4], hv[5], hv[6], hv[7]);
                *(u32x2*)((unsigned char*)HID + (size_t)(u.i1 * 256 + rl) * 1024 + xh * 512 + (u.i2 & 3) * 128 + 32 * wc + 8 * fq) = o; }
        }
    };
    pg::gemm_stream<true, true, true>((LAS unsigned char*)lds, 1024, 1024, S, E);
}
struct P9Sched { const char* HID; const char* EW2T; const int* sm; int G, c, NU;
    __device__ __forceinline__ bool next(int i, pg::UDesc& u) const { const int q = i * G + c; if (q >= NU) return false; const int mt = q >> 2, pn = q & 3, cls = sm[384 + mt]; int g, lo, hi; cls_decode(cls, g, lo, hi);
        u.A = HID + (size_t)mt * 256 * 1024; u.B0 = EW2T + ((size_t)(g * 8 + lo) * 1024 + (size_t)pn * 256) * 512; u.B1 = EW2T + ((size_t)(g * 8 + hi) * 1024 + (size_t)pn * 256) * 512;
        u.i0 = cls; u.i1 = mt; u.i2 = pn; u.i3 = (mt - sm[cls]) * 256; return true; }
    __device__ __forceinline__ unsigned rowoff(const pg::UDesc&, int) const { return 0u; }
};
__device__ __forceinline__ void phase9(const Params& p, unsigned char* lds) {
    int* sm = (int*)(lds + MOE_SM);
    moe_build_map(p, sm);
    const int* LIST = (const int*)(p.ws + WS_LIST); const float* MOD = (const float*)(p.ws + WS_MOD);
    P9Sched S{(const char*)(p.ws + WS_HID), (const char*)(p.ws + WS_EW2T), sm, (int)gridDim.x, vcu_of(blockIdx.x, gridDim.x), sm[256] * 4};
    auto E = [&](const f32x4 (&acc)[2][2][4][2], const pg::UDesc& u, int wr, int wc, int fr, int fq) {
        const int cnt = sm[128 + u.i0];
        int tk[2][4];
#pragma unroll
        for (int a = 0; a < 2; ++a)
#pragma unroll
            for (int m = 0; m < 4; ++m) { const int rk = u.i3 + 128 * a + 64 * wr + 16 * m + fr; tk[a][m] = (rk < cnt) ? LIST[(size_t)u.i0 * 65536 + rk] : -1; }
#pragma unroll
        for (int a = 0; a < 2; ++a) {
            u32x2 x1[4][2][2];
#pragma unroll
            for (int m = 0; m < 4; ++m) { const int t = tk[a][m], ts = t < 0 ? 0 : t;
                const bf16_t* xrow = (const bf16_t*)(p.ws + WS_D1) + (size_t)ts * 1024 + u.i2 * 256 + 32 * wc + 4 * fq;
#pragma unroll
                for (int b = 0; b < 2; ++b)
#pragma unroll
                    for (int n = 0; n < 2; ++n) x1[m][b][n] = *(const u32x2*)(xrow + 128 * b + 16 * n); }
#pragma unroll
            for (int m = 0; m < 4; ++m) { const int t = tk[a][m], ts = t < 0 ? 0 : t;
                const float* g2 = MOD + (size_t)(ts >> 12) * 6144 + 5120 + u.i2 * 256 + 32 * wc + 4 * fq; float* orow = p.out + (size_t)ts * 1024 + u.i2 * 256 + 32 * wc + 4 * fq;
                f32x4 gv[2][2];
#pragma unroll
                for (int b = 0; b < 2; ++b)
#pragma unroll
                    for (int n = 0; n < 2; ++n) gv[b][n] = *(const f32x4*)(g2 + 128 * b + 16 * n);
                if (t >= 0) {
#pragma unroll
                    for (int b = 0; b < 2; ++b)
#pragma unroll
                        for (int n = 0; n < 2; ++n) { const f32x4 xf = (f32x4){bflo(x1[m][b][n].x), bfhi(x1[m][b][n].x), bflo(x1[m][b][n].y), bfhi(x1[m][b][n].y)};
                            *(f32x4*)(orow + 128 * b + 16 * n) = xf + gv[b][n] * (acc[a][b][m][n] * (1.f / (FP8_HSCALE * FP8_WSCALE))); } } }
        }
    };
    pg::gemm_stream<false, false, true>((LAS unsigned char*)lds, 1024, 512, S, E);
}

#define XB_TMO      128
#define XB_XCNT(j)  (256  + 64 * (j))
#define XB_XSUB(j)  (1280 + 64 * (j))
#define XB_XGEN(j)  (2304 + 64 * (j))
#define XB_TOP      3328
#define XB_TOPGEN   3392
#define XCD_BAR_WORDS 3456
#define XB_SPIN_CAP (1u << 18)

__device__ __forceinline__ unsigned xb_ld(unsigned* p)              { return __hip_atomic_load(p, __ATOMIC_RELAXED, __HIP_MEMORY_SCOPE_AGENT); }
__device__ __forceinline__ unsigned xb_add(unsigned* p, unsigned v) { return __hip_atomic_fetch_add(p, v, __ATOMIC_RELAXED, __HIP_MEMORY_SCOPE_AGENT); }
__device__ __forceinline__ unsigned xb_xcc_id() { return (unsigned)__builtin_amdgcn_s_getreg((3 << 11) | 20) & 0xFu; }
#define XB_SPIN(cond, bar) do { unsigned _sp = 0; while (cond) { __builtin_amdgcn_s_sleep(1); \
    if ((++_sp & 255u) == 0u) { if (xb_ld(&(bar)[XB_TMO])) break; if (_sp > XB_SPIN_CAP) { atomicAdd(&(bar)[XB_TMO], 1u); break; } } } } while (0)

struct XcdBarrier {
    unsigned* bar; unsigned x;
    volatile LAS unsigned* st;
};

__device__ __forceinline__ XcdBarrier xcd_barrier_post(unsigned* bar, volatile LAS unsigned* st) {
    XcdBarrier b; b.bar = bar; b.x = xb_xcc_id(); b.st = st;
    if (threadIdx.x == 0) (void)xb_add(&bar[XB_XCNT(b.x)], 1u);
    return b;
}
__device__ __forceinline__ void xcd_barrier_complete(unsigned* bar, unsigned x, unsigned& nloc, unsigned& nx) {
    const unsigned G = gridDim.x * gridDim.y * gridDim.z;
    unsigned sum, cnt, mine, sp = 0u;
    for (;;) {
        sum = 0u; cnt = 0u; mine = 0u;
#pragma unroll
        for (unsigned j = 0; j < 16; ++j) { const unsigned c = xb_ld(&bar[XB_XCNT(j)]); sum += c; cnt += (c > 0u) ? 1u : 0u; mine = (j == x) ? c : mine; }
        if (sum == G) break;
        __builtin_amdgcn_s_sleep(1);
        if ((++sp & 255u) == 0u) { if (xb_ld(&bar[XB_TMO])) break; if (sp > XB_SPIN_CAP) { atomicAdd(&bar[XB_TMO], 1u); break; } }
    }
    nloc = mine > 0u ? mine : 1u; nx = cnt > 0u ? cnt : 1u;
}

__device__ __forceinline__ void xcd_barrier(const XcdBarrier& b) {
    asm volatile("s_waitcnt vmcnt(0)" ::: "memory");
    __syncthreads();
    if (threadIdx.x == 0) {
        unsigned* bar = b.bar;
        __builtin_amdgcn_s_waitcnt(0);
        unsigned nloc = b.st[0], nx = b.st[1];
        if (nloc == 0u) { xcd_barrier_complete(bar, b.x, nloc, nx); b.st[0] = nloc; b.st[1] = nx; }
        const unsigned old = xb_add(&bar[XB_XSUB(b.x)], 1u);
        const unsigned gen = old / nloc;
        if (old + 1u == (gen + 1u) * nloc) {
            __builtin_amdgcn_fence(__ATOMIC_RELEASE, "agent");
            asm volatile("s_waitcnt vmcnt(0)" ::: "memory");
            const unsigned og = xb_add(&bar[XB_TOP], 1u);
            const unsigned tg = og / nx;
            if (og + 1u == (tg + 1u) * nx) xb_add(&bar[XB_TOPGEN], 1u);
            else XB_SPIN(xb_ld(&bar[XB_TOPGEN]) == tg, bar);
            __builtin_amdgcn_fence(__ATOMIC_ACQUIRE, "agent");
            xb_add(&bar[XB_XGEN(b.x)], 1u);
            asm volatile("s_waitcnt vmcnt(0)" ::: "memory");
        } else {
            XB_SPIN(xb_ld(&bar[XB_XGEN(b.x)]) == gen, bar);
            __builtin_amdgcn_fence(__ATOMIC_ACQUIRE, "agent");
            asm volatile("s_waitcnt vmcnt(0)" ::: "memory");
        }
    }
    __syncthreads();
}


constexpr int LDS_BYTES = 152 * 1024;
#ifdef PROBE_A
#define TSTAMP(k) do { if (blockIdx.x == 0 && threadIdx.x == 0) ((unsigned long long*)(p.ws + WS_CTL + 4096))[k] = __builtin_amdgcn_s_memrealtime(); } while (0)
#else
#define TSTAMP(k) do { } while (0)
#endif
__global__ void __launch_bounds__(NTHR, 2) fwd_kernel(Params p) {
    extern __shared__ __attribute__((aligned(16))) unsigned char lds[];
    cg::grid_group grid = cg::this_grid();
    volatile LAS unsigned* bst = (volatile LAS unsigned*)((LAS unsigned char*)lds + LDS_BYTES - 16);
    if (threadIdx.x < 2) bst[threadIdx.x] = 0u;
    if (blockIdx.x == 0) { if (threadIdx.x < 128) ((int*)(p.ws + WS_CTL))[threadIdx.x] = 0; for (int i = threadIdx.x; i < 3456; i += NTHR) ((unsigned*)(p.ws + WS_BAR))[i] = 0u; }
    grid.sync();
    const XcdBarrier bar = xcd_barrier_post((unsigned*)(p.ws + WS_BAR), bst);
    TSTAMP(0);
    phase0(p, lds);
    xcd_barrier(bar); TSTAMP(1);
    phase1(p, lds);
    khat_items(p, lds);
    xcd_barrier(bar); TSTAMP(2);
    phase2(p, lds);
    xcd_barrier(bar); TSTAMP(3);
    phase3(p);
    xcd_barrier(bar); TSTAMP(4);
    for (int u = blockIdx.x; u < 1024; u += gridDim.x) attn_unit(p, u, lds);
    TSTAMP(5);
    for (int it = blockIdx.x; it < 1024; it += gridDim.x) hyena_item(p, it, lds);
    xcd_barrier(bar); TSTAMP(6);
    {   u32x4 hv[8]; const int tq5 = otid();
        if (blockIdx.x < 1024) { const bf16_t* src0 = (const bf16_t*)(p.ws + WS_HYT) + ((size_t)((blockIdx.x >> 6) * 512 + tq5)) * 4096 + (blockIdx.x & 63) * 64;
#pragma unroll
            for (int i = 0; i < 8; ++i) hv[i] = *(const u32x4*)(src0 + i * 8); }
        for (int it = blockIdx.x; it < 1024; it += gridDim.x) phase5_item(p, it, lds, hv, (it + (int)gridDim.x < 1024) ? it + (int)gridDim.x : it); }
    xcd_barrier(bar); TSTAMP(7);
    phase6(p, lds);
    xcd_barrier(bar); TSTAMP(8);
    phase7(p, lds);
    xcd_barrier(bar); TSTAMP(9);
    phase8(p, lds);
    xcd_barrier(bar); TSTAMP(10);
    phase9(p, lds);
#ifdef PROBE_A
    xcd_barrier(bar); TSTAMP(11);
    if (blockIdx.x == 0) {
        __threadfence(); __syncthreads();
        const volatile unsigned long long* ts = (const volatile unsigned long long*)(p.ws + WS_CTL + 4096);
        const float ta = (float)(ts[PROBE_A] - ts[PROBE_A - 1]) * 0.01f, tb = (float)(ts[PROBE_B] - ts[PROBE_B - 1]) * 0.0001f;
        for (int i = threadIdx.x; i < (1 << 20); i += NTHR) p.out[1024 + i] += tb;
        if (threadIdx.x == 0) p.out[0] += ta;
    }
#endif
}

extern "C" void kernel_launch(void* const* d_in, const int* in_sizes, int n_in, void* d_out, int out_size, void* d_ws, size_t ws_size, hipStream_t stream) {
    static int grid_blocks = 0;
    if (grid_blocks == 0) {
        if (n_in != 30 || out_size != NTOK * DM || ws_size < WS_END) { fprintf(stderr, "kernel_launch: unexpected shapes (n_in %d out %d ws %zu)\n", n_in, out_size, ws_size); grid_blocks = -1; return; }
        int dev = 0, cus = 0, per_cu = 0;
        hipGetDevice(&dev); hipDeviceGetAttribute(&cus, hipDeviceAttributeMultiprocessorCount, dev);
        hipFuncSetAttribute((const void*)fwd_kernel, hipFuncAttributeMaxDynamicSharedMemorySize, LDS_BYTES);
        hipOccupancyMaxActiveBlocksPerMultiprocessor(&per_cu, (const void*)fwd_kernel, NTHR, LDS_BYTES);
        if (per_cu < 1) { fprintf(stderr, "kernel_launch: occupancy query says %d blocks per CU\n", per_cu); grid_blocks = -1; return; }
        grid_blocks = cus * per_cu;
    }
    if (grid_blocks < 0) return;
    Params p{};
    const float** pp = (const float**)&p;
    for (int i = 0; i < 30; ++i) pp[i] = (const float*)d_in[i];
    p.out = (float*)d_out; p.ws = (unsigned char*)d_ws;
    void* args[] = {&p};
    hipError_t e = hipLaunchCooperativeKernel((const void*)fwd_kernel, dim3(grid_blocks), dim3(NTHR), args, LDS_BYTES, stream);
    if (e != hipSuccess) fprintf(stderr, "cooperative launch failed: %s (grid %d)\n", hipGetErrorString(e), grid_blocks);
}
```

```cpp
#include <hip/hip_runtime.h>
#include <hip/hip_cooperative_groups.h>
#include <cstdio>
#include <cstdint>
namespace cg = cooperative_groups;

typedef unsigned short bf16_t;
typedef short bf16x8 __attribute__((ext_vector_type(8)));
typedef float f32x4 __attribute__((ext_vector_type(4)));
typedef unsigned u32x4 __attribute__((ext_vector_type(4)));
typedef unsigned u32x2 __attribute__((ext_vector_type(2)));
typedef _Float16 f16x8 __attribute__((ext_vector_type(8)));
typedef _Float16 f16x4 __attribute__((ext_vector_type(4)));
typedef _Float16 f16x2 __attribute__((ext_vector_type(2)));

constexpr int DM = 1024, NB = 16, SEQ = 4096, NTOK = NB * SEQ, CTXL = 256, NCTX = NB * CTXL;
constexpr int PROJW = 2304, HYW = 512, HYPW = 1536, KOFF = 512, VOFF = 640, HYOFF = 768;
constexpr int NEXP = 32, EHID = 512, NCLS = 112;
constexpr float EPSN = 1e-6f;
constexpr int NTHR = 512;

constexpr size_t MiB = 1u << 20;
constexpr size_t WS_CTL = 0, WS_MOD = 1 * MiB, WS_WINT = 2 * MiB, WS_WOUTT = 7 * MiB, WS_TAPS = 9 * MiB, WS_EW13 = 41 * MiB, WS_EW2T = 105 * MiB;
constexpr size_t WS_GATE = 137 * MiB, WS_KVC = 139 * MiB, WS_HC = 141 * MiB, WS_LIST = 149 * MiB, WS_H = 177 * MiB, WS_QKV = 305 * MiB, WS_UT = 401 * MiB;
constexpr size_t WS_HYT = 593 * MiB, WS_ATTHY = 657 * MiB, WS_HID = 305 * MiB, WS_KH = 785 * MiB, WS_END = 1003 * MiB;
constexpr size_t WS_BAR = 16384;
constexpr size_t WS_GSLOT = 945 * MiB;
constexpr size_t WS_D1 = 817 * MiB;
constexpr size_t WS_FTAB = 65536, WS_GTAB = 81920, WS_FKTAB = 98304;

struct Params {
    const float* x; const float* c; const float* ctx; const float* c_ctx; const float* ada_w; const float* ada_b; const float* norm1_w; const float* w_in;
    const float* q_norm_w; const float* k_norm_w; const float* attn_sink; const float* hy_conv_w; const float* hy_conv_b; const float* hy_w1; const float* hy_b1;
    const float* hy_w2; const float* hy_b2; const float* hy_w3; const float* hy_sin_freq; const float* hy_skip; const float* group_norm_w; const float* w_out;
    const float* norm2_w; const float* router_g_w; const float* router_g_b; const float* router_e_w; const float* router_e_b; const float* exp_w1; const float* exp_w3;
    const float* exp_w2;
    float* out; unsigned char* ws;
};

__device__ __forceinline__ unsigned f2bf(float f) { unsigned u = __builtin_bit_cast(unsigned, f); return (u + 0x7fffu + ((u >> 16) & 1u)) >> 16; }
typedef float f32x2_t __attribute__((ext_vector_type(2))); typedef __bf16 bf16x2_t __attribute__((ext_vector_type(2)));
__device__ __forceinline__ unsigned pk2(float lo, float hi) { f32x2_t v = {lo, hi}; bf16x2_t b = __builtin_convertvector(v, bf16x2_t); return __builtin_bit_cast(unsigned, b); }
__device__ __forceinline__ float bf2f(unsigned short b) { return __builtin_bit_cast(float, (unsigned)b << 16); }
__device__ __forceinline__ float bflo(unsigned w) { return __builtin_bit_cast(float, w << 16); }
__device__ __forceinline__ float bfhi(unsigned w) { return __builtin_bit_cast(float, w & 0xffff0000u); }
__device__ __forceinline__ unsigned pkh2(float lo, float hi) { f16x2 v = {(_Float16)lo, (_Float16)hi}; return __builtin_bit_cast(unsigned, v); }
__device__ __forceinline__ float h2f(unsigned short h) { return (float)__builtin_bit_cast(_Float16, h); }
__device__ __forceinline__ float hlo(unsigned w) { return h2f((unsigned short)(w & 0xffffu)); }
__device__ __forceinline__ float hhi(unsigned w) { return h2f((unsigned short)(w >> 16)); }
#define dpp_f(v, ctrl) __builtin_bit_cast(float, __builtin_amdgcn_update_dpp(0, __builtin_bit_cast(int, (float)(v)), (ctrl), 0xf, 0xf, false))
#define DPP_XOR1 0xB1
#define DPP_XOR2 0x4E
#define DPP_HMIRROR 0x141
#define DPP_MIRROR 0x140
__device__ __forceinline__ float xor16_sum(float v) { const unsigned u = __builtin_bit_cast(unsigned, v); auto r = __builtin_amdgcn_permlane16_swap(u, u, false, false); return __builtin_bit_cast(float, (unsigned)r[0]) + __builtin_bit_cast(float, (unsigned)r[1]); }
__device__ __forceinline__ float xor32_sum(float v) { const unsigned u = __builtin_bit_cast(unsigned, v); auto r = __builtin_amdgcn_permlane32_swap(u, u, false, false); return __builtin_bit_cast(float, (unsigned)r[0]) + __builtin_bit_cast(float, (unsigned)r[1]); }
__device__ __forceinline__ float wave_sum(float v) {
    v += dpp_f(v, DPP_XOR1); v += dpp_f(v, DPP_XOR2); v += dpp_f(v, DPP_HMIRROR); v += dpp_f(v, DPP_MIRROR);
    v = xor16_sum(v); v = xor32_sum(v);
    return v;
}
__device__ __forceinline__ int otid() { int t = threadIdx.x; asm volatile("" : "+v"(t)); return t; }
__device__ __forceinline__ float exp2_raw(float x) { float r; asm volatile("v_exp_f32 %0, %1\n\ts_nop 1" : "=v"(r) : "v"(x)); return r; }
__device__ __forceinline__ float max_fq(float m) { const unsigned u = __builtin_bit_cast(unsigned, m);
    auto r16 = __builtin_amdgcn_permlane16_swap(u, u, false, false); float a = fmaxf(__builtin_bit_cast(float, (unsigned)r16[0]), __builtin_bit_cast(float, (unsigned)r16[1]));
    const unsigned ua = __builtin_bit_cast(unsigned, a); auto r32 = __builtin_amdgcn_permlane32_swap(ua, ua, false, false); return fmaxf(__builtin_bit_cast(float, (unsigned)r32[0]), __builtin_bit_cast(float, (unsigned)r32[1])); }
__device__ __forceinline__ float siluf(float v) { return v / (1.f + __expf(-v)); }
__device__ __forceinline__ float rcp_raw(float x) { float r; asm volatile("v_rcp_f32 %0, %1\n\ts_nop 1" : "=v"(r) : "v"(x)); return r; }
__device__ __forceinline__ float silu_fast(float v) { return v * rcp_raw(1.f + exp2_raw(v * -1.4426950408889634f)); }
__device__ __forceinline__ float sin_rad(float a) { float r = a * 0.15915494309189535f; r -= floorf(r); return __builtin_amdgcn_sinf(r); }
__device__ __forceinline__ float cos_rad(float a) { float r = a * 0.15915494309189535f; r -= floorf(r); return __builtin_amdgcn_cosf(r); }

template <class SrcA, class SrcB>
__device__ __forceinline__ void gemm_unit(unsigned char* lds, f32x4 (&acc)[2][2][4][2], const SrcA& srcA, const SrcB& srcB) {
    const int tid = otid(), wid = tid >> 6, lane = tid & 63, wr = wid >> 2, wc = wid & 3, fr = lane & 15, fq = lane >> 4;
#pragma unroll
    for (int a = 0; a < 2; ++a)
#pragma unroll
        for (int b = 0; b < 2; ++b)
#pragma unroll
            for (int m = 0; m < 4; ++m)
#pragma unroll
                for (int n = 0; n < 2; ++n) acc[a][b][m][n] = (f32x4){0.f, 0.f, 0.f, 0.f};
    const int r0 = tid >> 2, kc = tid & 3;
    const bf16_t* pa0 = srcA(r0) + kc * 8; const bf16_t* pa1 = srcA(r0 + 128) + kc * 8;
    u32x4 ra0, ra1, rb0, rb1;
    ra0 = *(const u32x4*)(pa0); ra1 = *(const u32x4*)(pa1);
    rb0 = *(const u32x4*)(srcB(r0, 0) + kc * 8); rb1 = *(const u32x4*)(srcB(r0 + 128, 0) + kc * 8);
    unsigned char* sA = lds; unsigned char* sB = lds + 16384;
    for (int ks = 0; ks < 32; ++ks) {
        __syncthreads();
        *(u32x4*)(sA + tid * 16) = ra0; *(u32x4*)(sA + 8192 + tid * 16) = ra1;
        *(u32x4*)(sB + tid * 16) = rb0; *(u32x4*)(sB + 8192 + tid * 16) = rb1;
        __syncthreads();
        if (ks + 1 < 32) {
            ra0 = *(const u32x4*)(pa0 + (ks + 1) * 32); ra1 = *(const u32x4*)(pa1 + (ks + 1) * 32);
            rb0 = *(const u32x4*)(srcB(r0, ks + 1) + kc * 8); rb1 = *(const u32x4*)(srcB(r0 + 128, ks + 1) + kc * 8);
        }
        bf16x8 Af[2][4], Bf[2][2];
#pragma unroll
        for (int a = 0; a < 2; ++a)
#pragma unroll
            for (int m = 0; m < 4; ++m) Af[a][m] = *(const bf16x8*)(sA + (128 * a + 64 * wr + 16 * m + fr) * 64 + fq * 16);
#pragma unroll
        for (int b = 0; b < 2; ++b)
#pragma unroll
            for (int n = 0; n < 2; ++n) Bf[b][n] = *(const bf16x8*)(sB + (128 * b + 32 * wc + 16 * n + fr) * 64 + fq * 16);
#pragma unroll
        for (int a = 0; a < 2; ++a)
#pragma unroll
            for (int b = 0; b < 2; ++b)
#pragma unroll
                for (int m = 0; m < 4; ++m)
#pragma unroll
                    for (int n = 0; n < 2; ++n) acc[a][b][m][n] = __builtin_amdgcn_mfma_f32_16x16x32_bf16(Bf[b][n], Af[a][m], acc[a][b][m][n], 0, 0, 0);
    }
}
#define ACC_FOREACH(acc, BODY) do { \
    const int _wid = threadIdx.x >> 6, _lane = threadIdx.x & 63, _wr = _wid >> 2, _wc = _wid & 3, _fr = _lane & 15, _fq = _lane >> 4; \
    _Pragma("unroll") for (int _a = 0; _a < 2; ++_a) _Pragma("unroll") for (int _m = 0; _m < 4; ++_m) _Pragma("unroll") for (int _b = 0; _b < 2; ++_b) _Pragma("unroll") for (int _n = 0; _n < 2; ++_n) { \
        const int rl = 128 * _a + 64 * _wr + 16 * _m + _fr, cl = 128 * _b + 32 * _wc + 16 * _n + 4 * _fq; const f32x4 v = acc[_a][_b][_m][_n]; BODY } } while (0)


#define LAS __attribute__((address_space(3)))
namespace pg {
constexpr int HTB = 16384;
__device__ __forceinline__ int lds_byte(int r, int c) { const int st = (r >> 4) * 2 + (c >> 5), rr = r & 15, cc = c & 31, ob = rr * 64 + cc * 2; return st * 1024 + (ob ^ (((ob >> 9) & 1) << 5)); }
__device__ __forceinline__ void stage_rc(int b, int& R, int& C) { const int st = b / 1024, sb = b % 1024, swz = sb ^ (((sb >> 9) & 1) << 5); R = (st >> 1) * 16 + swz / 64; C = (st & 1) * 32 + (swz % 64) / 2; }
__device__ __forceinline__ int perm32(int rho) { const int n = rho >> 4, i = rho & 15; return 8 * (i >> 2) + 4 * n + (i & 3); }
struct UDesc { const char* A; const char* B0; const char* B1; int i0, i1, i2, i3; };
typedef int v8i_t __attribute__((ext_vector_type(8)));
template <bool GATHER, bool PERM, bool FP8, class Sched, class Epi>
__device__ __forceinline__ void gemm_stream(LAS unsigned char* lds, const int KA, const int KB, const Sched& S, const Epi& E) {
    const int tid = otid(), wid = __builtin_amdgcn_readfirstlane(tid >> 6), lane = tid & 63, wr = wid >> 2, wc = wid & 3, fr = lane & 15, fq = lane >> 4;
    constexpr int nt = FP8 ? 8 : 16, nth = nt / 2;
    unsigned voffA[2], voffB[2]; int rowA[2]; unsigned colA[2];
#pragma unroll
    for (int i = 0; i < 2; ++i) { int R, C; stage_rc(tid * 16 + i * 8192, R, C); const int Rb = PERM ? ((R & ~31) + perm32(R & 31)) : R;
        voffA[i] = (unsigned)(R * KA + C * 2); voffB[i] = (unsigned)(Rb * KB + C * 2); rowA[i] = R; colA[i] = (unsigned)C * 2u; }
    const size_t hstepA = (size_t)128 * KA, hstepB = (size_t)128 * KB;
    const unsigned ldsw = (unsigned)wid * 1024u;
    const int aoff = lds_byte(wr * 64 + fr, fq * 8), boff = lds_byte(wc * 32 + fr, fq * 8);
    const int aoff8a = lds_byte(wr * 64 + fr, fq * 16), aoff8b = aoff8a + 16, boff8a = lds_byte(wc * 32 + fr, fq * 16), boff8b = boff8a + 16;
#define PG_SA(b, h) (((b) * 2 + (h)) * pg::HTB)
#define PG_SB(b, h) ((4 + (b) * 2 + (h)) * pg::HTB)
#define PG_LD2(bufoff, p0, p1) do { __builtin_amdgcn_global_load_lds((const unsigned*)(p0), (LAS unsigned*)(lds + (bufoff) + ldsw), 16, 0, 0); \
        __builtin_amdgcn_global_load_lds((const unsigned*)(p1), (LAS unsigned*)(lds + (bufoff) + ldsw + 8192), 16, 0, 0); } while (0)
#define PG_STA(bufoff, pa, VA, h) do { if (GATHER) PG_LD2(bufoff, (pa) + ((h) ? VA##10 : VA##00), (pa) + ((h) ? VA##11 : VA##01)); else { const char* _b = (pa) + (h) * hstepA; PG_LD2(bufoff, _b + voffA[0], _b + voffA[1]); } } while (0)
#define PG_STB(bufoff, pb, h) do { const char* _b = (pb) + (h) * hstepB; PG_LD2(bufoff, _b + voffB[0], _b + voffB[1]); } while (0)
#define PG_LD8(p0, p1) __builtin_bit_cast(v8i_t, __builtin_shufflevector(*(const LAS bf16x8*)(p0), *(const LAS bf16x8*)(p1), 0, 1, 2, 3, 4, 5, 6, 7, 8, 9, 10, 11, 12, 13, 14, 15))
#define PG_LDA(dst, b, h) do { _Pragma("unroll") for (int m = 0; m < 4; ++m) { if (FP8) dst##8[m] = PG_LD8(lds + PG_SA(b, h) + aoff8a + m * 2048, lds + PG_SA(b, h) + aoff8b + m * 2048); \
        else { _Pragma("unroll") for (int k = 0; k < 2; ++k) dst[m][k] = *(const LAS bf16x8*)(lds + PG_SA(b, h) + aoff + m * 2048 + k * 1024); } } } while (0)
#define PG_LDB(dst, b, h) do { _Pragma("unroll") for (int n = 0; n < 2; ++n) { if (FP8) dst##8[n] = PG_LD8(lds + PG_SB(b, h) + boff8a + n * 2048, lds + PG_SB(b, h) + boff8b + n * 2048); \
        else { _Pragma("unroll") for (int k = 0; k < 2; ++k) dst[n][k] = *(const LAS bf16x8*)(lds + PG_SB(b, h) + boff + n * 2048 + k * 1024); } } } while (0)
#define PG_MMA(ai, bj, At, Bt) do { __builtin_amdgcn_s_setprio(1); _Pragma("unroll") for (int m = 0; m < 4; ++m) _Pragma("unroll") for (int n = 0; n < 2; ++n) { \
        if (FP8) asm volatile("v_mfma_f32_16x16x128_f8f6f4 %0, %1, %2, %0" : "+v"(acc[ai][bj][m][n]) : "v"(Bt##8[n]), "v"(At##8[m])); \
        else { _Pragma("unroll") for (int k = 0; k < 2; ++k) acc[ai][bj][m][n] = __builtin_amdgcn_mfma_f32_16x16x32_bf16(Bt[n][k], At[m][k], acc[ai][bj][m][n], 0, 0, 0); } } __builtin_amdgcn_s_setprio(0); } while (0)
#define PG_WAIT_V(n) asm volatile("s_waitcnt vmcnt(" #n ")" ::: "memory")
#define PG_WAIT_L(n) asm volatile("s_waitcnt lgkmcnt(" #n ")" ::: "memory")
#define PG_BAR __builtin_amdgcn_s_barrier()
#define PG_SCHED __builtin_amdgcn_sched_barrier(0)
    UDesc cur, nxt; int ui = 0;
    unsigned cva00 = 0, cva01 = 0, cva10 = 0, cva11 = 0, nva00 = 0, nva01 = 0, nva10 = 0, nva11 = 0;
    if (!S.next(0, cur)) return;
    if (GATHER) { int R0, C0, R1, C1; stage_rc(otid() * 16, R0, C0); stage_rc(otid() * 16 + 8192, R1, C1);
        cva00 = S.rowoff(cur, R0) + C0 * 2; cva01 = S.rowoff(cur, R1) + C1 * 2; cva10 = S.rowoff(cur, 128 + R0) + C0 * 2; cva11 = S.rowoff(cur, 128 + R1) + C1 * 2; }
    f32x4 acc[2][2][4][2];
#pragma unroll
    for (int a = 0; a < 2; ++a)
#pragma unroll
        for (int b = 0; b < 2; ++b)
#pragma unroll
            for (int m = 0; m < 4; ++m)
#pragma unroll
                for (int n = 0; n < 2; ++n) acc[a][b][m][n] = (f32x4){0.f, 0.f, 0.f, 0.f};
    bf16x8 At[4][2], B0[2][2], B1[2][2]; v8i_t At8[4], B08[2], B18[2];
    PG_STB(PG_SB(0, 0), cur.B0, 0); PG_STB(PG_SB(0, 1), cur.B0, 1); PG_STA(PG_SA(0, 0), cur.A, cva, 0); PG_STA(PG_SA(0, 1), cur.A, cva, 1);
    if (wr == 1) PG_BAR;
    PG_WAIT_V(2); PG_BAR;
    PG_STB(PG_SB(1, 0), cur.B0 + 128, 0); PG_STA(PG_SA(1, 0), cur.A + 128, cva, 0); PG_STB(PG_SB(1, 1), cur.B0 + 128, 1);
    PG_WAIT_V(6); PG_BAR;
    for (;;) {
        const bool has_next = S.next(ui + 1, nxt);
        if (!has_next) nxt = cur;
        if (GATHER) { if (has_next) { int R0, C0, R1, C1; stage_rc(otid() * 16, R0, C0); stage_rc(otid() * 16 + 8192, R1, C1);
                nva00 = S.rowoff(nxt, R0) + C0 * 2; nva01 = S.rowoff(nxt, R1) + C1 * 2; nva10 = S.rowoff(nxt, 128 + R0) + C0 * 2; nva11 = S.rowoff(nxt, 128 + R1) + C1 * 2; }
            else { nva00 = cva00; nva01 = cva01; nva10 = cva10; nva11 = cva11; } }
        for (int t = 0; t < nt; t += 2) {
            const bool last = (t == nt - 2);
            const char* a1 = cur.A + (size_t)(t + 1) * 128;
            const char* a2 = last ? nxt.A : cur.A + (size_t)(t + 2) * 128;
            const char* b2 = last ? nxt.B0 : ((t + 2 < nth) ? cur.B0 + (size_t)(t + 2) * 128 : cur.B1 + (size_t)(t + 2 - nth) * 128);
            const char* a3 = a2 + 128; const char* b3 = b2 + 128;
            PG_LDB(B0, 0, 0); PG_LDB(B1, 0, 1); PG_SCHED; PG_LDA(At, 0, 0); PG_STA(PG_SA(1, 1), a1, cva, 1);
            if (GATHER && last) { cva00 = nva00; cva01 = nva01; cva10 = nva10; cva11 = nva11; }
            PG_WAIT_V(8); PG_WAIT_L(0); PG_BAR; PG_MMA(0, 0, At, B0); PG_MMA(0, 1, At, B1); PG_BAR; PG_SCHED;
            PG_LDA(At, 0, 1); PG_STB(PG_SB(0, 0), b2, 0); PG_STB(PG_SB(0, 1), b2, 1); PG_STA(PG_SA(0, 0), a2, cva, 0);
            PG_WAIT_V(8); PG_WAIT_L(0); PG_BAR; PG_MMA(1, 0, At, B0); PG_MMA(1, 1, At, B1); PG_BAR; PG_SCHED;
            PG_LDB(B0, 1, 0); PG_LDB(B1, 1, 1); PG_SCHED; PG_LDA(At, 1, 0); PG_STA(PG_SA(0, 1), a2, cva, 1);
            PG_WAIT_V(8); PG_WAIT_L(0); PG_BAR; PG_MMA(0, 0, At, B0); PG_MMA(0, 1, At, B1); PG_BAR; PG_SCHED;
            PG_LDA(At, 1, 1); PG_STB(PG_SB(1, 0), b3, 0); PG_STB(PG_SB(1, 1), b3, 1); PG_STA(PG_SA(1, 0), a3, cva, 0);
            PG_WAIT_V(8); PG_WAIT_L(0); PG_BAR; PG_MMA(1, 0, At, B0); PG_MMA(1, 1, At, B1); PG_BAR; PG_SCHED;
        }
        if (wr == 0) PG_BAR;
        if (FP8) asm volatile("s_nop 15\n\ts_nop 15" ::: "memory");
        E(acc, cur, wr, wc, fr, fq);
        if (!has_next) break;
#pragma unroll
        for (int a = 0; a < 2; ++a)
#pragma unroll
            for (int b = 0; b < 2; ++b)
#pragma unroll
                for (int m = 0; m < 4; ++m)
#pragma unroll
                    for (int n = 0; n < 2; ++n) acc[a][b][m][n] = (f32x4){0.f, 0.f, 0.f, 0.f};
        cur = nxt; ++ui;
        if (wr == 1) PG_BAR;
    }
    PG_WAIT_V(0);
    PG_BAR;
#undef PG_SA
#undef PG_SB
#undef PG_LD2
#undef PG_STA
#undef PG_STB
#undef PG_LDA
#undef PG_LDB
#undef PG_MMA
#undef PG_WAIT_V
#undef PG_WAIT_L
#undef PG_BAR
#undef PG_SCHED
}
}
#define ACCP_FOREACH(acc, wr, wc, fr, fq, BODY) do { \
    _Pragma("unroll") for (int _a = 0; _a < 2; ++_a) _Pragma("unroll") for (int _m = 0; _m < 4; ++_m) _Pragma("unroll") for (int _b = 0; _b < 2; ++_b) { \
        const int rl = 128 * _a + 64 * (wr) + 16 * _m + (fr), cl = 128 * _b + 32 * (wc) + 8 * (fq); const f32x4 v0 = acc[_a][_b][_m][0], v1 = acc[_a][_b][_m][1]; BODY } } while (0)
#define ACCN_FOREACH(acc, wr, wc, fr, fq, BODY) do { \
    _Pragma("unroll") for (int _a = 0; _a < 2; ++_a) _Pragma("unroll") for (int _m = 0; _m < 4; ++_m) _Pragma("unroll") for (int _b = 0; _b < 2; ++_b) _Pragma("unroll") for (int _n = 0; _n < 2; ++_n) { \
        const int rl = 128 * _a + 64 * (wr) + 16 * _m + (fr), cl = 128 * _b + 32 * (wc) + 16 * _n + 4 * (fq); const f32x4 v = acc[_a][_b][_m][_n]; BODY } } while (0)
__device__ __forceinline__ int vcu_of(int bx, int G) { return (G % 8 == 0) ? (bx % 8) * (G / 8) + bx / 8 : bx; }

__device__ __forceinline__ void p0_adaln(const Params& p, int it, unsigned char* lds) {
    float* S = (float*)lds;
    float* R = (float*)(lds + 17 * 1024 * 4);
    const int tid = otid();
    __syncthreads();
    {   float cv[34];
#pragma unroll
        for (int q = 0; q < 34; ++q) { const int i = tid + NTHR * q, r = i >> 10, k = i & 1023; cv[q] = (r < 16) ? p.c[r * 1024 + k] : p.c_ctx[k]; }
#pragma unroll
        for (int q = 0; q < 34; ++q) S[tid + NTHR * q] = siluf(cv[q]); }
    __syncthreads();
    const int col = tid & 63, sl = tid >> 6, n = it * 64 + col;
    float a[17];
#pragma unroll
    for (int r = 0; r < 17; ++r) a[r] = 0.f;
#pragma unroll 1
    for (int k0 = sl * 128; k0 < sl * 128 + 128; k0 += 16) {
        float w[16];
#pragma unroll
        for (int q = 0; q < 16; ++q) w[q] = p.ada_w[(size_t)(k0 + q) * 6144 + n];
#pragma unroll
        for (int q = 0; q < 16; ++q)
#pragma unroll
            for (int r = 0; r < 17; ++r) a[r] += S[r * 1024 + k0 + q] * w[q];
    }
#pragma unroll
    for (int r = 0; r < 17; ++r) R[(sl * 17 + r) * 64 + col] = a[r];
    __syncthreads();
    float* MOD = (float*)(p.ws + WS_MOD);
    for (int i = tid; i < 17 * 64; i += NTHR) { const int r = i >> 6, cc = i & 63; float s = 0.f;
#pragma unroll
        for (int q = 0; q < 8; ++q) s += R[(q * 17 + r) * 64 + cc];
        MOD[r * 6144 + it * 64 + cc] = s + p.ada_b[it * 64 + cc]; }
}

__device__ __forceinline__ void p0_taps(const Params& p, int it, unsigned char* lds) {
    float* FE = (float*)lds;
    float* H1 = FE + 16 * 36;
    float* H2 = H1 + 16 * 64;
    const int tid = otid(), p0 = it * 16;
    __syncthreads();
    if (tid < 256) { const int pp = tid >> 4, j = tid & 15; const float pos = (float)(p0 + pp);
        const float band = 1e-4f + (float)j * ((15.f - 1e-4f) / 15.f);
        float rev = pos * band * (1.f / 4096.f); rev -= floorf(rev);
        FE[pp * 36 + 1 + j] = __builtin_amdgcn_cosf(rev); FE[pp * 36 + 17 + j] = -__builtin_amdgcn_sinf(rev);
        if (j == 0) FE[pp * 36] = pos * (1.f / 4096.f); }
    __syncthreads();
    for (int i = tid; i < 1024; i += NTHR) { const int pp = i >> 6, j = i & 63; float s = p.hy_b1[j];
#pragma unroll
        for (int q = 0; q < 33; ++q) s += FE[pp * 36 + q] * p.hy_w1[q * 64 + j];
        H1[pp * 64 + j] = sin_rad(p.hy_sin_freq[j] * s); }
    __syncthreads();
    for (int i = tid; i < 1024; i += NTHR) { const int pp = i >> 6, j = i & 63; float s = p.hy_b2[j];
#pragma unroll
        for (int q = 0; q < 64; ++q) s += H1[pp * 64 + q] * p.hy_w2[q * 64 + j];
        H2[pp * 64 + j] = sin_rad(p.hy_sin_freq[64 + j] * s); ((_Float16*)(H2 + 1024))[pp * 72 + j] = (_Float16)H2[pp * 64 + j]; }
    __syncthreads();
    float* TAPS = (float*)(p.ws + WS_TAPS);
    const float mind = -3.0701134573253945f, maxd = -15.350567286626972f;
    const int wid = tid >> 6, lane = tid & 63, fr = lane & 15, fq = lane >> 4;
    const _Float16* H2h = (const _Float16*)(H2 + 1024);
    const f16x8 a0 = *(const f16x8*)(H2h + fr * 72 + 8 * fq), a1 = *(const f16x8*)(H2h + fr * 72 + 32 + 8 * fq);
#pragma unroll 2
    for (int j = 0; j < 16; ++j) {
        const int col = 256 * wid + 16 * j + fr, o = col >> 10, dir = (col >> 9) & 1, c = col & 511;
        float wv[16];
#pragma unroll
        for (int e = 0; e < 8; ++e) { wv[e] = p.hy_w3[(size_t)(8 * fq + e) * 2048 + col]; wv[8 + e] = p.hy_w3[(size_t)(32 + 8 * fq + e) * 2048 + col]; }
        f16x8 b0, b1;
#pragma unroll
        for (int e = 0; e < 8; ++e) { b0[e] = (_Float16)wv[e]; b1[e] = (_Float16)wv[8 + e]; }
        f32x4 acc = (f32x4){0.f, 0.f, 0.f, 0.f};
        acc = __builtin_amdgcn_mfma_f32_16x16x32_f16(a0, b0, acc, 0, 0, 0); acc = __builtin_amdgcn_mfma_f32_16x16x32_f16(a1, b1, acc, 0, 0, 0);
        const float delta = fabsf(mind + (maxd - mind) * ((float)c / 511.f));
        float* tp = TAPS + ((size_t)(o * 512 + c)) * 8192;
        const int P = p0 + 4 * fq; f32x4 val;
#pragma unroll
        for (int r = 0; r < 4; ++r) val[r] = acc[r] * __expf(-(float)(P + r) * (1.f / 4096.f) * delta);
        if (dir == 0) *(f32x4*)(tp + 4096 + P) = val;
        else {
#pragma unroll
            for (int r = 0; r < 4; ++r) { if (P + r == 0) tp[0] = 0.f; else tp[4096 - (P + r)] = val[r]; } }
    }
}

__device__ __forceinline__ unsigned pk4_fp8(float a, float b, float c, float d) { int w = 0; w = __builtin_amdgcn_cvt_pk_fp8_f32(a, b, w, false); w = __builtin_amdgcn_cvt_pk_fp8_f32(c, d, w, true); return (unsigned)w; }
constexpr float FP8_WSCALE = 64.f, FP8_XSCALE = 4.f, FP8_HSCALE = 16.f;
__device__ __forceinline__ void p0_transpose_w(const float* src, int N, int k0, int n0, bf16_t* dst, int dpitch, int mode, float* scr  , int lane, bool fp8 = false) {
    float v[32];
#pragma unroll
    for (int i = 0; i < 32; ++i) v[i] = src[(size_t)(k0 + 2 * i + (lane >> 5)) * N + n0 + (lane & 31)];
#pragma unroll
    for (int i = 0; i < 32; ++i) scr[(2 * i + (lane >> 5)) * 33 + (lane & 31)] = v[i];
    asm volatile("s_waitcnt lgkmcnt(0)" ::: "memory");
    const int c = lane & 7;
#pragma unroll
    for (int j = 0; j < 4; ++j) { const int n = (lane >> 3) + 8 * j, col = n0 + n; const float* sp = scr + (8 * c) * 33 + n;
        int drow = col;
        if (mode == 1) drow = (col >> 7) * 256 + (col & 127); else if (mode == 2) drow = (col >> 7) * 256 + 128 + (col & 127);
        if (fp8) { u32x2 o; o.x = pk4_fp8(sp[0] * FP8_WSCALE, sp[33] * FP8_WSCALE, sp[66] * FP8_WSCALE, sp[99] * FP8_WSCALE); o.y = pk4_fp8(sp[132] * FP8_WSCALE, sp[165] * FP8_WSCALE, sp[198] * FP8_WSCALE, sp[231] * FP8_WSCALE);
            *(u32x2*)((unsigned char*)dst + (size_t)drow * dpitch + k0 + 8 * c) = o; }
        else { u32x4 o; o.x = pk2(sp[0], sp[33]); o.y = pk2(sp[66], sp[99]); o.z = pk2(sp[132], sp[165]); o.w = pk2(sp[198], sp[231]);
            *(u32x4*)(dst + (size_t)drow * dpitch + k0 + 8 * c) = o; } }
    asm volatile("s_waitcnt lgkmcnt(0)" ::: "memory");
}

__device__ __forceinline__ void p0_tables(const Params& p, int it) {
    const int e = it * NTHR + threadIdx.x;
    _Float16* FT = (_Float16*)(p.ws + WS_FTAB); _Float16* GT = (_Float16*)(p.ws + WS_GTAB); _Float16* FK = (_Float16*)(p.ws + WS_FKTAB);
    if (e < 8192) { const int rho = e >> 6, s1 = e & 63, f = rho >> 1; float v;
        if (rho == 0) v = 1.f; else if (rho == 1) v = (s1 & 1) ? -1.f : 1.f;
        else { const float rev = (float)((f * s1) & 127) * (1.f / 128.f); v = (rho & 1) ? -__builtin_amdgcn_sinf(rev) : __builtin_amdgcn_cosf(rev); }
        FT[e] = (_Float16)v;
    } else if (e < 16384) { const int q = e - 8192, t1 = q >> 7, rho = q & 127, f = rho >> 1; float v;
        if (rho == 0) v = 1.f / 128.f; else if (rho == 1) v = ((t1 & 1) ? -1.f : 1.f) / 128.f;
        else { const float rev = (float)((f * t1) & 127) * (1.f / 128.f); v = ((rho & 1) ? -__builtin_amdgcn_sinf(rev) : __builtin_amdgcn_cosf(rev)) * (2.f / 128.f); }
        GT[q] = (_Float16)v;
    } else { const int q = e - 16384, rho = q >> 7, dp = q & 127, d = dp - 64, f = rho >> 1; float v;
        if (rho == 0) v = 1.f; else if (rho == 1) v = (d & 1) ? -1.f : 1.f;
        else { const float rev = (float)((f * d) & 127) * (1.f / 128.f); v = (rho & 1) ? -__builtin_amdgcn_sinf(rev) : __builtin_amdgcn_cosf(rev); }
        FK[q] = (_Float16)v;
    }
}

__device__ __forceinline__ void phase0(const Params& p, unsigned char* lds) {
    constexpr int I_WIN = 16 * 72, I_WOUT = 16 * 32, I_W1 = 32 * 16 * 16, I_W2 = 32 * 8 * 32;
    constexpr int NTR = I_WIN + I_WOUT + 2 * I_W1 + I_W2;
    for (int it = blockIdx.x; it < 64; it += gridDim.x) p0_tables(p, it);
    for (int it = blockIdx.x; it < 96; it += gridDim.x) p0_adaln(p, it, lds);
    for (int it = (blockIdx.x + 160) % gridDim.x; it < 256; it += gridDim.x) p0_taps(p, it, lds);
    __syncthreads();
    const int tidq = otid(), lane = tidq & 63, wid = tidq >> 6;
    float* scr = (float*)lds + wid * (64 * 33);
    constexpr int NA = 14720;
    const bool lightwg = blockIdx.x < 96 && gridDim.x > 96;
    const int nb2 = (gridDim.x > 96) ? (int)gridDim.x - 96 : (int)gridDim.x, bi2 = (gridDim.x > 96) ? (int)blockIdx.x - 96 : (int)blockIdx.x;
    for (int pass = 0; pass < 2; ++pass)
    for (int it = (pass == 0) ? (int)blockIdx.x * 8 + wid : NA + bi2 * 8 + wid; it < ((pass == 0) ? NA : NTR); it += ((pass == 0) ? (int)gridDim.x : nb2) * 8) {
        if (pass == 1 && lightwg) break;
        int r = it; const float* src; int N, k0, n0, dpitch, mode = 0; bf16_t* dst; bool f8 = false;
        if (r < I_WIN) { src = p.w_in; N = PROJW; k0 = (r / 72) * 64; n0 = (r % 72) * 32; dst = (bf16_t*)(p.ws + WS_WINT); dpitch = 1024; }
        else if ((r -= I_WIN) < I_WOUT) { src = p.w_out; N = 1024; k0 = (r / 32) * 64; n0 = (r % 32) * 32; dst = (bf16_t*)(p.ws + WS_WOUTT); dpitch = 1024; }
        else if ((r -= I_WOUT) < 2 * I_W1) { const int w3 = r >= I_W1; if (w3) r -= I_W1; const int e = r / 256, q = r % 256; src = (w3 ? p.exp_w3 : p.exp_w1) + (size_t)e * 1024 * 512; N = 512; k0 = (q / 16) * 64; n0 = (q % 16) * 32;
            dst = (bf16_t*)(p.ws + WS_EW13 + (size_t)e * 1024 * 1024); dpitch = 1024; mode = w3 ? 2 : 1; f8 = true; }
        else { r -= 2 * I_W1; const int e = r / 256, q = r % 256; src = p.exp_w2 + (size_t)e * 512 * 1024; N = 1024; k0 = (q / 32) * 64; n0 = (q % 32) * 32; dst = (bf16_t*)(p.ws + WS_EW2T + (size_t)e * 1024 * 512); dpitch = 512; f8 = true; }
        p0_transpose_w(src, N, k0, n0, dst, dpitch, mode, scr, lane, f8);
    }
}

__device__ __forceinline__ void norm_row(const Params& p, const float* xr, const float* md, bf16_t* orow, int lane) {
    f32x4 v[4]; float s = 0.f;
#pragma unroll
    for (int j = 0; j < 4; ++j) { v[j] = *(const f32x4*)(xr + 256 * j + lane * 4); s += v[j].x * v[j].x + v[j].y * v[j].y + v[j].z * v[j].z + v[j].w * v[j].w; }
    const float rstd = rsqrtf(wave_sum(s) * (1.f / 1024.f) + EPSN);
#pragma unroll
    for (int j = 0; j < 4; ++j) { const int k = 256 * j + lane * 4;
        const f32x4 nw = *(const f32x4*)(p.norm1_w + k), sh = *(const f32x4*)(md + k), sc = *(const f32x4*)(md + 1024 + k);
        const f32x4 y = (v[j] * rstd) * nw * (sc + 1.f) + sh;
        u32x2 o; o.x = pk2(y.x, y.y); o.y = pk2(y.z, y.w); *(u32x2*)(orow + k) = o; }
}
__device__ __forceinline__ void phase1(const Params& p, unsigned char* lds) {
    const int tidq = otid(), lane = tidq & 63, wid = tidq >> 6;
    const float* MOD = (const float*)(p.ws + WS_MOD);
    const int fr = lane & 15, fq = lane >> 4;
    for (int ct = blockIdx.x; ct < NCTX / 16; ct += gridDim.x) {
        bf16_t* As = (bf16_t*)lds;
        const bf16_t* WT = (const bf16_t*)(p.ws + WS_WINT); bf16_t* KVC = (bf16_t*)(p.ws + WS_KVC);
        __syncthreads();
        {   const float* md = MOD + (size_t)16 * 6144; f32x4 v[2][4]; float ss[2];
#pragma unroll
            for (int r = 0; r < 2; ++r)
#pragma unroll
                for (int j = 0; j < 4; ++j) v[r][j] = *(const f32x4*)(p.ctx + (size_t)(ct * 16 + 2 * wid + r) * 1024 + 256 * j + lane * 4);
#pragma unroll
            for (int r = 0; r < 2; ++r) { float q = 0.f;
#pragma unroll
                for (int j = 0; j < 4; ++j) q += v[r][j].x * v[r][j].x + v[r][j].y * v[r][j].y + v[r][j].z * v[r][j].z + v[r][j].w * v[r][j].w;
                ss[r] = wave_sum(q); }
#pragma unroll
            for (int j = 0; j < 4; ++j) { const int k = 256 * j + lane * 4;
                const f32x4 nw = *(const f32x4*)(p.norm1_w + k), sh = *(const f32x4*)(md + k), sc = *(const f32x4*)(md + 1024 + k); const f32x4 g = nw * (sc + 1.f);
#pragma unroll
                for (int r = 0; r < 2; ++r) { const float rstd = rsqrtf(ss[r] * (1.f / 1024.f) + EPSN); const f32x4 y = (v[r][j] * rstd) * g + sh;
                    u32x2 o; o.x = pk2(y.x, y.y); o.y = pk2(y.z, y.w); *(u32x2*)(As + (2 * wid + r) * 1032 + k) = o; } }
        }
        __syncthreads();
        f32x4 acc0 = (f32x4){0.f, 0.f, 0.f, 0.f}, acc1 = acc0;
        const bf16_t* b0 = WT + (size_t)(512 + 32 * wid + fr) * 1024 + 8 * fq; const bf16_t* b1 = b0 + 16 * 1024;
#pragma unroll 8
        for (int ks = 0; ks < 32; ++ks) {
            const bf16x8 af = *(const bf16x8*)(As + fr * 1032 + 32 * ks + 8 * fq);
            const bf16x8 bf0 = *(const bf16x8*)(b0 + 32 * ks), bf1 = *(const bf16x8*)(b1 + 32 * ks);
            acc0 = __builtin_amdgcn_mfma_f32_16x16x32_bf16(bf0, af, acc0, 0, 0, 0); acc1 = __builtin_amdgcn_mfma_f32_16x16x32_bf16(bf1, af, acc1, 0, 0, 0);
        }
        {   bf16_t* orow = KVC + (size_t)(ct * 16 + fr) * 256 + 32 * wid + 4 * fq;
            u32x2 o; o.x = pk2(acc0.x, acc0.y); o.y = pk2(acc0.z, acc0.w); *(u32x2*)(orow) = o;
            o.x = pk2(acc1.x, acc1.y); o.y = pk2(acc1.z, acc1.w); *(u32x2*)(orow + 16) = o; }
    }
    {
        const int nb = gridDim.x, bi = blockIdx.x;
        bf16_t* H = (bf16_t*)(p.ws + WS_H);
        for (int tq = bi * 8; tq < (NTOK / 256) * 8; tq += nb * 8) for (int row0 = (tq >> 3) * 256 + wid * 32 + (tq & 7) * 0; row0 < (tq >> 3) * 256 + wid * 32 + 32; row0 += 4) {
            f32x4 v[4][4]; float ss[4];
#pragma unroll
            for (int r = 0; r < 4; ++r)
#pragma unroll
                for (int j = 0; j < 4; ++j) v[r][j] = *(const f32x4*)(p.x + (size_t)(row0 + r) * 1024 + 256 * j + lane * 4);
#pragma unroll
            for (int r = 0; r < 4; ++r) { float s = 0.f;
#pragma unroll
                for (int j = 0; j < 4; ++j) s += v[r][j].x * v[r][j].x + v[r][j].y * v[r][j].y + v[r][j].z * v[r][j].z + v[r][j].w * v[r][j].w;
                ss[r] = s; }
#pragma unroll
            for (int r = 0; r < 4; ++r) ss[r] = wave_sum(ss[r]);
            const float* md = MOD + (size_t)(row0 >> 12) * 6144;
#pragma unroll
            for (int j = 0; j < 4; ++j) { const int k = 256 * j + lane * 4;
                const f32x4 nw = *(const f32x4*)(p.norm1_w + k), sh = *(const f32x4*)(md + k), sc = *(const f32x4*)(md + 1024 + k); const f32x4 g = nw * (sc + 1.f);
#pragma unroll
                for (int r = 0; r < 4; ++r) { const float rstd = rsqrtf(ss[r] * (1.f / 1024.f) + EPSN); const f32x4 y = (v[r][j] * rstd) * g + sh;
                    u32x2 o; o.x = pk2(y.x, y.y); o.y = pk2(y.z, y.w); *(u32x2*)(H + (size_t)(row0 + r) * 1024 + k) = o; } }
        }
    }
}

struct P2Sched { const char* H; const char* WT; int G, c;
    __device__ __forceinline__ bool next(int i, pg::UDesc& u) const { const int q = i * G + c; if (q >= 2304) return false;
        if (q < 768) { const int pm = q / 3, pn = q - 3 * pm; u.A = H + (size_t)pm * 256 * 2048; u.B0 = WT + (size_t)pn * 256 * 2048; u.i0 = 0; u.i1 = pm; u.i2 = pn; }
        else { const int v = q - 768, pn = v / 6, pm = v - 6 * pn; u.A = WT + (size_t)(768 + pm * 256) * 2048; u.B0 = H + (size_t)pn * 256 * 2048; u.i0 = 1; u.i1 = pm; u.i2 = pn; }
        u.B1 = u.B0 + 8 * 128; u.i3 = 0; return true; }
    __device__ __forceinline__ unsigned rowoff(const pg::UDesc&, int) const { return 0u; }
};
__device__ __forceinline__ void phase2(const Params& p, unsigned char* lds) {
    bf16_t* QKV = (bf16_t*)(p.ws + WS_QKV); _Float16* UT = (_Float16*)(p.ws + WS_UT);
    P2Sched S{(const char*)(p.ws + WS_H), (const char*)(p.ws + WS_WINT), (int)gridDim.x, vcu_of(blockIdx.x, gridDim.x)};
    auto E = [&](const f32x4 (&acc)[2][2][4][2], const pg::UDesc& u, int wr, int wc, int fr, int fq) {
        const int tok0 = u.i2 * 256, bb = tok0 >> 12, t0 = tok0 & 4095;
        unsigned short* base = u.i0 ? (unsigned short*)UT + ((size_t)(bb * 1536 + u.i1 * 256)) * 4096 + t0 : (unsigned short*)QKV + (size_t)(u.i1 * 256) * 768 + u.i2 * 256;
        const size_t pitch = u.i0 ? 4096 : 768; const bool f16o = u.i0 != 0;
        ACCP_FOREACH(acc, wr, wc, fr, fq, { u32x4 o;
            if (f16o) { o.x = pkh2(v0.x, v0.y); o.y = pkh2(v0.z, v0.w); o.z = pkh2(v1.x, v1.y); o.w = pkh2(v1.z, v1.w); }
            else { o.x = pk2(v0.x, v0.y); o.y = pk2(v0.z, v0.w); o.z = pk2(v1.x, v1.y); o.w = pk2(v1.z, v1.w); }
            *(u32x4*)(base + (size_t)rl * pitch + cl) = o; });
    };
    pg::gemm_stream<false, true, false>((LAS unsigned char*)lds, 2048, 2048, S, E);
}

__device__ __forceinline__ void phase3(const Params& p) {
    const int tidq = otid(), lane = tidq & 63, gw = blockIdx.x * 8 + (tidq >> 6), ngw = gridDim.x * 8;
    bf16_t* QKV = (bf16_t*)(p.ws + WS_QKV); bf16_t* KVC = (bf16_t*)(p.ws + WS_KVC);
    const float qw = p.q_norm_w[lane], kw = p.k_norm_w[lane];
    const int i16 = lane & 15; const float invf = exp2f(-(float)i16 * (13.287712379549449f / 16.f));
    float xn[10];
    if (gw < NTOK) {
#pragma unroll
        for (int hh = 0; hh < 10; ++hh) xn[hh] = bf2f(QKV[(size_t)gw * 768 + hh * 64 + lane]); }
    for (int row = gw; row < NTOK; row += ngw) {
        const int pos = row & 4095; const float ang = (float)((lane & 32) ? (pos & 63) : (pos >> 6)) * invf;
        const float cs = cos_rad(ang), sn = sin_rad(ang);
        bf16_t* rp = QKV + (size_t)row * 768;
        float xv[10], ss[10];
#pragma unroll
        for (int hh = 0; hh < 10; ++hh) { xv[hh] = xn[hh]; ss[hh] = xv[hh] * xv[hh]; }
        {   const int rn = (row + ngw < NTOK) ? row + ngw : row;
#pragma unroll
            for (int hh = 0; hh < 10; ++hh) xn[hh] = bf2f(QKV[(size_t)rn * 768 + hh * 64 + lane]); }
#pragma unroll
        for (int hh = 0; hh < 10; ++hh) ss[hh] = wave_sum(ss[hh]);
#pragma unroll
        for (int hh = 0; hh < 10; ++hh) {
            const float y = xv[hh] * rsqrtf(ss[hh] * (1.f / 64.f) + EPSN) * (hh < 8 ? qw : kw);
            const float pr = [&] { const unsigned uy = __builtin_bit_cast(unsigned, y); auto rr = __builtin_amdgcn_permlane16_swap(uy, uy, false, false); return (lane & 16) ? __builtin_bit_cast(float, (unsigned)rr[0]) : __builtin_bit_cast(float, (unsigned)rr[1]); }();
            const float o = (lane & 16) ? (y * cs + pr * sn) : (y * cs - pr * sn);
            rp[hh * 64 + lane] = (bf16_t)f2bf(hh < 8 ? o * (0.125f * 1.4426950408889634f) : o);
        }
    }
    for (int row = gw; row < NCTX; row += ngw) {
        bf16_t* rp = KVC + (size_t)row * 256;
        const float x0 = bf2f(rp[lane]), x1 = bf2f(rp[64 + lane]);
        const float r0 = rsqrtf(wave_sum(x0 * x0) * (1.f / 64.f) + EPSN), r1 = rsqrtf(wave_sum(x1 * x1) * (1.f / 64.f) + EPSN);
        rp[lane] = (bf16_t)f2bf(x0 * r0 * kw); rp[64 + lane] = (bf16_t)f2bf(x1 * r1 * kw);
    }
}

__device__ __forceinline__ void attn_unit(const Params& p, int u, unsigned char* lds) {
    const int tid = otid(), wid = tid >> 6, lane = tid & 63, fr = lane & 15, fq = lane >> 4;
    const int b = u >> 6, kvh = (u >> 5) & 1, qb = u & 31, q0 = qb * 128;
    const bf16_t* QKV = (const bf16_t*)(p.ws + WS_QKV); const bf16_t* KVC = (const bf16_t*)(p.ws + WS_KVC);
    bf16_t* ATT = (bf16_t*)(p.ws + WS_ATTHY);
    const int h = kvh * 4 + (wid >> 1), half = wid & 1, qrow0 = q0 + 64 * half;
    bf16x8 qf[4][2];
#pragma unroll
    for (int qt = 0; qt < 4; ++qt)
#pragma unroll
        for (int ks = 0; ks < 2; ++ks) qf[qt][ks] = *(const bf16x8*)(QKV + (size_t)(b * 4096 + qrow0 + 16 * qt + fr) * 768 + h * 64 + 32 * ks + 8 * fq);
    float mrow[4], lrow[4]; f32x4 ot[4][4];
    const float sink2 = p.attn_sink[h] * 1.4426950408889634f;
#pragma unroll
    for (int qt = 0; qt < 4; ++qt) { mrow[qt] = sink2; lrow[qt] = (fq == 0) ? 1.f : 0.f;
#pragma unroll
        for (int dt = 0; dt < 4; ++dt) ot[dt][qt] = (f32x4){0.f, 0.f, 0.f, 0.f}; }
    const int jlo = (qb == 0) ? 2 : 0, jhi = (qb == 31) ? 3 : 5, ntile = 4 + (jhi - jlo + 1);
    const int kr = tid >> 3, ch = tid & 7;
    auto krow_of = [&](int ti) -> const bf16_t* { return (ti < 4) ? KVC + (size_t)(b * 256 + ti * 64 + kr) * 256 + kvh * 64 + ch * 8 : QKV + (size_t)(b * 4096 + q0 - 128 + (ti - 4 + jlo) * 64 + kr) * 768 + KOFF + kvh * 64 + ch * 8; };
    u32x4 kreg = *(const u32x4*)krow_of(0), vreg = *(const u32x4*)(krow_of(0) + ((0 < 4) ? 128 : 128));
#pragma unroll 1
    for (int ti = 0; ti < ntile; ++ti) {
        const bool isctx = ti < 4; const int jb = ti - 4 + jlo;
        unsigned char* sK = lds + (ti & 1) * 18432;
        unsigned char* sV = sK + 64 * 144;
        {   *(u32x4*)(sK + kr * 144 + ch * 16) = kreg;
            bf16_t* sv = (bf16_t*)sV;
            sv[(ch * 8 + 0) * 72 + kr] = (bf16_t)(vreg.x & 0xffff); sv[(ch * 8 + 1) * 72 + kr] = (bf16_t)(vreg.x >> 16);
            sv[(ch * 8 + 2) * 72 + kr] = (bf16_t)(vreg.y & 0xffff); sv[(ch * 8 + 3) * 72 + kr] = (bf16_t)(vreg.y >> 16);
            sv[(ch * 8 + 4) * 72 + kr] = (bf16_t)(vreg.z & 0xffff); sv[(ch * 8 + 5) * 72 + kr] = (bf16_t)(vreg.z >> 16);
            sv[(ch * 8 + 6) * 72 + kr] = (bf16_t)(vreg.w & 0xffff); sv[(ch * 8 + 7) * 72 + kr] = (bf16_t)(vreg.w >> 16); }
        if (ti + 1 < ntile) { const bf16_t* kp = krow_of(ti + 1); kreg = *(const u32x4*)kp; vreg = *(const u32x4*)(kp + 128); }
        __syncthreads();
        const int rel = jb - 2 - half;
        const bool skip = !isctx && (rel < -2 || rel > 2), partial = !isctx && (rel == -2 || rel == 2);
        if (!skip) {
            f32x4 st[4][4];
#pragma unroll
            for (int kt = 0; kt < 4; ++kt) {
                const bf16x8 k0 = *(const bf16x8*)(sK + (16 * kt + fr) * 144 + fq * 16), k1 = *(const bf16x8*)(sK + (16 * kt + fr) * 144 + 64 + fq * 16);
#pragma unroll
                for (int qt = 0; qt < 4; ++qt) { f32x4 z = (f32x4){0.f, 0.f, 0.f, 0.f};
                    z = __builtin_amdgcn_mfma_f32_16x16x32_bf16(k0, qf[qt][0], z, 0, 0, 0); z = __builtin_amdgcn_mfma_f32_16x16x32_bf16(k1, qf[qt][1], z, 0, 0, 0); st[kt][qt] = z; }
            }
            if (partial) {
                const int kbase = q0 - 128 + 64 * jb;
#pragma unroll
                for (int qt = 0; qt < 4; ++qt) { const int qpos = qrow0 + 16 * qt + fr;
#pragma unroll
                    for (int kt = 0; kt < 4; ++kt)
#pragma unroll
                        for (int r = 0; r < 4; ++r) { const int dd = kbase + 16 * kt + 4 * fq + r - qpos; if (dd > 128 || dd < -128) st[kt][qt][r] = -1e30f; } }
            }
            float alpha[4]; bool grew = false;
#pragma unroll
            for (int qt = 0; qt < 4; ++qt) {
                float t0 = fmaxf(fmaxf(st[0][qt][0], st[0][qt][1]), fmaxf(st[0][qt][2], st[0][qt][3]));
#pragma unroll
                for (int kt = 1; kt < 4; ++kt) t0 = fmaxf(t0, fmaxf(fmaxf(st[kt][qt][0], st[kt][qt][1]), fmaxf(st[kt][qt][2], st[kt][qt][3])));
                t0 = max_fq(t0);
                const float mnew = fmaxf(mrow[qt], t0); alpha[qt] = exp2_raw(mrow[qt] - mnew); grew = grew || (mnew > mrow[qt]); mrow[qt] = mnew;
                float ls = 0.f;
#pragma unroll
                for (int kt = 0; kt < 4; ++kt)
#pragma unroll
                    for (int r = 0; r < 4; ++r) { const float pv = exp2_raw(st[kt][qt][r] - mnew); st[kt][qt][r] = pv; ls += pv; }
                lrow[qt] = lrow[qt] * alpha[qt] + ls;
            }
            if (__any(grew)) {
#pragma unroll
                for (int qt = 0; qt < 4; ++qt)
#pragma unroll
                    for (int dt = 0; dt < 4; ++dt) ot[dt][qt] = ot[dt][qt] * alpha[qt];
            }
#pragma unroll
            for (int ks = 0; ks < 2; ++ks) {
                bf16x8 pf[4];
#pragma unroll
                for (int qt = 0; qt < 4; ++qt) { const f32x4 a = st[2 * ks][qt], c = st[2 * ks + 1][qt];
                    u32x4 w; w.x = pk2(a.x, a.y); w.y = pk2(a.z, a.w); w.z = pk2(c.x, c.y); w.w = pk2(c.z, c.w); pf[qt] = __builtin_bit_cast(bf16x8, w); }
#pragma unroll
                for (int dt = 0; dt < 4; ++dt) {
                    const u32x2 v0 = *(const u32x2*)(sV + (16 * dt + fr) * 144 + (32 * ks + 4 * fq) * 2), v1 = *(const u32x2*)(sV + (16 * dt + fr) * 144 + (32 * ks + 16 + 4 * fq) * 2);
                    u32x4 w; w.x = v0.x; w.y = v0.y; w.z = v1.x; w.w = v1.y; const bf16x8 vf = __builtin_bit_cast(bf16x8, w);
#pragma unroll
                    for (int qt = 0; qt < 4; ++qt) ot[dt][qt] = __builtin_amdgcn_mfma_f32_16x16x32_bf16(vf, pf[qt], ot[dt][qt], 0, 0, 0);
                }
            }
        }
    }
#pragma unroll
    for (int qt = 0; qt < 4; ++qt) {
        float l = lrow[qt]; l += __shfl_xor(l, 16); l += __shfl_xor(l, 32);
        const float inv = 1.f / l;
        bf16_t* orow = ATT + (size_t)(b * 4096 + qrow0 + 16 * qt + fr) * 1024 + h * 64;
#pragma unroll
        for (int dt = 0; dt < 4; ++dt) { const f32x4 o = ot[dt][qt] * inv; u32x2 w; w.x = pk2(o.x, o.y); w.y = pk2(o.z, o.w); *(u32x2*)(orow + 16 * dt + 4 * fq) = w; }
    }
    __syncthreads();
}

__device__ __forceinline__ void khat_items(const Params& p, unsigned char* lds) {
    const int tid = otid(), wid = tid >> 6, lane = tid & 63, fr = lane & 15, fq = lane >> 4;
    _Float16* TT = (_Float16*)lds;
    _Float16* FKL = (_Float16*)(lds + 34816);
    const _Float16* FK = (const _Float16*)(p.ws + WS_FKTAB);
    __syncthreads();
    for (int i = tid; i < 128 * 136 / 2; i += NTHR) ((unsigned*)lds)[i] = 0u;
    for (int i = tid; i < 128 * 16; i += NTHR) { const int r = i >> 4, c8 = i & 15; *(u32x4*)(FKL + r * 136 + c8 * 8) = *(const u32x4*)(FK + r * 128 + c8 * 8); }
    int it = blockIdx.x;
    f32x4 tv[4];
    if (it < 1024) {
#pragma unroll
        for (int q = 0; q < 4; ++q) tv[q] = *(const f32x4*)((const float*)(p.ws + WS_TAPS) + (size_t)it * 8192 + tid * 16 + q * 4); }
    __syncthreads();
    for (; it < 1024; it += gridDim.x) {
#pragma unroll
        for (int q = 0; q < 4; ++q) { const int i0 = tid * 16 + q * 4;
#pragma unroll
            for (int e = 0; e < 4; ++e) { const int i = i0 + e, i1 = i >> 6, i2 = i & 63; const _Float16 h = (_Float16)tv[q][e];
                if (i1 >= 1) TT[(i2 + 63) * 136 + i1] = h;
                if (i2 >= 1 && i1 + 1 < 128) TT[(i2 - 1) * 136 + i1 + 1] = h; } }
        {   const int itn = (it + (int)gridDim.x < 1024) ? it + (int)gridDim.x : it;
#pragma unroll
            for (int q = 0; q < 4; ++q) tv[q] = *(const f32x4*)((const float*)(p.ws + WS_TAPS) + (size_t)itn * 8192 + tid * 16 + q * 4); }
        __syncthreads();
        f16x8 af[4];
#pragma unroll
        for (int ks = 0; ks < 4; ++ks) af[ks] = *(const f16x8*)(TT + (16 * wid + fr) * 136 + 32 * ks + 8 * fq);
        _Float16* KH = (_Float16*)(p.ws + WS_KH) + (size_t)it * (64 * 2 * 128);
#pragma unroll
        for (int nt = 0; nt < 8; ++nt) {
            f32x4 acc = (f32x4){0.f, 0.f, 0.f, 0.f};
#pragma unroll
            for (int ks = 0; ks < 4; ++ks) { const f16x8 bfv = *(const f16x8*)(FKL + (16 * nt + fr) * 136 + 32 * ks + 8 * fq); acc = __builtin_amdgcn_mfma_f32_16x16x32_f16(af[ks], bfv, acc, 0, 0, 0); }
            const int rho = 16 * nt + fr; u32x2 o; o.x = pkh2(acc[3], acc[2]); o.y = pkh2(acc[1], acc[0]);
            *(u32x2*)(KH + (size_t)rho * 128 + (124 - 16 * wid - 4 * fq)) = o;
        }
        __syncthreads();
    }
}

constexpr int HY_ZB = 0, HY_ZH = 73728, HY_ZHF = 1160  , HY_OH = HY_ZH + 8 * HY_ZHF * 2, HY_GT = HY_OH + 8 * 65 * 40  , HY_KC = HY_GT + 8 * 4608, HY_LDS_END = HY_KC + 8 * 576;
struct __attribute__((aligned(4))) hq4 { unsigned a, b, c, d; };
__device__ __forceinline__ f16x8 neg8(f16x8 v) { u32x4 w = __builtin_bit_cast(u32x4, v); w.x ^= 0x80008000u; w.y ^= 0x80008000u; w.z ^= 0x80008000u; w.w ^= 0x80008000u; return __builtin_bit_cast(f16x8, w); }
struct HyRow { u32x4 r[8]; };
__device__ __forceinline__ void hy_row_load(HyRow& R, const _Float16* ur, const int lane) {
#pragma unroll
    for (int i8 = 0; i8 < 8; ++i8) R.r[i8] = *(const u32x4*)(ur + 8 * (lane + 64 * i8));
}
__device__ __forceinline__ void hy_row_finish(const HyRow& R, const float w0, const float w1, const float w2, const float bb, _Float16* XG, const int lane) {
#pragma unroll
    for (int i8 = 0; i8 < 8; ++i8) { const int t0 = 8 * (lane + 64 * i8); float uv[10];
        unsigned oldl = 0u, oldr = 0u;
        if (i8 > 0) oldl = (unsigned)__builtin_amdgcn_readlane((int)R.r[i8 - 1].w, 63);
        if (i8 < 7) oldr = (unsigned)__builtin_amdgcn_readlane((int)R.r[i8 + 1].x, 0);
        const unsigned lw = (unsigned)__builtin_amdgcn_update_dpp((int)oldl, (int)R.r[i8].w, 0x138, 0xf, 0xf, false);
        const unsigned rw = (unsigned)__builtin_amdgcn_update_dpp((int)oldr, (int)R.r[i8].x, 0x130, 0xf, 0xf, false);
        uv[0] = hhi(lw); uv[9] = hlo(rw);
        uv[1] = hlo(R.r[i8].x); uv[2] = hhi(R.r[i8].x); uv[3] = hlo(R.r[i8].y); uv[4] = hhi(R.r[i8].y); uv[5] = hlo(R.r[i8].z); uv[6] = hhi(R.r[i8].z); uv[7] = hlo(R.r[i8].w); uv[8] = hhi(R.r[i8].w);
        float y[8];
#pragma unroll
        for (int i = 0; i < 8; ++i) y[i] = bb + uv[i] * w0 + uv[i + 1] * w1 + uv[i + 2] * w2;
        u32x4 w; w.x = pkh2(y[0], y[1]); w.y = pkh2(y[2], y[3]); w.z = pkh2(y[4], y[5]); w.w = pkh2(y[6], y[7]);
        *(u32x4*)(XG + (t0 >> 6) * 72 + (t0 & 63)) = w; }
}
__device__ __forceinline__ void hyena_item(const Params& p, const int it, const int itn, unsigned char* lds, HyRow& rr) {
    const int tid = otid(), wid = tid >> 6, lane = tid & 63, fr = lane & 15, fq = lane >> 4;
    const int c = it >> 1, b = (it & 1) * 8 + wid;
    _Float16* XG = (_Float16*)(lds + HY_ZB) + wid * (64 * 72);
    _Float16* ZH = (_Float16*)(lds + HY_ZH);
    _Float16* OH = (_Float16*)(lds + HY_OH);
    _Float16* GTW = (_Float16*)(lds + HY_GT) + wid * 2304;
    _Float16* KC = (_Float16*)(lds + HY_KC) + wid * 288;
    const _Float16* UT = (const _Float16*)(p.ws + WS_UT); const _Float16* FT = (const _Float16*)(p.ws + WS_FTAB); const _Float16* GT = (const _Float16*)(p.ws + WS_GTAB);
    bf16_t* HYT = (bf16_t*)(p.ws + WS_HYT);
    __syncthreads();
    if (lane < 32) KC[(lane >> 4) * 144 + 128 + (lane & 15)] = (_Float16)0.f;
    f16x4 id16;
#pragma unroll
    for (int i = 0; i < 4; ++i) id16[i] = (4 * fq + i == fr) ? (_Float16)1.f : (_Float16)0.f;
    u32x4 zf[4][2];
    HyRow rg; hy_row_load(rg, UT + ((size_t)(b * 1536 + 512 + c)) * 4096, lane);
    hy_row_finish(rr, p.hy_conv_w[c], p.hy_conv_w[1536 + c], p.hy_conv_w[3072 + c], p.hy_conv_b[c], XG, lane);
#pragma unroll
    for (int mt = 0; mt < 4; ++mt)
#pragma unroll
        for (int nt = 0; nt < 4; ++nt) { const u32x2 v = *(const u32x2*)(XG + (16 * nt + fr) * 72 + 16 * mt + 4 * fq);
            const f32x4 cT = __builtin_amdgcn_mfma_f32_16x16x16f16(__builtin_bit_cast(f16x4, v), id16, (f32x4){0.f, 0.f, 0.f, 0.f}, 0, 0, 0);
            if (nt & 1) { zf[mt][nt >> 1].z = pkh2(cT[0], cT[1]); zf[mt][nt >> 1].w = pkh2(cT[2], cT[3]); } else { zf[mt][nt >> 1].x = pkh2(cT[0], cT[1]); zf[mt][nt >> 1].y = pkh2(cT[2], cT[3]); }
        }
    hy_row_finish(rg, p.hy_conv_w[512 + c], p.hy_conv_w[1536 + 512 + c], p.hy_conv_w[3072 + 512 + c], p.hy_conv_b[512 + c], XG, lane);
#pragma unroll 1
    for (int o = 0; o < 2; ++o) {
        f32x4 accI[4][4];
#pragma unroll
        for (int mt = 0; mt < 4; ++mt)
#pragma unroll
            for (int nt = 0; nt < 4; ++nt) accI[mt][nt] = (f32x4){0.f, 0.f, 0.f, 0.f};
        const _Float16* KHo = (const _Float16*)(p.ws + WS_KH) + (size_t)(o * 512 + c) * (64 * 2 * 128);
        u32x4 kcn = (u32x4){0u, 0u, 0u, 0u}; f16x8 ffn[2];
        if (lane < 32) kcn = *(const u32x4*)(KHo + (size_t)wid * 256 + lane * 8);
#pragma unroll
        for (int ks = 0; ks < 2; ++ks) { const f16x4 lo = *(const f16x4*)(FT + fr * 64 + 32 * ks + 4 * fq), hi = *(const f16x4*)(FT + fr * 64 + 32 * ks + 16 + 4 * fq); ffn[ks] = __builtin_shufflevector(lo, hi, 0, 1, 2, 3, 4, 5, 6, 7); }
#pragma unroll 1
        for (int j = 0; j < 8; ++j) {
            const int f = 8 * j + wid;
            const u32x4 kcc = kcn; f16x8 ff[2]; f16x4 gf[4];
#pragma unroll
            for (int ks = 0; ks < 2; ++ks) ff[ks] = ffn[ks];
#pragma unroll
            for (int nt = 0; nt < 4; ++nt) gf[nt] = *(const f16x4*)(GT + (16 * nt + fr) * 128 + 16 * j + 4 * fq);
            if (j < 7) {
                if (lane < 32) kcn = *(const u32x4*)(KHo + (size_t)(f + 8) * 256 + lane * 8);
#pragma unroll
                for (int ks = 0; ks < 2; ++ks) { const f16x4 lo = *(const f16x4*)(FT + (16 * (j + 1) + fr) * 64 + 32 * ks + 4 * fq), hi = *(const f16x4*)(FT + (16 * (j + 1) + fr) * 64 + 32 * ks + 16 + 4 * fq); ffn[ks] = __builtin_shufflevector(lo, hi, 0, 1, 2, 3, 4, 5, 6, 7); }
            }
            if (lane < 32) *(u32x4*)(KC + (lane >> 4) * 144 + (lane & 15) * 8) = kcc;
            {   const int x = lane >> 5, q = (lane >> 1) & 15, sh = lane & 1;
                const u32x2* src = (const u32x2*)(KC + x * 144 + 8 * q + 4 * sh);
                const u32x2 r0 = src[0], r1 = src[1], r2 = src[2];
                const unsigned d0 = r0.x, d1 = r0.y, d2 = r1.x, d3 = r1.y, d4 = r2.x, d5 = r2.y;
                const unsigned a0 = __builtin_amdgcn_alignbit(d1, d0, 16), a1 = __builtin_amdgcn_alignbit(d2, d1, 16), a2 = __builtin_amdgcn_alignbit(d3, d2, 16), a3 = __builtin_amdgcn_alignbit(d4, d3, 16), a4 = __builtin_amdgcn_alignbit(d5, d4, 16);
                _Float16* dst = GTW + ((x * 8 + 4 * sh) * 18 + q) * 8;
                *(u32x4*)(dst) = (u32x4){a0, a1, a2, a3}; *(u32x4*)(dst + 144) = (u32x4){d1, d2, d3, d4};
                *(u32x4*)(dst + 288) = (u32x4){a1, a2, a3, a4}; *(u32x4*)(dst + 432) = (u32x4){d2, d3, d4, d5}; }
            {
#pragma unroll
                for (int mt = 0; mt < 4; ++mt) { f32x4 a = (f32x4){0.f, 0.f, 0.f, 0.f};
                    a = __builtin_amdgcn_mfma_f32_16x16x32_f16(__builtin_bit_cast(f16x8, zf[mt][0]), ff[0], a, 0, 0, 0); a = __builtin_amdgcn_mfma_f32_16x16x32_f16(__builtin_bit_cast(f16x8, zf[mt][1]), ff[1], a, 0, 0, 0);
                    u32x2 w; w.x = pkh2(a[0], a[1]); w.y = pkh2(a[2], a[3]);
                    *(u32x2*)(ZH + (fr >> 1) * HY_ZHF + (wid * 2 + (fr & 1)) * 72 + 16 * mt + 4 * fq) = w; }
            }
            __syncthreads();
            {   const int bb = fr >> 1, part = fr & 1;
                f16x8 a1[2], a2[2];
#pragma unroll
                for (int ks = 0; ks < 2; ++ks) {
                    const f16x8 s1v = *(const f16x8*)(ZH + wid * HY_ZHF + (bb * 2 + part) * 72 + 32 * ks + 8 * fq);
                    const f16x8 s2v = *(const f16x8*)(ZH + wid * HY_ZHF + (bb * 2 + (1 - part)) * 72 + 32 * ks + 8 * fq);
                    const f16x8 zero = (f16x8){0, 0, 0, 0, 0, 0, 0, 0};
                    if (f == 0) { a1[ks] = part ? zero : s1v; a2[ks] = part ? s1v : zero; }
                    else { a1[ks] = s1v; a2[ks] = part ? s2v : neg8(s2v); }
                }
                const int sg = 7 - (fr & 7), qb = 7 - (fr >> 3) + fq;
                f32x4 am[4];
#pragma unroll
                for (int nt = 0; nt < 4; ++nt) am[nt] = (f32x4){0.f, 0.f, 0.f, 0.f};
#pragma unroll
                for (int wi = 0; wi < 6; ++wi) { const int w = 2 * wi - 6;
                    const f16x8 b1 = *(const f16x8*)(GTW + ((0 * 8 + sg) * 18 + qb + w) * 8);
                    const f16x8 b2 = *(const f16x8*)(GTW + ((1 * 8 + sg) * 18 + qb + w) * 8);
#pragma unroll
                    for (int ks = 0; ks < 2; ++ks) { const int nt = (4 * ks - w) / 2;
                        if (nt >= 0 && nt < 4) { am[nt] = __builtin_amdgcn_mfma_f32_16x16x32_f16(a1[ks], b1, am[nt], 0, 0, 0); am[nt] = __builtin_amdgcn_mfma_f32_16x16x32_f16(a2[ks], b2, am[nt], 0, 0, 0); } } }
#pragma unroll
                for (int nt = 0; nt < 4; ++nt) { const int t2 = 16 * nt + fr;
                    *(unsigned*)(OH + ((2 * fq) * 65 + t2) * 20 + 2 * wid) = pkh2(am[nt][0], am[nt][1]);
                    *(unsigned*)(OH + ((2 * fq + 1) * 65 + t2) * 20 + 2 * wid) = pkh2(am[nt][2], am[nt][3]); }
            }
            __syncthreads();
            {
#pragma unroll
                for (int mt = 0; mt < 4; ++mt) { const f16x4 av = *(const f16x4*)(OH + (wid * 65 + 16 * mt + fr) * 20 + 4 * fq);
#pragma unroll
                    for (int nt = 0; nt < 4; ++nt) accI[mt][nt] = __builtin_amdgcn_mfma_f32_16x16x16f16(av, gf[nt], accI[mt][nt], 0, 0, 0); }
            }
        }
        {   const float sk = p.hy_skip[o * 512 + c];
            {   const int rown = (o == 0) ? (b * 1536 + 1024 + c) : (((itn & 1) * 8 + wid) * 1536 + (itn >> 1)); hy_row_load(rr, UT + (size_t)rown * 4096, lane); }
#pragma unroll
            for (int mt = 0; mt < 4; ++mt)
#pragma unroll
                for (int nt = 0; nt < 4; ++nt) {
                    _Float16* xp = XG + (16 * nt + fr) * 72 + 16 * mt + 4 * fq;
                    const u32x2 xr = *(const u32x2*)xp;
                    u32x2 zw; if (nt & 1) { zw.x = zf[mt][nt >> 1].z; zw.y = zf[mt][nt >> 1].w; } else { zw.x = zf[mt][nt >> 1].x; zw.y = zf[mt][nt >> 1].y; }
                    const f32x4 zo = __builtin_amdgcn_mfma_f32_16x16x16f16(__builtin_bit_cast(f16x4, zw), id16, (f32x4){0.f, 0.f, 0.f, 0.f}, 0, 0, 0);
                    float zn[4];
                    zn[0] = hlo(xr.x) * (accI[mt][nt][0] + sk * zo[0]); zn[1] = hhi(xr.x) * (accI[mt][nt][1] + sk * zo[1]);
                    zn[2] = hlo(xr.y) * (accI[mt][nt][2] + sk * zo[2]); zn[3] = hhi(xr.y) * (accI[mt][nt][3] + sk * zo[3]);
                    if (o == 0) {
                        u32x2 v; v.x = pkh2(zn[0], zn[1]); v.y = pkh2(zn[2], zn[3]);
                        const f32x4 cT = __builtin_amdgcn_mfma_f32_16x16x16f16(__builtin_bit_cast(f16x4, v), id16, (f32x4){0.f, 0.f, 0.f, 0.f}, 0, 0, 0);
                        if (nt & 1) { zf[mt][nt >> 1].z = pkh2(cT[0], cT[1]); zf[mt][nt >> 1].w = pkh2(cT[2], cT[3]); } else { zf[mt][nt >> 1].x = pkh2(cT[0], cT[1]); zf[mt][nt >> 1].y = pkh2(cT[2], cT[3]); }
                    } else { u32x2 w; w.x = pk2(zn[0], zn[1]); w.y = pk2(zn[2], zn[3]); *(u32x2*)xp = w; }
                }
            if (o == 0) hy_row_finish(rr, p.hy_conv_w[1024 + c], p.hy_conv_w[1536 + 1024 + c], p.hy_conv_w[3072 + 1024 + c], p.hy_conv_b[1024 + c], XG, lane);
            if (o == 1) {
                bf16_t* orow = HYT + ((size_t)(b * 512 + c)) * 4096;
#pragma unroll
                for (int i8 = 0; i8 < 8; ++i8) { const int t0 = 8 * (lane + 64 * i8); *(u32x4*)(orow + t0) = *(const u32x4*)(XG + (t0 >> 6) * 72 + (t0 & 63)); }
            }
        }
    }
}

__device__ __forceinline__ void phase5_item(const Params& p, int it, unsigned char* lds, u32x4 (&hv)[8], const int itn) {
    const int tid = otid(), b = it >> 6, t0 = (it & 63) * 64;
    bf16_t* TL = (bf16_t*)lds;
    float* RS = (float*)(lds + 512 * 66 * 2);
    float* RS2 = RS + 512;
    const bf16_t* HYT = (const bf16_t*)(p.ws + WS_HYT); bf16_t* AH = (bf16_t*)(p.ws + WS_ATTHY);
    __syncthreads();
    {
#pragma unroll
        for (int i = 0; i < 8; ++i) { const u32x4 v = hv[i]; unsigned* d = (unsigned*)(TL + tid * 66 + i * 8); d[0] = v.x; d[1] = v.y; d[2] = v.z; d[3] = v.w; }
        const bf16_t* srcn = HYT + ((size_t)((itn >> 6) * 512 + tid)) * 4096 + (itn & 63) * 64;
#pragma unroll
        for (int i = 0; i < 8; ++i) hv[i] = *(const u32x4*)(srcn + i * 8); }
    __syncthreads();
    {   const int tt = tid & 63, cg8 = tid >> 6; float s = 0.f;
#pragma unroll 16
        for (int cc = 0; cc < 64; ++cc) { const float v = bf2f(TL[(cg8 * 64 + cc) * 66 + tt]); s += v * v; }
        RS[cg8 * 64 + tt] = s; }
    __syncthreads();
    if (tid < 64) { float s = 0.f;
#pragma unroll
        for (int q = 0; q < 8; ++q) s += RS[q * 64 + tid];
        RS2[tid] = rsqrtf(s * (1.f / 512.f) + EPSN); }
    __syncthreads();
    {   const int tt = tid >> 3, ch = tid & 7; const float rstd = RS2[tt];
        bf16_t* orow = AH + (size_t)(b * 4096 + t0 + tt) * 1024;
        u32x4 av[8]; float s = 0.f;
#pragma unroll
        for (int g = 0; g < 8; ++g) av[g] = *(const u32x4*)(orow + g * 64 + ch * 8);
#pragma unroll
        for (int g = 0; g < 8; ++g) { const int c0 = g * 64 + ch * 8; float y[8]; const f32x4 gw0 = *(const f32x4*)(p.group_norm_w + 512 + c0), gw1 = *(const f32x4*)(p.group_norm_w + 512 + c0 + 4);
#pragma unroll
            for (int i = 0; i < 8; ++i) y[i] = bf2f(TL[(c0 + i) * 66 + tt]) * rstd * (i < 4 ? gw0[i] : gw1[i - 4]);
            u32x4 w; w.x = pk2(y[0], y[1]); w.y = pk2(y[2], y[3]); w.z = pk2(y[4], y[5]); w.w = pk2(y[6], y[7]); *(u32x4*)(orow + 512 + c0) = w; }
#pragma unroll
        for (int g = 0; g < 8; ++g) {
            const float a0 = bflo(av[g].x), a1 = bfhi(av[g].x), a2 = bflo(av[g].y), a3 = bfhi(av[g].y), a4 = bflo(av[g].z), a5 = bfhi(av[g].z), a6 = bflo(av[g].w), a7 = bfhi(av[g].w);
            s += a0 * a0 + a1 * a1 + a2 * a2 + a3 * a3 + a4 * a4 + a5 * a5 + a6 * a6 + a7 * a7; }
        s += dpp_f(s, DPP_XOR1); s += dpp_f(s, DPP_XOR2); s += dpp_f(s, DPP_HMIRROR);
        const float ra = rsqrtf(s * (1.f / 512.f) + EPSN);
#pragma unroll
        for (int g = 0; g < 8; ++g) { const int c0 = g * 64 + ch * 8; const f32x4 gw0 = *(const f32x4*)(p.group_norm_w + c0), gw1 = *(const f32x4*)(p.group_norm_w + c0 + 4);
            u32x4 w; w.x = pk2(bflo(av[g].x) * ra * gw0[0], bfhi(av[g].x) * ra * gw0[1]); w.y = pk2(bflo(av[g].y) * ra * gw0[2], bfhi(av[g].y) * ra * gw0[3]);
            w.z = pk2(bflo(av[g].z) * ra * gw1[0], bfhi(av[g].z) * ra * gw1[1]); w.w = pk2(bflo(av[g].w) * ra * gw1[2], bfhi(av[g].w) * ra * gw1[3]);
            *(u32x4*)(orow + c0) = w; }
    }
}

struct P6Sched { const char* AH; const char* WT; int G, c;
    __device__ __forceinline__ bool next(int i, pg::UDesc& u) const { const int q = i * G + c; if (q >= 1024) return false; const int pm = q >> 2, pn = q & 3;
        u.A = AH + (size_t)pm * 256 * 2048; u.B0 = WT + (size_t)pn * 256 * 2048; u.B1 = u.B0 + 8 * 128; u.i0 = 0; u.i1 = pm; u.i2 = pn; u.i3 = 0; return true; }
    __device__ __forceinline__ unsigned rowoff(const pg::UDesc&, int) const { return 0u; }
};
__device__ __forceinline__ void phase6(const Params& p, unsigned char* lds) {
    const float* MOD = (const float*)(p.ws + WS_MOD);
    P6Sched S{(const char*)(p.ws + WS_ATTHY), (const char*)(p.ws + WS_WOUTT), (int)gridDim.x, vcu_of(blockIdx.x, gridDim.x)};
    auto E = [&](const f32x4 (&acc)[2][2][4][2], const pg::UDesc& u, int wr, int wc, int fr, int fq) {
        const float* g1 = MOD + (size_t)((u.i1 * 256) >> 12) * 6144 + 2048 + u.i2 * 256 + 32 * wc + 8 * fq;
        f32x4 gv[2][2];
#pragma unroll
        for (int b = 0; b < 2; ++b)
#pragma unroll
            for (int n = 0; n < 2; ++n) gv[b][n] = *(const f32x4*)(g1 + 128 * b + 4 * n);
        bf16_t* D1 = (bf16_t*)(p.ws + WS_D1);
#pragma unroll
        for (int a = 0; a < 2; ++a)
#pragma unroll
            for (int m = 0; m < 4; ++m)
#pragma unroll
                for (int b = 0; b < 2; ++b) { const f32x4 v0 = acc[a][b][m][0] * gv[b][0], v1 = acc[a][b][m][1] * gv[b][1];
                    u32x4 o; o.x = pk2(v0.x, v0.y); o.y = pk2(v0.z, v0.w); o.z = pk2(v1.x, v1.y); o.w = pk2(v1.z, v1.w);
                    *(u32x4*)(D1 + (size_t)(u.i1 * 256 + 128 * a + 64 * wr + 16 * m + fr) * 1024 + u.i2 * 256 + 128 * b + 32 * wc + 8 * fq) = o; }
    };
    pg::gemm_stream<false, true, false>((LAS unsigned char*)lds, 2048, 2048, S, E);
}

__device__ __forceinline__ int pair_index(int lo, int hi) { return lo * 8 - (lo * (lo + 1)) / 2 + (hi - lo - 1); }
constexpr int P7_RW = 0, P7_HIST = 147456, P7_BASE = 147456 + 512, P7_TCLS = 147456 + 1024, P7_TRNK = 147456 + 2048, P7_TG = 147456 + 3072;
__device__ __forceinline__ void phase7(const Params& p, unsigned char* lds) {
    const int tid = otid(), lane = tid & 63, wid = tid >> 6;
    const float* MOD = (const float*)(p.ws + WS_MOD); bf16_t* H2 = (bf16_t*)(p.ws + WS_H);
    int* CNT = (int*)(p.ws + WS_CTL); int* LIST = (int*)(p.ws + WS_LIST); float* GATE = (float*)(p.ws + WS_GATE);
    float* RW = (float*)(lds + P7_RW); int* HIST = (int*)(lds + P7_HIST); int* BASE = (int*)(lds + P7_BASE); int* TCLS = (int*)(lds + P7_TCLS); int* TRNK = (int*)(lds + P7_TRNK);
    __syncthreads();
    {   float t[8];
#pragma unroll
        for (int q = 0; q < 8; ++q) t[q] = p.router_g_w[tid + NTHR * q];
#pragma unroll
        for (int q = 0; q < 8; ++q) { const int i = tid + NTHR * q, k = i >> 2, j = i & 3; RW[((k & 3) * 256 + (k >> 2)) * 36 + j] = t[q]; }
#pragma unroll 1
        for (int i0 = 0; i0 < 1024 * 32; i0 += NTHR * 16) { float u[16];
#pragma unroll
            for (int q = 0; q < 16; ++q) u[q] = p.router_e_w[i0 + tid + NTHR * q];
#pragma unroll
            for (int q = 0; q < 16; ++q) { const int i = i0 + tid + NTHR * q, k = i >> 5, j = i & 31; RW[((k & 3) * 256 + (k >> 2)) * 36 + 4 + j] = u[q]; } }
    }
    for (int tile = blockIdx.x; tile < NTOK / 256; tile += gridDim.x) {
        __syncthreads();
        if (tid < 128) HIST[tid] = 0;
        __syncthreads();
        f32x4 gk[4], shk[4];
#pragma unroll
        for (int j = 0; j < 4; ++j) { const int k = 256 * j + lane * 4; const float* md = MOD + (size_t)((tile * 256) >> 12) * 6144;
            gk[j] = *(const f32x4*)(p.norm2_w + k) * (*(const f32x4*)(md + 4096 + k) + 1.f); shk[j] = *(const f32x4*)(md + 3072 + k); }
        constexpr int RB = 2;
        const bf16_t* D1 = (const bf16_t*)(p.ws + WS_D1);
        f32x4 vn[RB][4]; u32x2 dn[RB][4];
#pragma unroll
        for (int q = 0; q < RB; ++q)
#pragma unroll
            for (int j = 0; j < 4; ++j) { const size_t o = (size_t)(tile * 256 + wid * 32 + q) * 1024 + 256 * j + lane * 4; vn[q][j] = *(const f32x4*)(p.x + o); dn[q][j] = *(const u32x2*)(D1 + o); }
#pragma unroll 1
        for (int rr = 0; rr < 32; rr += RB) {
            const int rl0 = wid * 32 + rr, row0 = tile * 256 + rl0;
            f32x4 v[RB][4]; float ss[RB];
#pragma unroll
            for (int q = 0; q < RB; ++q) { float s = 0.f;
#pragma unroll
                for (int j = 0; j < 4; ++j) { const f32x4 dl = (f32x4){bflo(dn[q][j].x), bfhi(dn[q][j].x), bflo(dn[q][j].y), bfhi(dn[q][j].y)}; v[q][j] = vn[q][j] + dl;
                    { u32x2 xb; xb.x = pk2(v[q][j].x, v[q][j].y); xb.y = pk2(v[q][j].z, v[q][j].w); *(u32x2*)((bf16_t*)(p.ws + WS_D1) + (size_t)(row0 + q) * 1024 + 256 * j + lane * 4) = xb; }
                    s += v[q][j].x * v[q][j].x + v[q][j].y * v[q][j].y + v[q][j].z * v[q][j].z + v[q][j].w * v[q][j].w; }
                ss[q] = s; }
            {   const int rp = (rr + RB < 32) ? row0 + RB : row0;
#pragma unroll
                for (int q = 0; q < RB; ++q)
#pragma unroll
                    for (int j = 0; j < 4; ++j) { const size_t o = (size_t)(rp + q) * 1024 + 256 * j + lane * 4; vn[q][j] = *(const f32x4*)(p.x + o); dn[q][j] = *(const u32x2*)(D1 + o); } }
#pragma unroll
            for (int q = 0; q < RB; ++q) ss[q] = wave_sum(ss[q]);
            float gl[RB][4];
#pragma unroll
            for (int q = 0; q < RB; ++q) { const float rstd = rsqrtf(ss[q] * (1.f / 1024.f) + EPSN);
#pragma unroll
                for (int e = 0; e < 4; ++e) gl[q][e] = 0.f;
#pragma unroll
                for (int j = 0; j < 4; ++j) { const int k = 256 * j + lane * 4;
                    const f32x4 y = (v[q][j] * rstd) * gk[j] + shk[j]; v[q][j] = y;
                    *(unsigned*)((unsigned char*)H2 + (size_t)(row0 + q) * 1024 + k) = pk4_fp8(fminf(fmaxf(y.x * FP8_XSCALE, -440.f), 440.f), fminf(fmaxf(y.y * FP8_XSCALE, -440.f), 440.f), fminf(fmaxf(y.z * FP8_XSCALE, -440.f), 440.f), fminf(fmaxf(y.w * FP8_XSCALE, -440.f), 440.f)); } }
#pragma unroll
            for (int j = 0; j < 4; ++j)
#pragma unroll
                for (int e = 0; e < 4; ++e) { const f32x4 w = *(const f32x4*)(RW + (e * 256 + 64 * j + lane) * 36);
#pragma unroll
                    for (int q = 0; q < RB; ++q) { const float ye = v[q][j][e]; gl[q][0] += ye * w.x; gl[q][1] += ye * w.y; gl[q][2] += ye * w.z; gl[q][3] += ye * w.w; } }
#pragma unroll
            for (int q = 0; q < RB; ++q)
#pragma unroll
                for (int e = 0; e < 4; ++e) gl[q][e] = wave_sum(gl[q][e]);
            int gsel[RB]; float gval[RB];
#pragma unroll
            for (int q = 0; q < RB; ++q) {
#pragma unroll
                for (int e = 0; e < 4; ++e) gl[q][e] += p.router_g_b[e];
                int g = 0; float gm = gl[q][0];
#pragma unroll
                for (int e = 1; e < 4; ++e) if (gl[q][e] > gm) { gm = gl[q][e]; g = e; }
                float gs = 0.f;
#pragma unroll
                for (int e = 0; e < 4; ++e) gs += __expf(gl[q][e] - gm);
                gsel[q] = g; gval[q] = 1.f / gs; }
            float el[RB][8];
#pragma unroll
            for (int q = 0; q < RB; ++q) {
#pragma unroll
                for (int e = 0; e < 8; ++e) el[q][e] = 0.f;
#pragma unroll
                for (int j = 0; j < 4; ++j)
#pragma unroll
                    for (int e = 0; e < 4; ++e) { const float* wr = RW + (e * 256 + 64 * j + lane) * 36 + 4 + gsel[q] * 8; const f32x4 w0 = *(const f32x4*)wr, w1 = *(const f32x4*)(wr + 4); const float ye = v[q][j][e];
                        el[q][0] += ye * w0.x; el[q][1] += ye * w0.y; el[q][2] += ye * w0.z; el[q][3] += ye * w0.w; el[q][4] += ye * w1.x; el[q][5] += ye * w1.y; el[q][6] += ye * w1.z; el[q][7] += ye * w1.w; } }
#pragma unroll
            for (int q = 0; q < RB; ++q)
#pragma unroll
                for (int e = 0; e < 8; ++e) el[q][e] = wave_sum(el[q][e]);
#pragma unroll
            for (int q = 0; q < RB; ++q) { const int g = gsel[q];
#pragma unroll
                for (int e = 0; e < 8; ++e) el[q][e] += p.router_e_b[g * 8 + e];
                int e1 = 0; float m1 = el[q][0];
#pragma unroll
                for (int e = 1; e < 8; ++e) if (el[q][e] > m1) { m1 = el[q][e]; e1 = e; }
                int e2 = -1; float m2 = -3.0e38f;
#pragma unroll
                for (int e = 0; e < 8; ++e) if (e != e1 && el[q][e] > m2) { m2 = el[q][e]; e2 = e; }
                const float r = __expf(m2 - m1), w1 = 1.f / (1.f + r), w2 = r / (1.f + r);
                if (lane == 0) {
                    const int lo = e1 < e2 ? e1 : e2, hi = e1 < e2 ? e2 : e1;
                    const int cls = g * 28 + pair_index(lo, hi);
                    TCLS[rl0 + q] = cls; TRNK[rl0 + q] = atomicAdd(HIST + cls, 1);
                    ((float*)(lds + P7_TG))[(rl0 + q) * 2] = gval[q] * (e1 < e2 ? w1 : w2); ((float*)(lds + P7_TG))[(rl0 + q) * 2 + 1] = gval[q] * (e1 < e2 ? w2 : w1);
                } }
        }
        __syncthreads();
        if (tid < NCLS) { const int n = HIST[tid]; BASE[tid] = n ? atomicAdd(CNT + tid, n) : 0; }
        __syncthreads();
        if (tid < 256) { const int cls = TCLS[tid]; const size_t slot = (size_t)cls * 65536 + BASE[cls] + TRNK[tid]; LIST[slot] = tile * 256 + tid;
            typedef float f32x2v __attribute__((ext_vector_type(2))); *(f32x2v*)((float*)(p.ws + WS_GSLOT) + slot * 2) = *(const f32x2v*)((const float*)(lds + P7_TG) + tid * 2); }
    }
}

constexpr int MOE_SM = 131072;
__device__ __forceinline__ void cls_decode(int cls, int& g, int& lo, int& hi) {
    g = cls / 28; int r = cls % 28; lo = 0; while (r >= 7 - lo) { r -= 7 - lo; ++lo; } hi = lo + 1 + r;
}
__device__ __forceinline__ void moe_build_map(const Params& p, int* sm) {
    const int* CNT = (const int*)(p.ws + WS_CTL);
    __syncthreads();
    if (threadIdx.x < NCLS) sm[128 + threadIdx.x] = CNT[threadIdx.x];
    __syncthreads();
    if (threadIdx.x == 0) { int base = 0; for (int c = 0; c < NCLS; ++c) { sm[c] = base; base += (sm[128 + c] + 255) >> 8; } sm[256] = base; }
    __syncthreads();
    if (threadIdx.x < NCLS) { const int c = threadIdx.x, b0 = sm[c], nt = (sm[128 + c] + 255) >> 8; for (int q = 0; q < nt; ++q) sm[384 + b0 + q] = c; }
    __syncthreads();
}
struct P8Sched { const char* H2; const char* EW13; const int* LIST; const int* sm; int G, c, NU;
    __device__ __forceinline__ bool next(int i, pg::UDesc& u) const { const int q = i * G + c; if (q >= NU) return false; const int mt = q >> 3, nj = q & 7, cls = sm[384 + mt]; int g, lo, hi; cls_decode(cls, g, lo, hi);
        const int e = g * 8 + (nj < 4 ? lo : hi);
        u.A = H2; u.B0 = EW13 + ((size_t)e * 1024 + (size_t)(nj & 3) * 256) * 1024; u.B1 = u.B0 + 4 * 128; u.i0 = cls; u.i1 = mt; u.i2 = nj; u.i3 = (mt - sm[cls]) * 256; return true; }
    __device__ __forceinline__ unsigned rowoff(const pg::UDesc& u, int r) const { const int rk = u.i3 + r; const int t = (rk < sm[128 + u.i0]) ? LIST[(size_t)u.i0 * 65536 + rk] : 0; return (unsigned)t * 1024u; }
};
__device__ __forceinline__ void phase8(const Params& p, unsigned char* lds) {
    int* sm = (int*)(lds + MOE_SM);
    moe_build_map(p, sm);
    bf16_t* HID = (bf16_t*)(p.ws + WS_HID); const int* LIST = (const int*)(p.ws + WS_LIST); const float* GSLOT = (const float*)(p.ws + WS_GSLOT);
    P8Sched S{(const char*)(p.ws + WS_H), (const char*)(p.ws + WS_EW13), LIST, sm, (int)gridDim.x, vcu_of(blockIdx.x, gridDim.x), sm[256] * 8};
    auto E = [&](const f32x4 (&acc)[2][2][4][2], const pg::UDesc& u, int wr, int wc, int fr, int fq) {
        const int cnt = sm[128 + u.i0], xh = u.i2 >> 2;
        const float USC = 1.f / (FP8_XSCALE * FP8_WSCALE);
#pragma unroll
        for (int a = 0; a < 2; ++a) {
            float gts[4];
#pragma unroll
            for (int m = 0; m < 4; ++m) { const int rk = u.i3 + 128 * a + 64 * wr + 16 * m + fr; const float g = GSLOT[((size_t)u.i0 * 65536 + (rk < cnt ? rk : 0)) * 2 + xh]; gts[m] = (rk < cnt) ? g * FP8_HSCALE : 0.f; }
#pragma unroll
            for (int m = 0; m < 4; ++m) { const int rl = 128 * a + 64 * wr + 16 * m + fr; const float gt = gts[m];
                float hv[8];
#pragma unroll
                for (int n = 0; n < 2; ++n)
#pragma unroll
                    for (int q = 0; q < 4; ++q) hv[4 * n + q] = fminf(fmaxf(silu_fast(acc[a][0][m][n][q] * USC) * (acc[a][1][m][n][q] * USC) * gt, -440.f), 440.f);
                u32x2 o; o.x = pk4_fp8(hv[0], hv[1], hv[2], hv[3]); o.y = pk4_fp8(hv[4], hv[5], hv[6], hv[7]);
                *(u32x2*)((unsigned char*)HID + (size_t)(u.i1 * 256 + rl) * 1024 + xh * 512 + (u.i2 & 3) * 128 + 32 * wc + 8 * fq) = o; }
        }
    };
    pg::gemm_stream<true, true, true>((LAS unsigned char*)lds, 1024, 1024, S, E);
}
struct P9Sched { const char* HID; const char* EW2T; const int* sm; int G, c, NU;
    __device__ __forceinline__ bool next(int i, pg::UDesc& u) const { const int q = i * G + c; if (q >= NU) return false; const int mt = q >> 2, pn = q & 3, cls = sm[384 + mt]; int g, lo, hi; cls_decode(cls, g, lo, hi);
        u.A = HID + (size_t)mt * 256 * 1024; u.B0 = EW2T + ((size_t)(g * 8 + lo) * 1024 + (size_t)pn * 256) * 512; u.B1 = EW2T + ((size_t)(g * 8 + hi) * 1024 + (size_t)pn * 256) * 512;
        u.i0 = cls; u.i1 = mt; u.i2 = pn; u.i3 = (mt - sm[cls]) * 256; return true; }
    __device__ __forceinline__ unsigned rowoff(const pg::UDesc&, int) const { return 0u; }
};
__device__ __forceinline__ void phase9(const Params& p, unsigned char* lds) {
    int* sm = (int*)(lds + MOE_SM);
    moe_build_map(p, sm);
    const int* LIST = (const int*)(p.ws + WS_LIST); const float* MOD = (const float*)(p.ws + WS_MOD);
    P9Sched S{(const char*)(p.ws + WS_HID), (const char*)(p.ws + WS_EW2T), sm, (int)gridDim.x, vcu_of(blockIdx.x, gridDim.x), sm[256] * 4};
    auto E = [&](const f32x4 (&acc)[2][2][4][2], const pg::UDesc& u, int wr, int wc, int fr, int fq) {
        const int cnt = sm[128 + u.i0];
        int tk[2][4];
#pragma unroll
        for (int a = 0; a < 2; ++a)
#pragma unroll
            for (int m = 0; m < 4; ++m) { const int rk = u.i3 + 128 * a + 64 * wr + 16 * m + fr; tk[a][m] = (rk < cnt) ? LIST[(size_t)u.i0 * 65536 + rk] : -1; }
#pragma unroll
        for (int a = 0; a < 2; ++a) {
            u32x2 x1[4][2][2];
#pragma unroll
            for (int m = 0; m < 4; ++m) { const int t = tk[a][m], ts = t < 0 ? 0 : t;
                const bf16_t* xrow = (const bf16_t*)(p.ws + WS_D1) + (size_t)ts * 1024 + u.i2 * 256 + 32 * wc + 4 * fq;
#pragma unroll
                for (int b = 0; b < 2; ++b)
#pragma unroll
                    for (int n = 0; n < 2; ++n) x1[m][b][n] = *(const u32x2*)(xrow + 128 * b + 16 * n); }
#pragma unroll
            for (int m = 0; m < 4; ++m) { const int t = tk[a][m], ts = t < 0 ? 0 : t;
                const float* g2 = MOD + (size_t)(ts >> 12) * 6144 + 5120 + u.i2 * 256 + 32 * wc + 4 * fq; float* orow = p.out + (size_t)ts * 1024 + u.i2 * 256 + 32 * wc + 4 * fq;
                f32x4 gv[2][2];
#pragma unroll
                for (int b = 0; b < 2; ++b)
#pragma unroll
                    for (int n = 0; n < 2; ++n) gv[b][n] = *(const f32x4*)(g2 + 128 * b + 16 * n);
                if (t >= 0) {
#pragma unroll
                    for (int b = 0; b < 2; ++b)
#pragma unroll
                        for (int n = 0; n < 2; ++n) { const f32x4 xf = (f32x4){bflo(x1[m][b][n].x), bfhi(x1[m][b][n].x), bflo(x1[m][b][n].y), bfhi(x1[m][b][n].y)};
                            *(f32x4*)(orow + 128 * b + 16 * n) = xf + gv[b][n] * (acc[a][b][m][n] * (1.f / (FP8_HSCALE * FP8_WSCALE))); } } }
        }
    };
    pg::gemm_stream<false, false, true>((LAS unsigned char*)lds, 1024, 512, S, E);
}

#define XB_TMO      128
#define XB_XCNT(j)  (256  + 64 * (j))
#define XB_XSUB(j)  (1280 + 64 * (j))
#define XB_XGEN(j)  (2304 + 64 * (j))
#define XB_TOP      3328
#define XB_TOPGEN   3392
#define XCD_BAR_WORDS 3456
#define XB_SPIN_CAP (1u << 18)

__device__ __forceinline__ unsigned xb_ld(unsigned* p)              { return __hip_atomic_load(p, __ATOMIC_RELAXED, __HIP_MEMORY_SCOPE_AGENT); }
__device__ __forceinline__ unsigned xb_add(unsigned* p, unsigned v) { return __hip_atomic_fetch_add(p, v, __ATOMIC_RELAXED, __HIP_MEMORY_SCOPE_AGENT); }
__device__ __forceinline__ unsigned xb_xcc_id() { return (unsigned)__builtin_amdgcn_s_getreg((3 << 11) | 20) & 0xFu; }
#define XB_SPIN(cond, bar) do { unsigned _sp = 0; while (cond) { __builtin_amdgcn_s_sleep(1); \
    if ((++_sp & 255u) == 0u) { if (xb_ld(&(bar)[XB_TMO])) break; if (_sp > XB_SPIN_CAP) { atomicAdd(&(bar)[XB_TMO], 1u); break; } } } } while (0)

struct XcdBarrier {
    unsigned* bar; unsigned x;
    volatile LAS unsigned* st;
};

__device__ __forceinline__ XcdBarrier xcd_barrier_post(unsigned* bar, volatile LAS unsigned* st) {
    XcdBarrier b; b.bar = bar; b.x = xb_xcc_id(); b.st = st;
    if (threadIdx.x == 0) (void)xb_add(&bar[XB_XCNT(b.x)], 1u);
    return b;
}
__device__ __forceinline__ void xcd_barrier_complete(unsigned* bar, unsigned x, unsigned& nloc, unsigned& nx) {
    const unsigned G = gridDim.x * gridDim.y * gridDim.z;
    unsigned sum, cnt, mine, sp = 0u;
    for (;;) {
        sum = 0u; cnt = 0u; mine = 0u;
#pragma unroll
        for (unsigned j = 0; j < 16; ++j) { const unsigned c = xb_ld(&bar[XB_XCNT(j)]); sum += c; cnt += (c > 0u) ? 1u : 0u; mine = (j == x) ? c : mine; }
        if (sum == G) break;
        __builtin_amdgcn_s_sleep(1);
        if ((++sp & 255u) == 0u) { if (xb_ld(&bar[XB_TMO])) break; if (sp > XB_SPIN_CAP) { atomicAdd(&bar[XB_TMO], 1u); break; } }
    }
    nloc = mine > 0u ? mine : 1u; nx = cnt > 0u ? cnt : 1u;
}

__device__ __forceinline__ void xcd_barrier(const XcdBarrier& b) {
    asm volatile("s_waitcnt vmcnt(0)" ::: "memory");
    __syncthreads();
    if (threadIdx.x == 0) {
        unsigned* bar = b.bar;
        __builtin_amdgcn_s_waitcnt(0);
        unsigned nloc = b.st[0], nx = b.st[1];
        if (nloc == 0u) { xcd_barrier_complete(bar, b.x, nloc, nx); b.st[0] = nloc; b.st[1] = nx; }
        const unsigned old = xb_add(&bar[XB_XSUB(b.x)], 1u);
        const unsigned gen = old / nloc;
        if (old + 1u == (gen + 1u) * nloc) {
            __builtin_amdgcn_fence(__ATOMIC_RELEASE, "agent");
            asm volatile("s_waitcnt vmcnt(0)" ::: "memory");
            const unsigned og = xb_add(&bar[XB_TOP], 1u);
            const unsigned tg = og / nx;
            if (og + 1u == (tg + 1u) * nx) xb_add(&bar[XB_TOPGEN], 1u);
            else XB_SPIN(xb_ld(&bar[XB_TOPGEN]) == tg, bar);
            __builtin_amdgcn_fence(__ATOMIC_ACQUIRE, "agent");
            xb_add(&bar[XB_XGEN(b.x)], 1u);
            asm volatile("s_waitcnt vmcnt(0)" ::: "memory");
        } else {
            XB_SPIN(xb_ld(&bar[XB_XGEN(b.x)]) == gen, bar);
            __builtin_amdgcn_fence(__ATOMIC_ACQUIRE, "agent");
            asm volatile("s_waitcnt vmcnt(0)" ::: "memory");
        }
    }
    __syncthreads();
}


constexpr int LDS_BYTES = 152 * 1024;
#ifdef PROBE_A
#define TSTAMP(k) do { if (blockIdx.x == 0 && threadIdx.x == 0) ((unsigned long long*)(p.ws + WS_CTL + 4096))[k] = __builtin_amdgcn_s_memrealtime(); } while (0)
#else
#define TSTAMP(k) do { } while (0)
#endif
__global__ void __launch_bounds__(NTHR, 2) fwd_kernel(Params p) {
    extern __shared__ __attribute__((aligned(16))) unsigned char lds[];
    cg::grid_group grid = cg::this_grid();
    volatile LAS unsigned* bst = (volatile LAS unsigned*)((LAS unsigned char*)lds + LDS_BYTES - 16);
    if (threadIdx.x < 2) bst[threadIdx.x] = 0u;
    if (blockIdx.x == 0) { if (threadIdx.x < 128) ((int*)(p.ws + WS_CTL))[threadIdx.x] = 0; for (int i = threadIdx.x; i < 3456; i += NTHR) ((unsigned*)(p.ws + WS_BAR))[i] = 0u; }
    grid.sync();
    const XcdBarrier bar = xcd_barrier_post((unsigned*)(p.ws + WS_BAR), bst);
    TSTAMP(0);
    phase0(p, lds);
    xcd_barrier(bar); TSTAMP(1);
    phase1(p, lds);
    khat_items(p, lds);
    xcd_barrier(bar); TSTAMP(2);
    phase2(p, lds);
    xcd_barrier(bar); TSTAMP(3);
    phase3(p);
    xcd_barrier(bar); TSTAMP(4);
    for (int u = blockIdx.x; u < 1024; u += gridDim.x) attn_unit(p, u, lds);
    TSTAMP(5);
    {   HyRow rr; int it = blockIdx.x;
        if (it < 1024) hy_row_load(rr, (const _Float16*)(p.ws + WS_UT) + ((size_t)(((it & 1) * 8 + (otid() >> 6)) * 1536 + (it >> 1))) * 4096, otid() & 63);
        for (; it < 1024; it += gridDim.x) { const int itn = (it + (int)gridDim.x < 1024) ? it + (int)gridDim.x : it; hyena_item(p, it, itn, lds, rr); } }
    xcd_barrier(bar); TSTAMP(6);
    {   u32x4 hv[8]; const int tq5 = otid();
        if (blockIdx.x < 1024) { const bf16_t* src0 = (const bf16_t*)(p.ws + WS_HYT) + ((size_t)((blockIdx.x >> 6) * 512 + tq5)) * 4096 + (blockIdx.x & 63) * 64;
#pragma unroll
            for (int i = 0; i < 8; ++i) hv[i] = *(const u32x4*)(src0 + i * 8); }
        for (int it = blockIdx.x; it < 1024; it += gridDim.x) phase5_item(p, it, lds, hv, (it + (int)gridDim.x < 1024) ? it + (int)gridDim.x : it); }
    xcd_barrier(bar); TSTAMP(7);
    phase6(p, lds);
    xcd_barrier(bar); TSTAMP(8);
    phase7(p, lds);
    xcd_barrier(bar); TSTAMP(9);
    phase8(p, lds);
    xcd_barrier(bar); TSTAMP(10);
    phase9(p, lds);
#ifdef PROBE_A
    xcd_barrier(bar); TSTAMP(11);
    if (blockIdx.x == 0) {
        __threadfence(); __syncthreads();
        const volatile unsigned long long* ts = (const volatile unsigned long long*)(p.ws + WS_CTL + 4096);
        const float ta = (float)(ts[PROBE_A] - ts[PROBE_A - 1]) * 0.01f, tb = (float)(ts[PROBE_B] - ts[PROBE_B - 1]) * 0.0001f;
        for (int i = threadIdx.x; i < (1 << 20); i += NTHR) p.out[1024 + i] += tb;
        if (threadIdx.x == 0) p.out[0] += ta;
    }
#endif
}

extern "C" void kernel_launch(void* const* d_in, const int* in_sizes, int n_in, void* d_out, int out_size, void* d_ws, size_t ws_size, hipStream_t stream) {
    static int grid_blocks = 0;
    if (grid_blocks == 0) {
        if (n_in != 30 || out_size != NTOK * DM || ws_size < WS_END) { fprintf(stderr, "kernel_launch: unexpected shapes (n_in %d out %d ws %zu)\n", n_in, out_size, ws_size); grid_blocks = -1; return; }
        int dev = 0, cus = 0, per_cu = 0;
        hipGetDevice(&dev); hipDeviceGetAttribute(&cus, hipDeviceAttributeMultiprocessorCount, dev);
        hipFuncSetAttribute((const void*)fwd_kernel, hipFuncAttributeMaxDynamicSharedMemorySize, LDS_BYTES);
        hipOccupancyMaxActiveBlocksPerMultiprocessor(&per_cu, (const void*)fwd_kernel, NTHR, LDS_BYTES);
        if (per_cu < 1) { fprintf(stderr, "kernel_launch: occupancy query says %d blocks per CU\n", per_cu); grid_blocks = -1; return; }
        grid_blocks = cus * per_cu;
    }
    if (grid_blocks < 0) return;
    Params p{};
    const float** pp = (const float**)&p;
    for (int i = 0; i < 30; ++i) pp[i] = (const float*)d_in[i];
    p.out = (float*)d_out; p.ws = (unsigned char*)d_ws;
    void* args[] = {&p};
    hipError_t e = hipLaunchCooperativeKernel((const void*)fwd_kernel, dim3(grid_blocks), dim3(NTHR), args, LDS_BYTES, stream);
    if (e != hipSuccess) fprintf(stderr, "cooperative launch failed: %s (grid %d)\n", hipGetErrorString(e), grid_blocks);
}
```

```cpp
#include <hip/hip_runtime.h>
#include <hip/hip_cooperative_groups.h>
#include <cstdio>
#include <cstdint>
namespace cg = cooperative_groups;

typedef unsigned short bf16_t;
typedef short bf16x8 __attribute__((ext_vector_type(8)));
typedef float f32x4 __attribute__((ext_vector_type(4)));
typedef unsigned u32x4 __attribute__((ext_vector_type(4)));
typedef unsigned u32x2 __attribute__((ext_vector_type(2)));
typedef _Float16 f16x8 __attribute__((ext_vector_type(8)));
typedef _Float16 f16x4 __attribute__((ext_vector_type(4)));
typedef _Float16 f16x2 __attribute__((ext_vector_type(2)));

constexpr int DM = 1024, NB = 16, SEQ = 4096, NTOK = NB * SEQ, CTXL = 256, NCTX = NB * CTXL;
constexpr int PROJW = 2304, HYW = 512, HYPW = 1536, KOFF = 512, VOFF = 640, HYOFF = 768;
constexpr int NEXP = 32, EHID = 512, NCLS = 112;
constexpr float EPSN = 1e-6f;
constexpr int NTHR = 512;

constexpr size_t MiB = 1u << 20;
constexpr size_t WS_CTL = 0, WS_MOD = 1 * MiB, WS_WINT = 2 * MiB, WS_WOUTT = 7 * MiB, WS_TAPS = 9 * MiB, WS_EW13 = 41 * MiB, WS_EW2T = 105 * MiB;
constexpr size_t WS_GATE = 137 * MiB, WS_KVC = 139 * MiB, WS_HC = 141 * MiB, WS_LIST = 149 * MiB, WS_H = 177 * MiB, WS_QKV = 305 * MiB, WS_UT = 401 * MiB;
constexpr size_t WS_HYT = 593 * MiB, WS_ATTHY = 657 * MiB, WS_HID = 305 * MiB, WS_KH = 785 * MiB, WS_END = 1003 * MiB;
constexpr size_t WS_BAR = 16384;
constexpr size_t WS_GSLOT = 945 * MiB;
constexpr size_t WS_D1 = 817 * MiB;
constexpr size_t WS_FTAB = 65536, WS_GTAB = 81920, WS_FKTAB = 98304;

struct Params {
    const float* x; const float* c; const float* ctx; const float* c_ctx; const float* ada_w; const float* ada_b; const float* norm1_w; const float* w_in;
    const float* q_norm_w; const float* k_norm_w; const float* attn_sink; const float* hy_conv_w; const float* hy_conv_b; const float* hy_w1; const float* hy_b1;
    const float* hy_w2; const float* hy_b2; const float* hy_w3; const float* hy_sin_freq; const float* hy_skip; const float* group_norm_w; const float* w_out;
    const float* norm2_w; const float* router_g_w; const float* router_g_b; const float* router_e_w; const float* router_e_b; const float* exp_w1; const float* exp_w3;
    const float* exp_w2;
    float* out; unsigned char* ws;
};

__device__ __forceinline__ unsigned f2bf(float f) { unsigned u = __builtin_bit_cast(unsigned, f); return (u + 0x7fffu + ((u >> 16) & 1u)) >> 16; }
typedef float f32x2_t __attribute__((ext_vector_type(2))); typedef __bf16 bf16x2_t __attribute__((ext_vector_type(2)));
__device__ __forceinline__ unsigned pk2(float lo, float hi) { f32x2_t v = {lo, hi}; bf16x2_t b = __builtin_convertvector(v, bf16x2_t); return __builtin_bit_cast(unsigned, b); }
__device__ __forceinline__ float bf2f(unsigned short b) { return __builtin_bit_cast(float, (unsigned)b << 16); }
__device__ __forceinline__ float bflo(unsigned w) { return __builtin_bit_cast(float, w << 16); }
__device__ __forceinline__ float bfhi(unsigned w) { return __builtin_bit_cast(float, w & 0xffff0000u); }
__device__ __forceinline__ unsigned pkh2(float lo, float hi) { f16x2 v = {(_Float16)lo, (_Float16)hi}; return __builtin_bit_cast(unsigned, v); }
__device__ __forceinline__ float h2f(unsigned short h) { return (float)__builtin_bit_cast(_Float16, h); }
__device__ __forceinline__ float hlo(unsigned w) { return h2f((unsigned short)(w & 0xffffu)); }
__device__ __forceinline__ float hhi(unsigned w) { return h2f((unsigned short)(w >> 16)); }
#define dpp_f(v, ctrl) __builtin_bit_cast(float, __builtin_amdgcn_update_dpp(0, __builtin_bit_cast(int, (float)(v)), (ctrl), 0xf, 0xf, false))
#define DPP_XOR1 0xB1
#define DPP_XOR2 0x4E
#define DPP_HMIRROR 0x141
#define DPP_MIRROR 0x140
__device__ __forceinline__ float xor16_sum(float v) { const unsigned u = __builtin_bit_cast(unsigned, v); auto r = __builtin_amdgcn_permlane16_swap(u, u, false, false); return __builtin_bit_cast(float, (unsigned)r[0]) + __builtin_bit_cast(float, (unsigned)r[1]); }
__device__ __forceinline__ float xor32_sum(float v) { const unsigned u = __builtin_bit_cast(unsigned, v); auto r = __builtin_amdgcn_permlane32_swap(u, u, false, false); return __builtin_bit_cast(float, (unsigned)r[0]) + __builtin_bit_cast(float, (unsigned)r[1]); }
__device__ __forceinline__ float wave_sum(float v) {
    v += dpp_f(v, DPP_XOR1); v += dpp_f(v, DPP_XOR2); v += dpp_f(v, DPP_HMIRROR); v += dpp_f(v, DPP_MIRROR);
    v = xor16_sum(v); v = xor32_sum(v);
    return v;
}
__device__ __forceinline__ int otid() { int t = threadIdx.x; asm volatile("" : "+v"(t)); return t; }
__device__ __forceinline__ float exp2_raw(float x) { float r; asm volatile("v_exp_f32 %0, %1\n\ts_nop 1" : "=v"(r) : "v"(x)); return r; }
__device__ __forceinline__ float max_fq(float m) { const unsigned u = __builtin_bit_cast(unsigned, m);
    auto r16 = __builtin_amdgcn_permlane16_swap(u, u, false, false); float a = fmaxf(__builtin_bit_cast(float, (unsigned)r16[0]), __builtin_bit_cast(float, (unsigned)r16[1]));
    const unsigned ua = __builtin_bit_cast(unsigned, a); auto r32 = __builtin_amdgcn_permlane32_swap(ua, ua, false, false); return fmaxf(__builtin_bit_cast(float, (unsigned)r32[0]), __builtin_bit_cast(float, (unsigned)r32[1])); }
__device__ __forceinline__ float siluf(float v) { return v / (1.f + __expf(-v)); }
__device__ __forceinline__ float rcp_raw(float x) { float r; asm volatile("v_rcp_f32 %0, %1\n\ts_nop 1" : "=v"(r) : "v"(x)); return r; }
__device__ __forceinline__ float silu_fast(float v) { return v * rcp_raw(1.f + exp2_raw(v * -1.4426950408889634f)); }
__device__ __forceinline__ float sin_rad(float a) { float r = a * 0.15915494309189535f; r -= floorf(r); return __builtin_amdgcn_sinf(r); }
__device__ __forceinline__ float cos_rad(float a) { float r = a * 0.15915494309189535f; r -= floorf(r); return __builtin_amdgcn_cosf(r); }

template <class SrcA, class SrcB>
__device__ __forceinline__ void gemm_unit(unsigned char* lds, f32x4 (&acc)[2][2][4][2], const SrcA& srcA, const SrcB& srcB) {
    const int tid = otid(), wid = tid >> 6, lane = tid & 63, wr = wid >> 2, wc = wid & 3, fr = lane & 15, fq = lane >> 4;
#pragma unroll
    for (int a = 0; a < 2; ++a)
#pragma unroll
        for (int b = 0; b < 2; ++b)
#pragma unroll
            for (int m = 0; m < 4; ++m)
#pragma unroll
                for (int n = 0; n < 2; ++n) acc[a][b][m][n] = (f32x4){0.f, 0.f, 0.f, 0.f};
    const int r0 = tid >> 2, kc = tid & 3;
    const bf16_t* pa0 = srcA(r0) + kc * 8; const bf16_t* pa1 = srcA(r0 + 128) + kc * 8;
    u32x4 ra0, ra1, rb0, rb1;
    ra0 = *(const u32x4*)(pa0); ra1 = *(const u32x4*)(pa1);
    rb0 = *(const u32x4*)(srcB(r0, 0) + kc * 8); rb1 = *(const u32x4*)(srcB(r0 + 128, 0) + kc * 8);
    unsigned char* sA = lds; unsigned char* sB = lds + 16384;
    for (int ks = 0; ks < 32; ++ks) {
        __syncthreads();
        *(u32x4*)(sA + tid * 16) = ra0; *(u32x4*)(sA + 8192 + tid * 16) = ra1;
        *(u32x4*)(sB + tid * 16) = rb0; *(u32x4*)(sB + 8192 + tid * 16) = rb1;
        __syncthreads();
        if (ks + 1 < 32) {
            ra0 = *(const u32x4*)(pa0 + (ks + 1) * 32); ra1 = *(const u32x4*)(pa1 + (ks + 1) * 32);
            rb0 = *(const u32x4*)(srcB(r0, ks + 1) + kc * 8); rb1 = *(const u32x4*)(srcB(r0 + 128, ks + 1) + kc * 8);
        }
        bf16x8 Af[2][4], Bf[2][2];
#pragma unroll
        for (int a = 0; a < 2; ++a)
#pragma unroll
            for (int m = 0; m < 4; ++m) Af[a][m] = *(const bf16x8*)(sA + (128 * a + 64 * wr + 16 * m + fr) * 64 + fq * 16);
#pragma unroll
        for (int b = 0; b < 2; ++b)
#pragma unroll
            for (int n = 0; n < 2; ++n) Bf[b][n] = *(const bf16x8*)(sB + (128 * b + 32 * wc + 16 * n + fr) * 64 + fq * 16);
#pragma unroll
        for (int a = 0; a < 2; ++a)
#pragma unroll
            for (int b = 0; b < 2; ++b)
#pragma unroll
                for (int m = 0; m < 4; ++m)
#pragma unroll
                    for (int n = 0; n < 2; ++n) acc[a][b][m][n] = __builtin_amdgcn_mfma_f32_16x16x32_bf16(Bf[b][n], Af[a][m], acc[a][b][m][n], 0, 0, 0);
    }
}
#define ACC_FOREACH(acc, BODY) do { \
    const int _wid = threadIdx.x >> 6, _lane = threadIdx.x & 63, _wr = _wid >> 2, _wc = _wid & 3, _fr = _lane & 15, _fq = _lane >> 4; \
    _Pragma("unroll") for (int _a = 0; _a < 2; ++_a) _Pragma("unroll") for (int _m = 0; _m < 4; ++_m) _Pragma("unroll") for (int _b = 0; _b < 2; ++_b) _Pragma("unroll") for (int _n = 0; _n < 2; ++_n) { \
        const int rl = 128 * _a + 64 * _wr + 16 * _m + _fr, cl = 128 * _b + 32 * _wc + 16 * _n + 4 * _fq; const f32x4 v = acc[_a][_b][_m][_n]; BODY } } while (0)


#define LAS __attribute__((address_space(3)))
namespace pg {
constexpr int HTB = 16384;
__device__ __forceinline__ int lds_byte(int r, int c) { const int st = (r >> 4) * 2 + (c >> 5), rr = r & 15, cc = c & 31, ob = rr * 64 + cc * 2; return st * 1024 + (ob ^ (((ob >> 9) & 1) << 5)); }
__device__ __forceinline__ void stage_rc(int b, int& R, int& C) { const int st = b / 1024, sb = b % 1024, swz = sb ^ (((sb >> 9) & 1) << 5); R = (st >> 1) * 16 + swz / 64; C = (st & 1) * 32 + (swz % 64) / 2; }
__device__ __forceinline__ int perm32(int rho) { const int n = rho >> 4, i = rho & 15; return 8 * (i >> 2) + 4 * n + (i & 3); }
struct UDesc { const char* A; const char* B0; const char* B1; int i0, i1, i2, i3; };
typedef int v8i_t __attribute__((ext_vector_type(8)));
template <bool GATHER, bool PERM, bool FP8, class Sched, class Epi>
__device__ __forceinline__ void gemm_stream(LAS unsigned char* lds, const int KA, const int KB, const Sched& S, const Epi& E) {
    const int tid = otid(), wid = __builtin_amdgcn_readfirstlane(tid >> 6), lane = tid & 63, wr = wid >> 2, wc = wid & 3, fr = lane & 15, fq = lane >> 4;
    constexpr int nt = FP8 ? 8 : 16, nth = nt / 2;
    unsigned voffA[2], voffB[2]; int rowA[2]; unsigned colA[2];
#pragma unroll
    for (int i = 0; i < 2; ++i) { int R, C; stage_rc(tid * 16 + i * 8192, R, C); const int Rb = PERM ? ((R & ~31) + perm32(R & 31)) : R;
        voffA[i] = (unsigned)(R * KA + C * 2); voffB[i] = (unsigned)(Rb * KB + C * 2); rowA[i] = R; colA[i] = (unsigned)C * 2u; }
    const size_t hstepA = (size_t)128 * KA, hstepB = (size_t)128 * KB;
    const unsigned ldsw = (unsigned)wid * 1024u;
    const int aoff = lds_byte(wr * 64 + fr, fq * 8), boff = lds_byte(wc * 32 + fr, fq * 8);
    const int aoff8a = lds_byte(wr * 64 + fr, fq * 16), aoff8b = aoff8a + 16, boff8a = lds_byte(wc * 32 + fr, fq * 16), boff8b = boff8a + 16;
#define PG_SA(b, h) (((b) * 2 + (h)) * pg::HTB)
#define PG_SB(b, h) ((4 + (b) * 2 + (h)) * pg::HTB)
#define PG_LD2(bufoff, p0, p1) do { __builtin_amdgcn_global_load_lds((const unsigned*)(p0), (LAS unsigned*)(lds + (bufoff) + ldsw), 16, 0, 0); \
        __builtin_amdgcn_global_load_lds((const unsigned*)(p1), (LAS unsigned*)(lds + (bufoff) + ldsw + 8192), 16, 0, 0); } while (0)
#define PG_STA(bufoff, pa, VA, h) do { if (GATHER) PG_LD2(bufoff, (pa) + ((h) ? VA##10 : VA##00), (pa) + ((h) ? VA##11 : VA##01)); else { const char* _b = (pa) + (h) * hstepA; PG_LD2(bufoff, _b + voffA[0], _b + voffA[1]); } } while (0)
#define PG_STB(bufoff, pb, h) do { const char* _b = (pb) + (h) * hstepB; PG_LD2(bufoff, _b + voffB[0], _b + voffB[1]); } while (0)
#define PG_LD8(p0, p1) __builtin_bit_cast(v8i_t, __builtin_shufflevector(*(const LAS bf16x8*)(p0), *(const LAS bf16x8*)(p1), 0, 1, 2, 3, 4, 5, 6, 7, 8, 9, 10, 11, 12, 13, 14, 15))
#define PG_LDA(dst, b, h) do { _Pragma("unroll") for (int m = 0; m < 4; ++m) { if (FP8) dst##8[m] = PG_LD8(lds + PG_SA(b, h) + aoff8a + m * 2048, lds + PG_SA(b, h) + aoff8b + m * 2048); \
        else { _Pragma("unroll") for (int k = 0; k < 2; ++k) dst[m][k] = *(const LAS bf16x8*)(lds + PG_SA(b, h) + aoff + m * 2048 + k * 1024); } } } while (0)
#define PG_LDB(dst, b, h) do { _Pragma("unroll") for (int n = 0; n < 2; ++n) { if (FP8) dst##8[n] = PG_LD8(lds + PG_SB(b, h) + boff8a + n * 2048, lds + PG_SB(b, h) + boff8b + n * 2048); \
        else { _Pragma("unroll") for (int k = 0; k < 2; ++k) dst[n][k] = *(const LAS bf16x8*)(lds + PG_SB(b, h) + boff + n * 2048 + k * 1024); } } } while (0)
#define PG_MMA(ai, bj, At, Bt) do { __builtin_amdgcn_s_setprio(1); _Pragma("unroll") for (int m = 0; m < 4; ++m) _Pragma("unroll") for (int n = 0; n < 2; ++n) { \
        if (FP8) asm volatile("v_mfma_f32_16x16x128_f8f6f4 %0, %1, %2, %0" : "+v"(acc[ai][bj][m][n]) : "v"(Bt##8[n]), "v"(At##8[m])); \
        else { _Pragma("unroll") for (int k = 0; k < 2; ++k) acc[ai][bj][m][n] = __builtin_amdgcn_mfma_f32_16x16x32_bf16(Bt[n][k], At[m][k], acc[ai][bj][m][n], 0, 0, 0); } } __builtin_amdgcn_s_setprio(0); } while (0)
#define PG_WAIT_V(n) asm volatile("s_waitcnt vmcnt(" #n ")" ::: "memory")
#define PG_WAIT_L(n) asm volatile("s_waitcnt lgkmcnt(" #n ")" ::: "memory")
#define PG_BAR __builtin_amdgcn_s_barrier()
#define PG_SCHED __builtin_amdgcn_sched_barrier(0)
    UDesc cur, nxt; int ui = 0;
    unsigned cva00 = 0, cva01 = 0, cva10 = 0, cva11 = 0, nva00 = 0, nva01 = 0, nva10 = 0, nva11 = 0;
    if (!S.next(0, cur)) return;
    if (GATHER) { int R0, C0, R1, C1; stage_rc(otid() * 16, R0, C0); stage_rc(otid() * 16 + 8192, R1, C1);
        cva00 = S.rowoff(cur, R0) + C0 * 2; cva01 = S.rowoff(cur, R1) + C1 * 2; cva10 = S.rowoff(cur, 128 + R0) + C0 * 2; cva11 = S.rowoff(cur, 128 + R1) + C1 * 2; }
    f32x4 acc[2][2][4][2];
#pragma unroll
    for (int a = 0; a < 2; ++a)
#pragma unroll
        for (int b = 0; b < 2; ++b)
#pragma unroll
            for (int m = 0; m < 4; ++m)
#pragma unroll
                for (int n = 0; n < 2; ++n) acc[a][b][m][n] = (f32x4){0.f, 0.f, 0.f, 0.f};
    bf16x8 At[4][2], B0[2][2], B1[2][2]; v8i_t At8[4], B08[2], B18[2];
    PG_STB(PG_SB(0, 0), cur.B0, 0); PG_STB(PG_SB(0, 1), cur.B0, 1); PG_STA(PG_SA(0, 0), cur.A, cva, 0); PG_STA(PG_SA(0, 1), cur.A, cva, 1);
    if (wr == 1) PG_BAR;
    PG_WAIT_V(2); PG_BAR;
    PG_STB(PG_SB(1, 0), cur.B0 + 128, 0); PG_STA(PG_SA(1, 0), cur.A + 128, cva, 0); PG_STB(PG_SB(1, 1), cur.B0 + 128, 1);
    PG_WAIT_V(6); PG_BAR;
    for (;;) {
        const bool has_next = S.next(ui + 1, nxt);
        if (!has_next) nxt = cur;
        if (GATHER) { if (has_next) { int R0, C0, R1, C1; stage_rc(otid() * 16, R0, C0); stage_rc(otid() * 16 + 8192, R1, C1);
                nva00 = S.rowoff(nxt, R0) + C0 * 2; nva01 = S.rowoff(nxt, R1) + C1 * 2; nva10 = S.rowoff(nxt, 128 + R0) + C0 * 2; nva11 = S.rowoff(nxt, 128 + R1) + C1 * 2; }
            else { nva00 = cva00; nva01 = cva01; nva10 = cva10; nva11 = cva11; } }
        for (int t = 0; t < nt; t += 2) {
            const bool last = (t == nt - 2);
            const char* a1 = cur.A + (size_t)(t + 1) * 128;
            const char* a2 = last ? nxt.A : cur.A + (size_t)(t + 2) * 128;
            const char* b2 = last ? nxt.B0 : ((t + 2 < nth) ? cur.B0 + (size_t)(t + 2) * 128 : cur.B1 + (size_t)(t + 2 - nth) * 128);
            const char* a3 = a2 + 128; const char* b3 = b2 + 128;
            PG_LDB(B0, 0, 0); PG_LDB(B1, 0, 1); PG_SCHED; PG_LDA(At, 0, 0); PG_STA(PG_SA(1, 1), a1, cva, 1);
            if (GATHER && last) { cva00 = nva00; cva01 = nva01; cva10 = nva10; cva11 = nva11; }
            PG_WAIT_V(8); PG_WAIT_L(0); PG_BAR; PG_MMA(0, 0, At, B0); PG_MMA(0, 1, At, B1); PG_BAR; PG_SCHED;
            PG_LDA(At, 0, 1); PG_STB(PG_SB(0, 0), b2, 0); PG_STB(PG_SB(0, 1), b2, 1); PG_STA(PG_SA(0, 0), a2, cva, 0);
            PG_WAIT_V(8); PG_WAIT_L(0); PG_BAR; PG_MMA(1, 0, At, B0); PG_MMA(1, 1, At, B1); PG_BAR; PG_SCHED;
            PG_LDB(B0, 1, 0); PG_LDB(B1, 1, 1); PG_SCHED; PG_LDA(At, 1, 0); PG_STA(PG_SA(0, 1), a2, cva, 1);
            PG_WAIT_V(8); PG_WAIT_L(0); PG_BAR; PG_MMA(0, 0, At, B0); PG_MMA(0, 1, At, B1); PG_BAR; PG_SCHED;
            PG_LDA(At, 1, 1); PG_STB(PG_SB(1, 0), b3, 0); PG_STB(PG_SB(1, 1), b3, 1); PG_STA(PG_SA(1, 0), a3, cva, 0);
            PG_WAIT_V(8); PG_WAIT_L(0); PG_BAR; PG_MMA(1, 0, At, B0); PG_MMA(1, 1, At, B1); PG_BAR; PG_SCHED;
        }
        if (wr == 0) PG_BAR;
        if (FP8) asm volatile("s_nop 15\n\ts_nop 15" ::: "memory");
        E(acc, cur, wr, wc, fr, fq);
        if (!has_next) break;
#pragma unroll
        for (int a = 0; a < 2; ++a)
#pragma unroll
            for (int b = 0; b < 2; ++b)
#pragma unroll
                for (int m = 0; m < 4; ++m)
#pragma unroll
                    for (int n = 0; n < 2; ++n) acc[a][b][m][n] = (f32x4){0.f, 0.f, 0.f, 0.f};
        cur = nxt; ++ui;
        if (wr == 1) PG_BAR;
    }
    PG_WAIT_V(0);
    PG_BAR;
#undef PG_SA
#undef PG_SB
#undef PG_LD2
#undef PG_STA
#undef PG_STB
#undef PG_LDA
#undef PG_LDB
#undef PG_MMA
#undef PG_WAIT_V
#undef PG_WAIT_L
#undef PG_BAR
#undef PG_SCHED
}
}
#define ACCP_FOREACH(acc, wr, wc, fr, fq, BODY) do { \
    _Pragma("unroll") for (int _a = 0; _a < 2; ++_a) _Pragma("unroll") for (int _m = 0; _m < 4; ++_m) _Pragma("unroll") for (int _b = 0; _b < 2; ++_b) { \
        const int rl = 128 * _a + 64 * (wr) + 16 * _m + (fr), cl = 128 * _b + 32 * (wc) + 8 * (fq); const f32x4 v0 = acc[_a][_b][_m][0], v1 = acc[_a][_b][_m][1]; BODY } } while (0)
#define ACCN_FOREACH(acc, wr, wc, fr, fq, BODY) do { \
    _Pragma("unroll") for (int _a = 0; _a < 2; ++_a) _Pragma("unroll") for (int _m = 0; _m < 4; ++_m) _Pragma("unroll") for (int _b = 0; _b < 2; ++_b) _Pragma("unroll") for (int _n = 0; _n < 2; ++_n) { \
        const int rl = 128 * _a + 64 * (wr) + 16 * _m + (fr), cl = 128 * _b + 32 * (wc) + 16 * _n + 4 * (fq); const f32x4 v = acc[_a][_b][_m][_n]; BODY } } while (0)
__device__ __forceinline__ int vcu_of(int bx, int G) { return (G % 8 == 0) ? (bx % 8) * (G / 8) + bx / 8 : bx; }

__device__ __forceinline__ void p0_adaln(const Params& p, int it, unsigned char* lds) {
    float* S = (float*)lds;
    float* R = (float*)(lds + 17 * 1024 * 4);
    const int tid = otid();
    __syncthreads();
    {   float cv[34];
#pragma unroll
        for (int q = 0; q < 34; ++q) { const int i = tid + NTHR * q, r = i >> 10, k = i & 1023; cv[q] = (r < 16) ? p.c[r * 1024 + k] : p.c_ctx[k]; }
#pragma unroll
        for (int q = 0; q < 34; ++q) S[tid + NTHR * q] = siluf(cv[q]); }
    __syncthreads();
    const int col = tid & 63, sl = tid >> 6, n = it * 64 + col;
    float a[17];
#pragma unroll
    for (int r = 0; r < 17; ++r) a[r] = 0.f;
#pragma unroll 1
    for (int k0 = sl * 128; k0 < sl * 128 + 128; k0 += 16) {
        float w[16];
#pragma unroll
        for (int q = 0; q < 16; ++q) w[q] = p.ada_w[(size_t)(k0 + q) * 6144 + n];
#pragma unroll
        for (int q = 0; q < 16; ++q)
#pragma unroll
            for (int r = 0; r < 17; ++r) a[r] += S[r * 1024 + k0 + q] * w[q];
    }
#pragma unroll
    for (int r = 0; r < 17; ++r) R[(sl * 17 + r) * 64 + col] = a[r];
    __syncthreads();
    float* MOD = (float*)(p.ws + WS_MOD);
    for (int i = tid; i < 17 * 64; i += NTHR) { const int r = i >> 6, cc = i & 63; float s = 0.f;
#pragma unroll
        for (int q = 0; q < 8; ++q) s += R[(q * 17 + r) * 64 + cc];
        MOD[r * 6144 + it * 64 + cc] = s + p.ada_b[it * 64 + cc]; }
}

__device__ __forceinline__ void p0_taps(const Params& p, int it, unsigned char* lds) {
    float* FE = (float*)lds;
    float* H1 = FE + 16 * 36;
    float* H2 = H1 + 16 * 64;
    const int tid = otid(), p0 = it * 16;
    __syncthreads();
    if (tid < 256) { const int pp = tid >> 4, j = tid & 15; const float pos = (float)(p0 + pp);
        const float band = 1e-4f + (float)j * ((15.f - 1e-4f) / 15.f);
        float rev = pos * band * (1.f / 4096.f); rev -= floorf(rev);
        FE[pp * 36 + 1 + j] = __builtin_amdgcn_cosf(rev); FE[pp * 36 + 17 + j] = -__builtin_amdgcn_sinf(rev);
        if (j == 0) FE[pp * 36] = pos * (1.f / 4096.f); }
    __syncthreads();
    for (int i = tid; i < 1024; i += NTHR) { const int pp = i >> 6, j = i & 63; float s = p.hy_b1[j];
#pragma unroll
        for (int q = 0; q < 33; ++q) s += FE[pp * 36 + q] * p.hy_w1[q * 64 + j];
        H1[pp * 64 + j] = sin_rad(p.hy_sin_freq[j] * s); }
    __syncthreads();
    for (int i = tid; i < 1024; i += NTHR) { const int pp = i >> 6, j = i & 63; float s = p.hy_b2[j];
#pragma unroll
        for (int q = 0; q < 64; ++q) s += H1[pp * 64 + q] * p.hy_w2[q * 64 + j];
        H2[pp * 64 + j] = sin_rad(p.hy_sin_freq[64 + j] * s); ((_Float16*)(H2 + 1024))[pp * 72 + j] = (_Float16)H2[pp * 64 + j]; }
    __syncthreads();
    float* TAPS = (float*)(p.ws + WS_TAPS);
    const float mind = -3.0701134573253945f, maxd = -15.350567286626972f;
    const int wid = tid >> 6, lane = tid & 63, fr = lane & 15, fq = lane >> 4;
    const _Float16* H2h = (const _Float16*)(H2 + 1024);
    const f16x8 a0 = *(const f16x8*)(H2h + fr * 72 + 8 * fq), a1 = *(const f16x8*)(H2h + fr * 72 + 32 + 8 * fq);
#pragma unroll 2
    for (int j = 0; j < 16; ++j) {
        const int col = 256 * wid + 16 * j + fr, o = col >> 10, dir = (col >> 9) & 1, c = col & 511;
        float wv[16];
#pragma unroll
        for (int e = 0; e < 8; ++e) { wv[e] = p.hy_w3[(size_t)(8 * fq + e) * 2048 + col]; wv[8 + e] = p.hy_w3[(size_t)(32 + 8 * fq + e) * 2048 + col]; }
        f16x8 b0, b1;
#pragma unroll
        for (int e = 0; e < 8; ++e) { b0[e] = (_Float16)wv[e]; b1[e] = (_Float16)wv[8 + e]; }
        f32x4 acc = (f32x4){0.f, 0.f, 0.f, 0.f};
        acc = __builtin_amdgcn_mfma_f32_16x16x32_f16(a0, b0, acc, 0, 0, 0); acc = __builtin_amdgcn_mfma_f32_16x16x32_f16(a1, b1, acc, 0, 0, 0);
        const float delta = fabsf(mind + (maxd - mind) * ((float)c / 511.f));
        float* tp = TAPS + ((size_t)(o * 512 + c)) * 8192;
        const int P = p0 + 4 * fq; f32x4 val;
#pragma unroll
        for (int r = 0; r < 4; ++r) val[r] = acc[r] * __expf(-(float)(P + r) * (1.f / 4096.f) * delta);
        if (dir == 0) *(f32x4*)(tp + 4096 + P) = val;
        else {
#pragma unroll
            for (int r = 0; r < 4; ++r) { if (P + r == 0) tp[0] = 0.f; else tp[4096 - (P + r)] = val[r]; } }
    }
}

__device__ __forceinline__ unsigned pk4_fp8(float a, float b, float c, float d) { int w = 0; w = __builtin_amdgcn_cvt_pk_fp8_f32(a, b, w, false); w = __builtin_amdgcn_cvt_pk_fp8_f32(c, d, w, true); return (unsigned)w; }
constexpr float FP8_WSCALE = 64.f, FP8_XSCALE = 4.f, FP8_HSCALE = 16.f;
__device__ __forceinline__ void p0_transpose_w(const float* src, int N, int k0, int n0, bf16_t* dst, int dpitch, int mode, float* scr  , int lane, bool fp8 = false) {
    float v[32];
#pragma unroll
    for (int i = 0; i < 32; ++i) v[i] = src[(size_t)(k0 + 2 * i + (lane >> 5)) * N + n0 + (lane & 31)];
#pragma unroll
    for (int i = 0; i < 32; ++i) scr[(2 * i + (lane >> 5)) * 33 + (lane & 31)] = v[i];
    asm volatile("s_waitcnt lgkmcnt(0)" ::: "memory");
    const int c = lane & 7;
#pragma unroll
    for (int j = 0; j < 4; ++j) { const int n = (lane >> 3) + 8 * j, col = n0 + n; const float* sp = scr + (8 * c) * 33 + n;
        int drow = col;
        if (mode == 1) drow = (col >> 7) * 256 + (col & 127); else if (mode == 2) drow = (col >> 7) * 256 + 128 + (col & 127);
        if (fp8) { u32x2 o; o.x = pk4_fp8(sp[0] * FP8_WSCALE, sp[33] * FP8_WSCALE, sp[66] * FP8_WSCALE, sp[99] * FP8_WSCALE); o.y = pk4_fp8(sp[132] * FP8_WSCALE, sp[165] * FP8_WSCALE, sp[198] * FP8_WSCALE, sp[231] * FP8_WSCALE);
            *(u32x2*)((unsigned char*)dst + (size_t)drow * dpitch + k0 + 8 * c) = o; }
        else { u32x4 o; o.x = pk2(sp[0], sp[33]); o.y = pk2(sp[66], sp[99]); o.z = pk2(sp[132], sp[165]); o.w = pk2(sp[198], sp[231]);
            *(u32x4*)(dst + (size_t)drow * dpitch + k0 + 8 * c) = o; } }
    asm volatile("s_waitcnt lgkmcnt(0)" ::: "memory");
}

__device__ __forceinline__ void p0_tables(const Params& p, int it) {
    const int e = it * NTHR + threadIdx.x;
    _Float16* FT = (_Float16*)(p.ws + WS_FTAB); _Float16* GT = (_Float16*)(p.ws + WS_GTAB); _Float16* FK = (_Float16*)(p.ws + WS_FKTAB);
    if (e < 8192) { const int rho = e >> 6, s1 = e & 63, f = rho >> 1; float v;
        if (rho == 0) v = 1.f; else if (rho == 1) v = (s1 & 1) ? -1.f : 1.f;
        else { const float rev = (float)((f * s1) & 127) * (1.f / 128.f); v = (rho & 1) ? -__builtin_amdgcn_sinf(rev) : __builtin_amdgcn_cosf(rev); }
        FT[e] = (_Float16)v;
    } else if (e < 16384) { const int q = e - 8192, t1 = q >> 7, rho = q & 127, f = rho >> 1; float v;
        if (rho == 0) v = 1.f / 128.f; else if (rho == 1) v = ((t1 & 1) ? -1.f : 1.f) / 128.f;
        else { const float rev = (float)((f * t1) & 127) * (1.f / 128.f); v = ((rho & 1) ? -__builtin_amdgcn_sinf(rev) : __builtin_amdgcn_cosf(rev)) * (2.f / 128.f); }
        GT[q] = (_Float16)v;
    } else { const int q = e - 16384, rho = q >> 7, dp = q & 127, d = dp - 64, f = rho >> 1; float v;
        if (rho == 0) v = 1.f; else if (rho == 1) v = (d & 1) ? -1.f : 1.f;
        else { const float rev = (float)((f * d) & 127) * (1.f / 128.f); v = (rho & 1) ? -__builtin_amdgcn_sinf(rev) : __builtin_amdgcn_cosf(rev); }
        FK[q] = (_Float16)v;
    }
}

__device__ __forceinline__ void phase0(const Params& p, unsigned char* lds) {
    constexpr int I_WIN = 16 * 72, I_WOUT = 16 * 32, I_W1 = 32 * 16 * 16, I_W2 = 32 * 8 * 32;
    constexpr int NTR = I_WIN + I_WOUT + 2 * I_W1 + I_W2;
    for (int it = blockIdx.x; it < 64; it += gridDim.x) p0_tables(p, it);
    for (int it = blockIdx.x; it < 96; it += gridDim.x) p0_adaln(p, it, lds);
    for (int it = (blockIdx.x + 160) % gridDim.x; it < 256; it += gridDim.x) p0_taps(p, it, lds);
    __syncthreads();
    const int tidq = otid(), lane = tidq & 63, wid = tidq >> 6;
    float* scr = (float*)lds + wid * (64 * 33);
    constexpr int NA = 14720;
    const bool lightwg = blockIdx.x < 96 && gridDim.x > 96;
    const int nb2 = (gridDim.x > 96) ? (int)gridDim.x - 96 : (int)gridDim.x, bi2 = (gridDim.x > 96) ? (int)blockIdx.x - 96 : (int)blockIdx.x;
    for (int pass = 0; pass < 2; ++pass)
    for (int it = (pass == 0) ? (int)blockIdx.x * 8 + wid : NA + bi2 * 8 + wid; it < ((pass == 0) ? NA : NTR); it += ((pass == 0) ? (int)gridDim.x : nb2) * 8) {
        if (pass == 1 && lightwg) break;
        int r = it; const float* src; int N, k0, n0, dpitch, mode = 0; bf16_t* dst; bool f8 = false;
        if (r < I_WIN) { src = p.w_in; N = PROJW; k0 = (r / 72) * 64; n0 = (r % 72) * 32; dst = (bf16_t*)(p.ws + WS_WINT); dpitch = 1024; }
        else if ((r -= I_WIN) < I_WOUT) { src = p.w_out; N = 1024; k0 = (r / 32) * 64; n0 = (r % 32) * 32; dst = (bf16_t*)(p.ws + WS_WOUTT); dpitch = 1024; }
        else if ((r -= I_WOUT) < 2 * I_W1) { const int w3 = r >= I_W1; if (w3) r -= I_W1; const int e = r / 256, q = r % 256; src = (w3 ? p.exp_w3 : p.exp_w1) + (size_t)e * 1024 * 512; N = 512; k0 = (q / 16) * 64; n0 = (q % 16) * 32;
            dst = (bf16_t*)(p.ws + WS_EW13 + (size_t)e * 1024 * 1024); dpitch = 1024; mode = w3 ? 2 : 1; f8 = true; }
        else { r -= 2 * I_W1; const int e = r / 256, q = r % 256; src = p.exp_w2 + (size_t)e * 512 * 1024; N = 1024; k0 = (q / 32) * 64; n0 = (q % 32) * 32; dst = (bf16_t*)(p.ws + WS_EW2T + (size_t)e * 1024 * 512); dpitch = 512; f8 = true; }
        p0_transpose_w(src, N, k0, n0, dst, dpitch, mode, scr, lane, f8);
    }
}

__device__ __forceinline__ void norm_row(const Params& p, const float* xr, const float* md, bf16_t* orow, int lane) {
    f32x4 v[4]; float s = 0.f;
#pragma unroll
    for (int j = 0; j < 4; ++j) { v[j] = *(const f32x4*)(xr + 256 * j + lane * 4); s += v[j].x * v[j].x + v[j].y * v[j].y + v[j].z * v[j].z + v[j].w * v[j].w; }
    const float rstd = rsqrtf(wave_sum(s) * (1.f / 1024.f) + EPSN);
#pragma unroll
    for (int j = 0; j < 4; ++j) { const int k = 256 * j + lane * 4;
        const f32x4 nw = *(const f32x4*)(p.norm1_w + k), sh = *(const f32x4*)(md + k), sc = *(const f32x4*)(md + 1024 + k);
        const f32x4 y = (v[j] * rstd) * nw * (sc + 1.f) + sh;
        u32x2 o; o.x = pk2(y.x, y.y); o.y = pk2(y.z, y.w); *(u32x2*)(orow + k) = o; }
}
__device__ __forceinline__ void phase1(const Params& p, unsigned char* lds) {
    const int tidq = otid(), lane = tidq & 63, wid = tidq >> 6;
    const float* MOD = (const float*)(p.ws + WS_MOD);
    const int fr = lane & 15, fq = lane >> 4;
    for (int ct = blockIdx.x; ct < NCTX / 16; ct += gridDim.x) {
        bf16_t* As = (bf16_t*)lds;
        const bf16_t* WT = (const bf16_t*)(p.ws + WS_WINT); bf16_t* KVC = (bf16_t*)(p.ws + WS_KVC);
        __syncthreads();
        {   const float* md = MOD + (size_t)16 * 6144; f32x4 v[2][4]; float ss[2];
#pragma unroll
            for (int r = 0; r < 2; ++r)
#pragma unroll
                for (int j = 0; j < 4; ++j) v[r][j] = *(const f32x4*)(p.ctx + (size_t)(ct * 16 + 2 * wid + r) * 1024 + 256 * j + lane * 4);
#pragma unroll
            for (int r = 0; r < 2; ++r) { float q = 0.f;
#pragma unroll
                for (int j = 0; j < 4; ++j) q += v[r][j].x * v[r][j].x + v[r][j].y * v[r][j].y + v[r][j].z * v[r][j].z + v[r][j].w * v[r][j].w;
                ss[r] = wave_sum(q); }
#pragma unroll
            for (int j = 0; j < 4; ++j) { const int k = 256 * j + lane * 4;
                const f32x4 nw = *(const f32x4*)(p.norm1_w + k), sh = *(const f32x4*)(md + k), sc = *(const f32x4*)(md + 1024 + k); const f32x4 g = nw * (sc + 1.f);
#pragma unroll
                for (int r = 0; r < 2; ++r) { const float rstd = rsqrtf(ss[r] * (1.f / 1024.f) + EPSN); const f32x4 y = (v[r][j] * rstd) * g + sh;
                    u32x2 o; o.x = pk2(y.x, y.y); o.y = pk2(y.z, y.w); *(u32x2*)(As + (2 * wid + r) * 1032 + k) = o; } }
        }
        __syncthreads();
        f32x4 acc0 = (f32x4){0.f, 0.f, 0.f, 0.f}, acc1 = acc0;
        const bf16_t* b0 = WT + (size_t)(512 + 32 * wid + fr) * 1024 + 8 * fq; const bf16_t* b1 = b0 + 16 * 1024;
#pragma unroll 8
        for (int ks = 0; ks < 32; ++ks) {
            const bf16x8 af = *(const bf16x8*)(As + fr * 1032 + 32 * ks + 8 * fq);
            const bf16x8 bf0 = *(const bf16x8*)(b0 + 32 * ks), bf1 = *(const bf16x8*)(b1 + 32 * ks);
            acc0 = __builtin_amdgcn_mfma_f32_16x16x32_bf16(bf0, af, acc0, 0, 0, 0); acc1 = __builtin_amdgcn_mfma_f32_16x16x32_bf16(bf1, af, acc1, 0, 0, 0);
        }
        {   bf16_t* orow = KVC + (size_t)(ct * 16 + fr) * 256 + 32 * wid + 4 * fq;
            u32x2 o; o.x = pk2(acc0.x, acc0.y); o.y = pk2(acc0.z, acc0.w); *(u32x2*)(orow) = o;
            o.x = pk2(acc1.x, acc1.y); o.y = pk2(acc1.z, acc1.w); *(u32x2*)(orow + 16) = o; }
    }
    {
        const int nb = gridDim.x, bi = blockIdx.x;
        bf16_t* H = (bf16_t*)(p.ws + WS_H);
        for (int tq = bi * 8; tq < (NTOK / 256) * 8; tq += nb * 8) for (int row0 = (tq >> 3) * 256 + wid * 32 + (tq & 7) * 0; row0 < (tq >> 3) * 256 + wid * 32 + 32; row0 += 4) {
            f32x4 v[4][4]; float ss[4];
#pragma unroll
            for (int r = 0; r < 4; ++r)
#pragma unroll
                for (int j = 0; j < 4; ++j) v[r][j] = *(const f32x4*)(p.x + (size_t)(row0 + r) * 1024 + 256 * j + lane * 4);
#pragma unroll
            for (int r = 0; r < 4; ++r) { float s = 0.f;
#pragma unroll
                for (int j = 0; j < 4; ++j) s += v[r][j].x * v[r][j].x + v[r][j].y * v[r][j].y + v[r][j].z * v[r][j].z + v[r][j].w * v[r][j].w;
                ss[r] = s; }
#pragma unroll
            for (int r = 0; r < 4; ++r) ss[r] = wave_sum(ss[r]);
            const float* md = MOD + (size_t)(row0 >> 12) * 6144;
#pragma unroll
            for (int j = 0; j < 4; ++j) { const int k = 256 * j + lane * 4;
                const f32x4 nw = *(const f32x4*)(p.norm1_w + k), sh = *(const f32x4*)(md + k), sc = *(const f32x4*)(md + 1024 + k); const f32x4 g = nw * (sc + 1.f);
#pragma unroll
                for (int r = 0; r < 4; ++r) { const float rstd = rsqrtf(ss[r] * (1.f / 1024.f) + EPSN); const f32x4 y = (v[r][j] * rstd) * g + sh;
                    u32x2 o; o.x = pk2(y.x, y.y); o.y = pk2(y.z, y.w); *(u32x2*)(H + (size_t)(row0 + r) * 1024 + k) = o; } }
        }
    }
}

struct P2Sched { const char* H; const char* WT; int G, c;
    __device__ __forceinline__ bool next(int i, pg::UDesc& u) const { const int q = i * G + c; if (q >= 2304) return false;
        if (q < 768) { const int pm = q / 3, pn = q - 3 * pm; u.A = H + (size_t)pm * 256 * 2048; u.B0 = WT + (size_t)pn * 256 * 2048; u.i0 = 0; u.i1 = pm; u.i2 = pn; }
        else { const int v = q - 768, pn = v / 6, pm = v - 6 * pn; u.A = WT + (size_t)(768 + pm * 256) * 2048; u.B0 = H + (size_t)pn * 256 * 2048; u.i0 = 1; u.i1 = pm; u.i2 = pn; }
        u.B1 = u.B0 + 8 * 128; u.i3 = 0; return true; }
    __device__ __forceinline__ unsigned rowoff(const pg::UDesc&, int) const { return 0u; }
};
__device__ __forceinline__ void phase2(const Params& p, unsigned char* lds) {
    bf16_t* QKV = (bf16_t*)(p.ws + WS_QKV); _Float16* UT = (_Float16*)(p.ws + WS_UT);
    P2Sched S{(const char*)(p.ws + WS_H), (const char*)(p.ws + WS_WINT), (int)gridDim.x, vcu_of(blockIdx.x, gridDim.x)};
    auto E = [&](const f32x4 (&acc)[2][2][4][2], const pg::UDesc& u, int wr, int wc, int fr, int fq) {
        const int tok0 = u.i2 * 256, bb = tok0 >> 12, t0 = tok0 & 4095;
        unsigned short* base = u.i0 ? (unsigned short*)UT + ((size_t)(bb * 1536 + u.i1 * 256)) * 4096 + t0 : (unsigned short*)QKV + (size_t)(u.i1 * 256) * 768 + u.i2 * 256;
        const size_t pitch = u.i0 ? 4096 : 768; const bool f16o = u.i0 != 0;
        ACCP_FOREACH(acc, wr, wc, fr, fq, { u32x4 o;
            if (f16o) { o.x = pkh2(v0.x, v0.y); o.y = pkh2(v0.z, v0.w); o.z = pkh2(v1.x, v1.y); o.w = pkh2(v1.z, v1.w); }
            else { o.x = pk2(v0.x, v0.y); o.y = pk2(v0.z, v0.w); o.z = pk2(v1.x, v1.y); o.w = pk2(v1.z, v1.w); }
            *(u32x4*)(base + (size_t)rl * pitch + cl) = o; });
    };
    pg::gemm_stream<false, true, false>((LAS unsigned char*)lds, 2048, 2048, S, E);
}

__device__ __forceinline__ void phase3(const Params& p) {
    const int tidq = otid(), lane = tidq & 63, gw = blockIdx.x * 8 + (tidq >> 6), ngw = gridDim.x * 8;
    bf16_t* QKV = (bf16_t*)(p.ws + WS_QKV); bf16_t* KVC = (bf16_t*)(p.ws + WS_KVC);
    const float qw = p.q_norm_w[lane], kw = p.k_norm_w[lane];
    const int i16 = lane & 15; const float invf = exp2f(-(float)i16 * (13.287712379549449f / 16.f));
    float xn[10];
    if (gw < NTOK) {
#pragma unroll
        for (int hh = 0; hh < 10; ++hh) xn[hh] = bf2f(QKV[(size_t)gw * 768 + hh * 64 + lane]); }
    for (int row = gw; row < NTOK; row += ngw) {
        const int pos = row & 4095; const float ang = (float)((lane & 32) ? (pos & 63) : (pos >> 6)) * invf;
        const float cs = cos_rad(ang), sn = sin_rad(ang);
        bf16_t* rp = QKV + (size_t)row * 768;
        float xv[10], ss[10];
#pragma unroll
        for (int hh = 0; hh < 10; ++hh) { xv[hh] = xn[hh]; ss[hh] = xv[hh] * xv[hh]; }
        {   const int rn = (row + ngw < NTOK) ? row + ngw : row;
#pragma unroll
            for (int hh = 0; hh < 10; ++hh) xn[hh] = bf2f(QKV[(size_t)rn * 768 + hh * 64 + lane]); }
#pragma unroll
        for (int hh = 0; hh < 10; ++hh) ss[hh] = wave_sum(ss[hh]);
#pragma unroll
        for (int hh = 0; hh < 10; ++hh) {
            const float y = xv[hh] * rsqrtf(ss[hh] * (1.f / 64.f) + EPSN) * (hh < 8 ? qw : kw);
            const float pr = [&] { const unsigned uy = __builtin_bit_cast(unsigned, y); auto rr = __builtin_amdgcn_permlane16_swap(uy, uy, false, false); return (lane & 16) ? __builtin_bit_cast(float, (unsigned)rr[0]) : __builtin_bit_cast(float, (unsigned)rr[1]); }();
            const float o = (lane & 16) ? (y * cs + pr * sn) : (y * cs - pr * sn);
            rp[hh * 64 + lane] = (bf16_t)f2bf(hh < 8 ? o * (0.125f * 1.4426950408889634f) : o);
        }
    }
    for (int row = gw; row < NCTX; row += ngw) {
        bf16_t* rp = KVC + (size_t)row * 256;
        const float x0 = bf2f(rp[lane]), x1 = bf2f(rp[64 + lane]);
        const float r0 = rsqrtf(wave_sum(x0 * x0) * (1.f / 64.f) + EPSN), r1 = rsqrtf(wave_sum(x1 * x1) * (1.f / 64.f) + EPSN);
        rp[lane] = (bf16_t)f2bf(x0 * r0 * kw); rp[64 + lane] = (bf16_t)f2bf(x1 * r1 * kw);
    }
}

typedef short s16x4_t __attribute__((ext_vector_type(4)));
__device__ __forceinline__ void attn_unit(const Params& p, int u, unsigned char* lds) {
    const int tid = otid(), wid = tid >> 6, lane = tid & 63, fr = lane & 15, fq = lane >> 4;
    const int b = u >> 6, kvh = (u >> 5) & 1, qb = u & 31, q0 = qb * 128;
    const bf16_t* QKV = (const bf16_t*)(p.ws + WS_QKV); const bf16_t* KVC = (const bf16_t*)(p.ws + WS_KVC);
    bf16_t* ATT = (bf16_t*)(p.ws + WS_ATTHY);
    const int h = kvh * 4 + (wid >> 1), half = wid & 1, qrow0 = q0 + 64 * half;
    bf16x8 qf[4][2];
#pragma unroll
    for (int qt = 0; qt < 4; ++qt)
#pragma unroll
        for (int ks = 0; ks < 2; ++ks) qf[qt][ks] = *(const bf16x8*)(QKV + (size_t)(b * 4096 + qrow0 + 16 * qt + fr) * 768 + h * 64 + 32 * ks + 8 * fq);
    float mrow[4], lrow[4]; f32x4 ot[4][4];
    const float sink2 = p.attn_sink[h] * 1.4426950408889634f;
#pragma unroll
    for (int qt = 0; qt < 4; ++qt) { mrow[qt] = sink2; lrow[qt] = (fq == 0) ? 1.f : 0.f;
#pragma unroll
        for (int dt = 0; dt < 4; ++dt) ot[dt][qt] = (f32x4){0.f, 0.f, 0.f, 0.f}; }
    const int jlo = (qb == 0) ? 2 : 0, jhi = (qb == 31) ? 3 : 5, ntile = 4 + (jhi - jlo + 1);
    const int kr = tid >> 3, ch = tid & 7;
    auto krow_of = [&](int ti) -> const bf16_t* { return (ti < 4) ? KVC + (size_t)(b * 256 + ti * 64 + kr) * 256 + kvh * 64 + ch * 8 : QKV + (size_t)(b * 4096 + q0 - 128 + (ti - 4 + jlo) * 64 + kr) * 768 + KOFF + kvh * 64 + ch * 8; };
    u32x4 kreg = *(const u32x4*)krow_of(0), vreg = *(const u32x4*)(krow_of(0) + ((0 < 4) ? 128 : 128));
#pragma unroll 1
    for (int ti = 0; ti < ntile; ++ti) {
        const bool isctx = ti < 4; const int jb = ti - 4 + jlo;
        unsigned char* sK = lds + (ti & 1) * 18432;
        unsigned char* sV = sK + 64 * 144;
        { *(u32x4*)(sK + kr * 144 + ch * 16) = kreg; *(u32x4*)(sV + kr * 144 + ch * 16) = vreg; }
        if (ti + 1 < ntile) { const bf16_t* kp = krow_of(ti + 1); kreg = *(const u32x4*)kp; vreg = *(const u32x4*)(kp + 128); }
        __syncthreads();
        const int rel = jb - 2 - half;
        const bool skip = !isctx && (rel < -2 || rel > 2), partial = !isctx && (rel == -2 || rel == 2);
        if (!skip) {
            f32x4 st[4][4];
#pragma unroll
            for (int kt = 0; kt < 4; ++kt) {
                const bf16x8 k0 = *(const bf16x8*)(sK + (16 * kt + fr) * 144 + fq * 16), k1 = *(const bf16x8*)(sK + (16 * kt + fr) * 144 + 64 + fq * 16);
#pragma unroll
                for (int qt = 0; qt < 4; ++qt) { f32x4 z = (f32x4){0.f, 0.f, 0.f, 0.f};
                    z = __builtin_amdgcn_mfma_f32_16x16x32_bf16(k0, qf[qt][0], z, 0, 0, 0); z = __builtin_amdgcn_mfma_f32_16x16x32_bf16(k1, qf[qt][1], z, 0, 0, 0); st[kt][qt] = z; }
            }
            if (partial) {
                const int kbase = q0 - 128 + 64 * jb;
#pragma unroll
                for (int qt = 0; qt < 4; ++qt) { const int qpos = qrow0 + 16 * qt + fr;
#pragma unroll
                    for (int kt = 0; kt < 4; ++kt)
#pragma unroll
                        for (int r = 0; r < 4; ++r) { const int dd = kbase + 16 * kt + 4 * fq + r - qpos; if (dd > 128 || dd < -128) st[kt][qt][r] = -1e30f; } }
            }
            float alpha[4]; bool grew = false;
#pragma unroll
            for (int qt = 0; qt < 4; ++qt) {
                float t0 = fmaxf(fmaxf(st[0][qt][0], st[0][qt][1]), fmaxf(st[0][qt][2], st[0][qt][3]));
#pragma unroll
                for (int kt = 1; kt < 4; ++kt) t0 = fmaxf(t0, fmaxf(fmaxf(st[kt][qt][0], st[kt][qt][1]), fmaxf(st[kt][qt][2], st[kt][qt][3])));
                t0 = max_fq(t0);
                const float mnew = fmaxf(mrow[qt], t0); alpha[qt] = exp2_raw(mrow[qt] - mnew); grew = grew || (mnew > mrow[qt]); mrow[qt] = mnew;
                float ls = 0.f;
#pragma unroll
                for (int kt = 0; kt < 4; ++kt)
#pragma unroll
                    for (int r = 0; r < 4; ++r) { const float pv = exp2_raw(st[kt][qt][r] - mnew); st[kt][qt][r] = pv; ls += pv; }
                lrow[qt] = lrow[qt] * alpha[qt] + ls;
            }
            if (__any(grew)) {
#pragma unroll
                for (int qt = 0; qt < 4; ++qt)
#pragma unroll
                    for (int dt = 0; dt < 4; ++dt) ot[dt][qt] = ot[dt][qt] * alpha[qt];
            }
#pragma unroll
            for (int ks = 0; ks < 2; ++ks) {
                bf16x8 pf[4];
#pragma unroll
                for (int qt = 0; qt < 4; ++qt) { const f32x4 a = st[2 * ks][qt], c = st[2 * ks + 1][qt];
                    u32x4 w; w.x = pk2(a.x, a.y); w.y = pk2(a.z, a.w); w.z = pk2(c.x, c.y); w.w = pk2(c.z, c.w); pf[qt] = __builtin_bit_cast(bf16x8, w); }
#pragma unroll
                for (int dt = 0; dt < 4; ++dt) {
                    const unsigned char* vb = sV + (32 * ks + 4 * fq + (fr >> 2)) * 144 + (16 * dt + 4 * (fr & 3)) * 2;
                    const u32x2 v0 = __builtin_bit_cast(u32x2, __builtin_amdgcn_ds_read_tr16_b64_v4i16((LAS s16x4_t*)(vb))), v1 = __builtin_bit_cast(u32x2, __builtin_amdgcn_ds_read_tr16_b64_v4i16((LAS s16x4_t*)(vb + 16 * 144)));
                    u32x4 w; w.x = v0.x; w.y = v0.y; w.z = v1.x; w.w = v1.y; const bf16x8 vf = __builtin_bit_cast(bf16x8, w);
#pragma unroll
                    for (int qt = 0; qt < 4; ++qt) ot[dt][qt] = __builtin_amdgcn_mfma_f32_16x16x32_bf16(vf, pf[qt], ot[dt][qt], 0, 0, 0);
                }
            }
        }
    }
#pragma unroll
    for (int qt = 0; qt < 4; ++qt) {
        float l = lrow[qt]; l += __shfl_xor(l, 16); l += __shfl_xor(l, 32);
        const float inv = 1.f / l;
        bf16_t* orow = ATT + (size_t)(b * 4096 + qrow0 + 16 * qt + fr) * 1024 + h * 64;
#pragma unroll
        for (int dt = 0; dt < 4; ++dt) { const f32x4 o = ot[dt][qt] * inv; u32x2 w; w.x = pk2(o.x, o.y); w.y = pk2(o.z, o.w); *(u32x2*)(orow + 16 * dt + 4 * fq) = w; }
    }
    __syncthreads();
}

__device__ __forceinline__ void khat_items(const Params& p, unsigned char* lds) {
    const int tid = otid(), wid = tid >> 6, lane = tid & 63, fr = lane & 15, fq = lane >> 4;
    _Float16* TT = (_Float16*)lds;
    _Float16* FKL = (_Float16*)(lds + 34816);
    const _Float16* FK = (const _Float16*)(p.ws + WS_FKTAB);
    __syncthreads();
    for (int i = tid; i < 128 * 136 / 2; i += NTHR) ((unsigned*)lds)[i] = 0u;
    for (int i = tid; i < 128 * 16; i += NTHR) { const int r = i >> 4, c8 = i & 15; *(u32x4*)(FKL + r * 136 + c8 * 8) = *(const u32x4*)(FK + r * 128 + c8 * 8); }
    int it = blockIdx.x;
    f32x4 tv[4];
    if (it < 1024) {
#pragma unroll
        for (int q = 0; q < 4; ++q) tv[q] = *(const f32x4*)((const float*)(p.ws + WS_TAPS) + (size_t)it * 8192 + tid * 16 + q * 4); }
    __syncthreads();
    for (; it < 1024; it += gridDim.x) {
#pragma unroll
        for (int q = 0; q < 4; ++q) { const int i0 = tid * 16 + q * 4;
#pragma unroll
            for (int e = 0; e < 4; ++e) { const int i = i0 + e, i1 = i >> 6, i2 = i & 63; const _Float16 h = (_Float16)tv[q][e];
                if (i1 >= 1) TT[(i2 + 63) * 136 + i1] = h;
                if (i2 >= 1 && i1 + 1 < 128) TT[(i2 - 1) * 136 + i1 + 1] = h; } }
        {   const int itn = (it + (int)gridDim.x < 1024) ? it + (int)gridDim.x : it;
#pragma unroll
            for (int q = 0; q < 4; ++q) tv[q] = *(const f32x4*)((const float*)(p.ws + WS_TAPS) + (size_t)itn * 8192 + tid * 16 + q * 4); }
        __syncthreads();
        f16x8 af[4];
#pragma unroll
        for (int ks = 0; ks < 4; ++ks) af[ks] = *(const f16x8*)(TT + (16 * wid + fr) * 136 + 32 * ks + 8 * fq);
        _Float16* KH = (_Float16*)(p.ws + WS_KH) + (size_t)it * (64 * 2 * 128);
#pragma unroll
        for (int nt = 0; nt < 8; ++nt) {
            f32x4 acc = (f32x4){0.f, 0.f, 0.f, 0.f};
#pragma unroll
            for (int ks = 0; ks < 4; ++ks) { const f16x8 bfv = *(const f16x8*)(FKL + (16 * nt + fr) * 136 + 32 * ks + 8 * fq); acc = __builtin_amdgcn_mfma_f32_16x16x32_f16(af[ks], bfv, acc, 0, 0, 0); }
            const int rho = 16 * nt + fr; u32x2 o; o.x = pkh2(acc[3], acc[2]); o.y = pkh2(acc[1], acc[0]);
            *(u32x2*)(KH + (size_t)rho * 128 + (124 - 16 * wid - 4 * fq)) = o;
        }
        __syncthreads();
    }
}

constexpr int HY_ZB = 0, HY_ZH = 73728, HY_ZHF = 1160  , HY_OH = HY_ZH + 8 * HY_ZHF * 2, HY_GT = HY_OH + 8 * 65 * 40  , HY_KC = HY_GT + 8 * 4608, HY_LDS_END = HY_KC + 8 * 576;
struct __attribute__((aligned(4))) hq4 { unsigned a, b, c, d; };
__device__ __forceinline__ f16x8 neg8(f16x8 v) { u32x4 w = __builtin_bit_cast(u32x4, v); w.x ^= 0x80008000u; w.y ^= 0x80008000u; w.z ^= 0x80008000u; w.w ^= 0x80008000u; return __builtin_bit_cast(f16x8, w); }
struct HyRow { u32x4 r[8]; };
__device__ __forceinline__ void hy_row_load(HyRow& R, const _Float16* ur, const int lane) {
#pragma unroll
    for (int i8 = 0; i8 < 8; ++i8) R.r[i8] = *(const u32x4*)(ur + 8 * (lane + 64 * i8));
}
__device__ __forceinline__ void hy_row_finish(const HyRow& R, const float w0, const float w1, const float w2, const float bb, _Float16* XG, const int lane) {
#pragma unroll
    for (int i8 = 0; i8 < 8; ++i8) { const int t0 = 8 * (lane + 64 * i8); float uv[10];
        unsigned oldl = 0u, oldr = 0u;
        if (i8 > 0) oldl = (unsigned)__builtin_amdgcn_readlane((int)R.r[i8 - 1].w, 63);
        if (i8 < 7) oldr = (unsigned)__builtin_amdgcn_readlane((int)R.r[i8 + 1].x, 0);
        const unsigned lw = (unsigned)__builtin_amdgcn_update_dpp((int)oldl, (int)R.r[i8].w, 0x138, 0xf, 0xf, false);
        const unsigned rw = (unsigned)__builtin_amdgcn_update_dpp((int)oldr, (int)R.r[i8].x, 0x130, 0xf, 0xf, false);
        uv[0] = hhi(lw); uv[9] = hlo(rw);
        uv[1] = hlo(R.r[i8].x); uv[2] = hhi(R.r[i8].x); uv[3] = hlo(R.r[i8].y); uv[4] = hhi(R.r[i8].y); uv[5] = hlo(R.r[i8].z); uv[6] = hhi(R.r[i8].z); uv[7] = hlo(R.r[i8].w); uv[8] = hhi(R.r[i8].w);
        float y[8];
#pragma unroll
        for (int i = 0; i < 8; ++i) y[i] = bb + uv[i] * w0 + uv[i + 1] * w1 + uv[i + 2] * w2;
        u32x4 w; w.x = pkh2(y[0], y[1]); w.y = pkh2(y[2], y[3]); w.z = pkh2(y[4], y[5]); w.w = pkh2(y[6], y[7]);
        *(u32x4*)(XG + (t0 >> 6) * 72 + (t0 & 63)) = w; }
}
__device__ __forceinline__ void hyena_item(const Params& p, const int it, const int itn, unsigned char* lds, HyRow& rr) {
    const int tid = otid(), wid = tid >> 6, lane = tid & 63, fr = lane & 15, fq = lane >> 4;
    const int c = it >> 1, b = (it & 1) * 8 + wid;
    _Float16* XG = (_Float16*)(lds + HY_ZB) + wid * (64 * 72);
    _Float16* ZH = (_Float16*)(lds + HY_ZH);
    _Float16* OH = (_Float16*)(lds + HY_OH);
    _Float16* GTW = (_Float16*)(lds + HY_GT) + wid * 2304;
    _Float16* KC = (_Float16*)(lds + HY_KC) + wid * 288;
    const _Float16* UT = (const _Float16*)(p.ws + WS_UT); const _Float16* FT = (const _Float16*)(p.ws + WS_FTAB); const _Float16* GT = (const _Float16*)(p.ws + WS_GTAB);
    bf16_t* HYT = (bf16_t*)(p.ws + WS_HYT);
    __syncthreads();
    if (lane < 32) KC[(lane >> 4) * 144 + 128 + (lane & 15)] = (_Float16)0.f;
    f16x4 id16;
#pragma unroll
    for (int i = 0; i < 4; ++i) id16[i] = (4 * fq + i == fr) ? (_Float16)1.f : (_Float16)0.f;
    u32x4 zf[4][2];
    HyRow rg; hy_row_load(rg, UT + ((size_t)(b * 1536 + 512 + c)) * 4096, lane);
    hy_row_finish(rr, p.hy_conv_w[c], p.hy_conv_w[1536 + c], p.hy_conv_w[3072 + c], p.hy_conv_b[c], XG, lane);
#pragma unroll
    for (int mt = 0; mt < 4; ++mt)
#pragma unroll
        for (int nt = 0; nt < 4; ++nt) { const u32x2 v = *(const u32x2*)(XG + (16 * nt + fr) * 72 + 16 * mt + 4 * fq);
            const f32x4 cT = __builtin_amdgcn_mfma_f32_16x16x16f16(__builtin_bit_cast(f16x4, v), id16, (f32x4){0.f, 0.f, 0.f, 0.f}, 0, 0, 0);
            if (nt & 1) { zf[mt][nt >> 1].z = pkh2(cT[0], cT[1]); zf[mt][nt >> 1].w = pkh2(cT[2], cT[3]); } else { zf[mt][nt >> 1].x = pkh2(cT[0], cT[1]); zf[mt][nt >> 1].y = pkh2(cT[2], cT[3]); }
        }
    hy_row_finish(rg, p.hy_conv_w[512 + c], p.hy_conv_w[1536 + 512 + c], p.hy_conv_w[3072 + 512 + c], p.hy_conv_b[512 + c], XG, lane);
#pragma unroll 1
    for (int o = 0; o < 2; ++o) {
        f32x4 accI[4][4];
#pragma unroll
        for (int mt = 0; mt < 4; ++mt)
#pragma unroll
            for (int nt = 0; nt < 4; ++nt) accI[mt][nt] = (f32x4){0.f, 0.f, 0.f, 0.f};
        const _Float16* KHo = (const _Float16*)(p.ws + WS_KH) + (size_t)(o * 512 + c) * (64 * 2 * 128);
        u32x4 kcn = (u32x4){0u, 0u, 0u, 0u}; f16x8 ffn[2];
        if (lane < 32) kcn = *(const u32x4*)(KHo + (size_t)wid * 256 + lane * 8);
#pragma unroll
        for (int ks = 0; ks < 2; ++ks) { const f16x4 lo = *(const f16x4*)(FT + fr * 64 + 32 * ks + 4 * fq), hi = *(const f16x4*)(FT + fr * 64 + 32 * ks + 16 + 4 * fq); ffn[ks] = __builtin_shufflevector(lo, hi, 0, 1, 2, 3, 4, 5, 6, 7); }
#pragma unroll 1
        for (int j = 0; j < 8; ++j) {
            const int f = 8 * j + wid;
            const u32x4 kcc = kcn; f16x8 ff[2]; f16x4 gf[4];
#pragma unroll
            for (int ks = 0; ks < 2; ++ks) ff[ks] = ffn[ks];
#pragma unroll
            for (int nt = 0; nt < 4; ++nt) gf[nt] = *(const f16x4*)(GT + (16 * nt + fr) * 128 + 16 * j + 4 * fq);
            if (j < 7) {
                if (lane < 32) kcn = *(const u32x4*)(KHo + (size_t)(f + 8) * 256 + lane * 8);
#pragma unroll
                for (int ks = 0; ks < 2; ++ks) { const f16x4 lo = *(const f16x4*)(FT + (16 * (j + 1) + fr) * 64 + 32 * ks + 4 * fq), hi = *(const f16x4*)(FT + (16 * (j + 1) + fr) * 64 + 32 * ks + 16 + 4 * fq); ffn[ks] = __builtin_shufflevector(lo, hi, 0, 1, 2, 3, 4, 5, 6, 7); }
            }
            if (lane < 32) *(u32x4*)(KC + (lane >> 4) * 144 + (lane & 15) * 8) = kcc;
            {   const int x = lane >> 5, q = (lane >> 1) & 15, sh = lane & 1;
                const u32x2* src = (const u32x2*)(KC + x * 144 + 8 * q + 4 * sh);
                const u32x2 r0 = src[0], r1 = src[1], r2 = src[2];
                const unsigned d0 = r0.x, d1 = r0.y, d2 = r1.x, d3 = r1.y, d4 = r2.x, d5 = r2.y;
                const unsigned a0 = __builtin_amdgcn_alignbit(d1, d0, 16), a1 = __builtin_amdgcn_alignbit(d2, d1, 16), a2 = __builtin_amdgcn_alignbit(d3, d2, 16), a3 = __builtin_amdgcn_alignbit(d4, d3, 16), a4 = __builtin_amdgcn_alignbit(d5, d4, 16);
                _Float16* dst = GTW + ((x * 8 + 4 * sh) * 18 + q) * 8;
                *(u32x4*)(dst) = (u32x4){a0, a1, a2, a3}; *(u32x4*)(dst + 144) = (u32x4){d1, d2, d3, d4};
                *(u32x4*)(dst + 288) = (u32x4){a1, a2, a3, a4}; *(u32x4*)(dst + 432) = (u32x4){d2, d3, d4, d5}; }
            {
#pragma unroll
                for (int mt = 0; mt < 4; ++mt) { f32x4 a = (f32x4){0.f, 0.f, 0.f, 0.f};
                    a = __builtin_amdgcn_mfma_f32_16x16x32_f16(__builtin_bit_cast(f16x8, zf[mt][0]), ff[0], a, 0, 0, 0); a = __builtin_amdgcn_mfma_f32_16x16x32_f16(__builtin_bit_cast(f16x8, zf[mt][1]), ff[1], a, 0, 0, 0);
                    u32x2 w; w.x = pkh2(a[0], a[1]); w.y = pkh2(a[2], a[3]);
                    *(u32x2*)(ZH + (fr >> 1) * HY_ZHF + (wid * 2 + (fr & 1)) * 72 + 16 * mt + 4 * fq) = w; }
            }
            __syncthreads();
            {   const int bb = fr >> 1, part = fr & 1;
                f16x8 a1[2], a2[2];
#pragma unroll
                for (int ks = 0; ks < 2; ++ks) {
                    const f16x8 s1v = *(const f16x8*)(ZH + wid * HY_ZHF + (bb * 2 + part) * 72 + 32 * ks + 8 * fq);
                    const f16x8 s2v = *(const f16x8*)(ZH + wid * HY_ZHF + (bb * 2 + (1 - part)) * 72 + 32 * ks + 8 * fq);
                    const f16x8 zero = (f16x8){0, 0, 0, 0, 0, 0, 0, 0};
                    if (f == 0) { a1[ks] = part ? zero : s1v; a2[ks] = part ? s1v : zero; }
                    else { a1[ks] = s1v; a2[ks] = part ? s2v : neg8(s2v); }
                }
                const int sg = 7 - (fr & 7), qb = 7 - (fr >> 3) + fq;
                f32x4 am[4];
#pragma unroll
                for (int nt = 0; nt < 4; ++nt) am[nt] = (f32x4){0.f, 0.f, 0.f, 0.f};
#pragma unroll
                for (int wi = 0; wi < 6; ++wi) { const int w = 2 * wi - 6;
                    const f16x8 b1 = *(const f16x8*)(GTW + ((0 * 8 + sg) * 18 + qb + w) * 8);
                    const f16x8 b2 = *(const f16x8*)(GTW + ((1 * 8 + sg) * 18 + qb + w) * 8);
#pragma unroll
                    for (int ks = 0; ks < 2; ++ks) { const int nt = (4 * ks - w) / 2;
                        if (nt >= 0 && nt < 4) { am[nt] = __builtin_amdgcn_mfma_f32_16x16x32_f16(a1[ks], b1, am[nt], 0, 0, 0); am[nt] = __builtin_amdgcn_mfma_f32_16x16x32_f16(a2[ks], b2, am[nt], 0, 0, 0); } } }
#pragma unroll
                for (int nt = 0; nt < 4; ++nt) { const int t2 = 16 * nt + fr;
                    *(unsigned*)(OH + ((2 * fq) * 65 + t2) * 20 + 2 * wid) = pkh2(am[nt][0], am[nt][1]);
                    *(unsigned*)(OH + ((2 * fq + 1) * 65 + t2) * 20 + 2 * wid) = pkh2(am[nt][2], am[nt][3]); }
            }
            __syncthreads();
            {
#pragma unroll
                for (int mt = 0; mt < 4; ++mt) { const f16x4 av = *(const f16x4*)(OH + (wid * 65 + 16 * mt + fr) * 20 + 4 * fq);
#pragma unroll
                    for (int nt = 0; nt < 4; ++nt) accI[mt][nt] = __builtin_amdgcn_mfma_f32_16x16x16f16(av, gf[nt], accI[mt][nt], 0, 0, 0); }
            }
        }
        {   const float sk = p.hy_skip[o * 512 + c];
            {   const int rown = (o == 0) ? (b * 1536 + 1024 + c) : (((itn & 1) * 8 + wid) * 1536 + (itn >> 1)); hy_row_load(rr, UT + (size_t)rown * 4096, lane); }
#pragma unroll
            for (int mt = 0; mt < 4; ++mt)
#pragma unroll
                for (int nt = 0; nt < 4; ++nt) {
                    _Float16* xp = XG + (16 * nt + fr) * 72 + 16 * mt + 4 * fq;
                    const u32x2 xr = *(const u32x2*)xp;
                    u32x2 zw; if (nt & 1) { zw.x = zf[mt][nt >> 1].z; zw.y = zf[mt][nt >> 1].w; } else { zw.x = zf[mt][nt >> 1].x; zw.y = zf[mt][nt >> 1].y; }
                    const f32x4 zo = __builtin_amdgcn_mfma_f32_16x16x16f16(__builtin_bit_cast(f16x4, zw), id16, (f32x4){0.f, 0.f, 0.f, 0.f}, 0, 0, 0);
                    float zn[4];
                    zn[0] = hlo(xr.x) * (accI[mt][nt][0] + sk * zo[0]); zn[1] = hhi(xr.x) * (accI[mt][nt][1] + sk * zo[1]);
                    zn[2] = hlo(xr.y) * (accI[mt][nt][2] + sk * zo[2]); zn[3] = hhi(xr.y) * (accI[mt][nt][3] + sk * zo[3]);
                    if (o == 0) {
                        u32x2 v; v.x = pkh2(zn[0], zn[1]); v.y = pkh2(zn[2], zn[3]);
                        const f32x4 cT = __builtin_amdgcn_mfma_f32_16x16x16f16(__builtin_bit_cast(f16x4, v), id16, (f32x4){0.f, 0.f, 0.f, 0.f}, 0, 0, 0);
                        if (nt & 1) { zf[mt][nt >> 1].z = pkh2(cT[0], cT[1]); zf[mt][nt >> 1].w = pkh2(cT[2], cT[3]); } else { zf[mt][nt >> 1].x = pkh2(cT[0], cT[1]); zf[mt][nt >> 1].y = pkh2(cT[2], cT[3]); }
                    } else { u32x2 w; w.x = pk2(zn[0], zn[1]); w.y = pk2(zn[2], zn[3]); *(u32x2*)xp = w; }
                }
            if (o == 0) hy_row_finish(rr, p.hy_conv_w[1024 + c], p.hy_conv_w[1536 + 1024 + c], p.hy_conv_w[3072 + 1024 + c], p.hy_conv_b[1024 + c], XG, lane);
            if (o == 1) {
                bf16_t* orow = HYT + ((size_t)(b * 512 + c)) * 4096;
#pragma unroll
                for (int i8 = 0; i8 < 8; ++i8) { const int t0 = 8 * (lane + 64 * i8); *(u32x4*)(orow + t0) = *(const u32x4*)(XG + (t0 >> 6) * 72 + (t0 & 63)); }
            }
        }
    }
}

__device__ __forceinline__ void phase5_item(const Params& p, int it, unsigned char* lds, u32x4 (&hv)[8], const int itn) {
    const int tid = otid(), b = it >> 6, t0 = (it & 63) * 64;
    bf16_t* TL = (bf16_t*)lds;
    float* RS = (float*)(lds + 512 * 66 * 2);
    float* RS2 = RS + 512;
    const bf16_t* HYT = (const bf16_t*)(p.ws + WS_HYT); bf16_t* AH = (bf16_t*)(p.ws + WS_ATTHY);
    __syncthreads();
    {
#pragma unroll
        for (int i = 0; i < 8; ++i) { const u32x4 v = hv[i]; unsigned* d = (unsigned*)(TL + tid * 66 + i * 8); d[0] = v.x; d[1] = v.y; d[2] = v.z; d[3] = v.w; }
        const bf16_t* srcn = HYT + ((size_t)((itn >> 6) * 512 + tid)) * 4096 + (itn & 63) * 64;
#pragma unroll
        for (int i = 0; i < 8; ++i) hv[i] = *(const u32x4*)(srcn + i * 8); }
    __syncthreads();
    {   const int tt = tid & 63, cg8 = tid >> 6; float s = 0.f;
#pragma unroll 16
        for (int cc = 0; cc < 64; ++cc) { const float v = bf2f(TL[(cg8 * 64 + cc) * 66 + tt]); s += v * v; }
        RS[cg8 * 64 + tt] = s; }
    __syncthreads();
    if (tid < 64) { float s = 0.f;
#pragma unroll
        for (int q = 0; q < 8; ++q) s += RS[q * 64 + tid];
        RS2[tid] = rsqrtf(s * (1.f / 512.f) + EPSN); }
    __syncthreads();
    {   const int tt = tid >> 3, ch = tid & 7; const float rstd = RS2[tt];
        bf16_t* orow = AH + (size_t)(b * 4096 + t0 + tt) * 1024;
        u32x4 av[8]; float s = 0.f;
#pragma unroll
        for (int g = 0; g < 8; ++g) av[g] = *(const u32x4*)(orow + g * 64 + ch * 8);
#pragma unroll
        for (int g = 0; g < 8; ++g) { const int c0 = g * 64 + ch * 8; float y[8]; const f32x4 gw0 = *(const f32x4*)(p.group_norm_w + 512 + c0), gw1 = *(const f32x4*)(p.group_norm_w + 512 + c0 + 4);
#pragma unroll
            for (int i = 0; i < 8; ++i) y[i] = bf2f(TL[(c0 + i) * 66 + tt]) * rstd * (i < 4 ? gw0[i] : gw1[i - 4]);
            u32x4 w; w.x = pk2(y[0], y[1]); w.y = pk2(y[2], y[3]); w.z = pk2(y[4], y[5]); w.w = pk2(y[6], y[7]); *(u32x4*)(orow + 512 + c0) = w; }
#pragma unroll
        for (int g = 0; g < 8; ++g) {
            const float a0 = bflo(av[g].x), a1 = bfhi(av[g].x), a2 = bflo(av[g].y), a3 = bfhi(av[g].y), a4 = bflo(av[g].z), a5 = bfhi(av[g].z), a6 = bflo(av[g].w), a7 = bfhi(av[g].w);
            s += a0 * a0 + a1 * a1 + a2 * a2 + a3 * a3 + a4 * a4 + a5 * a5 + a6 * a6 + a7 * a7; }
        s += dpp_f(s, DPP_XOR1); s += dpp_f(s, DPP_XOR2); s += dpp_f(s, DPP_HMIRROR);
        const float ra = rsqrtf(s * (1.f / 512.f) + EPSN);
#pragma unroll
        for (int g = 0; g < 8; ++g) { const int c0 = g * 64 + ch * 8; const f32x4 gw0 = *(const f32x4*)(p.group_norm_w + c0), gw1 = *(const f32x4*)(p.group_norm_w + c0 + 4);
            u32x4 w; w.x = pk2(bflo(av[g].x) * ra * gw0[0], bfhi(av[g].x) * ra * gw0[1]); w.y = pk2(bflo(av[g].y) * ra * gw0[2], bfhi(av[g].y) * ra * gw0[3]);
            w.z = pk2(bflo(av[g].z) * ra * gw1[0], bfhi(av[g].z) * ra * gw1[1]); w.w = pk2(bflo(av[g].w) * ra * gw1[2], bfhi(av[g].w) * ra * gw1[3]);
            *(u32x4*)(orow + c0) = w; }
    }
}

struct P6Sched { const char* AH; const char* WT; int G, c;
    __device__ __forceinline__ bool next(int i, pg::UDesc& u) const { const int q = i * G + c; if (q >= 1024) return false; const int pm = q >> 2, pn = q & 3;
        u.A = AH + (size_t)pm * 256 * 2048; u.B0 = WT + (size_t)pn * 256 * 2048; u.B1 = u.B0 + 8 * 128; u.i0 = 0; u.i1 = pm; u.i2 = pn; u.i3 = 0; return true; }
    __device__ __forceinline__ unsigned rowoff(const pg::UDesc&, int) const { return 0u; }
};
__device__ __forceinline__ void phase6(const Params& p, unsigned char* lds) {
    const float* MOD = (const float*)(p.ws + WS_MOD);
    P6Sched S{(const char*)(p.ws + WS_ATTHY), (const char*)(p.ws + WS_WOUTT), (int)gridDim.x, vcu_of(blockIdx.x, gridDim.x)};
    auto E = [&](const f32x4 (&acc)[2][2][4][2], const pg::UDesc& u, int wr, int wc, int fr, int fq) {
        const float* g1 = MOD + (size_t)((u.i1 * 256) >> 12) * 6144 + 2048 + u.i2 * 256 + 32 * wc + 8 * fq;
        f32x4 gv[2][2];
#pragma unroll
        for (int b = 0; b < 2; ++b)
#pragma unroll
            for (int n = 0; n < 2; ++n) gv[b][n] = *(const f32x4*)(g1 + 128 * b + 4 * n);
        bf16_t* D1 = (bf16_t*)(p.ws + WS_D1);
#pragma unroll
        for (int a = 0; a < 2; ++a)
#pragma unroll
            for (int m = 0; m < 4; ++m)
#pragma unroll
                for (int b = 0; b < 2; ++b) { const f32x4 v0 = acc[a][b][m][0] * gv[b][0], v1 = acc[a][b][m][1] * gv[b][1];
                    u32x4 o; o.x = pk2(v0.x, v0.y); o.y = pk2(v0.z, v0.w); o.z = pk2(v1.x, v1.y); o.w = pk2(v1.z, v1.w);
                    *(u32x4*)(D1 + (size_t)(u.i1 * 256 + 128 * a + 64 * wr + 16 * m + fr) * 1024 + u.i2 * 256 + 128 * b + 32 * wc + 8 * fq) = o; }
    };
    pg::gemm_stream<false, true, false>((LAS unsigned char*)lds, 2048, 2048, S, E);
}

__device__ __forceinline__ int pair_index(int lo, int hi) { return lo * 8 - (lo * (lo + 1)) / 2 + (hi - lo - 1); }
constexpr int P7_RW = 0, P7_HIST = 147456, P7_BASE = 147456 + 512, P7_TCLS = 147456 + 1024, P7_TRNK = 147456 + 2048, P7_TG = 147456 + 3072;
__device__ __forceinline__ void phase7(const Params& p, unsigned char* lds) {
    const int tid = otid(), lane = tid & 63, wid = tid >> 6;
    const float* MOD = (const float*)(p.ws + WS_MOD); bf16_t* H2 = (bf16_t*)(p.ws + WS_H);
    int* CNT = (int*)(p.ws + WS_CTL); int* LIST = (int*)(p.ws + WS_LIST); float* GATE = (float*)(p.ws + WS_GATE);
    float* RW = (float*)(lds + P7_RW); int* HIST = (int*)(lds + P7_HIST); int* BASE = (int*)(lds + P7_BASE); int* TCLS = (int*)(lds + P7_TCLS); int* TRNK = (int*)(lds + P7_TRNK);
    __syncthreads();
    {   float t[8];
#pragma unroll
        for (int q = 0; q < 8; ++q) t[q] = p.router_g_w[tid + NTHR * q];
#pragma unroll
        for (int q = 0; q < 8; ++q) { const int i = tid + NTHR * q, k = i >> 2, j = i & 3; RW[((k & 3) * 256 + (k >> 2)) * 36 + j] = t[q]; }
#pragma unroll 1
        for (int i0 = 0; i0 < 1024 * 32; i0 += NTHR * 16) { float u[16];
#pragma unroll
            for (int q = 0; q < 16; ++q) u[q] = p.router_e_w[i0 + tid + NTHR * q];
#pragma unroll
            for (int q = 0; q < 16; ++q) { const int i = i0 + tid + NTHR * q, k = i >> 5, j = i & 31; RW[((k & 3) * 256 + (k >> 2)) * 36 + 4 + j] = u[q]; } }
    }
    for (int tile = blockIdx.x; tile < NTOK / 256; tile += gridDim.x) {
        __syncthreads();
        if (tid < 128) HIST[tid] = 0;
        __syncthreads();
        f32x4 gk[4], shk[4];
#pragma unroll
        for (int j = 0; j < 4; ++j) { const int k = 256 * j + lane * 4; const float* md = MOD + (size_t)((tile * 256) >> 12) * 6144;
            gk[j] = *(const f32x4*)(p.norm2_w + k) * (*(const f32x4*)(md + 4096 + k) + 1.f); shk[j] = *(const f32x4*)(md + 3072 + k); }
        constexpr int RB = 2;
        const bf16_t* D1 = (const bf16_t*)(p.ws + WS_D1);
        f32x4 vn[RB][4]; u32x2 dn[RB][4];
#pragma unroll
        for (int q = 0; q < RB; ++q)
#pragma unroll
            for (int j = 0; j < 4; ++j) { const size_t o = (size_t)(tile * 256 + wid * 32 + q) * 1024 + 256 * j + lane * 4; vn[q][j] = *(const f32x4*)(p.x + o); dn[q][j] = *(const u32x2*)(D1 + o); }
#pragma unroll 1
        for (int rr = 0; rr < 32; rr += RB) {
            const int rl0 = wid * 32 + rr, row0 = tile * 256 + rl0;
            f32x4 v[RB][4]; float ss[RB];
#pragma unroll
            for (int q = 0; q < RB; ++q) { float s = 0.f;
#pragma unroll
                for (int j = 0; j < 4; ++j) { const f32x4 dl = (f32x4){bflo(dn[q][j].x), bfhi(dn[q][j].x), bflo(dn[q][j].y), bfhi(dn[q][j].y)}; v[q][j] = vn[q][j] + dl;
                    { u32x2 xb; xb.x = pk2(v[q][j].x, v[q][j].y); xb.y = pk2(v[q][j].z, v[q][j].w); *(u32x2*)((bf16_t*)(p.ws + WS_D1) + (size_t)(row0 + q) * 1024 + 256 * j + lane * 4) = xb; }
                    s += v[q][j].x * v[q][j].x + v[q][j].y * v[q][j].y + v[q][j].z * v[q][j].z + v[q][j].w * v[q][j].w; }
                ss[q] = s; }
            {   const int rp = (rr + RB < 32) ? row0 + RB : row0;
#pragma unroll
                for (int q = 0; q < RB; ++q)
#pragma unroll
                    for (int j = 0; j < 4; ++j) { const size_t o = (size_t)(rp + q) * 1024 + 256 * j + lane * 4; vn[q][j] = *(const f32x4*)(p.x + o); dn[q][j] = *(const u32x2*)(D1 + o); } }
#pragma unroll
            for (int q = 0; q < RB; ++q) ss[q] = wave_sum(ss[q]);
            float gl[RB][4];
#pragma unroll
            for (int q = 0; q < RB; ++q) { const float rstd = rsqrtf(ss[q] * (1.f / 1024.f) + EPSN);
#pragma unroll
                for (int e = 0; e < 4; ++e) gl[q][e] = 0.f;
#pragma unroll
                for (int j = 0; j < 4; ++j) { const int k = 256 * j + lane * 4;
                    const f32x4 y = (v[q][j] * rstd) * gk[j] + shk[j]; v[q][j] = y;
                    *(unsigned*)((unsigned char*)H2 + (size_t)(row0 + q) * 1024 + k) = pk4_fp8(fminf(fmaxf(y.x * FP8_XSCALE, -440.f), 440.f), fminf(fmaxf(y.y * FP8_XSCALE, -440.f), 440.f), fminf(fmaxf(y.z * FP8_XSCALE, -440.f), 440.f), fminf(fmaxf(y.w * FP8_XSCALE, -440.f), 440.f)); } }
#pragma unroll
            for (int j = 0; j < 4; ++j)
#pragma unroll
                for (int e = 0; e < 4; ++e) { const f32x4 w = *(const f32x4*)(RW + (e * 256 + 64 * j + lane) * 36);
#pragma unroll
                    for (int q = 0; q < RB; ++q) { const float ye = v[q][j][e]; gl[q][0] += ye * w.x; gl[q][1] += ye * w.y; gl[q][2] += ye * w.z; gl[q][3] += ye * w.w; } }
#pragma unroll
            for (int q = 0; q < RB; ++q)
#pragma unroll
                for (int e = 0; e < 4; ++e) gl[q][e] = wave_sum(gl[q][e]);
            int gsel[RB]; float gval[RB];
#pragma unroll
            for (int q = 0; q < RB; ++q) {
#pragma unroll
                for (int e = 0; e < 4; ++e) gl[q][e] += p.router_g_b[e];
                int g = 0; float gm = gl[q][0];
#pragma unroll
                for (int e = 1; e < 4; ++e) if (gl[q][e] > gm) { gm = gl[q][e]; g = e; }
                float gs = 0.f;
#pragma unroll
                for (int e = 0; e < 4; ++e) gs += __expf(gl[q][e] - gm);
                gsel[q] = g; gval[q] = 1.f / gs; }
            float el[RB][8];
#pragma unroll
            for (int q = 0; q < RB; ++q) {
#pragma unroll
                for (int e = 0; e < 8; ++e) el[q][e] = 0.f;
#pragma unroll
                for (int j = 0; j < 4; ++j)
#pragma unroll
                    for (int e = 0; e < 4; ++e) { const float* wr = RW + (e * 256 + 64 * j + lane) * 36 + 4 + gsel[q] * 8; const f32x4 w0 = *(const f32x4*)wr, w1 = *(const f32x4*)(wr + 4); const float ye = v[q][j][e];
                        el[q][0] += ye * w0.x; el[q][1] += ye * w0.y; el[q][2] += ye * w0.z; el[q][3] += ye * w0.w; el[q][4] += ye * w1.x; el[q][5] += ye * w1.y; el[q][6] += ye * w1.z; el[q][7] += ye * w1.w; } }
#pragma unroll
            for (int q = 0; q < RB; ++q)
#pragma unroll
                for (int e = 0; e < 8; ++e) el[q][e] = wave_sum(el[q][e]);
#pragma unroll
            for (int q = 0; q < RB; ++q) { const int g = gsel[q];
#pragma unroll
                for (int e = 0; e < 8; ++e) el[q][e] += p.router_e_b[g * 8 + e];
                int e1 = 0; float m1 = el[q][0];
#pragma unroll
                for (int e = 1; e < 8; ++e) if (el[q][e] > m1) { m1 = el[q][e]; e1 = e; }
                int e2 = -1; float m2 = -3.0e38f;
#pragma unroll
                for (int e = 0; e < 8; ++e) if (e != e1 && el[q][e] > m2) { m2 = el[q][e]; e2 = e; }
                const float r = __expf(m2 - m1), w1 = 1.f / (1.f + r), w2 = r / (1.f + r);
                if (lane == 0) {
                    const int lo = e1 < e2 ? e1 : e2, hi = e1 < e2 ? e2 : e1;
                    const int cls = g * 28 + pair_index(lo, hi);
                    TCLS[rl0 + q] = cls; TRNK[rl0 + q] = atomicAdd(HIST + cls, 1);
                    ((float*)(lds + P7_TG))[(rl0 + q) * 2] = gval[q] * (e1 < e2 ? w1 : w2); ((float*)(lds + P7_TG))[(rl0 + q) * 2 + 1] = gval[q] * (e1 < e2 ? w2 : w1);
                } }
        }
        __syncthreads();
        if (tid < NCLS) { const int n = HIST[tid]; BASE[tid] = n ? atomicAdd(CNT + tid, n) : 0; }
        __syncthreads();
        if (tid < 256) { const int cls = TCLS[tid]; const size_t slot = (size_t)cls * 65536 + BASE[cls] + TRNK[tid]; LIST[slot] = tile * 256 + tid;
            typedef float f32x2v __attribute__((ext_vector_type(2))); *(f32x2v*)((float*)(p.ws + WS_GSLOT) + slot * 2) = *(const f32x2v*)((const float*)(lds + P7_TG) + tid * 2); }
    }
}

constexpr int MOE_SM = 131072;
__device__ __forceinline__ void cls_decode(int cls, int& g, int& lo, int& hi) {
    g = cls / 28; int r = cls % 28; lo = 0; while (r >= 7 - lo) { r -= 7 - lo; ++lo; } hi = lo + 1 + r;
}
__device__ __forceinline__ void moe_build_map(const Params& p, int* sm) {
    const int* CNT = (const int*)(p.ws + WS_CTL);
    __syncthreads();
    if (threadIdx.x < NCLS) sm[128 + threadIdx.x] = CNT[threadIdx.x];
    __syncthreads();
    if (threadIdx.x == 0) { int base = 0; for (int c = 0; c < NCLS; ++c) { sm[c] = base; base += (sm[128 + c] + 255) >> 8; } sm[256] = base; }
    __syncthreads();
    if (threadIdx.x < NCLS) { const int c = threadIdx.x, b0 = sm[c], nt = (sm[128 + c] + 255) >> 8; for (int q = 0; q < nt; ++q) sm[384 + b0 + q] = c; }
    __syncthreads();
}
struct P8Sched { const char* H2; const char* EW13; const int* LIST; const int* sm; int G, c, NU;
    __device__ __forceinline__ bool next(int i, pg::UDesc& u) const { const int q = i * G + c; if (q >= NU) return false; const int mt = q >> 3, nj = q & 7, cls = sm[384 + mt]; int g, lo, hi; cls_decode(cls, g, lo, hi);
        const int e = g * 8 + (nj < 4 ? lo : hi);
        u.A = H2; u.B0 = EW13 + ((size_t)e * 1024 + (size_t)(nj & 3) * 256) * 1024; u.B1 = u.B0 + 4 * 128; u.i0 = cls; u.i1 = mt; u.i2 = nj; u.i3 = (mt - sm[cls]) * 256; return true; }
    __device__ __forceinline__ unsigned rowoff(const pg::UDesc& u, int r) const { const int rk = u.i3 + r; const int t = (rk < sm[128 + u.i0]) ? LIST[(size_t)u.i0 * 65536 + rk] : 0; return (unsigned)t * 1024u; }
};
__device__ __forceinline__ void phase8(const Params& p, unsigned char* lds) {
    int* sm = (int*)(lds + MOE_SM);
    moe_build_map(p, sm);
    bf16_t* HID = (bf16_t*)(p.ws + WS_HID); const int* LIST = (const int*)(p.ws + WS_LIST); const float* GSLOT = (const float*)(p.ws + WS_GSLOT);
    P8Sched S{(const char*)(p.ws + WS_H), (const char*)(p.ws + WS_EW13), LIST, sm, (int)gridDim.x, vcu_of(blockIdx.x, gridDim.x), sm[256] * 8};
    auto E = [&](const f32x4 (&acc)[2][2][4][2], const pg::UDesc& u, int wr, int wc, int fr, int fq) {
        const int cnt = sm[128 + u.i0], xh = u.i2 >> 2;
        const float USC = 1.f / (FP8_XSCALE * FP8_WSCALE);
#pragma unroll
        for (int a = 0; a < 2; ++a) {
            float gts[4];
#pragma unroll
            for (int m = 0; m < 4; ++m) { const int rk = u.i3 + 128 * a + 64 * wr + 16 * m + fr; const float g = GSLOT[((size_t)u.i0 * 65536 + (rk < cnt ? rk : 0)) * 2 + xh]; gts[m] = (rk < cnt) ? g * FP8_HSCALE : 0.f; }
#pragma unroll
            for (int m = 0; m < 4; ++m) { const int rl = 128 * a + 64 * wr + 16 * m + fr; const float gt = gts[m];
                float hv[8];
#pragma unroll
                for (int n = 0; n < 2; ++n)
#pragma unroll
                    for (int q = 0; q < 4; ++q) hv[4 * n + q] = fminf(fmaxf(silu_fast(acc[a][0][m][n][q] * USC) * (acc[a][1][m][n][q] * USC) * gt, -440.f), 440.f);
                u32x2 o; o.x = pk4_fp8(hv[0], hv[1], hv[2], hv[3]); o.y = pk4_fp8(hv[4], hv[5], hv[6], hv[7]);
                *(u32x2*)((unsigned char*)HID + (size_t)(u.i1 * 256 + rl) * 1024 + xh * 512 + (u.i2 & 3) * 128 + 32 * wc + 8 * fq) = o; }
        }
    };
    pg::gemm_stream<true, true, true>((LAS unsigned char*)lds, 1024, 1024, S, E);
}
struct P9Sched { const char* HID; const char* EW2T; const int* sm; int G, c, NU;
    __device__ __forceinline__ bool next(int i, pg::UDesc& u) const { const int q = i * G + c; if (q >= NU) return false; const int mt = q >> 2, pn = q & 3, cls = sm[384 + mt]; int g, lo, hi; cls_decode(cls, g, lo, hi);
        u.A = HID + (size_t)mt * 256 * 1024; u.B0 = EW2T + ((size_t)(g * 8 + lo) * 1024 + (size_t)pn * 256) * 512; u.B1 = EW2T + ((size_t)(g * 8 + hi) * 1024 + (size_t)pn * 256) * 512;
        u.i0 = cls; u.i1 = mt; u.i2 = pn; u.i3 = (mt - sm[cls]) * 256; return true; }
    __device__ __forceinline__ unsigned rowoff(const pg::UDesc&, int) const { return 0u; }
};
__device__ __forceinline__ void phase9(const Params& p, unsigned char* lds) {
    int* sm = (int*)(lds + MOE_SM);
    moe_build_map(p, sm);
    const int* LIST = (const int*)(p.ws + WS_LIST); const float* MOD = (const float*)(p.ws + WS_MOD);
    P9Sched S{(const char*)(p.ws + WS_HID), (const char*)(p.ws + WS_EW2T), sm, (int)gridDim.x, vcu_of(blockIdx.x, gridDim.x), sm[256] * 4};
    auto E = [&](const f32x4 (&acc)[2][2][4][2], const pg::UDesc& u, int wr, int wc, int fr, int fq) {
        const int cnt = sm[128 + u.i0];
        int tk[2][4];
#pragma unroll
        for (int a = 0; a < 2; ++a)
#pragma unroll
            for (int m = 0; m < 4; ++m) { const int rk = u.i3 + 128 * a + 64 * wr + 16 * m + fr; tk[a][m] = (rk < cnt) ? LIST[(size_t)u.i0 * 65536 + rk] : -1; }
#pragma unroll
        for (int a = 0; a < 2; ++a) {
            u32x2 x1[4][2][2];
#pragma unroll
            for (int m = 0; m < 4; ++m) { const int t = tk[a][m], ts = t < 0 ? 0 : t;
                const bf16_t* xrow = (const bf16_t*)(p.ws + WS_D1) + (size_t)ts * 1024 + u.i2 * 256 + 32 * wc + 4 * fq;
#pragma unroll
                for (int b = 0; b < 2; ++b)
#pragma unroll
                    for (int n = 0; n < 2; ++n) x1[m][b][n] = *(const u32x2*)(xrow + 128 * b + 16 * n); }
#pragma unroll
            for (int m = 0; m < 4; ++m) { const int t = tk[a][m], ts = t < 0 ? 0 : t;
                const float* g2 = MOD + (size_t)(ts >> 12) * 6144 + 5120 + u.i2 * 256 + 32 * wc + 4 * fq; float* orow = p.out + (size_t)ts * 1024 + u.i2 * 256 + 32 * wc + 4 * fq;
                f32x4 gv[2][2];
#pragma unroll
                for (int b = 0; b < 2; ++b)
#pragma unroll
                    for (int n = 0; n < 2; ++n) gv[b][n] = *(const f32x4*)(g2 + 128 * b + 16 * n);
                if (t >= 0) {
#pragma unroll
                    for (int b = 0; b < 2; ++b)
#pragma unroll
                        for (int n = 0; n < 2; ++n) { const f32x4 xf = (f32x4){bflo(x1[m][b][n].x), bfhi(x1[m][b][n].x), bflo(x1[m][b][n].y), bfhi(x1[m][b][n].y)};
                            *(f32x4*)(orow + 128 * b + 16 * n) = xf + gv[b][n] * (acc[a][b][m][n] * (1.f / (FP8_HSCALE * FP8_WSCALE))); } } }
        }
    };
    pg::gemm_stream<false, false, true>((LAS unsigned char*)lds, 1024, 512, S, E);
}

#define XB_TMO      128
#define XB_XCNT(j)  (256  + 64 * (j))
#define XB_XSUB(j)  (1280 + 64 * (j))
#define XB_XGEN(j)  (2304 + 64 * (j))
#define XB_TOP      3328
#define XB_TOPGEN   3392
#define XCD_BAR_WORDS 3456
#define XB_SPIN_CAP (1u << 18)

__device__ __forceinline__ unsigned xb_ld(unsigned* p)              { return __hip_atomic_load(p, __ATOMIC_RELAXED, __HIP_MEMORY_SCOPE_AGENT); }
__device__ __forceinline__ unsigned xb_add(unsigned* p, unsigned v) { return __hip_atomic_fetch_add(p, v, __ATOMIC_RELAXED, __HIP_MEMORY_SCOPE_AGENT); }
__device__ __forceinline__ unsigned xb_xcc_id() { return (unsigned)__builtin_amdgcn_s_getreg((3 << 11) | 20) & 0xFu; }
#define XB_SPIN(cond, bar) do { unsigned _sp = 0; while (cond) { __builtin_amdgcn_s_sleep(1); \
    if ((++_sp & 255u) == 0u) { if (xb_ld(&(bar)[XB_TMO])) break; if (_sp > XB_SPIN_CAP) { atomicAdd(&(bar)[XB_TMO], 1u); break; } } } } while (0)

struct XcdBarrier {
    unsigned* bar; unsigned x;
    volatile LAS unsigned* st;
};

__device__ __forceinline__ XcdBarrier xcd_barrier_post(unsigned* bar, volatile LAS unsigned* st) {
    XcdBarrier b; b.bar = bar; b.x = xb_xcc_id(); b.st = st;
    if (threadIdx.x == 0) (void)xb_add(&bar[XB_XCNT(b.x)], 1u);
    return b;
}
__device__ __forceinline__ void xcd_barrier_complete(unsigned* bar, unsigned x, unsigned& nloc, unsigned& nx) {
    const unsigned G = gridDim.x * gridDim.y * gridDim.z;
    unsigned sum, cnt, mine, sp = 0u;
    for (;;) {
        sum = 0u; cnt = 0u; mine = 0u;
#pragma unroll
        for (unsigned j = 0; j < 16; ++j) { const unsigned c = xb_ld(&bar[XB_XCNT(j)]); sum += c; cnt += (c > 0u) ? 1u : 0u; mine = (j == x) ? c : mine; }
        if (sum == G) break;
        __builtin_amdgcn_s_sleep(1);
        if ((++sp & 255u) == 0u) { if (xb_ld(&bar[XB_TMO])) break; if (sp > XB_SPIN_CAP) { atomicAdd(&bar[XB_TMO], 1u); break; } }
    }
    nloc = mine > 0u ? mine : 1u; nx = cnt > 0u ? cnt : 1u;
}

__device__ __forceinline__ void xcd_barrier(const XcdBarrier& b) {
    asm volatile("s_waitcnt vmcnt(0)" ::: "memory");
    __syncthreads();
    if (threadIdx.x == 0) {
        unsigned* bar = b.bar;
        __builtin_amdgcn_s_waitcnt(0);
        unsigned nloc = b.st[0], nx = b.st[1];
        if (nloc == 0u) { xcd_barrier_complete(bar, b.x, nloc, nx); b.st[0] = nloc; b.st[1] = nx; }
        const unsigned old = xb_add(&bar[XB_XSUB(b.x)], 1u);
        const unsigned gen = old / nloc;
        if (old + 1u == (gen + 1u) * nloc) {
            __builtin_amdgcn_fence(__ATOMIC_RELEASE, "agent");
            asm volatile("s_waitcnt vmcnt(0)" ::: "memory");
            const unsigned og = xb_add(&bar[XB_TOP], 1u);
            const unsigned tg = og / nx;
            if (og + 1u == (tg + 1u) * nx) xb_add(&bar[XB_TOPGEN], 1u);
            else XB_SPIN(xb_ld(&bar[XB_TOPGEN]) == tg, bar);
            __builtin_amdgcn_fence(__ATOMIC_ACQUIRE, "agent");
            xb_add(&bar[XB_XGEN(b.x)], 1u);
            asm volatile("s_waitcnt vmcnt(0)" ::: "memory");
        } else {
            XB_SPIN(xb_ld(&bar[XB_XGEN(b.x)]) == gen, bar);
            __builtin_amdgcn_fence(__ATOMIC_ACQUIRE, "agent");
            asm volatile("s_waitcnt vmcnt(0)" ::: "memory");
        }
    }
    __syncthreads();
}


constexpr int LDS_BYTES = 152 * 1024;
#ifdef PROBE_A
#define TSTAMP(k) do { if (blockIdx.x == 0 && threadIdx.x == 0) ((unsigned long long*)(p.ws + WS_CTL + 4096))[k] = __builtin_amdgcn_s_memrealtime(); } while (0)
#else
#define TSTAMP(k) do { } while (0)
#endif
__global__ void __launch_bounds__(NTHR, 2) fwd_kernel(Params p) {
    extern __shared__ __attribute__((aligned(16))) unsigned char lds[];
    cg::grid_group grid = cg::this_grid();
    volatile LAS unsigned* bst = (volatile LAS unsigned*)((LAS unsigned char*)lds + LDS_BYTES - 16);
    if (threadIdx.x < 2) bst[threadIdx.x] = 0u;
    if (blockIdx.x == 0) { if (threadIdx.x < 128) ((int*)(p.ws + WS_CTL))[threadIdx.x] = 0; for (int i = threadIdx.x; i < 3456; i += NTHR) ((unsigned*)(p.ws + WS_BAR))[i] = 0u; }
    grid.sync();
    const XcdBarrier bar = xcd_barrier_post((unsigned*)(p.ws + WS_BAR), bst);
    TSTAMP(0);
    phase0(p, lds);
    xcd_barrier(bar); TSTAMP(1);
    phase1(p, lds);
    khat_items(p, lds);
    xcd_barrier(bar); TSTAMP(2);
    phase2(p, lds);
    xcd_barrier(bar); TSTAMP(3);
    phase3(p);
    xcd_barrier(bar); TSTAMP(4);
    for (int u = blockIdx.x; u < 1024; u += gridDim.x) attn_unit(p, u, lds);
    TSTAMP(5);
    {   HyRow rr; int it = blockIdx.x;
        if (it < 1024) hy_row_load(rr, (const _Float16*)(p.ws + WS_UT) + ((size_t)(((it & 1) * 8 + (otid() >> 6)) * 1536 + (it >> 1))) * 4096, otid() & 63);
        for (; it < 1024; it += gridDim.x) { const int itn = (it + (int)gridDim.x < 1024) ? it + (int)gridDim.x : it; hyena_item(p, it, itn, lds, rr); } }
    xcd_barrier(bar); TSTAMP(6);
    {   u32x4 hv[8]; const int tq5 = otid();
        if (blockIdx.x < 1024) { const bf16_t* src0 = (const bf16_t*)(p.ws + WS_HYT) + ((size_t)((blockIdx.x >> 6) * 512 + tq5)) * 4096 + (blockIdx.x & 63) * 64;
#pragma unroll
            for (int i = 0; i < 8; ++i) hv[i] = *(const u32x4*)(src0 + i * 8); }
        for (int it = blockIdx.x; it < 1024; it += gridDim.x) phase5_item(p, it, lds, hv, (it + (int)gridDim.x < 1024) ? it + (int)gridDim.x : it); }
    xcd_barrier(bar); TSTAMP(7);
    phase6(p, lds);
    xcd_barrier(bar); TSTAMP(8);
    phase7(p, lds);
    xcd_barrier(bar); TSTAMP(9);
    phase8(p, lds);
    xcd_barrier(bar); TSTAMP(10);
    phase9(p, lds);
#ifdef PROBE_A
    xcd_barrier(bar); TSTAMP(11);
    if (blockIdx.x == 0) {
        __threadfence(); __syncthreads();
        const volatile unsigned long long* ts = (const volatile unsigned long long*)(p.ws + WS_CTL + 4096);
        const float ta = (float)(ts[PROBE_A] - ts[PROBE_A - 1]) * 0.01f, tb = (float)(ts[PROBE_B] - ts[PROBE_B - 1]) * 0.0001f;
        for (int i = threadIdx.x; i < (1 << 20); i += NTHR) p.out[1024 + i] += tb;
        if (threadIdx.x == 0) p.out[0] += ta;
    }
#endif
}

extern "C" void kernel_launch(void* const* d_in, const int* in_sizes, int n_in, void* d_out, int out_size, void* d_ws, size_t ws_size, hipStream_t stream) {
    static int grid_blocks = 0;
    if (grid_blocks == 0) {
        if (n_in != 30 || out_size != NTOK * DM || ws_size < WS_END) { fprintf(stderr, "kernel_launch: unexpected shapes (n_in %d out %d ws %zu)\n", n_in, out_size, ws_size); grid_blocks = -1; return; }
        int dev = 0, cus = 0, per_cu = 0;
        hipGetDevice(&dev); hipDeviceGetAttribute(&cus, hipDeviceAttributeMultiprocessorCount, dev);
        hipFuncSetAttribute((const void*)fwd_kernel, hipFuncAttributeMaxDynamicSharedMemorySize, LDS_BYTES);
        hipOccupancyMaxActiveBlocksPerMultiprocessor(&per_cu, (const void*)fwd_kernel, NTHR, LDS_BYTES);
        if (per_cu < 1) { fprintf(stderr, "kernel_launch: occupancy query says %d blocks per CU\n", per_cu); grid_blocks = -1; return; }
        grid_blocks = cus * per_cu;
    }
    if (grid_blocks < 0) return;
    Params p{};
    const float** pp = (const float**)&p;
    for (int i = 0; i < 30; ++i) pp[i] = (const float*)d_in[i];
    p.out = (float*)d_out; p.ws = (unsigned char*)d_ws;
    void* args[] = {&p};
    hipError_t e = hipLaunchCooperativeKernel((const void*)fwd_kernel, dim3(grid_blocks), dim3(NTHR), args, LDS_BYTES, stream);
    if (e != hipSuccess) fprintf(stderr, "cooperative launch failed: %s (grid %d)\n", hipGetErrorString(e), grid_blocks);
}
```

```cpp
#include <hip/hip_runtime.h>
#include <hip/hip_cooperative_groups.h>
#include <cstdio>
#include <cstdint>
namespace cg = cooperative_groups;

typedef unsigned short bf16_t;
typedef short bf16x8 __attribute__((ext_vector_type(8)));
typedef float f32x4 __attribute__((ext_vector_type(4)));
typedef unsigned u32x4 __attribute__((ext_vector_type(4)));
typedef unsigned u32x2 __attribute__((ext_vector_type(2)));
typedef _Float16 f16x8 __attribute__((ext_vector_type(8)));
typedef _Float16 f16x4 __attribute__((ext_vector_type(4)));
typedef _Float16 f16x2 __attribute__((ext_vector_type(2)));

constexpr int DM = 1024, NB = 16, SEQ = 4096, NTOK = NB * SEQ, CTXL = 256, NCTX = NB * CTXL;
constexpr int PROJW = 2304, HYW = 512, HYPW = 1536, KOFF = 512, VOFF = 640, HYOFF = 768;
constexpr int NEXP = 32, EHID = 512, NCLS = 112;
constexpr float EPSN = 1e-6f;
constexpr int NTHR = 512;

constexpr size_t MiB = 1u << 20;
constexpr size_t WS_CTL = 0, WS_MOD = 1 * MiB, WS_WINT = 2 * MiB, WS_WOUTT = 7 * MiB, WS_TAPS = 9 * MiB, WS_EW13 = 41 * MiB, WS_EW2T = 105 * MiB;
constexpr size_t WS_GATE = 137 * MiB, WS_KVC = 139 * MiB, WS_HC = 141 * MiB, WS_LIST = 149 * MiB, WS_H = 177 * MiB, WS_QKV = 305 * MiB, WS_UT = 401 * MiB;
constexpr size_t WS_HYT = 593 * MiB, WS_ATTHY = 657 * MiB, WS_HID = 305 * MiB, WS_KH = 785 * MiB, WS_END = 1003 * MiB;
constexpr size_t WS_BAR = 16384;
constexpr size_t WS_GSLOT = 945 * MiB;
constexpr size_t WS_D1 = 817 * MiB;
constexpr size_t WS_FTAB = 65536, WS_GTAB = 81920, WS_FKTAB = 98304;

struct Params {
    const float* x; const float* c; const float* ctx; const float* c_ctx; const float* ada_w; const float* ada_b; const float* norm1_w; const float* w_in;
    const float* q_norm_w; const float* k_norm_w; const float* attn_sink; const float* hy_conv_w; const float* hy_conv_b; const float* hy_w1; const float* hy_b1;
    const float* hy_w2; const float* hy_b2; const float* hy_w3; const float* hy_sin_freq; const float* hy_skip; const float* group_norm_w; const float* w_out;
    const float* norm2_w; const float* router_g_w; const float* router_g_b; const float* router_e_w; const float* router_e_b; const float* exp_w1; const float* exp_w3;
    const float* exp_w2;
    float* out; unsigned char* ws;
};

__device__ __forceinline__ unsigned f2bf(float f) { unsigned u = __builtin_bit_cast(unsigned, f); return (u + 0x7fffu + ((u >> 16) & 1u)) >> 16; }
typedef float f32x2_t __attribute__((ext_vector_type(2))); typedef __bf16 bf16x2_t __attribute__((ext_vector_type(2)));
__device__ __forceinline__ unsigned pk2(float lo, float hi) { f32x2_t v = {lo, hi}; bf16x2_t b = __builtin_convertvector(v, bf16x2_t); return __builtin_bit_cast(unsigned, b); }
__device__ __forceinline__ float bf2f(unsigned short b) { return __builtin_bit_cast(float, (unsigned)b << 16); }
__device__ __forceinline__ float bflo(unsigned w) { return __builtin_bit_cast(float, w << 16); }
__device__ __forceinline__ float bfhi(unsigned w) { return __builtin_bit_cast(float, w & 0xffff0000u); }
__device__ __forceinline__ unsigned pkh2(float lo, float hi) { f16x2 v = {(_Float16)lo, (_Float16)hi}; return __builtin_bit_cast(unsigned, v); }
__device__ __forceinline__ float h2f(unsigned short h) { return (float)__builtin_bit_cast(_Float16, h); }
__device__ __forceinline__ float hlo(unsigned w) { return h2f((unsigned short)(w & 0xffffu)); }
__device__ __forceinline__ float hhi(unsigned w) { return h2f((unsigned short)(w >> 16)); }
#define dpp_f(v, ctrl) __builtin_bit_cast(float, __builtin_amdgcn_update_dpp(0, __builtin_bit_cast(int, (float)(v)), (ctrl), 0xf, 0xf, false))
#define DPP_XOR1 0xB1
#define DPP_XOR2 0x4E
#define DPP_HMIRROR 0x141
#define DPP_MIRROR 0x140
__device__ __forceinline__ float xor16_sum(float v) { const unsigned u = __builtin_bit_cast(unsigned, v); auto r = __builtin_amdgcn_permlane16_swap(u, u, false, false); return __builtin_bit_cast(float, (unsigned)r[0]) + __builtin_bit_cast(float, (unsigned)r[1]); }
__device__ __forceinline__ float xor32_sum(float v) { const unsigned u = __builtin_bit_cast(unsigned, v); auto r = __builtin_amdgcn_permlane32_swap(u, u, false, false); return __builtin_bit_cast(float, (unsigned)r[0]) + __builtin_bit_cast(float, (unsigned)r[1]); }
__device__ __forceinline__ float wave_sum(float v) {
    v += dpp_f(v, DPP_XOR1); v += dpp_f(v, DPP_XOR2); v += dpp_f(v, DPP_HMIRROR); v += dpp_f(v, DPP_MIRROR);
    v = xor16_sum(v); v = xor32_sum(v);
    return v;
}
__device__ __forceinline__ int otid() { int t = threadIdx.x; asm volatile("" : "+v"(t)); return t; }
__device__ __forceinline__ float exp2_raw(float x) { float r; asm volatile("v_exp_f32 %0, %1\n\ts_nop 1" : "=v"(r) : "v"(x)); return r; }
__device__ __forceinline__ float max_fq(float m) { const unsigned u = __builtin_bit_cast(unsigned, m);
    auto r16 = __builtin_amdgcn_permlane16_swap(u, u, false, false); float a = fmaxf(__builtin_bit_cast(float, (unsigned)r16[0]), __builtin_bit_cast(float, (unsigned)r16[1]));
    const unsigned ua = __builtin_bit_cast(unsigned, a); auto r32 = __builtin_amdgcn_permlane32_swap(ua, ua, false, false); return fmaxf(__builtin_bit_cast(float, (unsigned)r32[0]), __builtin_bit_cast(float, (unsigned)r32[1])); }
__device__ __forceinline__ float siluf(float v) { return v / (1.f + __expf(-v)); }
__device__ __forceinline__ float rcp_raw(float x) { float r; asm volatile("v_rcp_f32 %0, %1\n\ts_nop 1" : "=v"(r) : "v"(x)); return r; }
__device__ __forceinline__ float silu_fast(float v) { return v * rcp_raw(1.f + exp2_raw(v * -1.4426950408889634f)); }
__device__ __forceinline__ float sin_rad(float a) { float r = a * 0.15915494309189535f; r -= floorf(r); return __builtin_amdgcn_sinf(r); }
__device__ __forceinline__ float cos_rad(float a) { float r = a * 0.15915494309189535f; r -= floorf(r); return __builtin_amdgcn_cosf(r); }

template <class SrcA, class SrcB>
__device__ __forceinline__ void gemm_unit(unsigned char* lds, f32x4 (&acc)[2][2][4][2], const SrcA& srcA, const SrcB& srcB) {
    const int tid = otid(), wid = tid >> 6, lane = tid & 63, wr = wid >> 2, wc = wid & 3, fr = lane & 15, fq = lane >> 4;
#pragma unroll
    for (int a = 0; a < 2; ++a)
#pragma unroll
        for (int b = 0; b < 2; ++b)
#pragma unroll
            for (int m = 0; m < 4; ++m)
#pragma unroll
                for (int n = 0; n < 2; ++n) acc[a][b][m][n] = (f32x4){0.f, 0.f, 0.f, 0.f};
    const int r0 = tid >> 2, kc = tid & 3;
    const bf16_t* pa0 = srcA(r0) + kc * 8; const bf16_t* pa1 = srcA(r0 + 128) + kc * 8;
    u32x4 ra0, ra1, rb0, rb1;
    ra0 = *(const u32x4*)(pa0); ra1 = *(const u32x4*)(pa1);
    rb0 = *(const u32x4*)(srcB(r0, 0) + kc * 8); rb1 = *(const u32x4*)(srcB(r0 + 128, 0) + kc * 8);
    unsigned char* sA = lds; unsigned char* sB = lds + 16384;
    for (int ks = 0; ks < 32; ++ks) {
        __syncthreads();
        *(u32x4*)(sA + tid * 16) = ra0; *(u32x4*)(sA + 8192 + tid * 16) = ra1;
        *(u32x4*)(sB + tid * 16) = rb0; *(u32x4*)(sB + 8192 + tid * 16) = rb1;
        __syncthreads();
        if (ks + 1 < 32) {
            ra0 = *(const u32x4*)(pa0 + (ks + 1) * 32); ra1 = *(const u32x4*)(pa1 + (ks + 1) * 32);
            rb0 = *(const u32x4*)(srcB(r0, ks + 1) + kc * 8); rb1 = *(const u32x4*)(srcB(r0 + 128, ks + 1) + kc * 8);
        }
        bf16x8 Af[2][4], Bf[2][2];
#pragma unroll
        for (int a = 0; a < 2; ++a)
#pragma unroll
            for (int m = 0; m < 4; ++m) Af[a][m] = *(const bf16x8*)(sA + (128 * a + 64 * wr + 16 * m + fr) * 64 + fq * 16);
#pragma unroll
        for (int b = 0; b < 2; ++b)
#pragma unroll
            for (int n = 0; n < 2; ++n) Bf[b][n] = *(const bf16x8*)(sB + (128 * b + 32 * wc + 16 * n + fr) * 64 + fq * 16);
#pragma unroll
        for (int a = 0; a < 2; ++a)
#pragma unroll
            for (int b = 0; b < 2; ++b)
#pragma unroll
                for (int m = 0; m < 4; ++m)
#pragma unroll
                    for (int n = 0; n < 2; ++n) acc[a][b][m][n] = __builtin_amdgcn_mfma_f32_16x16x32_bf16(Bf[b][n], Af[a][m], acc[a][b][m][n], 0, 0, 0);
    }
}
#define ACC_FOREACH(acc, BODY) do { \
    const int _wid = threadIdx.x >> 6, _lane = threadIdx.x & 63, _wr = _wid >> 2, _wc = _wid & 3, _fr = _lane & 15, _fq = _lane >> 4; \
    _Pragma("unroll") for (int _a = 0; _a < 2; ++_a) _Pragma("unroll") for (int _m = 0; _m < 4; ++_m) _Pragma("unroll") for (int _b = 0; _b < 2; ++_b) _Pragma("unroll") for (int _n = 0; _n < 2; ++_n) { \
        const int rl = 128 * _a + 64 * _wr + 16 * _m + _fr, cl = 128 * _b + 32 * _wc + 16 * _n + 4 * _fq; const f32x4 v = acc[_a][_b][_m][_n]; BODY } } while (0)


#define LAS __attribute__((address_space(3)))
namespace pg {
constexpr int HTB = 16384;
__device__ __forceinline__ int lds_byte(int r, int c) { const int st = (r >> 4) * 2 + (c >> 5), rr = r & 15, cc = c & 31, ob = rr * 64 + cc * 2; return st * 1024 + (ob ^ (((ob >> 9) & 1) << 5)); }
__device__ __forceinline__ void stage_rc(int b, int& R, int& C) { const int st = b / 1024, sb = b % 1024, swz = sb ^ (((sb >> 9) & 1) << 5); R = (st >> 1) * 16 + swz / 64; C = (st & 1) * 32 + (swz % 64) / 2; }
__device__ __forceinline__ int perm32(int rho) { const int n = rho >> 4, i = rho & 15; return 8 * (i >> 2) + 4 * n + (i & 3); }
struct UDesc { const char* A; const char* B0; const char* B1; int i0, i1, i2, i3; };
typedef int v8i_t __attribute__((ext_vector_type(8)));
template <bool GATHER, bool PERM, bool FP8, bool NC = false, class Sched, class Epi>
__device__ __forceinline__ void gemm_stream(LAS unsigned char* lds, const int KA, const int KB, const Sched& S, const Epi& E) {
    const int tid = otid(), wid = __builtin_amdgcn_readfirstlane(tid >> 6), lane = tid & 63, wr = wid >> 2, wc = wid & 3, fr = lane & 15, fq = lane >> 4;
    constexpr int nt = FP8 ? 8 : 16, nth = nt / 2;
    unsigned voffA[2], voffB[2]; int rowA[2]; unsigned colA[2];
#pragma unroll
    for (int i = 0; i < 2; ++i) { int R, C; stage_rc(tid * 16 + i * 8192, R, C); const int Rb = NC ? (64 * (R >> 5) + perm32(R & 31)) : (PERM ? ((R & ~31) + perm32(R & 31)) : R);
        voffA[i] = (unsigned)(R * KA + C * 2); voffB[i] = (unsigned)(Rb * KB + C * 2); rowA[i] = R; colA[i] = (unsigned)C * 2u; }
    const size_t hstepA = (size_t)128 * KA, hstepB = (size_t)(NC ? 32 : 128) * KB;
    const unsigned ldsw = (unsigned)wid * 1024u;
    const int aoff = lds_byte(wr * 64 + fr, fq * 8), boff = lds_byte(wc * 32 + fr, fq * 8);
    const int aoff8a = lds_byte(wr * 64 + fr, fq * 16), aoff8b = aoff8a + 16, boff8a = lds_byte(wc * 32 + fr, fq * 16), boff8b = boff8a + 16;
#define PG_SA(b, h) (((b) * 2 + (h)) * pg::HTB)
#define PG_SB(b, h) ((4 + (b) * 2 + (h)) * pg::HTB)
#define PG_LD2(bufoff, p0, p1) do { __builtin_amdgcn_global_load_lds((const unsigned*)(p0), (LAS unsigned*)(lds + (bufoff) + ldsw), 16, 0, 0); \
        __builtin_amdgcn_global_load_lds((const unsigned*)(p1), (LAS unsigned*)(lds + (bufoff) + ldsw + 8192), 16, 0, 0); } while (0)
#define PG_STA(bufoff, pa, VA, h) do { if (GATHER) PG_LD2(bufoff, (pa) + ((h) ? VA##10 : VA##00), (pa) + ((h) ? VA##11 : VA##01)); else { const char* _b = (pa) + (h) * hstepA; PG_LD2(bufoff, _b + voffA[0], _b + voffA[1]); } } while (0)
#define PG_STB(bufoff, pb, h) do { const char* _b = (pb) + (h) * hstepB; PG_LD2(bufoff, _b + voffB[0], _b + voffB[1]); } while (0)
#define PG_LD8(p0, p1) __builtin_bit_cast(v8i_t, __builtin_shufflevector(*(const LAS bf16x8*)(p0), *(const LAS bf16x8*)(p1), 0, 1, 2, 3, 4, 5, 6, 7, 8, 9, 10, 11, 12, 13, 14, 15))
#define PG_LDA(dst, b, h) do { _Pragma("unroll") for (int m = 0; m < 4; ++m) { if (FP8) dst##8[m] = PG_LD8(lds + PG_SA(b, h) + aoff8a + m * 2048, lds + PG_SA(b, h) + aoff8b + m * 2048); \
        else { _Pragma("unroll") for (int k = 0; k < 2; ++k) dst[m][k] = *(const LAS bf16x8*)(lds + PG_SA(b, h) + aoff + m * 2048 + k * 1024); } } } while (0)
#define PG_LDB(dst, b, h) do { _Pragma("unroll") for (int n = 0; n < 2; ++n) { if (FP8) dst##8[n] = PG_LD8(lds + PG_SB(b, h) + boff8a + n * 2048, lds + PG_SB(b, h) + boff8b + n * 2048); \
        else { _Pragma("unroll") for (int k = 0; k < 2; ++k) dst[n][k] = *(const LAS bf16x8*)(lds + PG_SB(b, h) + boff + n * 2048 + k * 1024); } } } while (0)
#define PG_MMA(ai, bj, At, Bt) do { __builtin_amdgcn_s_setprio(1); _Pragma("unroll") for (int m = 0; m < 4; ++m) _Pragma("unroll") for (int n = 0; n < 2; ++n) { \
        if (FP8) asm volatile("v_mfma_f32_16x16x128_f8f6f4 %0, %1, %2, %0" : "+v"(acc[ai][bj][m][n]) : "v"(Bt##8[n]), "v"(At##8[m])); \
        else { _Pragma("unroll") for (int k = 0; k < 2; ++k) acc[ai][bj][m][n] = __builtin_amdgcn_mfma_f32_16x16x32_bf16(Bt[n][k], At[m][k], acc[ai][bj][m][n], 0, 0, 0); } } __builtin_amdgcn_s_setprio(0); } while (0)
#define PG_WAIT_V(n) asm volatile("s_waitcnt vmcnt(" #n ")" ::: "memory")
#define PG_WAIT_L(n) asm volatile("s_waitcnt lgkmcnt(" #n ")" ::: "memory")
#define PG_BAR __builtin_amdgcn_s_barrier()
#define PG_SCHED __builtin_amdgcn_sched_barrier(0)
    UDesc cur, nxt; int ui = 0;
    unsigned cva00 = 0, cva01 = 0, cva10 = 0, cva11 = 0, nva00 = 0, nva01 = 0, nva10 = 0, nva11 = 0;
    if (!S.next(0, cur)) return;
    if (GATHER) { int R0, C0, R1, C1; stage_rc(otid() * 16, R0, C0); stage_rc(otid() * 16 + 8192, R1, C1);
        cva00 = S.rowoff(cur, R0) + C0 * 2; cva01 = S.rowoff(cur, R1) + C1 * 2; cva10 = S.rowoff(cur, 128 + R0) + C0 * 2; cva11 = S.rowoff(cur, 128 + R1) + C1 * 2; }
    f32x4 acc[2][2][4][2];
#pragma unroll
    for (int a = 0; a < 2; ++a)
#pragma unroll
        for (int b = 0; b < 2; ++b)
#pragma unroll
            for (int m = 0; m < 4; ++m)
#pragma unroll
                for (int n = 0; n < 2; ++n) acc[a][b][m][n] = (f32x4){0.f, 0.f, 0.f, 0.f};
    bf16x8 At[4][2], B0[2][2], B1[2][2]; v8i_t At8[4], B08[2], B18[2];
    PG_STB(PG_SB(0, 0), cur.B0, 0); PG_STB(PG_SB(0, 1), cur.B0, 1); PG_STA(PG_SA(0, 0), cur.A, cva, 0); PG_STA(PG_SA(0, 1), cur.A, cva, 1);
    if (wr == 1) PG_BAR;
    PG_WAIT_V(2); PG_BAR;
    PG_STB(PG_SB(1, 0), cur.B0 + 128, 0); PG_STA(PG_SA(1, 0), cur.A + 128, cva, 0); PG_STB(PG_SB(1, 1), cur.B0 + 128, 1);
    PG_WAIT_V(6); PG_BAR;
    for (;;) {
        const bool has_next = S.next(ui + 1, nxt);
        if (!has_next) nxt = cur;
        if (GATHER) { if (has_next) { int R0, C0, R1, C1; stage_rc(otid() * 16, R0, C0); stage_rc(otid() * 16 + 8192, R1, C1);
                nva00 = S.rowoff(nxt, R0) + C0 * 2; nva01 = S.rowoff(nxt, R1) + C1 * 2; nva10 = S.rowoff(nxt, 128 + R0) + C0 * 2; nva11 = S.rowoff(nxt, 128 + R1) + C1 * 2; }
            else { nva00 = cva00; nva01 = cva01; nva10 = cva10; nva11 = cva11; } }
        for (int t = 0; t < nt; t += 2) {
            const bool last = (t == nt - 2);
            const char* a1 = cur.A + (size_t)(t + 1) * 128;
            const char* a2 = last ? nxt.A : cur.A + (size_t)(t + 2) * 128;
            const char* b2 = last ? nxt.B0 : ((t + 2 < nth) ? cur.B0 + (size_t)(t + 2) * 128 : cur.B1 + (size_t)(t + 2 - nth) * 128);
            const char* a3 = a2 + 128; const char* b3 = b2 + 128;
            PG_LDB(B0, 0, 0); PG_LDB(B1, 0, 1); PG_SCHED; PG_LDA(At, 0, 0); PG_STA(PG_SA(1, 1), a1, cva, 1);
            if (GATHER && last) { cva00 = nva00; cva01 = nva01; cva10 = nva10; cva11 = nva11; }
            PG_WAIT_V(8); PG_WAIT_L(0); PG_BAR; PG_MMA(0, 0, At, B0); PG_MMA(0, 1, At, B1); PG_BAR; PG_SCHED;
            PG_LDA(At, 0, 1); PG_STB(PG_SB(0, 0), b2, 0); PG_STB(PG_SB(0, 1), b2, 1); PG_STA(PG_SA(0, 0), a2, cva, 0);
            PG_WAIT_V(8); PG_WAIT_L(0); PG_BAR; PG_MMA(1, 0, At, B0); PG_MMA(1, 1, At, B1); PG_BAR; PG_SCHED;
            PG_LDB(B0, 1, 0); PG_LDB(B1, 1, 1); PG_SCHED; PG_LDA(At, 1, 0); PG_STA(PG_SA(0, 1), a2, cva, 1);
            PG_WAIT_V(8); PG_WAIT_L(0); PG_BAR; PG_MMA(0, 0, At, B0); PG_MMA(0, 1, At, B1); PG_BAR; PG_SCHED;
            PG_LDA(At, 1, 1); PG_STB(PG_SB(1, 0), b3, 0); PG_STB(PG_SB(1, 1), b3, 1); PG_STA(PG_SA(1, 0), a3, cva, 0);
            PG_WAIT_V(8); PG_WAIT_L(0); PG_BAR; PG_MMA(1, 0, At, B0); PG_MMA(1, 1, At, B1); PG_BAR; PG_SCHED;
        }
        if (wr == 0) PG_BAR;
        if (FP8) asm volatile("s_nop 15\n\ts_nop 15" ::: "memory");
        E(acc, cur, wr, wc, fr, fq);
        if (!has_next) break;
#pragma unroll
        for (int a = 0; a < 2; ++a)
#pragma unroll
            for (int b = 0; b < 2; ++b)
#pragma unroll
                for (int m = 0; m < 4; ++m)
#pragma unroll
                    for (int n = 0; n < 2; ++n) acc[a][b][m][n] = (f32x4){0.f, 0.f, 0.f, 0.f};
        cur = nxt; ++ui;
        if (wr == 1) PG_BAR;
    }
    PG_WAIT_V(0);
    PG_BAR;
#undef PG_SA
#undef PG_SB
#undef PG_LD2
#undef PG_STA
#undef PG_STB
#undef PG_LDA
#undef PG_LDB
#undef PG_MMA
#undef PG_WAIT_V
#undef PG_WAIT_L
#undef PG_BAR
#undef PG_SCHED
}
}
#define ACCP_FOREACH(acc, wr, wc, fr, fq, BODY) do { \
    _Pragma("unroll") for (int _a = 0; _a < 2; ++_a) _Pragma("unroll") for (int _m = 0; _m < 4; ++_m) _Pragma("unroll") for (int _b = 0; _b < 2; ++_b) { \
        const int rl = 128 * _a + 64 * (wr) + 16 * _m + (fr), cl = 128 * _b + 32 * (wc) + 8 * (fq); const f32x4 v0 = acc[_a][_b][_m][0], v1 = acc[_a][_b][_m][1]; BODY } } while (0)
#define ACCC_FOREACH(acc, wr, wc, fr, fq, BODY) do { \
    _Pragma("unroll") for (int _a = 0; _a < 2; ++_a) _Pragma("unroll") for (int _m = 0; _m < 4; ++_m) _Pragma("unroll") for (int _b = 0; _b < 2; ++_b) { \
        const int rl = 128 * _a + 64 * (wr) + 16 * _m + (fr), cl = 64 * (wc) + 32 * _b + 8 * (fq); const f32x4 v0 = acc[_a][_b][_m][0], v1 = acc[_a][_b][_m][1]; BODY } } while (0)
template <bool NT = false>
__device__ __forceinline__ void store_pair16(unsigned short* base, const size_t pitch, const int rl, const int wc, const int fr, const int fq, const u32x4 o0, const u32x4 o1) {
    const bool oddl = (fr & 1) != 0; const u32x4 snd = oddl ? o0 : o1; u32x4 rcv;
    rcv.x = (unsigned)__builtin_amdgcn_update_dpp(0, (int)snd.x, DPP_XOR1, 0xf, 0xf, false); rcv.y = (unsigned)__builtin_amdgcn_update_dpp(0, (int)snd.y, DPP_XOR1, 0xf, 0xf, false);
    rcv.z = (unsigned)__builtin_amdgcn_update_dpp(0, (int)snd.z, DPP_XOR1, 0xf, 0xf, false); rcv.w = (unsigned)__builtin_amdgcn_update_dpp(0, (int)snd.w, DPP_XOR1, 0xf, 0xf, false);
    unsigned short* pe = base + (size_t)(rl & ~1) * pitch + 64 * wc + 8 * fq + (oddl ? 32 : 0);
    if (NT) { __builtin_nontemporal_store(oddl ? rcv : o0, (u32x4*)pe); __builtin_nontemporal_store(oddl ? o1 : rcv, (u32x4*)(pe + pitch)); }
    else { *(u32x4*)pe = oddl ? rcv : o0; *(u32x4*)(pe + pitch) = oddl ? o1 : rcv; }
}
#define ACCN_FOREACH(acc, wr, wc, fr, fq, BODY) do { \
    _Pragma("unroll") for (int _a = 0; _a < 2; ++_a) _Pragma("unroll") for (int _m = 0; _m < 4; ++_m) _Pragma("unroll") for (int _b = 0; _b < 2; ++_b) _Pragma("unroll") for (int _n = 0; _n < 2; ++_n) { \
        const int rl = 128 * _a + 64 * (wr) + 16 * _m + (fr), cl = 128 * _b + 32 * (wc) + 16 * _n + 4 * (fq); const f32x4 v = acc[_a][_b][_m][_n]; BODY } } while (0)
__device__ __forceinline__ int vcu_of(int bx, int G) { return (G % 8 == 0) ? (bx % 8) * (G / 8) + bx / 8 : bx; }

__device__ __forceinline__ void p0_adaln(const Params& p, int it, unsigned char* lds) {
    float* S = (float*)lds;
    float* R = (float*)(lds + 17 * 1024 * 4);
    const int tid = otid();
    __syncthreads();
    {   float cv[34];
#pragma unroll
        for (int q = 0; q < 34; ++q) { const int i = tid + NTHR * q, r = i >> 10, k = i & 1023; cv[q] = (r < 16) ? p.c[r * 1024 + k] : p.c_ctx[k]; }
#pragma unroll
        for (int q = 0; q < 34; ++q) S[tid + NTHR * q] = siluf(cv[q]); }
    __syncthreads();
    const int col = tid & 63, sl = tid >> 6, n = it * 64 + col;
    float a[17];
#pragma unroll
    for (int r = 0; r < 17; ++r) a[r] = 0.f;
#pragma unroll 1
    for (int k0 = sl * 128; k0 < sl * 128 + 128; k0 += 16) {
        float w[16];
#pragma unroll
        for (int q = 0; q < 16; ++q) w[q] = p.ada_w[(size_t)(k0 + q) * 6144 + n];
#pragma unroll
        for (int q = 0; q < 16; ++q)
#pragma unroll
            for (int r = 0; r < 17; ++r) a[r] += S[r * 1024 + k0 + q] * w[q];
    }
#pragma unroll
    for (int r = 0; r < 17; ++r) R[(sl * 17 + r) * 64 + col] = a[r];
    __syncthreads();
    float* MOD = (float*)(p.ws + WS_MOD);
    for (int i = tid; i < 17 * 64; i += NTHR) { const int r = i >> 6, cc = i & 63; float s = 0.f;
#pragma unroll
        for (int q = 0; q < 8; ++q) s += R[(q * 17 + r) * 64 + cc];
        MOD[r * 6144 + it * 64 + cc] = s + p.ada_b[it * 64 + cc]; }
}

__device__ __forceinline__ void p0_taps(const Params& p, int it, unsigned char* lds) {
    float* FE = (float*)lds;
    float* H1 = FE + 16 * 36;
    float* H2 = H1 + 16 * 64;
    const int tid = otid(), p0 = it * 16;
    __syncthreads();
    if (tid < 256) { const int pp = tid >> 4, j = tid & 15; const float pos = (float)(p0 + pp);
        const float band = 1e-4f + (float)j * ((15.f - 1e-4f) / 15.f);
        float rev = pos * band * (1.f / 4096.f); rev -= floorf(rev);
        FE[pp * 36 + 1 + j] = __builtin_amdgcn_cosf(rev); FE[pp * 36 + 17 + j] = -__builtin_amdgcn_sinf(rev);
        if (j == 0) FE[pp * 36] = pos * (1.f / 4096.f); }
    __syncthreads();
    for (int i = tid; i < 1024; i += NTHR) { const int pp = i >> 6, j = i & 63; float s = p.hy_b1[j];
#pragma unroll
        for (int q = 0; q < 33; ++q) s += FE[pp * 36 + q] * p.hy_w1[q * 64 + j];
        H1[pp * 64 + j] = sin_rad(p.hy_sin_freq[j] * s); }
    __syncthreads();
    for (int i = tid; i < 1024; i += NTHR) { const int pp = i >> 6, j = i & 63; float s = p.hy_b2[j];
#pragma unroll
        for (int q = 0; q < 64; ++q) s += H1[pp * 64 + q] * p.hy_w2[q * 64 + j];
        H2[pp * 64 + j] = sin_rad(p.hy_sin_freq[64 + j] * s); ((_Float16*)(H2 + 1024))[pp * 72 + j] = (_Float16)H2[pp * 64 + j]; }
    __syncthreads();
    float* TAPS = (float*)(p.ws + WS_TAPS);
    const float mind = -3.0701134573253945f, maxd = -15.350567286626972f;
    const int wid = tid >> 6, lane = tid & 63, fr = lane & 15, fq = lane >> 4;
    const _Float16* H2h = (const _Float16*)(H2 + 1024);
    const f16x8 a0 = *(const f16x8*)(H2h + fr * 72 + 8 * fq), a1 = *(const f16x8*)(H2h + fr * 72 + 32 + 8 * fq);
#pragma unroll 2
    for (int j = 0; j < 16; ++j) {
        const int col = 256 * wid + 16 * j + fr, o = col >> 10, dir = (col >> 9) & 1, c = col & 511;
        float wv[16];
#pragma unroll
        for (int e = 0; e < 8; ++e) { wv[e] = p.hy_w3[(size_t)(8 * fq + e) * 2048 + col]; wv[8 + e] = p.hy_w3[(size_t)(32 + 8 * fq + e) * 2048 + col]; }
        f16x8 b0, b1;
#pragma unroll
        for (int e = 0; e < 8; ++e) { b0[e] = (_Float16)wv[e]; b1[e] = (_Float16)wv[8 + e]; }
        f32x4 acc = (f32x4){0.f, 0.f, 0.f, 0.f};
        acc = __builtin_amdgcn_mfma_f32_16x16x32_f16(a0, b0, acc, 0, 0, 0); acc = __builtin_amdgcn_mfma_f32_16x16x32_f16(a1, b1, acc, 0, 0, 0);
        const float delta = fabsf(mind + (maxd - mind) * ((float)c / 511.f));
        float* tp = TAPS + ((size_t)(o * 512 + c)) * 8192;
        const int P = p0 + 4 * fq; f32x4 val;
#pragma unroll
        for (int r = 0; r < 4; ++r) val[r] = acc[r] * __expf(-(float)(P + r) * (1.f / 4096.f) * delta);
        if (dir == 0) *(f32x4*)(tp + 4096 + P) = val;
        else {
#pragma unroll
            for (int r = 0; r < 4; ++r) { if (P + r == 0) tp[0] = 0.f; else tp[4096 - (P + r)] = val[r]; } }
    }
}

__device__ __forceinline__ unsigned pk4_fp8(float a, float b, float c, float d) { int w = 0; w = __builtin_amdgcn_cvt_pk_fp8_f32(a, b, w, false); w = __builtin_amdgcn_cvt_pk_fp8_f32(c, d, w, true); return (unsigned)w; }
constexpr float FP8_WSCALE = 64.f, FP8_XSCALE = 4.f, FP8_HSCALE = 16.f;
struct TrItem { const float* src; bf16_t* dst; int N, k0, n0, dpitch, mode; bool f8; };
__device__ __forceinline__ void p0_tr_load(const TrItem& t, f32x4 (&v)[8], int lane) {
#pragma unroll
    for (int i = 0; i < 8; ++i) v[i] = __builtin_nontemporal_load((const f32x4*)(t.src + (size_t)(t.k0 + 8 * i + (lane >> 3)) * t.N + t.n0 + 4 * (lane & 7)));
}
__device__ __forceinline__ void p0_tr_finish(const TrItem& t, const f32x4 (&v)[8], float* scr  , int lane) {
#pragma unroll
    for (int i = 0; i < 8; ++i) { float* d = scr + (8 * i + (lane >> 3)) * 33 + 4 * (lane & 7); d[0] = v[i].x; d[1] = v[i].y; d[2] = v[i].z; d[3] = v[i].w; }
    asm volatile("s_waitcnt lgkmcnt(0)" ::: "memory");
    const int c = lane & 7;
#pragma unroll
    for (int j = 0; j < 4; ++j) { const int n = (lane >> 3) + 8 * j, col = t.n0 + n; const float* sp = scr + (8 * c) * 33 + n;
        int drow = col;
        if (t.mode == 1) drow = (col >> 7) * 256 + (col & 127); else if (t.mode == 2) drow = (col >> 7) * 256 + 128 + (col & 127);
        if (t.f8) { u32x2 o; o.x = pk4_fp8(sp[0] * FP8_WSCALE, sp[33] * FP8_WSCALE, sp[66] * FP8_WSCALE, sp[99] * FP8_WSCALE); o.y = pk4_fp8(sp[132] * FP8_WSCALE, sp[165] * FP8_WSCALE, sp[198] * FP8_WSCALE, sp[231] * FP8_WSCALE);
            *(u32x2*)((unsigned char*)t.dst + (size_t)drow * t.dpitch + t.k0 + 8 * c) = o; }
        else { u32x4 o; o.x = pk2(sp[0], sp[33]); o.y = pk2(sp[66], sp[99]); o.z = pk2(sp[132], sp[165]); o.w = pk2(sp[198], sp[231]);
            *(u32x4*)(t.dst + (size_t)drow * t.dpitch + t.k0 + 8 * c) = o; } }
    asm volatile("s_waitcnt lgkmcnt(0)" ::: "memory");
}
__device__ __forceinline__ void p0_transpose_w(const float* src, int N, int k0, int n0, bf16_t* dst, int dpitch, int mode, float* scr  , int lane, bool fp8 = false) {
    float v[32];
#pragma unroll
    for (int i = 0; i < 32; ++i) v[i] = src[(size_t)(k0 + 2 * i + (lane >> 5)) * N + n0 + (lane & 31)];
#pragma unroll
    for (int i = 0; i < 32; ++i) scr[(2 * i + (lane >> 5)) * 33 + (lane & 31)] = v[i];
    asm volatile("s_waitcnt lgkmcnt(0)" ::: "memory");
    const int c = lane & 7;
#pragma unroll
    for (int j = 0; j < 4; ++j) { const int n = (lane >> 3) + 8 * j, col = n0 + n; const float* sp = scr + (8 * c) * 33 + n;
        int drow = col;
        if (mode == 1) drow = (col >> 7) * 256 + (col & 127); else if (mode == 2) drow = (col >> 7) * 256 + 128 + (col & 127);
        if (fp8) { u32x2 o; o.x = pk4_fp8(sp[0] * FP8_WSCALE, sp[33] * FP8_WSCALE, sp[66] * FP8_WSCALE, sp[99] * FP8_WSCALE); o.y = pk4_fp8(sp[132] * FP8_WSCALE, sp[165] * FP8_WSCALE, sp[198] * FP8_WSCALE, sp[231] * FP8_WSCALE);
            *(u32x2*)((unsigned char*)dst + (size_t)drow * dpitch + k0 + 8 * c) = o; }
        else { u32x4 o; o.x = pk2(sp[0], sp[33]); o.y = pk2(sp[66], sp[99]); o.z = pk2(sp[132], sp[165]); o.w = pk2(sp[198], sp[231]);
            *(u32x4*)(dst + (size_t)drow * dpitch + k0 + 8 * c) = o; } }
    asm volatile("s_waitcnt lgkmcnt(0)" ::: "memory");
}

__device__ __forceinline__ void p0_tables(const Params& p, int it) {
    const int e = it * NTHR + threadIdx.x;
    _Float16* FT = (_Float16*)(p.ws + WS_FTAB); _Float16* GT = (_Float16*)(p.ws + WS_GTAB); _Float16* FK = (_Float16*)(p.ws + WS_FKTAB);
    if (e < 8192) { const int rho = e >> 6, s1 = e & 63, f = rho >> 1; float v;
        if (rho == 0) v = 1.f; else if (rho == 1) v = (s1 & 1) ? -1.f : 1.f;
        else { const float rev = (float)((f * s1) & 127) * (1.f / 128.f); v = (rho & 1) ? -__builtin_amdgcn_sinf(rev) : __builtin_amdgcn_cosf(rev); }
        FT[e] = (_Float16)v;
    } else if (e < 16384) { const int q = e - 8192, t1 = q >> 7, rho = q & 127, f = rho >> 1; float v;
        if (rho == 0) v = 1.f / 128.f; else if (rho == 1) v = ((t1 & 1) ? -1.f : 1.f) / 128.f;
        else { const float rev = (float)((f * t1) & 127) * (1.f / 128.f); v = ((rho & 1) ? -__builtin_amdgcn_sinf(rev) : __builtin_amdgcn_cosf(rev)) * (2.f / 128.f); }
        GT[q] = (_Float16)v;
    } else { const int q = e - 16384, rho = q >> 7, dp = q & 127, d = dp - 64, f = rho >> 1; float v;
        if (rho == 0) v = 1.f; else if (rho == 1) v = (d & 1) ? -1.f : 1.f;
        else { const float rev = (float)((f * d) & 127) * (1.f / 128.f); v = (rho & 1) ? -__builtin_amdgcn_sinf(rev) : __builtin_amdgcn_cosf(rev); }
        FK[q] = (_Float16)v;
    }
}

__device__ __forceinline__ void phase0(const Params& p, unsigned char* lds) {
    constexpr int I_WIN = 16 * 72, I_WOUT = 16 * 32, I_W1 = 32 * 16 * 16, I_W2 = 32 * 8 * 32;
    constexpr int NTR = I_WIN + I_WOUT + 2 * I_W1 + I_W2;
    for (int it = blockIdx.x; it < 64; it += gridDim.x) p0_tables(p, it);
    for (int it = blockIdx.x; it < 96; it += gridDim.x) p0_adaln(p, it, lds);
    const bool taps_first = (blockIdx.x & 1) == 0;
    if (taps_first) for (int it = (blockIdx.x + 160) % gridDim.x; it < 256; it += gridDim.x) p0_taps(p, it, lds);
    __syncthreads();
    const int tidq = otid(), lane = tidq & 63, wid = tidq >> 6;
    float* scr = (float*)lds + wid * (64 * 33);
    constexpr int NA = 11520;
    const bool lightwg = blockIdx.x < 96 && gridDim.x > 96;
    const int nb2 = (gridDim.x > 96) ? (int)gridDim.x - 96 : (int)gridDim.x, bi2 = (gridDim.x > 96) ? (int)blockIdx.x - 96 : (int)blockIdx.x;
    auto decode = [&](int r) -> TrItem { TrItem t; t.mode = 0; t.f8 = false;
        if (r < I_WIN) { t.src = p.w_in; t.N = PROJW; t.k0 = (r / 72) * 64; t.n0 = (r % 72) * 32; t.dst = (bf16_t*)(p.ws + WS_WINT); t.dpitch = 1024; }
        else if ((r -= I_WIN) < I_WOUT) { t.src = p.w_out; t.N = 1024; t.k0 = (r / 32) * 64; t.n0 = (r % 32) * 32; t.dst = (bf16_t*)(p.ws + WS_WOUTT); t.dpitch = 1024; }
        else if ((r -= I_WOUT) < 2 * I_W1) { const int w3 = r >= I_W1; if (w3) r -= I_W1; const int e = r / 256, q = r % 256; t.src = (w3 ? p.exp_w3 : p.exp_w1) + (size_t)e * 1024 * 512; t.N = 512; t.k0 = (q / 16) * 64; t.n0 = (q % 16) * 32;
            t.dst = (bf16_t*)(p.ws + WS_EW13 + (size_t)e * 1024 * 1024); t.dpitch = 1024; t.mode = w3 ? 2 : 1; t.f8 = true; }
        else { r -= 2 * I_W1; const int e = r / 256, q = r % 256; t.src = p.exp_w2 + (size_t)e * 512 * 1024; t.N = 1024; t.k0 = (q / 32) * 64; t.n0 = (q % 32) * 32; t.dst = (bf16_t*)(p.ws + WS_EW2T + (size_t)e * 1024 * 512); t.dpitch = 512; t.f8 = true; }
        return t; };
    auto step = [&](int it) -> int {
        if (it < NA) { const int n = it + (int)gridDim.x * 8; if (n < NA) return n; return lightwg ? NTR : NA + bi2 * 8 + wid; }
        return it + nb2 * 8; };
    int it = (int)blockIdx.x * 8 + wid;
    if (it >= NA) it = lightwg ? NTR : NA + bi2 * 8 + wid;
    if (it < NTR) {
        TrItem cur = decode(it); f32x4 va[8]; p0_tr_load(cur, va, lane);
        for (;;) {
            const int itn = step(it); const bool more = itn < NTR;
            TrItem nxt = cur; f32x4 vb[8];
            if (more) { nxt = decode(itn); p0_tr_load(nxt, vb, lane); }
            p0_tr_finish(cur, va, scr, lane);
            if (!more) break;
            cur = nxt; it = itn;
#pragma unroll
            for (int i = 0; i < 8; ++i) va[i] = vb[i];
        }
    }
    if (!taps_first) { __syncthreads(); for (int it2 = (blockIdx.x + 160) % gridDim.x; it2 < 256; it2 += gridDim.x) p0_taps(p, it2, lds); }
}

__device__ __forceinline__ void norm_row(const Params& p, const float* xr, const float* md, bf16_t* orow, int lane) {
    f32x4 v[4]; float s = 0.f;
#pragma unroll
    for (int j = 0; j < 4; ++j) { v[j] = *(const f32x4*)(xr + 256 * j + lane * 4); s += v[j].x * v[j].x + v[j].y * v[j].y + v[j].z * v[j].z + v[j].w * v[j].w; }
    const float rstd = rsqrtf(wave_sum(s) * (1.f / 1024.f) + EPSN);
#pragma unroll
    for (int j = 0; j < 4; ++j) { const int k = 256 * j + lane * 4;
        const f32x4 nw = *(const f32x4*)(p.norm1_w + k), sh = *(const f32x4*)(md + k), sc = *(const f32x4*)(md + 1024 + k);
        const f32x4 y = (v[j] * rstd) * nw * (sc + 1.f) + sh;
        u32x2 o; o.x = pk2(y.x, y.y); o.y = pk2(y.z, y.w); *(u32x2*)(orow + k) = o; }
}
__device__ __forceinline__ void phase1(const Params& p, unsigned char* lds) {
    const int tidq = otid(), lane = tidq & 63, wid = tidq >> 6;
    const float* MOD = (const float*)(p.ws + WS_MOD);
    const int fr = lane & 15, fq = lane >> 4;
    for (int ct = blockIdx.x; ct < NCTX / 16; ct += gridDim.x) {
        bf16_t* As = (bf16_t*)lds;
        const bf16_t* WT = (const bf16_t*)(p.ws + WS_WINT); bf16_t* KVC = (bf16_t*)(p.ws + WS_KVC);
        __syncthreads();
        {   const float* md = MOD + (size_t)16 * 6144; f32x4 v[2][4]; float ss[2];
#pragma unroll
            for (int r = 0; r < 2; ++r)
#pragma unroll
                for (int j = 0; j < 4; ++j) v[r][j] = *(const f32x4*)(p.ctx + (size_t)(ct * 16 + 2 * wid + r) * 1024 + 256 * j + lane * 4);
#pragma unroll
            for (int r = 0; r < 2; ++r) { float q = 0.f;
#pragma unroll
                for (int j = 0; j < 4; ++j) q += v[r][j].x * v[r][j].x + v[r][j].y * v[r][j].y + v[r][j].z * v[r][j].z + v[r][j].w * v[r][j].w;
                ss[r] = wave_sum(q); }
#pragma unroll
            for (int j = 0; j < 4; ++j) { const int k = 256 * j + lane * 4;
                const f32x4 nw = *(const f32x4*)(p.norm1_w + k), sh = *(const f32x4*)(md + k), sc = *(const f32x4*)(md + 1024 + k); const f32x4 g = nw * (sc + 1.f);
#pragma unroll
                for (int r = 0; r < 2; ++r) { const float rstd = rsqrtf(ss[r] * (1.f / 1024.f) + EPSN); const f32x4 y = (v[r][j] * rstd) * g + sh;
                    u32x2 o; o.x = pk2(y.x, y.y); o.y = pk2(y.z, y.w); *(u32x2*)(As + (2 * wid + r) * 1032 + k) = o; } }
        }
        __syncthreads();
        f32x4 acc0 = (f32x4){0.f, 0.f, 0.f, 0.f}, acc1 = acc0;
        const bf16_t* b0 = WT + (size_t)(512 + 32 * wid + fr) * 1024 + 8 * fq; const bf16_t* b1 = b0 + 16 * 1024;
#pragma unroll 8
        for (int ks = 0; ks < 32; ++ks) {
            const bf16x8 af = *(const bf16x8*)(As + fr * 1032 + 32 * ks + 8 * fq);
            const bf16x8 bf0 = *(const bf16x8*)(b0 + 32 * ks), bf1 = *(const bf16x8*)(b1 + 32 * ks);
            acc0 = __builtin_amdgcn_mfma_f32_16x16x32_bf16(bf0, af, acc0, 0, 0, 0); acc1 = __builtin_amdgcn_mfma_f32_16x16x32_bf16(bf1, af, acc1, 0, 0, 0);
        }
        {   bf16_t* orow = KVC + (size_t)(ct * 16 + fr) * 256 + 32 * wid + 4 * fq;
            u32x2 o; o.x = pk2(acc0.x, acc0.y); o.y = pk2(acc0.z, acc0.w); *(u32x2*)(orow) = o;
            o.x = pk2(acc1.x, acc1.y); o.y = pk2(acc1.z, acc1.w); *(u32x2*)(orow + 16) = o; }
    }
    {
        const int nb = gridDim.x, bi = blockIdx.x;
        bf16_t* H = (bf16_t*)(p.ws + WS_H);
        for (int tq = bi * 8; tq < (NTOK / 256) * 8; tq += nb * 8) for (int row0 = (tq >> 3) * 256 + wid * 32 + (tq & 7) * 0; row0 < (tq >> 3) * 256 + wid * 32 + 32; row0 += 4) {
            f32x4 v[4][4]; float ss[4];
#pragma unroll
            for (int r = 0; r < 4; ++r)
#pragma unroll
                for (int j = 0; j < 4; ++j) v[r][j] = __builtin_nontemporal_load((const f32x4*)(p.x + (size_t)(row0 + r) * 1024 + 256 * j + lane * 4));
#pragma unroll
            for (int r = 0; r < 4; ++r) { float s = 0.f;
#pragma unroll
                for (int j = 0; j < 4; ++j) s += v[r][j].x * v[r][j].x + v[r][j].y * v[r][j].y + v[r][j].z * v[r][j].z + v[r][j].w * v[r][j].w;
                ss[r] = s; }
#pragma unroll
            for (int r = 0; r < 4; ++r) ss[r] = wave_sum(ss[r]);
            const float* md = MOD + (size_t)(row0 >> 12) * 6144;
#pragma unroll
            for (int j = 0; j < 4; ++j) { const int k = 256 * j + lane * 4;
                const f32x4 nw = *(const f32x4*)(p.norm1_w + k), sh = *(const f32x4*)(md + k), sc = *(const f32x4*)(md + 1024 + k); const f32x4 g = nw * (sc + 1.f);
#pragma unroll
                for (int r = 0; r < 4; ++r) { const float rstd = rsqrtf(ss[r] * (1.f / 1024.f) + EPSN); const f32x4 y = (v[r][j] * rstd) * g + sh;
                    u32x2 o; o.x = pk2(y.x, y.y); o.y = pk2(y.z, y.w); __builtin_nontemporal_store(o, (u32x2*)(H + (size_t)(row0 + r) * 1024 + k)); } }
        }
    }
}

struct P2Sched { const char* H; const char* WT; int G, c;
    __device__ __forceinline__ bool next(int i, pg::UDesc& u) const { const int q = i * G + c; if (q >= 2304) return false;
        const int tile = q / 9, j = q - 9 * tile;
        if (j < 3) { u.A = H + (size_t)tile * 256 * 2048; u.B0 = WT + (size_t)j * 256 * 2048; u.i0 = 0; u.i1 = tile; u.i2 = j; }
        else { const int pm = j - 3; u.A = WT + (size_t)(768 + pm * 256) * 2048; u.B0 = H + (size_t)tile * 256 * 2048; u.i0 = 1; u.i1 = pm; u.i2 = tile; }
        u.B1 = u.B0 + 8 * 128; u.i3 = 0; return true; }
    __device__ __forceinline__ unsigned rowoff(const pg::UDesc&, int) const { return 0u; }
};
__device__ __forceinline__ void phase2(const Params& p, unsigned char* lds) {
    bf16_t* QKV = (bf16_t*)(p.ws + WS_QKV); _Float16* UT = (_Float16*)(p.ws + WS_UT);
    P2Sched S{(const char*)(p.ws + WS_H), (const char*)(p.ws + WS_WINT), (int)gridDim.x, vcu_of(blockIdx.x, gridDim.x)};
    auto E = [&](const f32x4 (&acc)[2][2][4][2], const pg::UDesc& u, int wr, int wc, int fr, int fq) {
        const int tok0 = u.i2 * 256, bb = tok0 >> 12, t0 = tok0 & 4095;
        unsigned short* base = u.i0 ? (unsigned short*)UT + ((size_t)(bb * 1536 + u.i1 * 256)) * 4096 + t0 : (unsigned short*)QKV + (size_t)(u.i1 * 256) * 768 + u.i2 * 256;
        const size_t pitch = u.i0 ? 4096 : 768; const bool f16o = u.i0 != 0;
        const bool qk = (u.i0 == 0) && (u.i2 < 2 || wc < 2);
        if (!qk) {
            if (f16o) {
#pragma unroll
                for (int a = 0; a < 2; ++a)
#pragma unroll
                    for (int m = 0; m < 4; ++m) { const int rl = 128 * a + 64 * wr + 16 * m + fr; u32x4 o[2];
#pragma unroll
                        for (int b = 0; b < 2; ++b) { const f32x4 v0 = acc[a][b][m][0], v1 = acc[a][b][m][1]; o[b].x = pkh2(v0.x, v0.y); o[b].y = pkh2(v0.z, v0.w); o[b].z = pkh2(v1.x, v1.y); o[b].w = pkh2(v1.z, v1.w); }
                        store_pair16<true>(base, pitch, rl, wc, fr, fq, o[0], o[1]); }
            } else {
#pragma unroll
                for (int a = 0; a < 2; ++a)
#pragma unroll
                    for (int m = 0; m < 4; ++m) { const int rl = 128 * a + 64 * wr + 16 * m + fr; u32x4 o[2];
#pragma unroll
                        for (int b = 0; b < 2; ++b) { const f32x4 v0 = acc[a][b][m][0], v1 = acc[a][b][m][1]; o[b].x = pk2(v0.x, v0.y); o[b].y = pk2(v0.z, v0.w); o[b].z = pk2(v1.x, v1.y); o[b].w = pk2(v1.z, v1.w); }
                        store_pair16(base, pitch, rl, wc, fr, fq, o[0], o[1]); }
            }
        } else {
            const bool isq = u.i2 < 2; const float* nwp = (isq ? p.q_norm_w : p.k_norm_w) + 8 * fq;
            const float osc = isq ? (0.125f * 1.4426950408889634f) : 1.f;
            f32x4 nw[2][2]; float invf[2][4];
#pragma unroll
            for (int b = 0; b < 2; ++b)
#pragma unroll
                for (int n = 0; n < 2; ++n) nw[b][n] = *(const f32x4*)(nwp + 32 * b + 4 * n) * osc;
#pragma unroll
            for (int n = 0; n < 2; ++n)
#pragma unroll
                for (int q = 0; q < 4; ++q) invf[n][q] = exp2f(-(float)(8 * (fq & 1) + 4 * n + q) * (13.287712379549449f / 16.f));
            const bool hi16 = (fq & 2) != 0;
#pragma unroll
            for (int a = 0; a < 2; ++a) {
                float ycoord = (float)(4 * (u.i1 & 15) + 2 * a + wr); asm volatile("" : "+v"(ycoord));
                float cy[2][4], sy[2][4];
#pragma unroll
                for (int n = 0; n < 2; ++n)
#pragma unroll
                    for (int q = 0; q < 4; ++q) { const float ang = ycoord * invf[n][q]; cy[n][q] = cos_rad(ang); sy[n][q] = sin_rad(ang); }
#pragma unroll
                for (int m = 0; m < 4; ++m) {
                    const int rl = 128 * a + 64 * wr + 16 * m + fr; float xcoord = (float)(16 * m + fr); asm volatile("" : "+v"(xcoord));
                    float ss = 0.f;
#pragma unroll
                    for (int b = 0; b < 2; ++b)
#pragma unroll
                        for (int n = 0; n < 2; ++n) { const f32x4 v = acc[a][b][m][n]; ss += v.x * v.x + v.y * v.y + v.z * v.z + v.w * v.w; }
                    ss = xor16_sum(ss); ss = xor32_sum(ss);
                    const float rstd = rsqrtf(ss * (1.f / 64.f) + EPSN);
                    u32x4 ob[2];
#pragma unroll
                    for (int b = 0; b < 2; ++b) { float o8[8];
#pragma unroll
                        for (int n = 0; n < 2; ++n)
#pragma unroll
                            for (int q = 0; q < 4; ++q) {
                                const float y = acc[a][b][m][n][q] * rstd * nw[b][n][q];
                                const unsigned uy = __builtin_bit_cast(unsigned, y); auto rr = __builtin_amdgcn_permlane32_swap(uy, uy, false, false);
                                const float pr = hi16 ? __builtin_bit_cast(float, (unsigned)rr[0]) : __builtin_bit_cast(float, (unsigned)rr[1]);
                                float cs, sn;
                                if (b == 0) { cs = cy[n][q]; sn = sy[n][q]; } else { const float ang = xcoord * invf[n][q]; cs = cos_rad(ang); sn = sin_rad(ang); }
                                o8[4 * n + q] = hi16 ? (y * cs + pr * sn) : (y * cs - pr * sn); }
                        ob[b].x = pk2(o8[0], o8[1]); ob[b].y = pk2(o8[2], o8[3]); ob[b].z = pk2(o8[4], o8[5]); ob[b].w = pk2(o8[6], o8[7]); }
                    store_pair16(base, pitch, rl, wc, fr, fq, ob[0], ob[1]);
                }
            }
        }
    };
    pg::gemm_stream<false, true, false, true>((LAS unsigned char*)lds, 2048, 2048, S, E);
}

__device__ __forceinline__ void phase3_ctx(const Params& p) {
    const int tidq = otid(), lane = tidq & 63, gw = blockIdx.x * 8 + (tidq >> 6), ngw = gridDim.x * 8;
    bf16_t* KVC = (bf16_t*)(p.ws + WS_KVC);
    const float kw = p.k_norm_w[lane];
    for (int row = gw; row < NCTX; row += ngw) {
        bf16_t* rp = KVC + (size_t)row * 256;
        const float x0 = bf2f(rp[lane]), x1 = bf2f(rp[64 + lane]);
        const float r0 = rsqrtf(wave_sum(x0 * x0) * (1.f / 64.f) + EPSN), r1 = rsqrtf(wave_sum(x1 * x1) * (1.f / 64.f) + EPSN);
        rp[lane] = (bf16_t)f2bf(x0 * r0 * kw); rp[64 + lane] = (bf16_t)f2bf(x1 * r1 * kw);
    }
}

typedef short s16x4_t __attribute__((ext_vector_type(4)));
__device__ __forceinline__ void attn_unit(const Params& p, int u, unsigned char* lds) {
    const int tid = otid(), wid = tid >> 6, lane = tid & 63, fr = lane & 15, fq = lane >> 4;
    const int b = u >> 6, kvh = (u >> 5) & 1, qb = u & 31, q0 = qb * 128;
    const bf16_t* QKV = (const bf16_t*)(p.ws + WS_QKV); const bf16_t* KVC = (const bf16_t*)(p.ws + WS_KVC);
    bf16_t* ATT = (bf16_t*)(p.ws + WS_ATTHY);
    const int h = kvh * 4 + (wid >> 1), half = wid & 1, qrow0 = q0 + 64 * half;
    bf16x8 qf[4][2];
#pragma unroll
    for (int qt = 0; qt < 4; ++qt)
#pragma unroll
        for (int ks = 0; ks < 2; ++ks) qf[qt][ks] = *(const bf16x8*)(QKV + (size_t)(b * 4096 + qrow0 + 16 * qt + fr) * 768 + h * 64 + 32 * ks + 8 * fq);
    float mrow[4], lrow[4]; f32x4 ot[4][4];
    const float sink2 = p.attn_sink[h] * 1.4426950408889634f;
#pragma unroll
    for (int qt = 0; qt < 4; ++qt) { mrow[qt] = sink2; lrow[qt] = (fq == 0) ? 1.f : 0.f;
#pragma unroll
        for (int dt = 0; dt < 4; ++dt) ot[dt][qt] = (f32x4){0.f, 0.f, 0.f, 0.f}; }
    const int jlo = (qb == 0) ? 2 : 0, jhi = (qb == 31) ? 3 : 5, ntile = 4 + (jhi - jlo + 1);
    const int kr = tid >> 3, ch = tid & 7;
    auto krow_of = [&](int ti) -> const bf16_t* { return (ti < 4) ? KVC + (size_t)(b * 256 + ti * 64 + kr) * 256 + kvh * 64 + ch * 8 : QKV + (size_t)(b * 4096 + q0 - 128 + (ti - 4 + jlo) * 64 + kr) * 768 + KOFF + kvh * 64 + ch * 8; };
    u32x4 kreg = *(const u32x4*)krow_of(0), vreg = *(const u32x4*)(krow_of(0) + ((0 < 4) ? 128 : 128));
#pragma unroll 1
    for (int ti = 0; ti < ntile; ++ti) {
        const bool isctx = ti < 4; const int jb = ti - 4 + jlo;
        unsigned char* sK = lds + (ti & 1) * 18432;
        unsigned char* sV = sK + 64 * 144;
        { *(u32x4*)(sK + kr * 144 + ch * 16) = kreg; *(u32x4*)(sV + kr * 144 + ch * 16) = vreg; }
        if (ti + 1 < ntile) { const bf16_t* kp = krow_of(ti + 1); kreg = *(const u32x4*)kp; vreg = *(const u32x4*)(kp + 128); }
        __syncthreads();
        const int rel = jb - 2 - half;
        const bool skip = !isctx && (rel < -2 || rel > 2), partial = !isctx && (rel == -2 || rel == 2);
        if (!skip) {
            f32x4 st[4][4];
#pragma unroll
            for (int kt = 0; kt < 4; ++kt) {
                const bf16x8 k0 = *(const bf16x8*)(sK + (16 * kt + fr) * 144 + fq * 16), k1 = *(const bf16x8*)(sK + (16 * kt + fr) * 144 + 64 + fq * 16);
#pragma unroll
                for (int qt = 0; qt < 4; ++qt) { f32x4 z = (f32x4){0.f, 0.f, 0.f, 0.f};
                    z = __builtin_amdgcn_mfma_f32_16x16x32_bf16(k0, qf[qt][0], z, 0, 0, 0); z = __builtin_amdgcn_mfma_f32_16x16x32_bf16(k1, qf[qt][1], z, 0, 0, 0); st[kt][qt] = z; }
            }
            if (partial) {
                const int kbase = q0 - 128 + 64 * jb;
#pragma unroll
                for (int qt = 0; qt < 4; ++qt) { const int qpos = qrow0 + 16 * qt + fr;
#pragma unroll
                    for (int kt = 0; kt < 4; ++kt)
#pragma unroll
                        for (int r = 0; r < 4; ++r) { const int dd = kbase + 16 * kt + 4 * fq + r - qpos; if (dd > 128 || dd < -128) st[kt][qt][r] = -1e30f; } }
            }
            float alpha[4]; bool grew = false;
#pragma unroll
            for (int qt = 0; qt < 4; ++qt) {
                float t0 = fmaxf(fmaxf(st[0][qt][0], st[0][qt][1]), fmaxf(st[0][qt][2], st[0][qt][3]));
#pragma unroll
                for (int kt = 1; kt < 4; ++kt) t0 = fmaxf(t0, fmaxf(fmaxf(st[kt][qt][0], st[kt][qt][1]), fmaxf(st[kt][qt][2], st[kt][qt][3])));
                t0 = max_fq(t0);
                const float mnew = fmaxf(mrow[qt], t0); alpha[qt] = exp2_raw(mrow[qt] - mnew); grew = grew || (mnew > mrow[qt]); mrow[qt] = mnew;
                float ls = 0.f;
#pragma unroll
                for (int kt = 0; kt < 4; ++kt)
#pragma unroll
                    for (int r = 0; r < 4; ++r) { const float pv = exp2_raw(st[kt][qt][r] - mnew); st[kt][qt][r] = pv; ls += pv; }
                lrow[qt] = lrow[qt] * alpha[qt] + ls;
            }
            if (__any(grew)) {
#pragma unroll
                for (int qt = 0; qt < 4; ++qt)
#pragma unroll
                    for (int dt = 0; dt < 4; ++dt) ot[dt][qt] = ot[dt][qt] * alpha[qt];
            }
#pragma unroll
            for (int ks = 0; ks < 2; ++ks) {
                bf16x8 pf[4];
#pragma unroll
                for (int qt = 0; qt < 4; ++qt) { const f32x4 a = st[2 * ks][qt], c = st[2 * ks + 1][qt];
                    u32x4 w; w.x = pk2(a.x, a.y); w.y = pk2(a.z, a.w); w.z = pk2(c.x, c.y); w.w = pk2(c.z, c.w); pf[qt] = __builtin_bit_cast(bf16x8, w); }
#pragma unroll
                for (int dt = 0; dt < 4; ++dt) {
                    const unsigned char* vb = sV + (32 * ks + 4 * fq + (fr >> 2)) * 144 + (16 * dt + 4 * (fr & 3)) * 2;
                    const u32x2 v0 = __builtin_bit_cast(u32x2, __builtin_amdgcn_ds_read_tr16_b64_v4i16((LAS s16x4_t*)(vb))), v1 = __builtin_bit_cast(u32x2, __builtin_amdgcn_ds_read_tr16_b64_v4i16((LAS s16x4_t*)(vb + 16 * 144)));
                    u32x4 w; w.x = v0.x; w.y = v0.y; w.z = v1.x; w.w = v1.y; const bf16x8 vf = __builtin_bit_cast(bf16x8, w);
#pragma unroll
                    for (int qt = 0; qt < 4; ++qt) ot[dt][qt] = __builtin_amdgcn_mfma_f32_16x16x32_bf16(vf, pf[qt], ot[dt][qt], 0, 0, 0);
                }
            }
        }
    }
#pragma unroll
    for (int qt = 0; qt < 4; ++qt) {
        float l = lrow[qt]; l += __shfl_xor(l, 16); l += __shfl_xor(l, 32);
        const float inv = 1.f / l;
        bf16_t* orow = ATT + (size_t)(b * 4096 + qrow0 + 16 * qt + fr) * 1024 + h * 64;
#pragma unroll
        for (int dt = 0; dt < 4; ++dt) { const f32x4 o = ot[dt][qt] * inv; u32x2 w; w.x = pk2(o.x, o.y); w.y = pk2(o.z, o.w); *(u32x2*)(orow + 16 * dt + 4 * fq) = w; }
    }
    __syncthreads();
}

__device__ __forceinline__ void khat_items(const Params& p, unsigned char* lds) {
    const int tid = otid(), wid = tid >> 6, lane = tid & 63, fr = lane & 15, fq = lane >> 4;
    _Float16* TT = (_Float16*)lds;
    _Float16* FKL = (_Float16*)(lds + 34816);
    const _Float16* FK = (const _Float16*)(p.ws + WS_FKTAB);
    __syncthreads();
    for (int i = tid; i < 128 * 136 / 2; i += NTHR) ((unsigned*)lds)[i] = 0u;
    for (int i = tid; i < 128 * 16; i += NTHR) { const int r = i >> 4, c8 = i & 15; *(u32x4*)(FKL + r * 136 + c8 * 8) = *(const u32x4*)(FK + r * 128 + c8 * 8); }
    int it = blockIdx.x;
    f32x4 tv[4];
    if (it < 1024) {
#pragma unroll
        for (int q = 0; q < 4; ++q) tv[q] = *(const f32x4*)((const float*)(p.ws + WS_TAPS) + (size_t)it * 8192 + tid * 16 + q * 4); }
    __syncthreads();
    for (; it < 1024; it += gridDim.x) {
#pragma unroll
        for (int q = 0; q < 4; ++q) { const int i0 = tid * 16 + q * 4;
#pragma unroll
            for (int e = 0; e < 4; ++e) { const int i = i0 + e, i1 = i >> 6, i2 = i & 63; const _Float16 h = (_Float16)tv[q][e];
                if (i1 >= 1) TT[(i2 + 63) * 136 + i1] = h;
                if (i2 >= 1 && i1 + 1 < 128) TT[(i2 - 1) * 136 + i1 + 1] = h; } }
        {   const int itn = (it + (int)gridDim.x < 1024) ? it + (int)gridDim.x : it;
#pragma unroll
            for (int q = 0; q < 4; ++q) tv[q] = *(const f32x4*)((const float*)(p.ws + WS_TAPS) + (size_t)itn * 8192 + tid * 16 + q * 4); }
        __syncthreads();
        f16x8 af[4];
#pragma unroll
        for (int ks = 0; ks < 4; ++ks) af[ks] = *(const f16x8*)(TT + (16 * wid + fr) * 136 + 32 * ks + 8 * fq);
        _Float16* KH = (_Float16*)(p.ws + WS_KH) + (size_t)it * (64 * 2 * 128);
#pragma unroll
        for (int nt = 0; nt < 8; ++nt) {
            f32x4 acc = (f32x4){0.f, 0.f, 0.f, 0.f};
#pragma unroll
            for (int ks = 0; ks < 4; ++ks) { const f16x8 bfv = *(const f16x8*)(FKL + (16 * nt + fr) * 136 + 32 * ks + 8 * fq); acc = __builtin_amdgcn_mfma_f32_16x16x32_f16(af[ks], bfv, acc, 0, 0, 0); }
            const int rho = 16 * nt + fr; u32x2 o; o.x = pkh2(acc[3], acc[2]); o.y = pkh2(acc[1], acc[0]);
            *(u32x2*)(KH + (size_t)rho * 128 + (124 - 16 * wid - 4 * fq)) = o;
        }
        __syncthreads();
    }
}

constexpr int HY_ZB = 0, HY_ZH = 73728, HY_ZHF = 1160  , HY_OH = HY_ZH + 8 * HY_ZHF * 2, HY_GT = HY_OH + 8 * 65 * 40  , HY_KC = HY_GT + 8 * 4608, HY_LDS_END = HY_KC + 8 * 576;
struct __attribute__((aligned(4))) hq4 { unsigned a, b, c, d; };
__device__ __forceinline__ f16x8 neg8(f16x8 v) { u32x4 w = __builtin_bit_cast(u32x4, v); w.x ^= 0x80008000u; w.y ^= 0x80008000u; w.z ^= 0x80008000u; w.w ^= 0x80008000u; return __builtin_bit_cast(f16x8, w); }
struct HyRow { u32x4 r[8]; };
__device__ __forceinline__ void hy_row_load(HyRow& R, const _Float16* ur, const int lane) {
#pragma unroll
    for (int i8 = 0; i8 < 8; ++i8) R.r[i8] = __builtin_nontemporal_load((const u32x4*)(ur + 8 * (lane + 64 * i8)));
}
__device__ __forceinline__ void hy_row_finish(const HyRow& R, const float w0, const float w1, const float w2, const float bb, _Float16* XG, const int lane) {
#pragma unroll
    for (int i8 = 0; i8 < 8; ++i8) { const int t0 = 8 * (lane + 64 * i8); float uv[10];
        unsigned oldl = 0u, oldr = 0u;
        if (i8 > 0) oldl = (unsigned)__builtin_amdgcn_readlane((int)R.r[i8 - 1].w, 63);
        if (i8 < 7) oldr = (unsigned)__builtin_amdgcn_readlane((int)R.r[i8 + 1].x, 0);
        const unsigned lw = (unsigned)__builtin_amdgcn_update_dpp((int)oldl, (int)R.r[i8].w, 0x138, 0xf, 0xf, false);
        const unsigned rw = (unsigned)__builtin_amdgcn_update_dpp((int)oldr, (int)R.r[i8].x, 0x130, 0xf, 0xf, false);
        uv[0] = hhi(lw); uv[9] = hlo(rw);
        uv[1] = hlo(R.r[i8].x); uv[2] = hhi(R.r[i8].x); uv[3] = hlo(R.r[i8].y); uv[4] = hhi(R.r[i8].y); uv[5] = hlo(R.r[i8].z); uv[6] = hhi(R.r[i8].z); uv[7] = hlo(R.r[i8].w); uv[8] = hhi(R.r[i8].w);
        float y[8];
#pragma unroll
        for (int i = 0; i < 8; ++i) y[i] = bb + uv[i] * w0 + uv[i + 1] * w1 + uv[i + 2] * w2;
        u32x4 w; w.x = pkh2(y[0], y[1]); w.y = pkh2(y[2], y[3]); w.z = pkh2(y[4], y[5]); w.w = pkh2(y[6], y[7]);
        *(u32x4*)(XG + (t0 >> 6) * 72 + (t0 & 63)) = w; }
}
__device__ __forceinline__ void hyena_item(const Params& p, const int it, const int itn, unsigned char* lds, HyRow& rr) {
    const int tid = otid(), wid = tid >> 6, lane = tid & 63, fr = lane & 15, fq = lane >> 4;
    const int c = it >> 1, b = (it & 1) * 8 + wid;
    _Float16* XG = (_Float16*)(lds + HY_ZB) + wid * (64 * 72);
    _Float16* ZH = (_Float16*)(lds + HY_ZH);
    _Float16* OH = (_Float16*)(lds + HY_OH);
    _Float16* GTW = (_Float16*)(lds + HY_GT) + wid * 2304;
    _Float16* KC = (_Float16*)(lds + HY_KC) + wid * 288;
    const _Float16* UT = (const _Float16*)(p.ws + WS_UT); const _Float16* FT = (const _Float16*)(p.ws + WS_FTAB); const _Float16* GT = (const _Float16*)(p.ws + WS_GTAB);
    bf16_t* HYT = (bf16_t*)(p.ws + WS_HYT);
    __syncthreads();
    if (lane < 32) KC[(lane >> 4) * 144 + 128 + (lane & 15)] = (_Float16)0.f;
    f16x4 id16;
#pragma unroll
    for (int i = 0; i < 4; ++i) id16[i] = (4 * fq + i == fr) ? (_Float16)1.f : (_Float16)0.f;
    u32x4 zf[4][2];
    HyRow rg; hy_row_load(rg, UT + ((size_t)(b * 1536 + 512 + c)) * 4096, lane);
    hy_row_finish(rr, p.hy_conv_w[c], p.hy_conv_w[1536 + c], p.hy_conv_w[3072 + c], p.hy_conv_b[c], XG, lane);
#pragma unroll
    for (int mt = 0; mt < 4; ++mt)
#pragma unroll
        for (int nt = 0; nt < 4; ++nt) { const u32x2 v = *(const u32x2*)(XG + (16 * nt + fr) * 72 + 16 * mt + 4 * fq);
            const f32x4 cT = __builtin_amdgcn_mfma_f32_16x16x16f16(__builtin_bit_cast(f16x4, v), id16, (f32x4){0.f, 0.f, 0.f, 0.f}, 0, 0, 0);
            if (nt & 1) { zf[mt][nt >> 1].z = pkh2(cT[0], cT[1]); zf[mt][nt >> 1].w = pkh2(cT[2], cT[3]); } else { zf[mt][nt >> 1].x = pkh2(cT[0], cT[1]); zf[mt][nt >> 1].y = pkh2(cT[2], cT[3]); }
        }
    hy_row_finish(rg, p.hy_conv_w[512 + c], p.hy_conv_w[1536 + 512 + c], p.hy_conv_w[3072 + 512 + c], p.hy_conv_b[512 + c], XG, lane);
#pragma unroll 1
    for (int o = 0; o < 2; ++o) {
        f32x4 accI[4][4];
#pragma unroll
        for (int mt = 0; mt < 4; ++mt)
#pragma unroll
            for (int nt = 0; nt < 4; ++nt) accI[mt][nt] = (f32x4){0.f, 0.f, 0.f, 0.f};
        const _Float16* KHo = (const _Float16*)(p.ws + WS_KH) + (size_t)(o * 512 + c) * (64 * 2 * 128);
        u32x4 kcn = (u32x4){0u, 0u, 0u, 0u}; f16x8 ffn[2];
        if (lane < 32) kcn = *(const u32x4*)(KHo + (size_t)wid * 256 + lane * 8);
#pragma unroll
        for (int ks = 0; ks < 2; ++ks) { const f16x4 lo = *(const f16x4*)(FT + fr * 64 + 32 * ks + 4 * fq), hi = *(const f16x4*)(FT + fr * 64 + 32 * ks + 16 + 4 * fq); ffn[ks] = __builtin_shufflevector(lo, hi, 0, 1, 2, 3, 4, 5, 6, 7); }
#pragma unroll 1
        for (int j = 0; j < 8; ++j) {
            const int f = 8 * j + wid;
            const u32x4 kcc = kcn; f16x8 ff[2]; f16x4 gf[4];
#pragma unroll
            for (int ks = 0; ks < 2; ++ks) ff[ks] = ffn[ks];
#pragma unroll
            for (int nt = 0; nt < 4; ++nt) gf[nt] = *(const f16x4*)(GT + (16 * nt + fr) * 128 + 16 * j + 4 * fq);
            if (j < 7) {
                if (lane < 32) kcn = *(const u32x4*)(KHo + (size_t)(f + 8) * 256 + lane * 8);
#pragma unroll
                for (int ks = 0; ks < 2; ++ks) { const f16x4 lo = *(const f16x4*)(FT + (16 * (j + 1) + fr) * 64 + 32 * ks + 4 * fq), hi = *(const f16x4*)(FT + (16 * (j + 1) + fr) * 64 + 32 * ks + 16 + 4 * fq); ffn[ks] = __builtin_shufflevector(lo, hi, 0, 1, 2, 3, 4, 5, 6, 7); }
            }
            if (lane < 32) *(u32x4*)(KC + (lane >> 4) * 144 + (lane & 15) * 8) = kcc;
            {   const int x = lane >> 5, q = (lane >> 1) & 15, sh = lane & 1;
                const u32x2* src = (const u32x2*)(KC + x * 144 + 8 * q + 4 * sh);
                const u32x2 r0 = src[0], r1 = src[1], r2 = src[2];
                const unsigned d0 = r0.x, d1 = r0.y, d2 = r1.x, d3 = r1.y, d4 = r2.x, d5 = r2.y;
                const unsigned a0 = __builtin_amdgcn_alignbit(d1, d0, 16), a1 = __builtin_amdgcn_alignbit(d2, d1, 16), a2 = __builtin_amdgcn_alignbit(d3, d2, 16), a3 = __builtin_amdgcn_alignbit(d4, d3, 16), a4 = __builtin_amdgcn_alignbit(d5, d4, 16);
                _Float16* dst = GTW + ((x * 8 + 4 * sh) * 18 + q) * 8;
                *(u32x4*)(dst) = (u32x4){a0, a1, a2, a3}; *(u32x4*)(dst + 144) = (u32x4){d1, d2, d3, d4};
                *(u32x4*)(dst + 288) = (u32x4){a1, a2, a3, a4}; *(u32x4*)(dst + 432) = (u32x4){d2, d3, d4, d5}; }
            {
#pragma unroll
                for (int mt = 0; mt < 4; ++mt) { f32x4 a = (f32x4){0.f, 0.f, 0.f, 0.f};
                    a = __builtin_amdgcn_mfma_f32_16x16x32_f16(__builtin_bit_cast(f16x8, zf[mt][0]), ff[0], a, 0, 0, 0); a = __builtin_amdgcn_mfma_f32_16x16x32_f16(__builtin_bit_cast(f16x8, zf[mt][1]), ff[1], a, 0, 0, 0);
                    u32x2 w; w.x = pkh2(a[0], a[1]); w.y = pkh2(a[2], a[3]);
                    *(u32x2*)(ZH + (fr >> 1) * HY_ZHF + (wid * 2 + (fr & 1)) * 72 + 16 * mt + 4 * fq) = w; }
            }
            __syncthreads();
            {   const int bb = fr >> 1, part = fr & 1;
                f16x8 a1[2], a2[2];
                {
                    const unsigned pm = part ? 0xffffffffu : 0u, sgn = 0x80008000u & ~pm;
                    u32x4 s1v[2], s2v[2];
#pragma unroll
                    for (int ks = 0; ks < 2; ++ks) { s1v[ks] = *(const u32x4*)(ZH + wid * HY_ZHF + (bb * 2 + part) * 72 + 32 * ks + 8 * fq); s2v[ks] = *(const u32x4*)(ZH + wid * HY_ZHF + (bb * 2 + (1 - part)) * 72 + 32 * ks + 8 * fq); }
#pragma unroll
                    for (int ks = 0; ks < 2; ++ks) {
                        u32x4 x1, x2;
                        if (f == 0) { x1 = s1v[ks] & ~pm; x2 = s1v[ks] & pm; }
                        else { x1 = s1v[ks]; x2 = s2v[ks] ^ sgn; }
                        a1[ks] = __builtin_bit_cast(f16x8, x1); a2[ks] = __builtin_bit_cast(f16x8, x2); }
                }
                const int sg = 7 - (fr & 7), qb = 7 - (fr >> 3) + fq;
                f32x4 am[4];
#pragma unroll
                for (int nt = 0; nt < 4; ++nt) am[nt] = (f32x4){0.f, 0.f, 0.f, 0.f};
#pragma unroll
                for (int wi = 0; wi < 6; ++wi) { const int w = 2 * wi - 6;
                    const f16x8 b1 = *(const f16x8*)(GTW + ((0 * 8 + sg) * 18 + qb + w) * 8);
                    const f16x8 b2 = *(const f16x8*)(GTW + ((1 * 8 + sg) * 18 + qb + w) * 8);
#pragma unroll
                    for (int ks = 0; ks < 2; ++ks) { const int nt = (4 * ks - w) / 2;
                        if (nt >= 0 && nt < 4) { am[nt] = __builtin_amdgcn_mfma_f32_16x16x32_f16(a1[ks], b1, am[nt], 0, 0, 0); am[nt] = __builtin_amdgcn_mfma_f32_16x16x32_f16(a2[ks], b2, am[nt], 0, 0, 0); } } }
#pragma unroll
                for (int nt = 0; nt < 4; ++nt) { const int t2 = 16 * nt + fr;
                    *(unsigned*)(OH + ((2 * fq) * 65 + t2) * 20 + 2 * wid) = pkh2(am[nt][0], am[nt][1]);
                    *(unsigned*)(OH + ((2 * fq + 1) * 65 + t2) * 20 + 2 * wid) = pkh2(am[nt][2], am[nt][3]); }
            }
            __syncthreads();
            {
#pragma unroll
                for (int mt = 0; mt < 4; ++mt) { const f16x4 av = *(const f16x4*)(OH + (wid * 65 + 16 * mt + fr) * 20 + 4 * fq);
#pragma unroll
                    for (int nt = 0; nt < 4; ++nt) accI[mt][nt] = __builtin_amdgcn_mfma_f32_16x16x16f16(av, gf[nt], accI[mt][nt], 0, 0, 0); }
            }
        }
        {   const float sk = p.hy_skip[o * 512 + c];
            {   const int rown = (o == 0) ? (b * 1536 + 1024 + c) : (((itn & 1) * 8 + wid) * 1536 + (itn >> 1)); hy_row_load(rr, UT + (size_t)rown * 4096, lane); }
#pragma unroll
            for (int mt = 0; mt < 4; ++mt)
#pragma unroll
                for (int nt = 0; nt < 4; ++nt) {
                    _Float16* xp = XG + (16 * nt + fr) * 72 + 16 * mt + 4 * fq;
                    const u32x2 xr = *(const u32x2*)xp;
                    u32x2 zw; if (nt & 1) { zw.x = zf[mt][nt >> 1].z; zw.y = zf[mt][nt >> 1].w; } else { zw.x = zf[mt][nt >> 1].x; zw.y = zf[mt][nt >> 1].y; }
                    const f32x4 zo = __builtin_amdgcn_mfma_f32_16x16x16f16(__builtin_bit_cast(f16x4, zw), id16, (f32x4){0.f, 0.f, 0.f, 0.f}, 0, 0, 0);
                    float zn[4];
                    zn[0] = hlo(xr.x) * (accI[mt][nt][0] + sk * zo[0]); zn[1] = hhi(xr.x) * (accI[mt][nt][1] + sk * zo[1]);
                    zn[2] = hlo(xr.y) * (accI[mt][nt][2] + sk * zo[2]); zn[3] = hhi(xr.y) * (accI[mt][nt][3] + sk * zo[3]);
                    if (o == 0) {
                        u32x2 v; v.x = pkh2(zn[0], zn[1]); v.y = pkh2(zn[2], zn[3]);
                        const f32x4 cT = __builtin_amdgcn_mfma_f32_16x16x16f16(__builtin_bit_cast(f16x4, v), id16, (f32x4){0.f, 0.f, 0.f, 0.f}, 0, 0, 0);
                        if (nt & 1) { zf[mt][nt >> 1].z = pkh2(cT[0], cT[1]); zf[mt][nt >> 1].w = pkh2(cT[2], cT[3]); } else { zf[mt][nt >> 1].x = pkh2(cT[0], cT[1]); zf[mt][nt >> 1].y = pkh2(cT[2], cT[3]); }
                    } else { u32x2 w; w.x = pk2(zn[0], zn[1]); w.y = pk2(zn[2], zn[3]); *(u32x2*)xp = w; }
                }
            if (o == 0) hy_row_finish(rr, p.hy_conv_w[1024 + c], p.hy_conv_w[1536 + 1024 + c], p.hy_conv_w[3072 + 1024 + c], p.hy_conv_b[1024 + c], XG, lane);
            if (o == 1) {
                bf16_t* orow = HYT + ((size_t)(b * 512 + c)) * 4096;
#pragma unroll
                for (int i8 = 0; i8 < 8; ++i8) { const int t0 = 8 * (lane + 64 * i8); *(u32x4*)(orow + t0) = *(const u32x4*)(XG + (t0 >> 6) * 72 + (t0 & 63)); }
            }
        }
    }
}

__device__ __forceinline__ void phase5_item(const Params& p, int it, unsigned char* lds, u32x4 (&hv)[8], const int itn) {
    const int tid = otid(), b = it >> 6, t0 = (it & 63) * 64;
    bf16_t* TL = (bf16_t*)lds;
    float* RS = (float*)(lds + 512 * 66 * 2);
    float* RS2 = RS + 512;
    const bf16_t* HYT = (const bf16_t*)(p.ws + WS_HYT); bf16_t* AH = (bf16_t*)(p.ws + WS_ATTHY);
    __syncthreads();
    {
#pragma unroll
        for (int i = 0; i < 8; ++i) { const u32x4 v = hv[i]; unsigned* d = (unsigned*)(TL + tid * 66 + i * 8); d[0] = v.x; d[1] = v.y; d[2] = v.z; d[3] = v.w; }
        const bf16_t* srcn = HYT + ((size_t)((itn >> 6) * 512 + tid)) * 4096 + (itn & 63) * 64;
#pragma unroll
        for (int i = 0; i < 8; ++i) hv[i] = *(const u32x4*)(srcn + i * 8); }
    __syncthreads();
    {   const int tt = tid & 63, cg8 = tid >> 6; float s = 0.f;
#pragma unroll 16
        for (int cc = 0; cc < 64; ++cc) { const float v = bf2f(TL[(cg8 * 64 + cc) * 66 + tt]); s += v * v; }
        RS[cg8 * 64 + tt] = s; }
    __syncthreads();
    if (tid < 64) { float s = 0.f;
#pragma unroll
        for (int q = 0; q < 8; ++q) s += RS[q * 64 + tid];
        RS2[tid] = rsqrtf(s * (1.f / 512.f) + EPSN); }
    __syncthreads();
    {   const int tt = tid >> 3, ch = tid & 7; const float rstd = RS2[tt];
        bf16_t* orow = AH + (size_t)(b * 4096 + t0 + tt) * 1024;
        u32x4 av[8]; float s = 0.f;
#pragma unroll
        for (int g = 0; g < 8; ++g) av[g] = *(const u32x4*)(orow + g * 64 + ch * 8);
#pragma unroll
        for (int g = 0; g < 8; ++g) { const int c0 = g * 64 + ch * 8; float y[8]; const f32x4 gw0 = *(const f32x4*)(p.group_norm_w + 512 + c0), gw1 = *(const f32x4*)(p.group_norm_w + 512 + c0 + 4);
#pragma unroll
            for (int i = 0; i < 8; ++i) y[i] = bf2f(TL[(c0 + i) * 66 + tt]) * rstd * (i < 4 ? gw0[i] : gw1[i - 4]);
            u32x4 w; w.x = pk2(y[0], y[1]); w.y = pk2(y[2], y[3]); w.z = pk2(y[4], y[5]); w.w = pk2(y[6], y[7]); *(u32x4*)(orow + 512 + c0) = w; }
#pragma unroll
        for (int g = 0; g < 8; ++g) {
            const float a0 = bflo(av[g].x), a1 = bfhi(av[g].x), a2 = bflo(av[g].y), a3 = bfhi(av[g].y), a4 = bflo(av[g].z), a5 = bfhi(av[g].z), a6 = bflo(av[g].w), a7 = bfhi(av[g].w);
            s += a0 * a0 + a1 * a1 + a2 * a2 + a3 * a3 + a4 * a4 + a5 * a5 + a6 * a6 + a7 * a7; }
        s += dpp_f(s, DPP_XOR1); s += dpp_f(s, DPP_XOR2); s += dpp_f(s, DPP_HMIRROR);
        const float ra = rsqrtf(s * (1.f / 512.f) + EPSN);
#pragma unroll
        for (int g = 0; g < 8; ++g) { const int c0 = g * 64 + ch * 8; const f32x4 gw0 = *(const f32x4*)(p.group_norm_w + c0), gw1 = *(const f32x4*)(p.group_norm_w + c0 + 4);
            u32x4 w; w.x = pk2(bflo(av[g].x) * ra * gw0[0], bfhi(av[g].x) * ra * gw0[1]); w.y = pk2(bflo(av[g].y) * ra * gw0[2], bfhi(av[g].y) * ra * gw0[3]);
            w.z = pk2(bflo(av[g].z) * ra * gw1[0], bfhi(av[g].z) * ra * gw1[1]); w.w = pk2(bflo(av[g].w) * ra * gw1[2], bfhi(av[g].w) * ra * gw1[3]);
            *(u32x4*)(orow + c0) = w; }
    }
}

struct P6Sched { const char* AH; const char* WT; int G, c;
    __device__ __forceinline__ bool next(int i, pg::UDesc& u) const { const int q = i * G + c; if (q >= 1024) return false; const int pm = q >> 2, pn = q & 3;
        u.A = AH + (size_t)pm * 256 * 2048; u.B0 = WT + (size_t)pn * 256 * 2048; u.B1 = u.B0 + 8 * 128; u.i0 = 0; u.i1 = pm; u.i2 = pn; u.i3 = 0; return true; }
    __device__ __forceinline__ unsigned rowoff(const pg::UDesc&, int) const { return 0u; }
};
__device__ __forceinline__ void phase6(const Params& p, unsigned char* lds) {
    const float* MOD = (const float*)(p.ws + WS_MOD);
    P6Sched S{(const char*)(p.ws + WS_ATTHY), (const char*)(p.ws + WS_WOUTT), (int)gridDim.x, vcu_of(blockIdx.x, gridDim.x)};
    auto E = [&](const f32x4 (&acc)[2][2][4][2], const pg::UDesc& u, int wr, int wc, int fr, int fq) {
        const float* g1 = MOD + (size_t)((u.i1 * 256) >> 12) * 6144 + 2048 + u.i2 * 256 + 64 * wc + 8 * fq;
        f32x4 gv[2][2];
#pragma unroll
        for (int b = 0; b < 2; ++b)
#pragma unroll
            for (int n = 0; n < 2; ++n) gv[b][n] = *(const f32x4*)(g1 + 32 * b + 4 * n);
        bf16_t* D1 = (bf16_t*)(p.ws + WS_D1);
#pragma unroll
        for (int a = 0; a < 2; ++a)
#pragma unroll
            for (int m = 0; m < 4; ++m) { u32x4 o[2];
#pragma unroll
                for (int b = 0; b < 2; ++b) { const f32x4 v0 = acc[a][b][m][0] * gv[b][0], v1 = acc[a][b][m][1] * gv[b][1];
                    o[b].x = pk2(v0.x, v0.y); o[b].y = pk2(v0.z, v0.w); o[b].z = pk2(v1.x, v1.y); o[b].w = pk2(v1.z, v1.w); }
                store_pair16((unsigned short*)D1 + (size_t)(u.i1 * 256) * 1024 + u.i2 * 256, 1024, 128 * a + 64 * wr + 16 * m + fr, wc, fr, fq, o[0], o[1]); }
    };
    pg::gemm_stream<false, true, false, true>((LAS unsigned char*)lds, 2048, 2048, S, E);
}

__device__ __forceinline__ int pair_index(int lo, int hi) { return lo * 8 - (lo * (lo + 1)) / 2 + (hi - lo - 1); }
constexpr int P7_RW = 0, P7_HIST = 147456, P7_BASE = 147456 + 512, P7_TCLS = 147456 + 1024, P7_TRNK = 147456 + 2048, P7_TG = 147456 + 3072;
__device__ __forceinline__ void phase7(const Params& p, unsigned char* lds) {
    const int tid = otid(), lane = tid & 63, wid = tid >> 6;
    const float* MOD = (const float*)(p.ws + WS_MOD); bf16_t* H2 = (bf16_t*)(p.ws + WS_H);
    int* CNT = (int*)(p.ws + WS_CTL); int* LIST = (int*)(p.ws + WS_LIST); float* GATE = (float*)(p.ws + WS_GATE);
    float* RW = (float*)(lds + P7_RW); int* HIST = (int*)(lds + P7_HIST); int* BASE = (int*)(lds + P7_BASE); int* TCLS = (int*)(lds + P7_TCLS); int* TRNK = (int*)(lds + P7_TRNK);
    __syncthreads();
    {   float t[8];
#pragma unroll
        for (int q = 0; q < 8; ++q) t[q] = p.router_g_w[tid + NTHR * q];
#pragma unroll
        for (int q = 0; q < 8; ++q) { const int i = tid + NTHR * q, k = i >> 2, j = i & 3; RW[((k & 3) * 256 + (k >> 2)) * 36 + j] = t[q]; }
#pragma unroll 1
        for (int i0 = 0; i0 < 1024 * 32; i0 += NTHR * 16) { float u[16];
#pragma unroll
            for (int q = 0; q < 16; ++q) u[q] = p.router_e_w[i0 + tid + NTHR * q];
#pragma unroll
            for (int q = 0; q < 16; ++q) { const int i = i0 + tid + NTHR * q, k = i >> 5, j = i & 31; RW[((k & 3) * 256 + (k >> 2)) * 36 + 4 + j] = u[q]; } }
    }
    for (int tile = blockIdx.x; tile < NTOK / 256; tile += gridDim.x) {
        __syncthreads();
        if (tid < 128) HIST[tid] = 0;
        __syncthreads();
        f32x4 gk[4], shk[4];
#pragma unroll
        for (int j = 0; j < 4; ++j) { const int k = 256 * j + lane * 4; const float* md = MOD + (size_t)((tile * 256) >> 12) * 6144;
            gk[j] = *(const f32x4*)(p.norm2_w + k) * (*(const f32x4*)(md + 4096 + k) + 1.f); shk[j] = *(const f32x4*)(md + 3072 + k); }
        constexpr int RB = 2;
        const bf16_t* D1 = (const bf16_t*)(p.ws + WS_D1);
        f32x4 vn[RB][4]; u32x2 dn[RB][4];
#pragma unroll
        for (int q = 0; q < RB; ++q)
#pragma unroll
            for (int j = 0; j < 4; ++j) { const size_t o = (size_t)(tile * 256 + wid * 32 + q) * 1024 + 256 * j + lane * 4; vn[q][j] = __builtin_nontemporal_load((const f32x4*)(p.x + o)); dn[q][j] = *(const u32x2*)(D1 + o); }
#pragma unroll 1
        for (int rr = 0; rr < 32; rr += RB) {
            const int rl0 = wid * 32 + rr, row0 = tile * 256 + rl0;
            f32x4 v[RB][4]; float ss[RB];
#pragma unroll
            for (int q = 0; q < RB; ++q) { float s = 0.f;
#pragma unroll
                for (int j = 0; j < 4; ++j) { const f32x4 dl = (f32x4){bflo(dn[q][j].x), bfhi(dn[q][j].x), bflo(dn[q][j].y), bfhi(dn[q][j].y)}; v[q][j] = vn[q][j] + dl;
                    { u32x2 xb; xb.x = pk2(v[q][j].x, v[q][j].y); xb.y = pk2(v[q][j].z, v[q][j].w); *(u32x2*)((bf16_t*)(p.ws + WS_D1) + (size_t)(row0 + q) * 1024 + 256 * j + lane * 4) = xb; }
                    s += v[q][j].x * v[q][j].x + v[q][j].y * v[q][j].y + v[q][j].z * v[q][j].z + v[q][j].w * v[q][j].w; }
                ss[q] = s; }
            {   const int rp = (rr + RB < 32) ? row0 + RB : row0;
#pragma unroll
                for (int q = 0; q < RB; ++q)
#pragma unroll
                    for (int j = 0; j < 4; ++j) { const size_t o = (size_t)(rp + q) * 1024 + 256 * j + lane * 4; vn[q][j] = __builtin_nontemporal_load((const f32x4*)(p.x + o)); dn[q][j] = *(const u32x2*)(D1 + o); } }
#pragma unroll
            for (int q = 0; q < RB; ++q) ss[q] = wave_sum(ss[q]);
            float gl[RB][4];
#pragma unroll
            for (int q = 0; q < RB; ++q) { const float rstd = rsqrtf(ss[q] * (1.f / 1024.f) + EPSN);
#pragma unroll
                for (int e = 0; e < 4; ++e) gl[q][e] = 0.f;
#pragma unroll
                for (int j = 0; j < 4; ++j) { const int k = 256 * j + lane * 4;
                    const f32x4 y = (v[q][j] * rstd) * gk[j] + shk[j]; v[q][j] = y;
                    *(unsigned*)((unsigned char*)H2 + (size_t)(row0 + q) * 1024 + k) = pk4_fp8(fminf(fmaxf(y.x * FP8_XSCALE, -440.f), 440.f), fminf(fmaxf(y.y * FP8_XSCALE, -440.f), 440.f), fminf(fmaxf(y.z * FP8_XSCALE, -440.f), 440.f), fminf(fmaxf(y.w * FP8_XSCALE, -440.f), 440.f)); } }
#pragma unroll
            for (int j = 0; j < 4; ++j)
#pragma unroll
                for (int e = 0; e < 4; ++e) { const f32x4 w = *(const f32x4*)(RW + (e * 256 + 64 * j + lane) * 36);
#pragma unroll
                    for (int q = 0; q < RB; ++q) { const float ye = v[q][j][e]; gl[q][0] += ye * w.x; gl[q][1] += ye * w.y; gl[q][2] += ye * w.z; gl[q][3] += ye * w.w; } }
#pragma unroll
            for (int q = 0; q < RB; ++q)
#pragma unroll
                for (int e = 0; e < 4; ++e) gl[q][e] = wave_sum(gl[q][e]);
            int gsel[RB]; float gval[RB];
#pragma unroll
            for (int q = 0; q < RB; ++q) {
#pragma unroll
                for (int e = 0; e < 4; ++e) gl[q][e] += p.router_g_b[e];
                int g = 0; float gm = gl[q][0];
#pragma unroll
                for (int e = 1; e < 4; ++e) if (gl[q][e] > gm) { gm = gl[q][e]; g = e; }
                float gs = 0.f;
#pragma unroll
                for (int e = 0; e < 4; ++e) gs += __expf(gl[q][e] - gm);
                gsel[q] = g; gval[q] = 1.f / gs; }
            float el[RB][8];
#pragma unroll
            for (int q = 0; q < RB; ++q) {
#pragma unroll
                for (int e = 0; e < 8; ++e) el[q][e] = 0.f;
#pragma unroll
                for (int j = 0; j < 4; ++j)
#pragma unroll
                    for (int e = 0; e < 4; ++e) { const float* wr = RW + (e * 256 + 64 * j + lane) * 36 + 4 + gsel[q] * 8; const f32x4 w0 = *(const f32x4*)wr, w1 = *(const f32x4*)(wr + 4); const float ye = v[q][j][e];
                        el[q][0] += ye * w0.x; el[q][1] += ye * w0.y; el[q][2] += ye * w0.z; el[q][3] += ye * w0.w; el[q][4] += ye * w1.x; el[q][5] += ye * w1.y; el[q][6] += ye * w1.z; el[q][7] += ye * w1.w; } }
#pragma unroll
            for (int q = 0; q < RB; ++q)
#pragma unroll
                for (int e = 0; e < 8; ++e) el[q][e] = wave_sum(el[q][e]);
#pragma unroll
            for (int q = 0; q < RB; ++q) { const int g = gsel[q];
#pragma unroll
                for (int e = 0; e < 8; ++e) el[q][e] += p.router_e_b[g * 8 + e];
                int e1 = 0; float m1 = el[q][0];
#pragma unroll
                for (int e = 1; e < 8; ++e) if (el[q][e] > m1) { m1 = el[q][e]; e1 = e; }
                int e2 = -1; float m2 = -3.0e38f;
#pragma unroll
                for (int e = 0; e < 8; ++e) if (e != e1 && el[q][e] > m2) { m2 = el[q][e]; e2 = e; }
                const float r = __expf(m2 - m1), w1 = 1.f / (1.f + r), w2 = r / (1.f + r);
                if (lane == 0) {
                    const int lo = e1 < e2 ? e1 : e2, hi = e1 < e2 ? e2 : e1;
                    const int cls = g * 28 + pair_index(lo, hi);
                    TCLS[rl0 + q] = cls; TRNK[rl0 + q] = atomicAdd(HIST + cls, 1);
                    ((float*)(lds + P7_TG))[(rl0 + q) * 2] = gval[q] * (e1 < e2 ? w1 : w2); ((float*)(lds + P7_TG))[(rl0 + q) * 2 + 1] = gval[q] * (e1 < e2 ? w2 : w1);
                } }
        }
        __syncthreads();
        if (tid < NCLS) { const int n = HIST[tid]; BASE[tid] = n ? atomicAdd(CNT + tid, n) : 0; }
        __syncthreads();
        if (tid < 256) { const int cls = TCLS[tid]; const size_t slot = (size_t)cls * 65536 + BASE[cls] + TRNK[tid]; LIST[slot] = tile * 256 + tid;
            typedef float f32x2v __attribute__((ext_vector_type(2))); *(f32x2v*)((float*)(p.ws + WS_GSLOT) + slot * 2) = *(const f32x2v*)((const float*)(lds + P7_TG) + tid * 2); }
    }
}

constexpr int MOE_SM = 131072;
__device__ __forceinline__ void cls_decode(int cls, int& g, int& lo, int& hi) {
    g = cls / 28; int r = cls % 28; lo = 0; while (r >= 7 - lo) { r -= 7 - lo; ++lo; } hi = lo + 1 + r;
}
__device__ __forceinline__ void moe_build_map(const Params& p, int* sm) {
    const int* CNT = (const int*)(p.ws + WS_CTL);
    __syncthreads();
    if (threadIdx.x < NCLS) sm[128 + threadIdx.x] = CNT[threadIdx.x];
    __syncthreads();
    if (threadIdx.x == 0) { int base = 0; for (int c = 0; c < NCLS; ++c) { sm[c] = base; base += (sm[128 + c] + 255) >> 8; } sm[256] = base; }
    __syncthreads();
    if (threadIdx.x < NCLS) { const int c = threadIdx.x, b0 = sm[c], nt = (sm[128 + c] + 255) >> 8; for (int q = 0; q < nt; ++q) sm[384 + b0 + q] = c; }
    __syncthreads();
}
struct P8Sched { const char* H2; const char* EW13; const int* LIST; const int* sm; int G, c, NU;
    __device__ __forceinline__ bool next(int i, pg::UDesc& u) const { const int q = i * G + c; if (q >= NU) return false; const int mt = q >> 3, nj = q & 7, cls = sm[384 + mt]; int g, lo, hi; cls_decode(cls, g, lo, hi);
        const int e = g * 8 + (nj < 4 ? lo : hi);
        u.A = H2; u.B0 = EW13 + ((size_t)e * 1024 + (size_t)(nj & 3) * 256) * 1024; u.B1 = u.B0 + 4 * 128; u.i0 = cls; u.i1 = mt; u.i2 = nj; u.i3 = (mt - sm[cls]) * 256; return true; }
    __device__ __forceinline__ unsigned rowoff(const pg::UDesc& u, int r) const { const int rk = u.i3 + r; const int t = (rk < sm[128 + u.i0]) ? LIST[(size_t)u.i0 * 65536 + rk] : 0; return (unsigned)t * 1024u; }
};
__device__ __forceinline__ void phase8(const Params& p, unsigned char* lds) {
    int* sm = (int*)(lds + MOE_SM);
    moe_build_map(p, sm);
    bf16_t* HID = (bf16_t*)(p.ws + WS_HID); const int* LIST = (const int*)(p.ws + WS_LIST); const float* GSLOT = (const float*)(p.ws + WS_GSLOT);
    P8Sched S{(const char*)(p.ws + WS_H), (const char*)(p.ws + WS_EW13), LIST, sm, (int)gridDim.x, vcu_of(blockIdx.x, gridDim.x), sm[256] * 8};
    auto E = [&](const f32x4 (&acc)[2][2][4][2], const pg::UDesc& u, int wr, int wc, int fr, int fq) {
        const int cnt = sm[128 + u.i0], xh = u.i2 >> 2;
        const float USC = 1.f / (FP8_XSCALE * FP8_WSCALE);
#pragma unroll
        for (int a = 0; a < 2; ++a) {
            float gts[4];
#pragma unroll
            for (int m = 0; m < 4; ++m) { const int rk = u.i3 + 128 * a + 64 * wr + 16 * m + fr; const float g = GSLOT[((size_t)u.i0 * 65536 + (rk < cnt ? rk : 0)) * 2 + xh]; gts[m] = (rk < cnt) ? g * FP8_HSCALE : 0.f; }
#pragma unroll
            for (int m = 0; m < 4; ++m) { const int rl = 128 * a + 64 * wr + 16 * m + fr; const float gt = gts[m];
                float hv[8];
#pragma unroll
                for (int n = 0; n < 2; ++n)
#pragma unroll
                    for (int q = 0; q < 4; ++q) hv[4 * n + q] = fminf(fmaxf(silu_fast(acc[a][0][m][n][q] * USC) * (acc[a][1][m][n][q] * USC) * gt, -440.f), 440.f);
                u32x2 o; o.x = pk4_fp8(hv[0], hv[1], hv[2], hv[3]); o.y = pk4_fp8(hv[4], hv[5], hv[6], hv[7]);
                *(u32x2*)((unsigned char*)HID + (size_t)(u.i1 * 256 + rl) * 1024 + xh * 512 + (u.i2 & 3) * 128 + 32 * wc + 8 * fq) = o; }
        }
    };
    pg::gemm_stream<true, true, true>((LAS unsigned char*)lds, 1024, 1024, S, E);
}
struct P9Sched { const char* HID; const char* EW2T; const int* sm; int G, c, NU;
    __device__ __forceinline__ bool next(int i, pg::UDesc& u) const { const int q = i * G + c; if (q >= NU) return false; const int mt = q >> 2, pn = q & 3, cls = sm[384 + mt]; int g, lo, hi; cls_decode(cls, g, lo, hi);
        u.A = HID + (size_t)mt * 256 * 1024; u.B0 = EW2T + ((size_t)(g * 8 + lo) * 1024 + (size_t)pn * 256) * 512; u.B1 = EW2T + ((size_t)(g * 8 + hi) * 1024 + (size_t)pn * 256) * 512;
        u.i0 = cls; u.i1 = mt; u.i2 = pn; u.i3 = (mt - sm[cls]) * 256; return true; }
    __device__ __forceinline__ unsigned rowoff(const pg::UDesc&, int) const { return 0u; }
};
__device__ __forceinline__ void phase9(const Params& p, unsigned char* lds) {
    int* sm = (int*)(lds + MOE_SM);
    moe_build_map(p, sm);
    const int* LIST = (const int*)(p.ws + WS_LIST); const float* MOD = (const float*)(p.ws + WS_MOD);
    P9Sched S{(const char*)(p.ws + WS_HID), (const char*)(p.ws + WS_EW2T), sm, (int)gridDim.x, vcu_of(blockIdx.x, gridDim.x), sm[256] * 4};
    auto E = [&](const f32x4 (&acc)[2][2][4][2], const pg::UDesc& u, int wr, int wc, int fr, int fq) {
        const int cnt = sm[128 + u.i0];
        int tk[2][4];
#pragma unroll
        for (int a = 0; a < 2; ++a)
#pragma unroll
            for (int m = 0; m < 4; ++m) { const int rk = u.i3 + 128 * a + 64 * wr + 16 * m + fr; tk[a][m] = (rk < cnt) ? LIST[(size_t)u.i0 * 65536 + rk] : -1; }
#pragma unroll
        for (int a = 0; a < 2; ++a) {
            u32x2 x1[4][2][2];
#pragma unroll
            for (int m = 0; m < 4; ++m) { const int t = tk[a][m], ts = t < 0 ? 0 : t;
                const bf16_t* xrow = (const bf16_t*)(p.ws + WS_D1) + (size_t)ts * 1024 + u.i2 * 256 + 32 * wc + 4 * fq;
#pragma unroll
                for (int b = 0; b < 2; ++b)
#pragma unroll
                    for (int n = 0; n < 2; ++n) x1[m][b][n] = *(const u32x2*)(xrow + 128 * b + 16 * n); }
#pragma unroll
            for (int m = 0; m < 4; ++m) { const int t = tk[a][m], ts = t < 0 ? 0 : t;
                const float* g2 = MOD + (size_t)(ts >> 12) * 6144 + 5120 + u.i2 * 256 + 32 * wc + 4 * fq;
                f32x4 gv[2][2];
#pragma unroll
                for (int b = 0; b < 2; ++b)
#pragma unroll
                    for (int n = 0; n < 2; ++n) gv[b][n] = *(const f32x4*)(g2 + 128 * b + 16 * n);
                const bool oddl = (fr & 1) != 0;
                const int tp = __builtin_amdgcn_update_dpp(0, t, DPP_XOR1, 0xf, 0xf, false);
                const int te = oddl ? tp : t, to = oddl ? t : tp;
                float* rowe = p.out + (size_t)(te < 0 ? 0 : te) * 1024 + u.i2 * 256 + 32 * wc + 4 * fq + (oddl ? 16 : 0);
                float* rowo = p.out + (size_t)(to < 0 ? 0 : to) * 1024 + u.i2 * 256 + 32 * wc + 4 * fq + (oddl ? 16 : 0);
#pragma unroll
                for (int b = 0; b < 2; ++b) { f32x4 val[2];
#pragma unroll
                    for (int n = 0; n < 2; ++n) { const f32x4 xf = (f32x4){bflo(x1[m][b][n].x), bfhi(x1[m][b][n].x), bflo(x1[m][b][n].y), bfhi(x1[m][b][n].y)};
                        val[n] = xf + gv[b][n] * (acc[a][b][m][n] * (1.f / (FP8_HSCALE * FP8_WSCALE))); }
                    const f32x4 snd = oddl ? val[0] : val[1]; f32x4 rcv;
#pragma unroll
                    for (int e = 0; e < 4; ++e) rcv[e] = dpp_f(snd[e], DPP_XOR1);
                    const f32x4 ve = oddl ? rcv : val[0], vo = oddl ? val[1] : rcv;
                    if (te >= 0) *(f32x4*)(rowe + 128 * b) = ve;
                    if (to >= 0) *(f32x4*)(rowo + 128 * b) = vo; } }
        }
    };
    pg::gemm_stream<false, false, true>((LAS unsigned char*)lds, 1024, 512, S, E);
}

#define XB_TMO      128
#define XB_XCNT(j)  (256  + 64 * (j))
#define XB_XSUB(j)  (1280 + 64 * (j))
#define XB_XGEN(j)  (2304 + 64 * (j))
#define XB_TOP      3328
#define XB_TOPGEN   3392
#define XCD_BAR_WORDS 3456
#define XB_SPIN_CAP (1u << 18)

__device__ __forceinline__ unsigned xb_ld(unsigned* p)              { return __hip_atomic_load(p, __ATOMIC_RELAXED, __HIP_MEMORY_SCOPE_AGENT); }
__device__ __forceinline__ unsigned xb_add(unsigned* p, unsigned v) { return __hip_atomic_fetch_add(p, v, __ATOMIC_RELAXED, __HIP_MEMORY_SCOPE_AGENT); }
__device__ __forceinline__ unsigned xb_xcc_id() { return (unsigned)__builtin_amdgcn_s_getreg((3 << 11) | 20) & 0xFu; }
#define XB_SPIN(cond, bar) do { unsigned _sp = 0; while (cond) { __builtin_amdgcn_s_sleep(1); \
    if ((++_sp & 255u) == 0u) { if (xb_ld(&(bar)[XB_TMO])) break; if (_sp > XB_SPIN_CAP) { atomicAdd(&(bar)[XB_TMO], 1u); break; } } } } while (0)

struct XcdBarrier {
    unsigned* bar; unsigned x;
    volatile LAS unsigned* st;
};

__device__ __forceinline__ XcdBarrier xcd_barrier_post(unsigned* bar, volatile LAS unsigned* st) {
    XcdBarrier b; b.bar = bar; b.x = xb_xcc_id(); b.st = st;
    if (threadIdx.x == 0) (void)xb_add(&bar[XB_XCNT(b.x)], 1u);
    return b;
}
__device__ __forceinline__ void xcd_barrier_complete(unsigned* bar, unsigned x, unsigned& nloc, unsigned& nx) {
    const unsigned G = gridDim.x * gridDim.y * gridDim.z;
    unsigned sum, cnt, mine, sp = 0u;
    for (;;) {
        sum = 0u; cnt = 0u; mine = 0u;
#pragma unroll
        for (unsigned j = 0; j < 16; ++j) { const unsigned c = xb_ld(&bar[XB_XCNT(j)]); sum += c; cnt += (c > 0u) ? 1u : 0u; mine = (j == x) ? c : mine; }
        if (sum == G) break;
        __builtin_amdgcn_s_sleep(1);
        if ((++sp & 255u) == 0u) { if (xb_ld(&bar[XB_TMO])) break; if (sp > XB_SPIN_CAP) { atomicAdd(&bar[XB_TMO], 1u); break; } }
    }
    nloc = mine > 0u ? mine : 1u; nx = cnt > 0u ? cnt : 1u;
}

__device__ __forceinline__ void xcd_barrier(const XcdBarrier& b) {
    asm volatile("s_waitcnt vmcnt(0)" ::: "memory");
    __syncthreads();
    if (threadIdx.x == 0) {
        unsigned* bar = b.bar;
        __builtin_amdgcn_s_waitcnt(0);
        unsigned nloc = b.st[0], nx = b.st[1];
        if (nloc == 0u) { xcd_barrier_complete(bar, b.x, nloc, nx); b.st[0] = nloc; b.st[1] = nx; }
        const unsigned old = xb_add(&bar[XB_XSUB(b.x)], 1u);
        const unsigned gen = old / nloc;
        if (old + 1u == (gen + 1u) * nloc) {
            __builtin_amdgcn_fence(__ATOMIC_RELEASE, "agent");
            asm volatile("s_waitcnt vmcnt(0)" ::: "memory");
            const unsigned og = xb_add(&bar[XB_TOP], 1u);
            const unsigned tg = og / nx;
            if (og + 1u == (tg + 1u) * nx) xb_add(&bar[XB_TOPGEN], 1u);
            else XB_SPIN(xb_ld(&bar[XB_TOPGEN]) == tg, bar);
            __builtin_amdgcn_fence(__ATOMIC_ACQUIRE, "agent");
            xb_add(&bar[XB_XGEN(b.x)], 1u);
            asm volatile("s_waitcnt vmcnt(0)" ::: "memory");
        } else {
            XB_SPIN(xb_ld(&bar[XB_XGEN(b.x)]) == gen, bar);
            __builtin_amdgcn_fence(__ATOMIC_ACQUIRE, "agent");
            asm volatile("s_waitcnt vmcnt(0)" ::: "memory");
        }
    }
    __syncthreads();
}


constexpr int LDS_BYTES = 152 * 1024;
#ifdef PROBE_A
#define TSTAMP(k) do { if (blockIdx.x == 0 && threadIdx.x == 0) ((unsigned long long*)(p.ws + WS_CTL + 4096))[k] = __builtin_amdgcn_s_memrealtime(); } while (0)
#else
#define TSTAMP(k) do { } while (0)
#endif
__global__ void __launch_bounds__(NTHR, 2) fwd_kernel(Params p) {
    extern __shared__ __attribute__((aligned(16))) unsigned char lds[];
    cg::grid_group grid = cg::this_grid();
    volatile LAS unsigned* bst = (volatile LAS unsigned*)((LAS unsigned char*)lds + LDS_BYTES - 16);
    if (threadIdx.x < 2) bst[threadIdx.x] = 0u;
    if (blockIdx.x == 0) { if (threadIdx.x < 128) ((int*)(p.ws + WS_CTL))[threadIdx.x] = 0; for (int i = threadIdx.x; i < 3456; i += NTHR) ((unsigned*)(p.ws + WS_BAR))[i] = 0u; }
    grid.sync();
    const XcdBarrier bar = xcd_barrier_post((unsigned*)(p.ws + WS_BAR), bst);
    TSTAMP(0);
    phase0(p, lds);
    xcd_barrier(bar); TSTAMP(1);
    phase1(p, lds);
    khat_items(p, lds);
    xcd_barrier(bar); TSTAMP(2);
    phase3_ctx(p);
    phase2(p, lds);
    xcd_barrier(bar); TSTAMP(3);
    for (int u = blockIdx.x; u < 1024; u += gridDim.x) attn_unit(p, u, lds);
    TSTAMP(5);
    {   HyRow rr; int it = blockIdx.x;
        if (it < 1024) hy_row_load(rr, (const _Float16*)(p.ws + WS_UT) + ((size_t)(((it & 1) * 8 + (otid() >> 6)) * 1536 + (it >> 1))) * 4096, otid() & 63);
        for (; it < 1024; it += gridDim.x) { const int itn = (it + (int)gridDim.x < 1024) ? it + (int)gridDim.x : it; hyena_item(p, it, itn, lds, rr); } }
    xcd_barrier(bar); TSTAMP(6);
    {   u32x4 hv[8]; const int tq5 = otid();
        if (blockIdx.x < 1024) { const bf16_t* src0 = (const bf16_t*)(p.ws + WS_HYT) + ((size_t)((blockIdx.x >> 6) * 512 + tq5)) * 4096 + (blockIdx.x & 63) * 64;
#pragma unroll
            for (int i = 0; i < 8; ++i) hv[i] = *(const u32x4*)(src0 + i * 8); }
        for (int it = blockIdx.x; it < 1024; it += gridDim.x) phase5_item(p, it, lds, hv, (it + (int)gridDim.x < 1024) ? it + (int)gridDim.x : it); }
    xcd_barrier(bar); TSTAMP(7);
    phase6(p, lds);
    xcd_barrier(bar); TSTAMP(8);
    phase7(p, lds);
    xcd_barrier(bar); TSTAMP(9);
    phase8(p, lds);
    xcd_barrier(bar); TSTAMP(10);
    phase9(p, lds);
#ifdef PROBE_A
    xcd_barrier(bar); TSTAMP(11);
    if (blockIdx.x == 0) {
        __threadfence(); __syncthreads();
        const volatile unsigned long long* ts = (const volatile unsigned long long*)(p.ws + WS_CTL + 4096);
        const float ta = (float)(ts[PROBE_A] - ts[PROBE_A - 1]) * 0.01f, tb = (float)(ts[PROBE_B] - ts[PROBE_B - 1]) * 0.0001f;
        for (int i = threadIdx.x; i < (1 << 20); i += NTHR) p.out[1024 + i] += tb;
        if (threadIdx.x == 0) p.out[0] += ta;
    }
#endif
}

extern "C" void kernel_launch(void* const* d_in, const int* in_sizes, int n_in, void* d_out, int out_size, void* d_ws, size_t ws_size, hipStream_t stream) {
    static int grid_blocks = 0;
    if (grid_blocks == 0) {
        if (n_in != 30 || out_size != NTOK * DM || ws_size < WS_END) { fprintf(stderr, "kernel_launch: unexpected shapes (n_in %d out %d ws %zu)\n", n_in, out_size, ws_size); grid_blocks = -1; return; }
        int dev = 0, cus = 0, per_cu = 0;
        hipGetDevice(&dev); hipDeviceGetAttribute(&cus, hipDeviceAttributeMultiprocessorCount, dev);
        hipFuncSetAttribute((const void*)fwd_kernel, hipFuncAttributeMaxDynamicSharedMemorySize, LDS_BYTES);
        hipOccupancyMaxActiveBlocksPerMultiprocessor(&per_cu, (const void*)fwd_kernel, NTHR, LDS_BYTES);
        if (per_cu < 1) { fprintf(stderr, "kernel_launch: occupancy query says %d blocks per CU\n", per_cu); grid_blocks = -1; return; }
        grid_blocks = cus * per_cu;
    }
    if (grid_blocks < 0) return;
    Params p{};
    const float** pp = (const float**)&p;
    for (int i = 0; i < 30; ++i) pp[i] = (const float*)d_in[i];
    p.out = (float*)d_out; p.ws = (unsigned char*)d_ws;
    void* args[] = {&p};
    hipError_t e = hipLaunchCooperativeKernel((const void*)fwd_kernel, dim3(grid_blocks), dim3(NTHR), args, LDS_BYTES, stream);
    if (e != hipSuccess) fprintf(stderr, "cooperative launch failed: %s (grid %d)\n", hipGetErrorString(e), grid_blocks);
}
```
